# Optimizing an MI355X kernel written in HIP

```python
import math
import jax, jax.numpy as jnp
from jax import lax
import numpy as np

D_MODEL = 1024
BATCH = 8
SEQ = 2048
DEPTH = 4

CHUNK = 64
Q_BLOCK = 128
N_BRANCH = 3
MIX_WIDTH = D_MODEL // 2

N_HEADS_A = 4
HEAD_DIM_A = MIX_WIDTH // (2 * N_HEADS_A)
LAMBDA_INIT_BASE = 0.8
LAMBDA_INIT_SCALE = 0.6
LAMBDA_INIT_DECAY = 0.3
N_REL_BUCKETS = 32
REL_MAX_DIST = 128

SGU_CHUNK = 128
SGU_GROUPS = 4
SGU_WIDTH = MIX_WIDTH
SGU_GROUP_CH = SGU_WIDTH // SGU_GROUPS

N_HEADS_C = 8
Q_LORA = D_MODEL // 4
KV_LORA = D_MODEL // 8
NOPE_DIM = 64
ROPE_DIM = 32
V_DIM_C = MIX_WIDTH // N_HEADS_C
ROPE_THETA = 10000.0

N_GROUPS = 4
EXPERTS_PER_GROUP = 8
TOP_K_IN_GROUP = 2
D_FF_EXPERT = D_MODEL // 4

EPS = 1e-6
NEG_INF = -1e30
MAX_POS_OFFSET = 8192

IN_SIZES = (N_HEADS_A * 2 * HEAD_DIM_A,
            N_HEADS_A * 2 * HEAD_DIM_A,
            N_HEADS_A * 2 * HEAD_DIM_A,
            2 * SGU_WIDTH,
            Q_LORA,
            KV_LORA,
            ROPE_DIM,
            N_BRANCH * D_MODEL)
IN_WIDTH = sum(IN_SIZES)
IN_SPLITS = tuple(int(v) for v in np.cumsum(IN_SIZES)[:-1])

kernel_name = "hybrid_chunk_causal_diffattn_sgu_mla_hmoe"


def rms_norm(x, g):
    xf = x.astype(jnp.float32)
    y = xf * lax.rsqrt(jnp.mean(xf * xf, axis=-1, keepdims=True) + EPS)
    return (y * g.astype(jnp.float32)).astype(x.dtype)


def chunk_mask(q_start, kv_len):
    q_chunk = (q_start + jnp.arange(Q_BLOCK)) // CHUNK
    k_chunk = jnp.arange(kv_len) // CHUNK
    return k_chunk[None, :] <= q_chunk[:, None]


def t5_bucket(rel):
    nb = N_REL_BUCKETS // 2
    max_exact = nb // 2
    n = jnp.abs(rel)
    large = max_exact + (jnp.log(jnp.maximum(n, 1).astype(jnp.float32) / max_exact)
                         / math.log(REL_MAX_DIST / max_exact) * (nb - max_exact)).astype(jnp.int32)
    large = jnp.minimum(large, nb - 1)
    return jnp.where(rel > 0, nb, 0) + jnp.where(n < max_exact, n, large)


def rel_bias_block(table, q_start, kv_len):
    rel = jnp.arange(kv_len)[None, :] - (q_start + jnp.arange(Q_BLOCK))[:, None]
    return jnp.transpose(table[t5_bucket(rel)], (2, 0, 1)).astype(jnp.float32)


def masked_softmax(scores, mask):
    return jax.nn.softmax(jnp.where(mask, scores, NEG_INF), axis=-1)


def block_sweep(fn, seq_len):
    return jnp.concatenate([fn(start, start + Q_BLOCK) for start in range(0, seq_len, Q_BLOCK)], axis=1)


def apply_rope(x, cos, sin):
    half = x.shape[-1] // 2
    x1, x2 = x[..., :half], x[..., half:]
    return jnp.concatenate([x1 * cos - x2 * sin, x2 * cos + x1 * sin], axis=-1)


def differential_attention(q, k, v, lam, lambda_init, out_g, rel_table):
    b, s = q.shape[:2]
    scale = HEAD_DIM_A ** -0.5

    def block(start, end):
        sc = jnp.einsum('bqhmd,bkhmd->bmhqk', q[:, start:end], k[:, :end]).astype(jnp.float32) * scale
        sc = sc + rel_bias_block(rel_table, start, end)
        p = masked_softmax(sc, chunk_mask(start, end))
        attn = p[:, 0] - lam * p[:, 1]
        return jnp.einsum('bhqk,bkhe->bqhe', attn.astype(v.dtype), v[:, :end])

    o = block_sweep(block, s)
    o = rms_norm(o, out_g) * (1.0 - lambda_init)
    return o.reshape(b, s, N_HEADS_A * 2 * HEAD_DIM_A)


def spatial_gating(z, v_g, w_s, b_s):
    b, s = z.shape[:2]
    z = jax.nn.gelu(z)
    u, v = jnp.split(z, 2, axis=-1)
    v = rms_norm(v, v_g).reshape(b, s // SGU_CHUNK, SGU_CHUNK, SGU_GROUPS, SGU_GROUP_CH)
    pos_chunk = jnp.arange(SGU_CHUNK) // CHUNK
    allowed = pos_chunk[None, :] <= pos_chunk[:, None]
    w = jnp.where(allowed[None], w_s, 0)
    vs = jnp.einsum('gij,bnjgc->bnigc', w, v) + jnp.transpose(b_s)[:, :, None]
    return u * vs.reshape(b, s, SGU_WIDTH)


def latent_attention(xq, xkv, xr, cos, sin, lat_g, w_uq, w_ukv, qk_g):
    b, s = xq.shape[:2]
    cq = rms_norm(xq, lat_g[:Q_LORA])
    ckv = rms_norm(xkv, lat_g[Q_LORA:])
    q = (cq @ w_uq).reshape(b, s, N_HEADS_C, NOPE_DIM + ROPE_DIM)
    kv = (ckv @ w_ukv).reshape(b, s, N_HEADS_C, NOPE_DIM + V_DIM_C)
    q_nope = rms_norm(q[..., :NOPE_DIM], qk_g[0, :NOPE_DIM])
    q_rope = apply_rope(rms_norm(q[..., NOPE_DIM:], qk_g[0, NOPE_DIM:]), cos[:, :, None], sin[:, :, None])
    k_nope = rms_norm(kv[..., :NOPE_DIM], qk_g[1, :NOPE_DIM])
    v = kv[..., NOPE_DIM:]
    k_rope = apply_rope(rms_norm(xr, qk_g[1, NOPE_DIM:]), cos, sin)
    scale = (NOPE_DIM + ROPE_DIM) ** -0.5

    def block(start, end):
        sc = (jnp.einsum('bqhd,bkhd->bhqk', q_nope[:, start:end], k_nope[:, :end])
              + jnp.einsum('bqhr,bkr->bhqk', q_rope[:, start:end], k_rope[:, :end])).astype(jnp.float32) * scale
        p = masked_softmax(sc, chunk_mask(start, end))
        return jnp.einsum('bhqk,bkhe->bqhe', p.astype(v.dtype), v[:, :end])

    return block_sweep(block, s).reshape(b, s, N_HEADS_C * V_DIM_C)


def hierarchical_moe(h, wg, bg, we, be, w_gate, w_up, w_down):
    b, s, d = h.shape
    hf = h.reshape(-1, d)
    n = hf.shape[0]
    g_prob = jax.nn.softmax((hf @ wg + bg).astype(jnp.float32), axis=-1)
    g_w, g_idx = lax.top_k(g_prob, 1)
    g_onehot = jax.nn.one_hot(g_idx[:, 0], N_GROUPS, dtype=jnp.float32)
    e_logits = (hf @ we + be).astype(jnp.float32).reshape(n, N_GROUPS, EXPERTS_PER_GROUP)
    e_logits = jnp.einsum('nge,ng->ne', e_logits, g_onehot)
    e_w, e_idx = lax.top_k(jax.nn.softmax(e_logits, axis=-1), TOP_K_IN_GROUP)
    e_w = e_w / jnp.sum(e_w, axis=-1, keepdims=True)
    e_gate = jnp.sum(jax.nn.one_hot(e_idx, EXPERTS_PER_GROUP, dtype=jnp.float32) * e_w[..., None], axis=1)
    comb = (g_onehot[:, :, None] * (g_w * e_gate)[:, None, :]).astype(h.dtype)
    out = jnp.zeros_like(hf)
    for g in range(N_GROUPS):
        a = jnp.einsum('nd,edf->nef', hf, w_gate[g])
        u = jnp.einsum('nd,edf->nef', hf, w_up[g])
        act = jax.nn.silu(a) * u * comb[:, g, :, None]
        out = out + jnp.einsum('nef,efd->nd', act, w_down[g])
    return out.reshape(b, s, d)


def setup_inputs(seed: int = 0) -> dict:
    key = jax.random.key(seed)
    ks = jax.random.split(key, 32)
    f32 = jnp.float32

    def nrm(k, shape, scale):
        return jax.random.normal(k, shape, f32) * scale

    def gain(k, shape):
        return 1.0 + 0.02 * jax.random.normal(k, shape, f32)

    G, E, F, D = N_GROUPS, EXPERTS_PER_GROUP, D_FF_EXPERT, D_MODEL
    offset = jax.random.randint(ks[2], (BATCH, 1), 0, MAX_POS_OFFSET, dtype=jnp.int32)
    positions = (offset + jnp.arange(SEQ, dtype=jnp.int32)[None, :]).astype(jnp.int32)
    return {
        "x": nrm(ks[0], (BATCH, SEQ, D), 1.0),
        "c": nrm(ks[1], (BATCH, D), 1.0),
        "positions": positions,
        "w_ada": nrm(ks[3], (DEPTH, D, 6 * D), 0.3 * D ** -0.5),
        "b_ada": nrm(ks[4], (DEPTH, 6 * D), 0.01),
        "norm_g": gain(ks[5], (DEPTH, 2, D)),
        "w_in": nrm(ks[6], (DEPTH, D, IN_WIDTH), D ** -0.5),
        "diff_qk_g": gain(ks[7], (DEPTH, 2, HEAD_DIM_A)),
        "diff_lambda": nrm(ks[8], (DEPTH, 4, HEAD_DIM_A), 0.1),
        "diff_out_g": gain(ks[9], (DEPTH, 2 * HEAD_DIM_A)),
        "rel_bias": nrm(ks[10], (N_REL_BUCKETS, N_HEADS_A), 0.5),
        "sgu_v_g": gain(ks[11], (DEPTH, SGU_WIDTH)),
        "sgu_w": nrm(ks[12], (DEPTH, SGU_GROUPS, SGU_CHUNK, SGU_CHUNK), 0.5 * SGU_CHUNK ** -0.5),
        "sgu_b": 1.0 + nrm(ks[13], (DEPTH, SGU_GROUPS, SGU_CHUNK), 0.05),
        "mla_lat_g": gain(ks[14], (DEPTH, Q_LORA + KV_LORA)),
        "mla_w_uq": nrm(ks[15], (DEPTH, Q_LORA, N_HEADS_C * (NOPE_DIM + ROPE_DIM)), Q_LORA ** -0.5),
        "mla_w_ukv": nrm(ks[16], (DEPTH, KV_LORA, N_HEADS_C * (NOPE_DIM + V_DIM_C)), KV_LORA ** -0.5),
        "mla_qk_g": gain(ks[17], (DEPTH, 2, NOPE_DIM + ROPE_DIM)),
        "w_branch": nrm(ks[18], (DEPTH, N_BRANCH, MIX_WIDTH, D), MIX_WIDTH ** -0.5),
        "w_out": nrm(ks[19], (DEPTH, D, D), D ** -0.5),
        "router_g_w": nrm(ks[20], (DEPTH, D, G), D ** -0.5),
        "router_g_b": nrm(ks[21], (DEPTH, G), 0.01),
        "router_e_w": nrm(ks[22], (DEPTH, D, G * E), D ** -0.5),
        "router_e_b": nrm(ks[23], (DEPTH, G * E), 0.01),
        "w_e_gate": nrm(ks[24], (DEPTH, G, E, D, F), D ** -0.5),
        "w_e_up": nrm(ks[25], (DEPTH, G, E, D, F), D ** -0.5),
        "w_e_down": nrm(ks[26], (DEPTH, G, E, F, D), F ** -0.5),
    }


def reference(x, c, positions, w_ada, b_ada, norm_g, w_in, diff_qk_g, diff_lambda, diff_out_g, rel_bias,
              sgu_v_g, sgu_w, sgu_b, mla_lat_g, mla_w_uq, mla_w_ukv, mla_qk_g, w_branch, w_out,
              router_g_w, router_g_b, router_e_w, router_e_b, w_e_gate, w_e_up, w_e_down):
    b, s, d = x.shape
    inv_freq = ROPE_THETA ** (-jnp.arange(0, ROPE_DIM, 2, dtype=jnp.float32) / ROPE_DIM)
    ang = positions.astype(jnp.float32)[..., None] * inv_freq
    cos = jnp.cos(ang).astype(x.dtype)
    sin = jnp.sin(ang).astype(x.dtype)
    c_act = jax.nn.silu(c)

    for l in range(DEPTH):
        mod = c_act @ w_ada[l] + b_ada[l]
        shift1, scale1, gate1, shift2, scale2, gate2 = [m[:, None, :] for m in jnp.split(mod, 6, axis=-1)]

        h = rms_norm(x, norm_g[l, 0]) * (1 + scale1) + shift1
        xa_q, xa_k, xa_v, xb, xc_q, xc_kv, xc_r, xg = jnp.split(h @ w_in[l], IN_SPLITS, axis=-1)

        lambda_init = LAMBDA_INIT_BASE - LAMBDA_INIT_SCALE * math.exp(-LAMBDA_INIT_DECAY * l)
        dl = diff_lambda[l].astype(jnp.float32)
        lam = jnp.exp(jnp.sum(dl[0] * dl[1])) - jnp.exp(jnp.sum(dl[2] * dl[3])) + lambda_init
        qa = rms_norm(xa_q.reshape(b, s, N_HEADS_A, 2, HEAD_DIM_A), diff_qk_g[l, 0])
        ka = rms_norm(xa_k.reshape(b, s, N_HEADS_A, 2, HEAD_DIM_A), diff_qk_g[l, 1])
        va = xa_v.reshape(b, s, N_HEADS_A, 2 * HEAD_DIM_A)
        o_a = differential_attention(qa, ka, va, lam, lambda_init, diff_out_g[l], rel_bias)

        o_b = spatial_gating(xb, sgu_v_g[l], sgu_w[l], sgu_b[l])

        o_c = latent_attention(xc_q, xc_kv, xc_r, cos, sin, mla_lat_g[l], mla_w_uq[l], mla_w_ukv[l], mla_qk_g[l])

        branches = jnp.stack([o_a, o_b, o_c], axis=2)
        gates = jax.nn.sigmoid(xg.reshape(b, s, N_BRANCH, d))
        merged = jnp.einsum('bsnd,bsnd->bsd', gates, jnp.einsum('bsnw,nwd->bsnd', branches, w_branch[l]))
        x = x + gate1 * (merged @ w_out[l])

        h = rms_norm(x, norm_g[l, 1]) * (1 + scale2) + shift2
        x = x + gate2 * hierarchical_moe(h, router_g_w[l], router_g_b[l], router_e_w[l], router_e_b[l],
                                         w_e_gate[l], w_e_up[l], w_e_down[l])
    return x
```

```cpp
#include <hip/hip_runtime.h>
#include <cstdio>
#define NSUB 8
#define ABL 0
namespace nv {
typedef float f32x16 __attribute__((ext_vector_type(16)));
constexpr int B_ = 8, S_ = 2048, D_ = 1024, M_ = B_ * S_, L_ = 4, INW = 6048;

struct GP { const float* A; const float* B; float* C; int M, N, K, lda, ldb, ldc; const int* gather; const int* zcnt; const int* zoff; long strideB; };
__global__ void __launch_bounds__(256) gemm(GP p) {
    const int z = blockIdx.z; int M = p.M, roff = 0;
    if (p.zcnt) { M = p.zcnt[z]; roff = p.zoff[z]; }
    const int wave = threadIdx.x >> 6, lane = threadIdx.x & 63;
    const int m0 = blockIdx.y * 64 + (wave >> 1) * 32, n0 = blockIdx.x * 64 + (wave & 1) * 32;
    if (m0 >= M || n0 >= p.N) return;
    const int i = lane & 31, kk = lane >> 5;
    int mr = m0 + i; if (mr > M - 1) mr = M - 1;
    int arow = roff + mr; if (p.gather) arow = p.gather[arow];
    const float* Ap = p.A + (size_t)arow * p.lda + kk;
    int nc = n0 + i; if (nc > p.N - 1) nc = p.N - 1;
    const float* Bp = p.B + (size_t)z * p.strideB + (size_t)kk * p.ldb + nc;
    f32x16 acc = {0.f, 0.f, 0.f, 0.f, 0.f, 0.f, 0.f, 0.f, 0.f, 0.f, 0.f, 0.f, 0.f, 0.f, 0.f, 0.f};
    const int K = p.K; const size_t ldb = p.ldb;
#pragma unroll 8
    for (int k0 = 0; k0 < K; k0 += 2) { const float a = Ap[k0]; const float b = Bp[(size_t)k0 * ldb]; acc = __builtin_amdgcn_mfma_f32_32x32x2f32(a, b, acc, 0, 0, 0); }
#pragma unroll
    for (int r = 0; r < 16; ++r) { const int row = (r & 3) + 8 * (r >> 2) + 4 * (lane >> 5);
        if (m0 + row < M && n0 + i < p.N) p.C[(size_t)(roff + m0 + row) * p.ldc + n0 + i] = acc[r]; }
}
static void launch_gemm(hipStream_t st, const float* A, const float* Bm, float* C, int M, int N, int K, int lda, int ldb, int ldc,
                        const int* gather = nullptr, const int* zcnt = nullptr, const int* zoff = nullptr, long strideB = 0, int Z = 1, int Mmax = 0) {
    GP p{A, Bm, C, M, N, K, lda, ldb, ldc, gather, zcnt, zoff, strideB};
    const int mm = zcnt ? Mmax : M;
    dim3 grid((N + 63) / 64, (mm + 63) / 64, Z);
    gemm<<<grid, 256, 0, st>>>(p);
}

__device__ __forceinline__ float silu_f(float v) { return v / (1.f + expf(-v)); }
__device__ __forceinline__ float wsum(float v) {
#pragma unroll
    for (int o = 1; o < 64; o <<= 1) v += __shfl_xor(v, o);
    return v;
}
__global__ void mod_k(const float* c, const float* w_ada, const float* b_ada, float* mod) {
    const int idx = blockIdx.x * blockDim.x + threadIdx.x; if (idx >= L_ * 6 * D_) return;
    const int l = idx / (6 * D_), j = idx % (6 * D_);
    float acc[B_]; for (int b = 0; b < B_; ++b) acc[b] = 0.f;
    const float* w = w_ada + (size_t)l * D_ * 6 * D_ + j;
    for (int k = 0; k < D_; ++k) { const float wv = w[(size_t)k * 6 * D_];
#pragma unroll
        for (int b = 0; b < B_; ++b) acc[b] += silu_f(c[b * D_ + k]) * wv; }
    for (int b = 0; b < B_; ++b) mod[((size_t)l * B_ + b) * 6 * D_ + j] = acc[b] + b_ada[l * 6 * D_ + j];
}
__global__ void misc_k(const float* diff_lambda, const int* positions, const float* rel_bias, float* lam, float* cs, float* sn, float* biasT) {
    const int idx = blockIdx.x * blockDim.x + threadIdx.x;
    if (idx < L_) { const float* dl = diff_lambda + idx * 4 * 64; float s01 = 0.f, s23 = 0.f;
        for (int i = 0; i < 64; ++i) { s01 += dl[i] * dl[64 + i]; s23 += dl[128 + i] * dl[192 + i]; }
        const float li = 0.8f - 0.6f * expf(-0.3f * (float)idx);
        lam[idx] = expf(s01) - expf(s23) + li; }
    if (idx < M_ * 16) { const int m = idx / 16, i = idx % 16;
        const float inv_freq = powf(10000.f, -(float)(2 * i) / 32.f);
        const float ang = (float)positions[m] * inv_freq; cs[idx] = cosf(ang); sn[idx] = sinf(ang); }
    if (idx < 4 * 2111) { const int h = idx / 2111, rel = idx % 2111 - 2047; const int n = rel < 0 ? -rel : rel;
        int large = 8 + (int)(logf((float)(n > 1 ? n : 1) / 8.f) / 2.772588722239781f * 8.f); if (large > 15) large = 15;
        const int bucket = (rel > 0 ? 16 : 0) + (n < 8 ? n : large);
        biasT[idx] = rel_bias[bucket * 4 + h]; }
}
__global__ void normmod_k(const float* x, const float* g, const float* shift, const float* scale, float* h) {
    const int m = blockIdx.x * 4 + (threadIdx.x >> 6), lane = threadIdx.x & 63; const int b = m / S_;
    const float* xr = x + (size_t)m * D_; float v[16]; float s = 0.f;
#pragma unroll
    for (int i = 0; i < 16; ++i) { v[i] = xr[lane + 64 * i]; s += v[i] * v[i]; }
    const float rstd = rsqrtf(wsum(s) * (1.f / D_) + 1e-6f);
#pragma unroll
    for (int i = 0; i < 16; ++i) { const int d = lane + 64 * i; h[(size_t)m * D_ + d] = v[i] * rstd * g[d] * (1.f + scale[b * 6 * D_ + d]) + shift[b * 6 * D_ + d]; }
}
__global__ void grpnorm_k(const float* in, float* out, int rows, int ngrp, int width, int ld, int old_, const float* g, float mul) {
    const int idx = blockIdx.x * blockDim.x + threadIdx.x; if (idx >= rows * ngrp) return;
    const int r = idx / ngrp, gi = idx % ngrp; const float* p = in + (size_t)r * ld + gi * width; float* o = out + (size_t)r * old_ + gi * width;
    float s = 0.f; for (int i = 0; i < width; ++i) s += p[i] * p[i];
    const float rstd = rsqrtf(s / (float)width + 1e-6f);
    for (int i = 0; i < width; ++i) o[i] = p[i] * rstd * g[i] * mul;
}
struct AP { const float* Q; const float* K; const float* K2; const float* V; float* O; const float* biasT;
           int qld, qhs, kld, khs, k2ld, vld, vhs, vshift, old_, ohs, nhm; float scale; };
template <int DQK, int DK1, bool BIAS>
__global__ void __launch_bounds__(256) attn_k(AP p) {
    const int chunk = blockIdx.x, bh = blockIdx.y, b = bh / p.nhm, hm = bh % p.nhm;
    const int qi = threadIdx.x & 63, sl = __builtin_amdgcn_readfirstlane(threadIdx.x >> 6);
    const int qpos = chunk * 64 + qi; const size_t tok = (size_t)b * S_ + qpos;
    float q[DQK];
    const float* qp = p.Q + tok * p.qld + hm * p.qhs;
#pragma unroll
    for (int d = 0; d < DQK; ++d) q[d] = qp[d] * p.scale;
    float o[32]; for (int e = 0; e < 32; ++e) o[e] = 0.f;
    float mx = -1e30f, l = 0.f;
    const int nk = (chunk + 1) * 64; const int vh = hm >> p.vshift;
    const float* bt = BIAS ? p.biasT + (hm >> 1) * 2111 + 2047 - qpos : nullptr;
    for (int j = 0; j < nk; ++j) {
        const float* kp = p.K + ((size_t)b * S_ + j) * p.kld + hm * p.khs;
        float s = 0.f;
#pragma unroll
        for (int d = 0; d < DK1; ++d) s += q[d] * kp[d];
        if (DQK > DK1) { const float* k2 = p.K2 + ((size_t)b * S_ + j) * p.k2ld;
#pragma unroll
            for (int d = 0; d < DQK - DK1; ++d) s += q[DK1 + d] * k2[d]; }
        if (BIAS) s += bt[j];
        const float mn = fmaxf(mx, s), corr = expf(mx - mn), pe = expf(s - mn);
        l = l * corr + pe; mx = mn;
        const float* vp = p.V + ((size_t)b * S_ + j) * p.vld + vh * p.vhs + sl * 32;
#pragma unroll
        for (int e = 0; e < 32; ++e) o[e] = o[e] * corr + pe * vp[e];
    }
    const float il = 1.f / l; float* op = p.O + tok * p.old_ + hm * p.ohs + sl * 32;
#pragma unroll
    for (int e = 0; e < 32; ++e) op[e] = o[e] * il;
}
__global__ void diffcomb_k(const float* Oraw, const float* lam, int l, const float* g, float* oa) {
    const int idx = blockIdx.x * blockDim.x + threadIdx.x; if (idx >= M_ * 4) return;
    const int m = idx / 4, h = idx % 4; const float la = lam[l]; const float li = 0.8f - 0.6f * expf(-0.3f * (float)l);
    const float* o0 = Oraw + (size_t)m * 1024 + (h * 2) * 128; const float* o1 = o0 + 128; float s = 0.f;
    for (int e = 0; e < 128; ++e) { const float v = o0[e] - la * o1[e]; s += v * v; }
    const float rstd = rsqrtf(s / 128.f + 1e-6f);
    for (int e = 0; e < 128; ++e) oa[(size_t)m * 512 + h * 128 + e] = (o0[e] - la * o1[e]) * rstd * g[e] * (1.f - li);
}
__device__ __forceinline__ float gelu_t(float x) { return 0.5f * x * (1.f + tanhf(0.7978845608028654f * (x + 0.044715f * x * x * x))); }
__global__ void sgu_vn_k(const float* xb, int ld, const float* vg, float* vn) {
    const int m = blockIdx.x * 4 + (threadIdx.x >> 6), lane = threadIdx.x & 63; const float* p = xb + (size_t)m * ld + 512; float v[8]; float s = 0.f;
#pragma unroll
    for (int i = 0; i < 8; ++i) { v[i] = gelu_t(p[lane + 64 * i]); s += v[i] * v[i]; }
    const float rstd = rsqrtf(wsum(s) / 512.f + 1e-6f);
#pragma unroll
    for (int i = 0; i < 8; ++i) vn[(size_t)m * 512 + lane + 64 * i] = v[i] * rstd * vg[lane + 64 * i];
}
__global__ void sgu_k(const float* xb, int ld, const float* vn, const float* w, const float* bs, float* ob) {
    const int idx = blockIdx.x * blockDim.x + threadIdx.x; if (idx >= M_ * 512) return;
    const int m = idx / 512, ch = idx % 512, g = ch / 128, i = m % 128, m0 = m - i; const int jmax = (i / 64 + 1) * 64;
    float acc = 0.f; const float* wr = w + ((size_t)g * 128 + i) * 128;
    for (int j = 0; j < jmax; ++j) acc += wr[j] * vn[(size_t)(m0 + j) * 512 + ch];
    acc += bs[g * 128 + i];
    ob[idx] = gelu_t(xb[(size_t)m * ld + ch]) * acc;
}
__global__ void mla_q_k(float* q, const float* qkg, const float* cs, const float* sn) {
    const int idx = blockIdx.x * blockDim.x + threadIdx.x; if (idx >= M_ * 8) return;
    const int m = idx / 8; float* p = q + (size_t)idx * 96; float s = 0.f;
    for (int i = 0; i < 64; ++i) s += p[i] * p[i];
    float rstd = rsqrtf(s / 64.f + 1e-6f);
    for (int i = 0; i < 64; ++i) p[i] = p[i] * rstd * qkg[i];
    s = 0.f; for (int i = 0; i < 32; ++i) s += p[64 + i] * p[64 + i];
    rstd = rsqrtf(s / 32.f + 1e-6f); float r[32];
    for (int i = 0; i < 32; ++i) r[i] = p[64 + i] * rstd * qkg[64 + i];
    for (int i = 0; i < 16; ++i) { const float c = cs[m * 16 + i], sv = sn[m * 16 + i]; p[64 + i] = r[i] * c - r[16 + i] * sv; p[80 + i] = r[16 + i] * c + r[i] * sv; }
}
__global__ void mla_k_k(float* kv, const float* qkg1) {
    const int idx = blockIdx.x * blockDim.x + threadIdx.x; if (idx >= M_ * 8) return;
    float* p = kv + (size_t)idx * 128; float s = 0.f;
    for (int i = 0; i < 64; ++i) s += p[i] * p[i];
    const float rstd = rsqrtf(s / 64.f + 1e-6f);
    for (int i = 0; i < 64; ++i) p[i] = p[i] * rstd * qkg1[i];
}
__global__ void mla_kr_k(const float* in, int ld, const float* qkg1, const float* cs, const float* sn, float* kr) {
    const int m = blockIdx.x * blockDim.x + threadIdx.x; if (m >= M_) return;
    const float* p = in + (size_t)m * ld; float s = 0.f; float r[32];
    for (int i = 0; i < 32; ++i) s += p[i] * p[i];
    const float rstd = rsqrtf(s / 32.f + 1e-6f);
    for (int i = 0; i < 32; ++i) r[i] = p[i] * rstd * qkg1[64 + i];
    for (int i = 0; i < 16; ++i) { const float c = cs[m * 16 + i], sv = sn[m * 16 + i]; kr[m * 32 + i] = r[i] * c - r[16 + i] * sv; kr[m * 32 + 16 + i] = r[16 + i] * c + r[i] * sv; }
}
__global__ void merge_k(const float* xg, int ld, int n, const float* P, float* merged) {
    const size_t idx = (size_t)blockIdx.x * blockDim.x + threadIdx.x; if (idx >= (size_t)M_ * D_) return;
    const int m = idx / D_, d = idx % D_; const float gt = 1.f / (1.f + expf(-xg[(size_t)m * ld + n * D_ + d]));
    const float v = gt * P[idx]; merged[idx] = (n == 0) ? v : merged[idx] + v;
}
__global__ void resid_k(float* x, const float* gate, const float* T) {
    const size_t idx = (size_t)blockIdx.x * blockDim.x + threadIdx.x; if (idx >= (size_t)M_ * D_) return;
    const int m = idx / D_, d = idx % D_, b = m / S_; x[idx] += gate[b * 6 * D_ + d] * T[idx];
}
__global__ void route_k(const float* lg, const float* le, const float* bg, const float* be, int* cnt, int* eid, float* wgt, int* pos) {
    const int m = blockIdx.x * blockDim.x + threadIdx.x; if (m >= M_) return;
    float g[4]; float mx = -1e30f; int gi = 0;
    for (int i = 0; i < 4; ++i) { g[i] = lg[m * 4 + i] + bg[i]; if (g[i] > mx) { mx = g[i]; gi = i; } }
    float sum = 0.f; for (int i = 0; i < 4; ++i) sum += expf(g[i] - mx);
    const float gw = 1.f / sum;
    float e[8]; float emx = -1e30f; int e0 = 0;
    for (int i = 0; i < 8; ++i) { e[i] = le[m * 32 + gi * 8 + i] + be[gi * 8 + i]; if (e[i] > emx) { emx = e[i]; e0 = i; } }
    float e2 = -1e30f; int e1 = 0;
    for (int i = 0; i < 8; ++i) if (i != e0 && e[i] > e2) { e2 = e[i]; e1 = i; }
    const float p0 = 1.f, p1 = expf(e2 - emx); const float w0 = p0 / (p0 + p1), w1 = p1 / (p0 + p1);
    const int id0 = gi * 8 + e0, id1 = gi * 8 + e1;
    eid[m * 2] = id0; eid[m * 2 + 1] = id1; wgt[m * 2] = gw * w0; wgt[m * 2 + 1] = gw * w1;
    pos[m * 2] = atomicAdd(&cnt[id0], 1); pos[m * 2 + 1] = atomicAdd(&cnt[id1], 1);
}
__global__ void offs_k(const int* cnt, int* off) { if (threadIdx.x == 0 && blockIdx.x == 0) { int a = 0; for (int e = 0; e < 32; ++e) { off[e] = a; a += (cnt[e] + 255) / 256 * 256; } off[32] = a; } }
__global__ void fill_k(const int* eid, const float* wgt, const int* pos, const int* off, int* gather, float* roww, int* rowof) {
    const int idx = blockIdx.x * blockDim.x + threadIdx.x; if (idx >= M_ * 2) return;
    const int row = off[eid[idx]] + pos[idx]; gather[row] = idx >> 1; roww[row] = wgt[idx]; rowof[idx] = row;
}
__global__ void act_k(const float* ga, const float* ua, const float* roww, float* act, int nrows) {
    const size_t idx = (size_t)blockIdx.x * blockDim.x + threadIdx.x; if (idx >= (size_t)nrows * 256) return;
    const int row = idx / 256; act[idx] = silu_f(ga[idx]) * ua[idx] * roww[row];
}
__global__ void moecomb_k(float* x, const float* gate, const float* DN, const int* rowof) {
    const size_t idx = (size_t)blockIdx.x * blockDim.x + threadIdx.x; if (idx >= (size_t)M_ * D_) return;
    const int m = idx / D_, d = idx % D_, b = m / S_;
    x[idx] += gate[b * 6 * D_ + d] * (DN[(size_t)rowof[m * 2] * D_ + d] + DN[(size_t)rowof[m * 2 + 1] * D_ + d]);
}
__global__ void copy_k(const float* a, float* o, size_t n) { const size_t i = (size_t)blockIdx.x * blockDim.x + threadIdx.x; if (i < n) o[i] = a[i]; }

struct In { const float *x, *c; const int* positions; const float *w_ada, *b_ada, *norm_g, *w_in, *diff_qk_g, *diff_lambda, *diff_out_g, *rel_bias, *sgu_v_g, *sgu_w, *sgu_b,
            *mla_lat_g, *mla_w_uq, *mla_w_ukv, *mla_qk_g, *w_branch, *w_out, *router_g_w, *router_g_b, *router_e_w, *router_e_b, *w_e_gate, *w_e_up, *w_e_down; };
struct Ws { float *X, *H, *R1, *R2, *OA, *OB, *OC, *MERGED, *T, *MOD, *LAM, *CS, *SN, *BIAST, *KR, *LG, *LE, *WGT, *ROWW; int *CNT, *OFF, *EID, *POS, *GATHER, *ROWOF; };
static size_t carve(Ws& w, char* base) {
    size_t o = 0; auto take = [&](size_t bytes) { char* p = base + o; o += (bytes + 255) / 256 * 256; return p; };
    w.X = (float*)take((size_t)M_ * D_ * 4); w.H = (float*)take((size_t)M_ * D_ * 4);
    w.R1 = (float*)take((size_t)M_ * 3072 * 4);
    w.R2 = (float*)take((size_t)M_ * 1024 * 4);
    w.T = (float*)take((size_t)M_ * 1024 * 4);
    w.OA = (float*)take((size_t)M_ * 512 * 4); w.OB = (float*)take((size_t)M_ * 512 * 4); w.OC = (float*)take((size_t)M_ * 512 * 4);
    w.MERGED = (float*)take((size_t)M_ * D_ * 4);
    w.MOD = (float*)take((size_t)L_ * B_ * 6 * D_ * 4); w.LAM = (float*)take(256); w.CS = (float*)take((size_t)M_ * 16 * 4); w.SN = (float*)take((size_t)M_ * 16 * 4);
    w.BIAST = (float*)take(4 * 2111 * 4); w.KR = (float*)take((size_t)M_ * 32 * 4); w.LG = (float*)take((size_t)M_ * 4 * 4); w.LE = (float*)take((size_t)M_ * 32 * 4);
    w.WGT = (float*)take((size_t)M_ * 2 * 4); w.ROWW = (float*)take(40960 * 4);
    w.CNT = (int*)take(256); w.OFF = (int*)take(256); w.EID = (int*)take((size_t)M_ * 2 * 4); w.POS = (int*)take((size_t)M_ * 2 * 4); w.GATHER = (int*)take(40960 * 4); w.ROWOF = (int*)take((size_t)M_ * 2 * 4);
    return o;
}
#define EW(n) dim3((unsigned)(((size_t)(n) + 255) / 256)), dim3(256), 0, st
static void forward(const In& in, Ws& w, hipStream_t st, int nsub, int abl = 0) {
    copy_k<<<EW((size_t)M_ * D_)>>>(in.x, w.X, (size_t)M_ * D_);
    mod_k<<<EW(L_ * 6 * D_)>>>(in.c, in.w_ada, in.b_ada, w.MOD);
    misc_k<<<EW(M_ * 16)>>>(in.diff_lambda, in.positions, in.rel_bias, w.LAM, w.CS, w.SN, w.BIAST);
    for (int l = 0; l < L_; ++l) {
        if (2 * l >= nsub) break;
        const float* mod = w.MOD + (size_t)l * B_ * 6 * D_;
        const float* win = in.w_in + (size_t)l * D_ * INW;
        normmod_k<<<M_ / 4, 256, 0, st>>>(w.X, in.norm_g + (size_t)l * 2 * D_, mod, mod + D_, w.H);
        launch_gemm(st, w.H, win, w.R1, M_, 1536, D_, D_, INW, 1536);
        grpnorm_k<<<EW(M_ * 8)>>>(w.R1, w.R1, M_, 8, 64, 1536, 1536, in.diff_qk_g + l * 128, 1.f);
        grpnorm_k<<<EW(M_ * 8)>>>(w.R1 + 512, w.R1 + 512, M_, 8, 64, 1536, 1536, in.diff_qk_g + l * 128 + 64, 1.f);
        { AP a{w.R1, w.R1 + 512, nullptr, w.R1 + 1024, w.R2, w.BIAST, 1536, 64, 1536, 64, 0, 1536, 128, 1, 1024, 128, 8, 0.125f};
          attn_k<64, 64, true><<<dim3(S_ / 64, B_ * 8), 256, 0, st>>>(a); }
        diffcomb_k<<<EW(M_ * 4)>>>(w.R2, w.LAM, l, in.diff_out_g + l * 128, w.OA);
        launch_gemm(st, w.H, win + 1536, w.R1, M_, 1024, D_, D_, INW, 1024);
        sgu_vn_k<<<M_ / 4, 256, 0, st>>>(w.R1, 1024, in.sgu_v_g + l * 512, w.T);
        sgu_k<<<EW((size_t)M_ * 512)>>>(w.R1, 1024, w.T, in.sgu_w + (size_t)l * 4 * 128 * 128, in.sgu_b + l * 512, w.OB);
        launch_gemm(st, w.H, win + 2560, w.R1, M_, 416, D_, D_, INW, 416);
        grpnorm_k<<<EW(M_)>>>(w.R1, w.R1, M_, 1, 256, 416, 416, in.mla_lat_g + l * 384, 1.f);
        grpnorm_k<<<EW(M_)>>>(w.R1 + 256, w.R1 + 256, M_, 1, 128, 416, 416, in.mla_lat_g + l * 384 + 256, 1.f);
        mla_kr_k<<<EW(M_)>>>(w.R1 + 384, 416, in.mla_qk_g + l * 192 + 96, w.CS, w.SN, w.KR);
        launch_gemm(st, w.R1, in.mla_w_uq + (size_t)l * 256 * 768, w.R2, M_, 768, 256, 416, 768, 768);
        launch_gemm(st, w.R1 + 256, in.mla_w_ukv + (size_t)l * 128 * 1024, w.T, M_, 1024, 128, 416, 1024, 1024);
        mla_q_k<<<EW(M_ * 8)>>>(w.R2, in.mla_qk_g + l * 192, w.CS, w.SN);
        mla_k_k<<<EW(M_ * 8)>>>(w.T, in.mla_qk_g + l * 192 + 96);
        { AP a{w.R2, w.T, w.KR, w.T + 64, w.OC, nullptr, 768, 96, 1024, 128, 32, 1024, 128, 0, 512, 64, 8, 0.10206207261596577f};
          attn_k<96, 64, false><<<dim3(S_ / 64, B_ * 8), 128, 0, st>>>(a); }
        launch_gemm(st, w.H, win + 2976, w.R1, M_, 3072, D_, D_, INW, 3072);
        for (int n = 0; n < 3; ++n) {
            const float* br = n == 0 ? w.OA : (n == 1 ? w.OB : w.OC);
            launch_gemm(st, br, in.w_branch + ((size_t)l * 3 + n) * 512 * D_, w.T, M_, D_, 512, 512, D_, D_);
            if (abl & (1 << n)) hipMemsetAsync(w.T, 0, (size_t)M_ * D_ * 4, st);
            merge_k<<<EW((size_t)M_ * D_)>>>(w.R1, 3072, n, w.T, w.MERGED);
        }
        launch_gemm(st, w.MERGED, in.w_out + (size_t)l * D_ * D_, w.T, M_, D_, D_, D_, D_, D_);
        resid_k<<<EW((size_t)M_ * D_)>>>(w.X, mod + 2 * D_, w.T);
        if (2 * l + 1 >= nsub) break;
        normmod_k<<<M_ / 4, 256, 0, st>>>(w.X, in.norm_g + (size_t)l * 2 * D_ + D_, mod + 3 * D_, mod + 4 * D_, w.H);
        launch_gemm(st, w.H, in.router_g_w + (size_t)l * D_ * 4, w.LG, M_, 4, D_, D_, 4, 4);
        launch_gemm(st, w.H, in.router_e_w + (size_t)l * D_ * 32, w.LE, M_, 32, D_, D_, 32, 32);
        hipMemsetAsync(w.CNT, 0, 256, st);
        route_k<<<EW(M_)>>>(w.LG, w.LE, in.router_g_b + l * 4, in.router_e_b + l * 32, w.CNT, w.EID, w.WGT, w.POS);
        offs_k<<<1, 64, 0, st>>>(w.CNT, w.OFF);
        fill_k<<<EW(M_ * 2)>>>(w.EID, w.WGT, w.POS, w.OFF, w.GATHER, w.ROWW, w.ROWOF);
        float* GA = w.R1; float* UA = w.R1 + (size_t)40960 * 256; float* ACT = w.R1 + (size_t)2 * 40960 * 256; float* DN = w.R1 + (size_t)3 * 40960 * 256;
        DN = w.R2;
        launch_gemm(st, w.H, in.w_e_gate + (size_t)l * 32 * D_ * 256, GA, 0, 256, D_, D_, 256, 256, w.GATHER, w.CNT, w.OFF, (long)D_ * 256, 32, M_);
        launch_gemm(st, w.H, in.w_e_up + (size_t)l * 32 * D_ * 256, UA, 0, 256, D_, D_, 256, 256, w.GATHER, w.CNT, w.OFF, (long)D_ * 256, 32, M_);
        act_k<<<EW((size_t)40960 * 256)>>>(GA, UA, w.ROWW, ACT, 40960);
        launch_gemm(st, ACT, in.w_e_down + (size_t)l * 32 * 256 * D_, DN, 0, D_, 256, 256, D_, D_, nullptr, w.CNT, w.OFF, (long)256 * D_, 32, M_);
        moecomb_k<<<EW((size_t)M_ * D_)>>>(w.X, mod + 5 * D_, DN, w.ROWOF);
    }
}
#undef EW
}
extern "C" void kernel_launch(void* const* d_in, const int* in_sizes, int n_in,
                              void* d_out, int out_size, void* d_ws, size_t ws_size,
                              hipStream_t stream) {
    nv::In in;
    in.x = (const float*)d_in[0]; in.c = (const float*)d_in[1]; in.positions = (const int*)d_in[2];
    in.w_ada = (const float*)d_in[3]; in.b_ada = (const float*)d_in[4]; in.norm_g = (const float*)d_in[5]; in.w_in = (const float*)d_in[6];
    in.diff_qk_g = (const float*)d_in[7]; in.diff_lambda = (const float*)d_in[8]; in.diff_out_g = (const float*)d_in[9]; in.rel_bias = (const float*)d_in[10];
    in.sgu_v_g = (const float*)d_in[11]; in.sgu_w = (const float*)d_in[12]; in.sgu_b = (const float*)d_in[13];
    in.mla_lat_g = (const float*)d_in[14]; in.mla_w_uq = (const float*)d_in[15]; in.mla_w_ukv = (const float*)d_in[16]; in.mla_qk_g = (const float*)d_in[17];
    in.w_branch = (const float*)d_in[18]; in.w_out = (const float*)d_in[19]; in.router_g_w = (const float*)d_in[20]; in.router_g_b = (const float*)d_in[21];
    in.router_e_w = (const float*)d_in[22]; in.router_e_b = (const float*)d_in[23]; in.w_e_gate = (const float*)d_in[24]; in.w_e_up = (const float*)d_in[25]; in.w_e_down = (const float*)d_in[26];
    nv::Ws w; const size_t need = nv::carve(w, (char*)d_ws);
    if (need > ws_size) { fprintf(stderr, "ws too small: need %zu have %zu\n", need, ws_size); return; }
    nv::forward(in, w, stream, NSUB, ABL);
    nv::copy_k<<<(unsigned)(((size_t)nv::M_ * nv::D_ + 255) / 256), 256, 0, stream>>>(w.X, (float*)d_out, (size_t)nv::M_ * nv::D_);
}
```

```cpp
#include <hip/hip_runtime.h>
#include <cstdio>
#include <cstdint>
#define NLAUNCH 1
namespace fk {
#define LAS __attribute__((address_space(3)))
#define GAS __attribute__((address_space(1)))
typedef unsigned short bf16;
typedef short bf16x8 __attribute__((ext_vector_type(8)));
typedef short s16x4 __attribute__((ext_vector_type(4)));
typedef float f32x2 __attribute__((ext_vector_type(2)));
typedef float f32x4 __attribute__((ext_vector_type(4)));
typedef float f32x16 __attribute__((ext_vector_type(16)));
typedef unsigned u32x2 __attribute__((ext_vector_type(2)));
typedef unsigned u32x4 __attribute__((ext_vector_type(4)));
typedef __bf16 bf16x2_t __attribute__((ext_vector_type(2)));
constexpr int NB = 8, S = 2048, D = 1024, M = NB * S, NL = 4;
constexpr int NWAVES = 8, NTHR = 512;
constexpr float LOG2E = 1.4426950408889634f;

__device__ __forceinline__ unsigned cvtpk(float lo, float hi) { f32x2 v = {lo, hi}; bf16x2_t b = __builtin_convertvector(v, bf16x2_t); return __builtin_bit_cast(unsigned, b); }
__device__ __forceinline__ float bf_lo(unsigned u) { return __builtin_bit_cast(float, u << 16); }
__device__ __forceinline__ float bf_hi(unsigned u) { return __builtin_bit_cast(float, u & 0xffff0000u); }
__device__ __forceinline__ float bf2f(bf16 u) { return __builtin_bit_cast(float, (unsigned)u << 16); }
__device__ __forceinline__ float wave_sum(float v) {
#pragma unroll
    for (int o = 1; o < 64; o <<= 1) v += __shfl_xor(v, o);
    return v;
}
__device__ __forceinline__ float fast_sigmoid(float x) { return __builtin_amdgcn_rcpf(1.f + __builtin_amdgcn_exp2f(-x * LOG2E)); }
__device__ __forceinline__ float gelu_tanh(float x) { const float y = 0.7978845608028654f * (x + 0.044715f * x * x * x); return x * fast_sigmoid(2.f * y); }
#define LDS_WAIT() asm volatile("s_waitcnt lgkmcnt(0)" ::: "memory")
#define VM_WAIT() asm volatile("s_waitcnt vmcnt(0)" ::: "memory")

#define XB_TMO      128
#define XB_XCNT(j)  (256  + 64 * (j))
#define XB_XSUB(j)  (1280 + 64 * (j))
#define XB_XGEN(j)  (2304 + 64 * (j))
#define XB_TOP      3328
#define XB_TOPGEN   3392
#define XCD_BAR_WORDS 3456
#define XB_SPIN_CAP (1u << 18)
__device__ __forceinline__ unsigned xb_ld(unsigned* p)              { return __hip_atomic_load(p, __ATOMIC_RELAXED, __HIP_MEMORY_SCOPE_AGENT); }
__device__ __forceinline__ unsigned xb_add(unsigned* p, unsigned v) { return __hip_atomic_fetch_add(p, v, __ATOMIC_RELAXED, __HIP_MEMORY_SCOPE_AGENT); }
__device__ __forceinline__ unsigned xb_xcc_id() { return (unsigned)__builtin_amdgcn_s_getreg((3 << 11) | 20) & 0xFu; }
#define XB_SPIN(cond, bar) do { unsigned _sp = 0; while (cond) { __builtin_amdgcn_s_sleep(1); \
    if ((++_sp & 255u) == 0u) { if (xb_ld(&(bar)[XB_TMO])) break; if (_sp > XB_SPIN_CAP) { atomicAdd(&(bar)[XB_TMO], 1u); break; } } } } while (0)
struct XcdBarrier { unsigned* bar; unsigned x; volatile LAS unsigned* st; };
__device__ __forceinline__ XcdBarrier xcd_barrier_post(unsigned* bar, volatile LAS unsigned* st) {
    XcdBarrier b; b.bar = bar; b.x = xb_xcc_id(); b.st = st;
    if (threadIdx.x == 0) (void)xb_add(&bar[XB_XCNT(b.x)], 1u);
    return b;
}
__device__ __forceinline__ void xcd_barrier_complete(unsigned* bar, unsigned x, unsigned& nloc, unsigned& nx) {
    const unsigned G = gridDim.x * gridDim.y * gridDim.z;
    unsigned sum, cnt, mine, sp = 0u;
    for (;;) {
        sum = 0u; cnt = 0u; mine = 0u;
#pragma unroll
        for (unsigned j = 0; j < 16; ++j) { const unsigned c = xb_ld(&bar[XB_XCNT(j)]); sum += c; cnt += (c > 0u) ? 1u : 0u; mine = (j == x) ? c : mine; }
        if (sum == G) break;
        __builtin_amdgcn_s_sleep(1);
        if ((++sp & 255u) == 0u) { if (xb_ld(&bar[XB_TMO])) break; if (sp > XB_SPIN_CAP) { atomicAdd(&bar[XB_TMO], 1u); break; } }
    }
    nloc = mine > 0u ? mine : 1u; nx = cnt > 0u ? cnt : 1u;
}
__device__ __forceinline__ void xcd_barrier(const XcdBarrier& b) {
    asm volatile("s_waitcnt vmcnt(0)" ::: "memory");
    __syncthreads();
    if (threadIdx.x == 0) {
        unsigned* bar = b.bar;
        __builtin_amdgcn_s_waitcnt(0);
        unsigned nloc = b.st[0], nx = b.st[1];
        if (nloc == 0u) { xcd_barrier_complete(bar, b.x, nloc, nx); b.st[0] = nloc; b.st[1] = nx; }
        const unsigned old = xb_add(&bar[XB_XSUB(b.x)], 1u);
        const unsigned gen = old / nloc;
        if (old + 1u == (gen + 1u) * nloc) {
            __builtin_amdgcn_fence(__ATOMIC_RELEASE, "agent");
            asm volatile("s_waitcnt vmcnt(0)" ::: "memory");
            const unsigned og = xb_add(&bar[XB_TOP], 1u);
            const unsigned tg = og / nx;
            if (og + 1u == (tg + 1u) * nx) xb_add(&bar[XB_TOPGEN], 1u);
            else XB_SPIN(xb_ld(&bar[XB_TOPGEN]) == tg, bar);
            __builtin_amdgcn_fence(__ATOMIC_ACQUIRE, "agent");
            xb_add(&bar[XB_XGEN(b.x)], 1u);
            asm volatile("s_waitcnt vmcnt(0)" ::: "memory");
        } else {
            XB_SPIN(xb_ld(&bar[XB_XGEN(b.x)]) == gen, bar);
            __builtin_amdgcn_fence(__ATOMIC_ACQUIRE, "agent");
            asm volatile("s_waitcnt vmcnt(0)" ::: "memory");
        }
    }
    __syncthreads();
}

constexpr int BM = 256, BK = 64, HALF = 128, HTB = HALF * BK * 2;
__device__ __forceinline__ void stage_rc(int b, int& R, int& C) { const int st = b / 1024, sb = b % 1024, swz = sb ^ (((sb >> 9) & 1) << 5); R = (st >> 1) * 16 + swz / 64; C = (st & 1) * 32 + (swz % 64) / 2; }
__device__ __forceinline__ int lds_byte(int r, int c) { const int st = (r >> 4) * 2 + (c >> 5), rr = r & 15, cc = c & 31, ob = rr * 64 + cc * 2; return st * 1024 + (ob ^ (((ob >> 9) & 1) << 5)); }
__device__ __forceinline__ int perm32(int rho) { const int n = rho >> 4, i = rho & 15; return 8 * (i >> 2) + 4 * n + (i & 3); }

struct GUnit { const char* A; const char* B; int nt; int i0, i1, i2; };
template <class Epi, class Sched>
__device__ __forceinline__ void gemm_phase(LAS unsigned char* lds, const Sched& S, const Epi& E) {
    int tid = threadIdx.x; asm volatile("" : "+v"(tid));
    const int wid = __builtin_amdgcn_readfirstlane(tid >> 6), lane = tid & 63, wr = wid >> 2, wc = wid & 3, fr = lane & 15, fq = lane >> 4;
    int R0, C0, R1, C1; stage_rc(tid * 16, R0, C0); stage_rc(tid * 16 + 8192, R1, C1);
    const unsigned ldb = S.ldb_bytes();
    unsigned voffB[2];
    voffB[0] = (unsigned)((R0 & ~31) + perm32(R0 & 31)) * ldb + (unsigned)C0 * 2u; voffB[1] = (unsigned)((R1 & ~31) + perm32(R1 & 31)) * ldb + (unsigned)C1 * 2u;
    unsigned voffBh[2]; voffBh[0] = voffB[0] + (unsigned)HALF * ldb; voffBh[1] = voffB[1] + (unsigned)HALF * ldb;
    const unsigned ldsw = (unsigned)wid * 1024u;
    const int aoff = lds_byte(wr * 64 + fr, fq * 8), boff = lds_byte(wc * 32 + fr, fq * 8);
#define PG8_SA(b, h) (((b) * 2 + (h)) * HTB)
#define PG8_SB(b, h) ((4 + (b) * 2 + (h)) * HTB)
#define PG8_STAGE(bufoff, gbase, voff, kofs) do { _Pragma("unroll") for (int _i = 0; _i < 2; ++_i) \
        __builtin_amdgcn_global_load_lds((const unsigned*)((const char*)(gbase) + (unsigned)((voff)[_i] + (kofs))), (LAS unsigned*)(lds + (bufoff) + ldsw + _i * 8192), 16, 0, 0); } while (0)
#define PG8_LDA(dst, b, h) do { _Pragma("unroll") for (int m = 0; m < 4; ++m) _Pragma("unroll") for (int k = 0; k < 2; ++k) dst[m][k] = *(const LAS bf16x8*)(lds + PG8_SA(b, h) + aoff + m * 2048 + k * 1024); } while (0)
#define PG8_LDB(dst, b, h) do { _Pragma("unroll") for (int n = 0; n < 2; ++n) _Pragma("unroll") for (int k = 0; k < 2; ++k) dst[n][k] = *(const LAS bf16x8*)(lds + PG8_SB(b, h) + boff + n * 2048 + k * 1024); } while (0)
#define PG8_MMA(ai, bj, At, Bt) do { __builtin_amdgcn_s_setprio(1); _Pragma("unroll") for (int m = 0; m < 4; ++m) _Pragma("unroll") for (int n = 0; n < 2; ++n) _Pragma("unroll") for (int k = 0; k < 2; ++k) \
        acc[ai][bj][m][n] = __builtin_amdgcn_mfma_f32_16x16x32_bf16(Bt[n][k], At[m][k], acc[ai][bj][m][n], 0, 0, 0); __builtin_amdgcn_s_setprio(0); } while (0)
#define PG8_WAIT_V(n) asm volatile("s_waitcnt vmcnt(" #n ")" ::: "memory")
#define PG8_WAIT_L(n) asm volatile("s_waitcnt lgkmcnt(" #n ")" ::: "memory")
#define PG8_BAR __builtin_amdgcn_s_barrier()
#define PG8_SCHED __builtin_amdgcn_sched_barrier(0)
    GUnit cur, nxt; int ui = 0;
    if (!S.next(0, cur)) return;
    f32x4 acc[2][2][4][2];
#pragma unroll
    for (int a = 0; a < 2; ++a)
#pragma unroll
        for (int b = 0; b < 2; ++b)
#pragma unroll
            for (int m = 0; m < 4; ++m)
#pragma unroll
                for (int n = 0; n < 2; ++n) acc[a][b][m][n] = (f32x4){0.f, 0.f, 0.f, 0.f};
    bf16x8 At[4][2], B0[2][2], B1[2][2];
    unsigned oAc[2][2], oAn[2][2];
    S.offs(cur, R0, R1, C0, C1, oAc);
    const char* cA = cur.A; const char* cB = cur.B;
    PG8_STAGE(PG8_SB(0, 0), cB, voffB, 0u); PG8_STAGE(PG8_SB(0, 1), cB, voffBh, 0u); PG8_STAGE(PG8_SA(0, 0), cA, oAc[0], 0u); PG8_STAGE(PG8_SA(0, 1), cA, oAc[1], 0u);
    if (wr == 1) PG8_BAR;
    PG8_WAIT_V(2); PG8_BAR;
    PG8_STAGE(PG8_SB(1, 0), cB, voffB, 128u); PG8_STAGE(PG8_SA(1, 0), cA, oAc[0], 128u); PG8_STAGE(PG8_SB(1, 1), cB, voffBh, 128u);
    PG8_WAIT_V(6); PG8_BAR;
    for (;;) {
        const bool has_next = S.next(ui + 1, nxt);
        const char* nA = has_next ? nxt.A : cA; const char* nB = has_next ? nxt.B : cB;
        if constexpr (Sched::GATHER) { if (has_next) S.offs(nxt, R0, R1, C0, C1, oAn);
            else { oAn[0][0] = oAc[0][0]; oAn[0][1] = oAc[0][1]; oAn[1][0] = oAc[1][0]; oAn[1][1] = oAc[1][1]; } }
        int nt = cur.nt; asm volatile("" : "+s"(nt));
        for (int t = 0; t < nt; t += 2) {
            const bool last = (t == nt - 2);
            const unsigned k1 = (unsigned)(t + 1) * 128u, k2 = last ? 0u : (unsigned)(t + 2) * 128u, k3 = k2 + 128u;
            const char* a2 = last ? nA : cA; const char* b2 = last ? nB : cB;
            unsigned o2[2][2];
            if constexpr (Sched::GATHER) { o2[0][0] = last ? oAn[0][0] : oAc[0][0]; o2[0][1] = last ? oAn[0][1] : oAc[0][1]; o2[1][0] = last ? oAn[1][0] : oAc[1][0]; o2[1][1] = last ? oAn[1][1] : oAc[1][1]; }
            else { o2[0][0] = oAc[0][0]; o2[0][1] = oAc[0][1]; o2[1][0] = oAc[1][0]; o2[1][1] = oAc[1][1]; }
            PG8_LDB(B0, 0, 0); PG8_LDB(B1, 0, 1); PG8_SCHED; PG8_LDA(At, 0, 0); PG8_STAGE(PG8_SA(1, 1), cA, oAc[1], k1);
            PG8_WAIT_V(8); PG8_WAIT_L(0); PG8_BAR; PG8_MMA(0, 0, At, B0); PG8_MMA(0, 1, At, B1); PG8_BAR; PG8_SCHED;
            PG8_LDA(At, 0, 1); PG8_STAGE(PG8_SB(0, 0), b2, voffB, k2); PG8_STAGE(PG8_SB(0, 1), b2, voffBh, k2); PG8_STAGE(PG8_SA(0, 0), a2, o2[0], k2);
            PG8_WAIT_V(8); PG8_WAIT_L(0); PG8_BAR; PG8_MMA(1, 0, At, B0); PG8_MMA(1, 1, At, B1); PG8_BAR; PG8_SCHED;
            PG8_LDB(B0, 1, 0); PG8_LDB(B1, 1, 1); PG8_SCHED; PG8_LDA(At, 1, 0); PG8_STAGE(PG8_SA(0, 1), a2, o2[1], k2);
            PG8_WAIT_V(8); PG8_WAIT_L(0); PG8_BAR; PG8_MMA(0, 0, At, B0); PG8_MMA(0, 1, At, B1); PG8_BAR; PG8_SCHED;
            PG8_LDA(At, 1, 1); PG8_STAGE(PG8_SB(1, 0), b2, voffB, k3); PG8_STAGE(PG8_SB(1, 1), b2, voffBh, k3); PG8_STAGE(PG8_SA(1, 0), a2, o2[0], k3);
            PG8_WAIT_V(8); PG8_WAIT_L(0); PG8_BAR; PG8_MMA(1, 0, At, B0); PG8_MMA(1, 1, At, B1); PG8_BAR; PG8_SCHED;
        }
        if (wr == 0) PG8_BAR;
        { int fr2 = fr, fq2 = fq; asm volatile("" : "+v"(fr2), "+v"(fq2)); E(acc, cur, wr, wc, fr2, fq2); }
        if (!has_next) break;
#pragma unroll
        for (int a = 0; a < 2; ++a)
#pragma unroll
            for (int b = 0; b < 2; ++b)
#pragma unroll
                for (int m = 0; m < 4; ++m)
#pragma unroll
                    for (int n = 0; n < 2; ++n) acc[a][b][m][n] = (f32x4){0.f, 0.f, 0.f, 0.f};
        cur = nxt; cA = nA; cB = nB; ++ui;
        if constexpr (Sched::GATHER) { oAc[0][0] = oAn[0][0]; oAc[0][1] = oAn[0][1]; oAc[1][0] = oAn[1][0]; oAc[1][1] = oAn[1][1]; }
        if (wr == 1) PG8_BAR;
    }
    PG8_WAIT_V(0);
    PG8_BAR;
#undef PG8_SA
#undef PG8_SB
#undef PG8_STAGE
#undef PG8_LDA
#undef PG8_LDB
#undef PG8_MMA
#undef PG8_WAIT_V
#undef PG8_WAIT_L
#undef PG8_BAR
#undef PG8_SCHED
}
}
namespace fk {
constexpr size_t MiB = 1u << 20;
constexpr size_t WS_CTL = 0, CTL_ZERO_BYTES = 64 * 1024;
constexpr size_t WS_MOD = 1 * MiB;
constexpr size_t WS_BT = WS_MOD + 832 * 1024;
constexpr size_t WS_LAM = WS_BT + 4096;
constexpr size_t WS_CS = 2 * MiB, WS_SN = 3 * MiB;
constexpr size_t WS_LIST = 4 * MiB, WS_ROWW = 6 * MiB, WS_TOKSLOT = 8 * MiB;
constexpr size_t WS_WIN = 10 * MiB;
constexpr size_t WS_WUQ = 58 * MiB;
constexpr size_t WS_WUKV = 60 * MiB;
constexpr size_t WS_WBR = 62 * MiB;
constexpr size_t WS_WOUT = 74 * MiB;
constexpr size_t WS_WGU = 82 * MiB;
constexpr size_t WS_WDN = 210 * MiB;
constexpr size_t WS_X = 274 * MiB;
constexpr size_t WS_POOL = 338 * MiB;
constexpr size_t WS_Y1 = WS_POOL;
constexpr size_t WS_Z = WS_POOL;
constexpr size_t WS_ACT = WS_POOL + 64 * MiB;
constexpr size_t WS_XG = WS_POOL + 96 * MiB;
constexpr size_t WS_QC = WS_POOL + 192 * MiB;
constexpr size_t WS_KVC = WS_POOL + 216 * MiB;
constexpr size_t WS_KR = WS_POOL + 248 * MiB;
constexpr size_t WS_MERGED = WS_POOL + 192 * MiB;
constexpr size_t WS_OA = WS_POOL + 250 * MiB, WS_OB = WS_POOL + 266 * MiB, WS_OC = WS_POOL + 282 * MiB;
constexpr size_t WS_H = WS_POOL + 298 * MiB;
constexpr size_t WS_END = WS_POOL + 330 * MiB;
constexpr int CW_BAR = 1024;
constexpr int CW_CNT = 8192;
static_assert((CW_BAR + XCD_BAR_WORDS) <= CW_CNT && (CW_CNT + 4 * 32) * 4 <= (int)CTL_ZERO_BYTES, "ctl map");
constexpr int RING_BYTES = 131072, TAB_OFF = RING_BYTES, MISC_OFF = TAB_OFF + 8192, LDS_BYTES = 147456;

struct Params {
    const float *x, *c; const int* positions; const float *w_ada, *b_ada, *norm_g, *w_in, *diff_qk_g, *diff_lambda, *diff_out_g, *rel_bias, *sgu_v_g, *sgu_w, *sgu_b,
        *mla_lat_g, *mla_w_uq, *mla_w_ukv, *mla_qk_g, *w_branch, *w_out, *router_g_w, *router_g_b, *router_e_w, *router_e_b, *w_e_gate, *w_e_up, *w_e_down;
    float* out; unsigned char* ws; int ph_lo, ph_hi; int l_lo, l_hi; int nlayers, pad_;
};

__device__ __forceinline__ void transpose_item(const float* W, int K, int ldw, int c0, int ncols, bf16* WT, int row_off, LAS float* scr, int item, int lane, int ldt = 0) {
    if (ldt == 0) ldt = K;
    const int nblk = ncols / 32, kb = item / nblk, nb = item % nblk, k0 = 64 * kb, n0 = 32 * nb;
#pragma unroll 8
    for (int i = 0; i < 32; ++i) { const int kk = 2 * i + (lane >> 5); scr[kk * 33 + (lane & 31)] = W[(size_t)(k0 + kk) * ldw + c0 + n0 + (lane & 31)]; }
    LDS_WAIT(); asm volatile("" ::: "memory");
    const int c = lane & 7;
#pragma unroll
    for (int j = 0; j < 4; ++j) { const int n = (lane >> 3) + 8 * j; const LAS float* s = scr + (8 * c) * 33 + n;
        u32x4 o; o.x = cvtpk(s[0 * 33], s[1 * 33]); o.y = cvtpk(s[2 * 33], s[3 * 33]); o.z = cvtpk(s[4 * 33], s[5 * 33]); o.w = cvtpk(s[6 * 33], s[7 * 33]);
        *(GAS u32x4*)(WT + (size_t)(row_off + n0 + n) * ldt + k0 + 8 * c) = o; }
    LDS_WAIT(); asm volatile("" ::: "memory");
}
}
namespace fk {
struct Frame { LAS unsigned char* lds; unsigned char* ws; int tid, lane, wave, G, bid, gw, NGW; };

constexpr int IT_IN1 = 16 * 93, IT_IN2 = 16 * 96, IT_UQ = 4 * 24, IT_UKV = 2 * 32, IT_BR = 8 * 32, IT_OUT = 16 * 32, IT_NONEXP = IT_IN1 + IT_IN2 + IT_UQ + IT_UKV + 3 * IT_BR + IT_OUT;
constexpr int IT_EXP = 4 * 64 + 128, IT_LAYER = IT_NONEXP + 32 * IT_EXP, IT_TOTAL = NL * IT_LAYER;
__device__ __forceinline__ void p0_prologue(Frame& F, const Params& p) {
    unsigned char* ws = F.ws;
    LAS float* cact = (LAS float*)(F.lds);
    for (int i = F.tid; i < NB * D; i += NTHR) { const float v = p.c[i]; cact[i] = v / (1.f + __expf(-v)); }
    __syncthreads();
    LAS float* part = (LAS float*)(F.lds + 32768);
    float* MOD = (float*)(ws + WS_MOD);
    for (int it = F.bid; it < NL * 96; it += F.G) {
        const int l = it / 96, cg = it % 96, col = cg * 64 + F.lane;
        const float* w = p.w_ada + (size_t)l * D * 6 * D + (size_t)(F.wave * 128) * 6 * D + col;
        float acc[NB];
#pragma unroll
        for (int b = 0; b < NB; ++b) acc[b] = 0.f;
#pragma unroll 8
        for (int k = 0; k < 128; ++k) { const float wv = w[(size_t)k * 6 * D];
#pragma unroll
            for (int b = 0; b < NB; ++b) acc[b] += cact[b * D + F.wave * 128 + k] * wv; }
#pragma unroll
        for (int b = 0; b < NB; ++b) part[(F.wave * NB + b) * 64 + F.lane] = acc[b];
        __syncthreads();
        { const int b = F.tid >> 6, c = F.tid & 63; float s = 0.f;
#pragma unroll
          for (int wv = 0; wv < 8; ++wv) s += part[(wv * NB + b) * 64 + c];
          MOD[((size_t)l * NB + b) * 6 * D + cg * 64 + c] = s + p.b_ada[l * 6 * D + cg * 64 + c]; }
        __syncthreads();
    }
    const int gt = F.bid * NTHR + F.tid, NGT = F.G * NTHR;
    if (gt < NL) { const float* dl = p.diff_lambda + gt * 256; float s01 = 0.f, s23 = 0.f;
        for (int i = 0; i < 64; ++i) { s01 += dl[i] * dl[64 + i]; s23 += dl[128 + i] * dl[192 + i]; }
        ((float*)(ws + WS_LAM))[gt] = expf(s01) - expf(s23) + (0.8f - 0.6f * expf(-0.3f * (float)gt)); }
    if (gt >= 1024 && gt < 1024 + 4 * 256) { const int i = gt - 1024, h = i >> 8, rel = (i & 255) - 191; const int n = rel < 0 ? -rel : rel;
        int large = 8 + (int)(logf((float)(n > 1 ? n : 1) / 8.f) / 2.772588722239781f * 8.f); if (large > 15) large = 15;
        const int bucket = (rel > 0 ? 16 : 0) + (n < 8 ? n : large);
        ((float*)(ws + WS_BT))[i] = (p.rel_bias[bucket * 4 + h] - p.rel_bias[15 * 4 + h]) * LOG2E; }
    for (int i = gt; i < M * 16; i += NGT) { const int m = i >> 4, j = i & 15; const float inv_freq = powf(10000.f, -(float)(2 * j) / 32.f);
        const float ang = (float)p.positions[m] * inv_freq; ((float*)(ws + WS_CS))[i] = cosf(ang); ((float*)(ws + WS_SN))[i] = sinf(ang); }
    for (int i = gt; i < NL * 96 * 128; i += NGT) { const int l = i / (96 * 128), r = i % (96 * 128); ((u32x4*)(ws + WS_WIN + (size_t)l * 6144 * 2048 + (size_t)2976 * 2048))[r] = (u32x4){0u, 0u, 0u, 0u}; }
    for (int i = gt; i < NL * 1024 * 16; i += NGT) { const int rr = i >> 4, q = i & 15; ((u32x4*)(ws + WS_WUKV + (size_t)rr * 512 + 256))[q] = (u32x4){0u, 0u, 0u, 0u}; }
    LAS float* scr = (LAS float*)(F.lds + 49152 + F.wave * 8448);
    for (int it = F.gw; it < IT_TOTAL; it += F.NGW) {
        const int l = it / IT_LAYER; int r = it % IT_LAYER;
        if (r < IT_IN1) { transpose_item(p.w_in + (size_t)l * D * 6048, 1024, 6048, 0, 2976, (bf16*)(ws + WS_WIN) + (size_t)l * 6144 * 1024, 0, scr, r, F.lane); continue; } r -= IT_IN1;
        if (r < IT_IN2) { transpose_item(p.w_in + (size_t)l * D * 6048, 1024, 6048, 2976, 3072, (bf16*)(ws + WS_WIN) + (size_t)l * 6144 * 1024, 3072, scr, r, F.lane); continue; } r -= IT_IN2;
        if (r < IT_UQ) { transpose_item(p.mla_w_uq + (size_t)l * 256 * 768, 256, 768, 0, 768, (bf16*)(ws + WS_WUQ) + (size_t)l * 768 * 256, 0, scr, r, F.lane); continue; } r -= IT_UQ;
        if (r < IT_UKV) { transpose_item(p.mla_w_ukv + (size_t)l * 128 * 1024, 128, 1024, 0, 1024, (bf16*)(ws + WS_WUKV) + (size_t)l * 1024 * 256, 0, scr, r, F.lane, 256); continue; } r -= IT_UKV;
        if (r < 3 * IT_BR) { const int n = r / IT_BR; transpose_item(p.w_branch + ((size_t)l * 3 + n) * 512 * 1024, 512, 1024, 0, 1024, (bf16*)(ws + WS_WBR) + ((size_t)l * 3 + n) * 1024 * 512, 0, scr, r % IT_BR, F.lane); continue; } r -= 3 * IT_BR;
        if (r < IT_OUT) { transpose_item(p.w_out + (size_t)l * D * D, 1024, 1024, 0, 1024, (bf16*)(ws + WS_WOUT) + (size_t)l * D * D, 0, scr, r, F.lane); continue; } r -= IT_OUT;
        const int e = r / IT_EXP, q = r % IT_EXP; const size_t le = (size_t)l * 32 + e;
        if (q < 256) { const int jj = q >> 6; const float* src = ((jj & 1) ? p.w_e_up : p.w_e_gate) + le * 1024 * 256;
            transpose_item(src, 1024, 256, (jj >> 1) * 128, 128, (bf16*)(ws + WS_WGU) + le * 512 * 1024, jj * 128, scr, q & 63, F.lane); }
        else transpose_item(p.w_e_down + le * 256 * 1024, 256, 1024, 0, 1024, (bf16*)(ws + WS_WDN) + le * 1024 * 256, 0, scr, q - 256, F.lane);
    }
}

template <int MODE>
__device__ __forceinline__ void row_normmod(Frame& F, const float* xin, float* X, const bf16* Z, const float* gateprev, const float* g, const float* shift, const float* scale, bf16* H, float* out) {
    for (int m = F.gw; m < M; m += F.NGW) {
        const int b = m / S;
        f32x4 v[4];
#pragma unroll
        for (int j = 0; j < 4; ++j) {
            const int d = 4 * F.lane + 256 * j;
            if (MODE == 0) v[j] = *(const GAS f32x4*)(xin + (size_t)m * D + d); else v[j] = *(const GAS f32x4*)(X + (size_t)m * D + d);
            if (MODE >= 2) { const u32x2 z0 = *(const GAS u32x2*)(Z + (size_t)(2 * m) * D + d), z1 = *(const GAS u32x2*)(Z + (size_t)(2 * m + 1) * D + d);
                const f32x4 gt = *(const GAS f32x4*)(gateprev + (size_t)b * 6 * D + d);
                v[j].x += gt.x * (bf_lo(z0.x) + bf_lo(z1.x)); v[j].y += gt.y * (bf_hi(z0.x) + bf_hi(z1.x)); v[j].z += gt.z * (bf_lo(z0.y) + bf_lo(z1.y)); v[j].w += gt.w * (bf_hi(z0.y) + bf_hi(z1.y)); }
            if (MODE == 0 || MODE == 2) *(GAS f32x4*)(X + (size_t)m * D + d) = v[j];
            if (MODE == 3) *(GAS f32x4*)(out + (size_t)m * D + d) = v[j];
        }
        if (MODE == 3) continue;
        float s = 0.f;
#pragma unroll
        for (int j = 0; j < 4; ++j) s += (v[j].x * v[j].x + v[j].y * v[j].y) + (v[j].z * v[j].z + v[j].w * v[j].w);
        const float rstd = rsqrtf(wave_sum(s) * (1.f / D) + 1e-6f);
#pragma unroll
        for (int j = 0; j < 4; ++j) { const int d = 4 * F.lane + 256 * j;
            const f32x4 gg = *(const GAS f32x4*)(g + d), sc = *(const GAS f32x4*)(scale + (size_t)b * 6 * D + d), sh = *(const GAS f32x4*)(shift + (size_t)b * 6 * D + d);
            const float o0 = v[j].x * rstd * gg.x * (1.f + sc.x) + sh.x, o1 = v[j].y * rstd * gg.y * (1.f + sc.y) + sh.y, o2 = v[j].z * rstd * gg.z * (1.f + sc.z) + sh.z, o3 = v[j].w * rstd * gg.w * (1.f + sc.w) + sh.w;
            u32x2 o; o.x = cvtpk(o0, o1); o.y = cvtpk(o2, o3); *(GAS u32x2*)(H + (size_t)m * D + d) = o; }
    }
}

struct SchedDense {
    static constexpr bool GATHER = false;
    const char* A; const char* B; unsigned lda_b, ldb_b; int nM, nN, nt, G, c;
    __device__ __forceinline__ bool next(int i, GUnit& u) const {
        const long L = (long)i * G + c; const int nwg = nM * nN; if (L >= nwg) return false;
        int wgid = (int)L; { const int q = nwg / 8, r = nwg % 8, xcd = wgid % 8, off = wgid / 8; wgid = (xcd < r ? xcd * (q + 1) : r * (q + 1) + (xcd - r) * q) + off; }
        const int nig = 8 * nN, gid = wgid / nig, fm = gid * 8, gsz = (nM - fm) < 8 ? (nM - fm) : 8;
        const int pm = fm + ((wgid % nig) % gsz), pn = (wgid % nig) / gsz;
        u.A = A + (size_t)pm * 256 * lda_b; u.B = B + (size_t)pn * 256 * ldb_b; u.nt = nt; u.i0 = pm; u.i1 = pn; u.i2 = 0; return true;
    }
    __device__ __forceinline__ void offs(const GUnit&, int R0, int R1, int C0, int C1, unsigned (&oA)[2][2]) const {
        oA[0][0] = (unsigned)R0 * lda_b + C0 * 2u; oA[0][1] = (unsigned)R1 * lda_b + C1 * 2u; oA[1][0] = (unsigned)(R0 + 128) * lda_b + C0 * 2u; oA[1][1] = (unsigned)(R1 + 128) * lda_b + C1 * 2u; }
    __device__ __forceinline__ unsigned ldb_bytes() const { return ldb_b; }
};
struct EpiStoreBf16 {
    bf16* O0; bf16* O1; int split, ldc0, ldc1;
    __device__ __forceinline__ void operator()(const f32x4 (&acc)[2][2][4][2], const GUnit& u, int wr, int wc, int fr, int fq) const {
        const int pn = u.i1; bf16* base; int ldc; if (pn < split) { base = O0 + 256 * pn; ldc = ldc0; } else { base = O1 + 256 * (pn - split); ldc = ldc1; }
        const int row0 = u.i0 * 256 + wr * 64 + fr, col0 = wc * 32 + 8 * fq;
#pragma unroll
        for (int ai = 0; ai < 2; ++ai)
#pragma unroll
            for (int m = 0; m < 4; ++m) { bf16* rowp = base + (size_t)(row0 + ai * 128 + m * 16) * ldc + col0;
#pragma unroll
                for (int bj = 0; bj < 2; ++bj) { const f32x4 v0 = acc[ai][bj][m][0], v1 = acc[ai][bj][m][1];
                    u32x4 w; w.x = cvtpk(v0[0], v0[1]); w.y = cvtpk(v0[2], v0[3]); w.z = cvtpk(v1[0], v1[1]); w.w = cvtpk(v1[2], v1[3]);
                    *(GAS u32x4*)(rowp + bj * 128) = w; } }
    }
};
}
namespace fk {
typedef short v4i16_t __attribute__((ext_vector_type(4)));
typedef LAS const char* lds_cptr;
__device__ __forceinline__ float grp_sum(float s, int lanes) {
    if (lanes > 1) s += __shfl_xor(s, 1); if (lanes > 2) s += __shfl_xor(s, 2); if (lanes > 4) s += __shfl_xor(s, 4);
    if (lanes > 8) s += __shfl_xor(s, 8); if (lanes > 16) s += __shfl_xor(s, 16); if (lanes > 32) s += __shfl_xor(s, 32);
    return s;
}
__device__ __forceinline__ void unpack8(const u32x4 w, float (&v)[8]) { v[0] = bf_lo(w.x); v[1] = bf_hi(w.x); v[2] = bf_lo(w.y); v[3] = bf_hi(w.y); v[4] = bf_lo(w.z); v[5] = bf_hi(w.z); v[6] = bf_lo(w.w); v[7] = bf_hi(w.w); }
__device__ __forceinline__ u32x4 pack8(const float (&v)[8]) { u32x4 w; w.x = cvtpk(v[0], v[1]); w.y = cvtpk(v[2], v[3]); w.z = cvtpk(v[4], v[5]); w.w = cvtpk(v[6], v[7]); return w; }
__device__ __forceinline__ void norm8(float (&v)[8], int lanes, float inv_width, const float* g, float mul) {
    float s = 0.f;
#pragma unroll
    for (int t = 0; t < 8; ++t) s += v[t] * v[t];
    const float rstd = rsqrtf(grp_sum(s, lanes) * inv_width + 1e-6f) * mul;
#pragma unroll
    for (int t = 0; t < 8; ++t) v[t] = v[t] * rstd * g[t];
}
__device__ __forceinline__ void rope8(float (&v)[8], int j, const float* cs, const float* sn) {
    const int i0 = 8 * (j & 1);
#pragma unroll
    for (int t = 0; t < 8; ++t) { const float o = __shfl_xor(v[t], 2); const float c = cs[i0 + t], s = sn[i0 + t]; v[t] = (j < 2) ? (v[t] * c - o * s) : (v[t] * c + o * s); }
}
__device__ __forceinline__ void prep1(Frame& F, const Params& p, int l) {
    bf16* Y1 = (bf16*)(F.ws + WS_Y1); bf16* KR = (bf16*)(F.ws + WS_KR); const float* CS = (const float*)(F.ws + WS_CS); const float* SN = (const float*)(F.ws + WS_SN);
    const float* gq = p.diff_qk_g + l * 128; const float* gk = gq + 64; const float* latg = p.mla_lat_g + l * 384; const float* kg = p.mla_qk_g + l * 192 + 96;
    const int ln = F.lane;
    for (int m = F.gw; m < M; m += F.NGW) {
        bf16* y = Y1 + (size_t)m * 3072; float v[8];
        { u32x4 w = *(GAS u32x4*)(y + 8 * ln); unpack8(w, v); norm8(v, 8, 1.f / 64.f, gq + (8 * ln & 63), 0.125f * LOG2E); *(GAS u32x4*)(y + 8 * ln) = pack8(v); }
        { u32x4 w = *(GAS u32x4*)(y + 512 + 8 * ln); unpack8(w, v); norm8(v, 8, 1.f / 64.f, gk + (8 * ln & 63), 1.f); *(GAS u32x4*)(y + 512 + 8 * ln) = pack8(v); }
        if (ln < 32) { u32x4 w = *(GAS u32x4*)(y + 2560 + 8 * ln); unpack8(w, v); norm8(v, 32, 1.f / 256.f, latg + 8 * ln, 1.f); *(GAS u32x4*)(y + 2560 + 8 * ln) = pack8(v); }
        else if (ln < 48) { const int j = ln - 32; u32x4 w = *(GAS u32x4*)(y + 2816 + 8 * j); unpack8(w, v); norm8(v, 16, 1.f / 128.f, latg + 256 + 8 * j, 1.f); *(GAS u32x4*)(y + 2816 + 8 * j) = pack8(v); }
        else if (ln < 52) { const int j = ln - 48; u32x4 w = *(GAS u32x4*)(y + 2944 + 8 * j); unpack8(w, v); norm8(v, 4, 1.f / 32.f, kg + 64 + 8 * j, 1.f);
            rope8(v, j, CS + (size_t)m * 16, SN + (size_t)m * 16); *(GAS u32x4*)(KR + (size_t)m * 32 + 8 * j) = pack8(v); }
    }
}
__device__ __forceinline__ void prep2(Frame& F, const Params& p, int l) {
    bf16* QC = (bf16*)(F.ws + WS_QC); bf16* KVC = (bf16*)(F.ws + WS_KVC); const float* CS = (const float*)(F.ws + WS_CS); const float* SN = (const float*)(F.ws + WS_SN);
    const float* g0 = p.mla_qk_g + l * 192; const float* g1 = g0 + 96; const int ln = F.lane; const float qs = 0.10206207261596577f * LOG2E;
    for (int m = F.gw; m < M; m += F.NGW) {
        float v[8];
        { bf16* q = QC + (size_t)m * 768 + (ln >> 3) * 96 + (ln & 7) * 8; u32x4 w = *(GAS u32x4*)q; unpack8(w, v); norm8(v, 8, 1.f / 64.f, g0 + (ln & 7) * 8, qs); *(GAS u32x4*)q = pack8(v); }
        if (ln < 32) { const int j = ln & 3; bf16* q = QC + (size_t)m * 768 + (ln >> 2) * 96 + 64 + j * 8; u32x4 w = *(GAS u32x4*)q; unpack8(w, v); norm8(v, 4, 1.f / 32.f, g0 + 64 + j * 8, qs);
            rope8(v, j, CS + (size_t)m * 16, SN + (size_t)m * 16); *(GAS u32x4*)q = pack8(v); }
        { bf16* k = KVC + (size_t)m * 1024 + (ln >> 3) * 128 + (ln & 7) * 8; u32x4 w = *(GAS u32x4*)k; unpack8(w, v); norm8(v, 8, 1.f / 64.f, g1 + (ln & 7) * 8, 1.f); *(GAS u32x4*)k = pack8(v); }
    }
}

__device__ __forceinline__ int crow(int r, int hi) { return (r & 3) + 8 * (r >> 2) + 4 * hi; }
__device__ __forceinline__ s16x4 vtr(lds_cptr p) { return __builtin_bit_cast(s16x4, __builtin_amdgcn_ds_read_tr16_b64_v4i16((LAS v4i16_t*)p)); }
#define ATT_WAITV(n) asm volatile("s_waitcnt vmcnt(" #n ")" ::: "memory")
template <bool DUAL>
__device__ __forceinline__ void attn_unit(Frame& F, const Params& p, int l, int b, int h, int qb) {
    constexpr int NQF = DUAL ? 4 : 6, NVB = DUAL ? 4 : 2, KP = DUAL ? 16 : 12, NP = DUAL ? 32 : 24, PP = NP / 8, SLOT = NP * 1024, NSLOT = 3;
    constexpr int QROWS = DUAL ? 128 : 256;
    const int lane = F.lane, wid = F.wave, r32_ = lane & 31, hi_ = lane >> 5;
    const int wq = DUAL ? (wid & 3) : wid, map = DUAL ? (wid >> 2) : 0;
    const int q0 = qb * QROWS + wq * 32;
    const int cw = q0 >> 6, NT = ((qb * QROWS + QROWS) >> 6);
    const size_t tok0 = (size_t)b * S;
    LAS unsigned char* lds = F.lds;
    LAS float* wsf = (LAS float*)(lds + TAB_OFF + 4096 + wid * 256);
    LAS float* tab = (LAS float*)(lds + TAB_OFF);
    const bf16* src[PP];
#pragma unroll
    for (int i = 0; i < PP; ++i) {
        const int x = wid * PP + i;
        if (DUAL) {
            const bf16* Y1 = (const bf16*)(F.ws + WS_Y1);
            if (x < KP) src[i] = Y1 + (tok0 + lane) * 3072 + 512 + h * 128 + (x >> 3) * 64 + (x & 7) * 8;
            else { const int v = x - KP; src[i] = Y1 + (tok0 + 16 * (v & 3) + (lane >> 2)) * 3072 + 1024 + h * 128 + (v >> 2) * 32 + (lane & 3) * 8; }
        } else {
            const bf16* KVC = (const bf16*)(F.ws + WS_KVC); const bf16* KR = (const bf16*)(F.ws + WS_KR);
            const int xx = x < 20 ? x : 0;
            if (xx < 8) src[i] = KVC + (tok0 + lane) * 1024 + h * 128 + xx * 8;
            else if (xx < 12) src[i] = KR + (tok0 + lane) * 32 + (xx - 8) * 8;
            else { const int v = xx - 12; src[i] = KVC + (tok0 + 16 * (v & 3) + (lane >> 2)) * 1024 + h * 128 + 64 + (v >> 2) * 32 + (lane & 3) * 8; }
        }
    }
    constexpr int TSTEP = DUAL ? 64 * 3072 : 0;
#define ATT_DMA(t, slot) do { _Pragma("unroll") for (int i_ = 0; i_ < PP; ++i_) { const int x_ = wid * PP + i_; \
        size_t step_; if (DUAL) step_ = (size_t)(t) * TSTEP; else { const int xx_ = x_ < 20 ? x_ : 0; step_ = (size_t)(t) * 64 * ((xx_ >= 8 && xx_ < 12) ? 32 : 1024); } \
        __builtin_amdgcn_global_load_lds((const unsigned*)(src[i_] + step_), (LAS unsigned*)(lds + (slot) * SLOT + x_ * 1024), 16, 0, 0); } } while (0)
    bf16x8 qf[NQF];
    {
        const bf16* Qw = DUAL ? (const bf16*)(F.ws + WS_Y1) + (tok0 + q0 + r32_) * 3072 + h * 128 + map * 64 : (const bf16*)(F.ws + WS_QC) + (tok0 + q0 + r32_) * 768 + h * 96;
#pragma unroll
        for (int d0 = 0; d0 < NQF; ++d0) qf[d0] = *(const GAS bf16x8*)(Qw + d0 * 16 + hi_ * 8);
    }
    if (DUAL) { if (F.tid < 256) tab[F.tid] = ((const float*)(F.ws + WS_BT))[h * 256 + F.tid]; }
    VM_WAIT();
    ATT_DMA(0, 0); if (NT > 1) ATT_DMA(1, 1);
    f32x16 o[NVB];
#pragma unroll
    for (int d = 0; d < NVB; ++d) o[d] = (f32x16){0.f, 0.f, 0.f, 0.f, 0.f, 0.f, 0.f, 0.f, 0.f, 0.f, 0.f, 0.f, 0.f, 0.f, 0.f, 0.f};
    float mrun = -1e30f, lrun = 0.f;
    const int vlane = ((lane >> 4) & 1) * 32 + (lane & 3) * 8 + (4 * hi_ + ((lane & 15) >> 2)) * 64;
    for (int j = 0; j < NT; ++j) {
        const int sl = j % NSLOT;
        if (j + 1 < NT) { if (PP == 4) ATT_WAITV(4); else ATT_WAITV(3); } else ATT_WAITV(0);
        __builtin_amdgcn_s_barrier();
        if (j + 2 < NT) ATT_DMA(j + 2, (j + 2) % NSLOT);
        if (j <= cw) {
            const lds_cptr kb = (lds_cptr)(lds + sl * SLOT + (DUAL ? map * 8192 : 0) + hi_ * 1024 + r32_ * 16);
            f32x16 p0 = (f32x16){0.f, 0.f, 0.f, 0.f, 0.f, 0.f, 0.f, 0.f, 0.f, 0.f, 0.f, 0.f, 0.f, 0.f, 0.f, 0.f}, p1 = p0;
#pragma unroll
            for (int d0 = 0; d0 < NQF; ++d0) {
                const bf16x8 k0 = *(const LAS bf16x8*)(kb + d0 * 2048), k1 = *(const LAS bf16x8*)(kb + d0 * 2048 + 512);
                p0 = __builtin_amdgcn_mfma_f32_32x32x16_bf16(k0, qf[d0], p0, 0, 0, 0); p1 = __builtin_amdgcn_mfma_f32_32x32x16_bf16(k1, qf[d0], p1, 0, 0, 0);
            }
            if (DUAL) { if (j >= cw - 2) { const int base = 64 * j - (q0 + r32_) + 191 + 4 * hi_;
#pragma unroll
                for (int r = 0; r < 16; ++r) { const int kk = (r & 3) + 8 * (r >> 2); p0[r] += tab[base + kk]; p1[r] += tab[base + kk + 32]; } } }
            float mx = p0[0];
#pragma unroll
            for (int r = 1; r < 16; ++r) mx = fmaxf(mx, p0[r]);
#pragma unroll
            for (int r = 0; r < 16; ++r) mx = fmaxf(mx, p1[r]);
            mx = fmaxf(mx, __shfl_xor(mx, 32));
            if (__any(mx - mrun > 8.f)) {
                const float mn = fmaxf(mrun, mx), f = __builtin_amdgcn_exp2f(mrun - mn); lrun *= f; mrun = mn;
                if (hi_ == 0) wsf[r32_] = f;
                LDS_WAIT();
#pragma unroll
                for (int r = 0; r < 16; ++r) { const float fr_ = wsf[crow(r, hi_)];
#pragma unroll
                    for (int d = 0; d < NVB; ++d) o[d][r] *= fr_; }
            }
            float ls = 0.f;
#pragma unroll
            for (int r = 0; r < 16; ++r) { p0[r] = __builtin_amdgcn_exp2f(p0[r] - mrun); p1[r] = __builtin_amdgcn_exp2f(p1[r] - mrun); ls += p0[r] + p1[r]; }
            lrun += ls;
            u32x4 pw0, pw1, pw2, pw3;
            pw0 = (u32x4){cvtpk(p0[0], p0[1]), cvtpk(p0[2], p0[3]), cvtpk(p0[4], p0[5]), cvtpk(p0[6], p0[7])};
            pw1 = (u32x4){cvtpk(p0[8], p0[9]), cvtpk(p0[10], p0[11]), cvtpk(p0[12], p0[13]), cvtpk(p0[14], p0[15])};
            pw2 = (u32x4){cvtpk(p1[0], p1[1]), cvtpk(p1[2], p1[3]), cvtpk(p1[4], p1[5]), cvtpk(p1[6], p1[7])};
            pw3 = (u32x4){cvtpk(p1[8], p1[9]), cvtpk(p1[10], p1[11]), cvtpk(p1[12], p1[13]), cvtpk(p1[14], p1[15])};
            const bf16x8 pa0 = __builtin_bit_cast(bf16x8, pw0), pa1 = __builtin_bit_cast(bf16x8, pw1), pa2 = __builtin_bit_cast(bf16x8, pw2), pa3 = __builtin_bit_cast(bf16x8, pw3);
            const lds_cptr vb = (lds_cptr)(lds + sl * SLOT + KP * 1024 + vlane);
#pragma unroll
            for (int d = 0; d < NVB; ++d) {
                __builtin_amdgcn_sched_barrier(0);
                s16x4 lo[4], hh[4];
#pragma unroll
                for (int ks = 0; ks < 4; ++ks) { lo[ks] = vtr(vb + d * 4096 + ks * 1024); hh[ks] = vtr(vb + d * 4096 + ks * 1024 + 512); }
#define ATT_PK(k) (bf16x8){lo[k][0], lo[k][1], lo[k][2], lo[k][3], hh[k][0], hh[k][1], hh[k][2], hh[k][3]}
                o[d] = __builtin_amdgcn_mfma_f32_32x32x16_bf16(pa0, ATT_PK(0), o[d], 0, 0, 0);
                o[d] = __builtin_amdgcn_mfma_f32_32x32x16_bf16(pa1, ATT_PK(1), o[d], 0, 0, 0);
                o[d] = __builtin_amdgcn_mfma_f32_32x32x16_bf16(pa2, ATT_PK(2), o[d], 0, 0, 0);
                o[d] = __builtin_amdgcn_mfma_f32_32x32x16_bf16(pa3, ATT_PK(3), o[d], 0, 0, 0);
#undef ATT_PK
            }
        }
    }
    int r32 = r32_, hi = hi_; asm volatile("" : "+v"(r32), "+v"(hi));
    lrun += __shfl_xor(lrun, 32);
    if (hi == 0) wsf[32 + r32] = __builtin_amdgcn_rcpf(lrun);
    LDS_WAIT();
    float rli[16];
#pragma unroll
    for (int r = 0; r < 16; ++r) rli[r] = wsf[32 + crow(r, hi)];
    __builtin_amdgcn_s_barrier();
    if (DUAL) {
        LAS float* stg = (LAS float*)(lds) + (size_t)wq * 32 * 132;
        if (map == 1) {
#pragma unroll
            for (int d = 0; d < NVB; ++d)
#pragma unroll
                for (int r = 0; r < 16; ++r) stg[crow(r, hi) * 132 + d * 32 + r32] = o[d][r] * rli[r];
        }
        LDS_WAIT(); __builtin_amdgcn_s_barrier();
        if (map == 0) {
            const float lam = ((const float*)(F.ws + WS_LAM))[l]; const float li = 1.f - (0.8f - 0.6f * __expf(-0.3f * (float)l));
            float ss[16];
#pragma unroll
            for (int r = 0; r < 16; ++r) { float s = 0.f;
#pragma unroll
                for (int d = 0; d < NVB; ++d) { const float v = o[d][r] * rli[r] - lam * stg[crow(r, hi) * 132 + d * 32 + r32]; o[d][r] = v; s += v * v; }
                ss[r] = s; }
#pragma unroll
            for (int r = 0; r < 16; ++r) { float s = ss[r]; s += __shfl_xor(s, 1); s += __shfl_xor(s, 2); s += __shfl_xor(s, 4); s += __shfl_xor(s, 8); s += __shfl_xor(s, 16); ss[r] = rsqrtf(s * (1.f / 128.f) + 1e-6f) * li; }
            const float* og = p.diff_out_g + l * 128; bf16* OA = (bf16*)(F.ws + WS_OA) + (tok0 + q0) * 512 + h * 128;
#pragma unroll
            for (int d = 0; d < NVB; ++d) { const float gg = og[d * 32 + r32];
#pragma unroll
                for (int r = 0; r < 16; ++r) OA[(size_t)crow(r, hi) * 512 + d * 32 + r32] = (bf16)(cvtpk(o[d][r] * ss[r] * gg, 0.f) & 0xffffu); }
        }
    } else {
        LAS bf16* stg = (LAS bf16*)(lds) + wid * 2048;
#pragma unroll
        for (int r = 0; r < 16; ++r) { const int orow = crow(r, hi);
#pragma unroll
            for (int d = 0; d < NVB; ++d) stg[orow * 64 + d * 32 + r32] = (bf16)(cvtpk(o[d][r] * rli[r], 0.f) & 0xffffu); }
        LDS_WAIT();
        bf16* Ow = (bf16*)(F.ws + WS_OC) + (tok0 + q0) * 512 + h * 64;
#pragma unroll
        for (int i = 0; i < 4; ++i) { const int row = i * 8 + (lane >> 3), ch = lane & 7; const u32x4 v = *(const LAS u32x4*)(stg + row * 64 + ch * 8); *(GAS u32x4*)(Ow + (size_t)row * 512 + ch * 8) = v; }
    }
    LDS_WAIT(); VM_WAIT(); __builtin_amdgcn_s_barrier();
#undef ATT_DMA
}
template <bool DUAL>
__device__ __forceinline__ void attn_phase(Frame& F, const Params& p, int l) {
    const int vcu = (F.G % 8 == 0) ? (F.bid % 8) * (F.G / 8) + F.bid / 8 : F.bid;
    if (DUAL) { for (int v = vcu; v < 256; v += F.G) { const int bh = v >> 3, s = v & 7; attn_unit<true>(F, p, l, bh >> 2, bh & 3, s); attn_unit<true>(F, p, l, bh >> 2, bh & 3, 15 - s); } }
    else { for (int v = vcu; v < 256; v += F.G) { const int bh = v >> 2, s = v & 3; attn_unit<false>(F, p, l, bh >> 3, bh & 7, s); attn_unit<false>(F, p, l, bh >> 3, bh & 7, 7 - s); } }
}
}
namespace fk {
__device__ __forceinline__ void sgu_unit(Frame& F, const Params& p, int l, int unit) {
    const int g = unit & 3, bn = unit >> 2; const size_t m0 = (size_t)bn * 128;
    const int lane = F.lane, wid = F.wave, r32 = lane & 31, hi = lane >> 5;
    LAS unsigned char* lds = F.lds; LAS unsigned char* Wt = lds; LAS unsigned char* Vt = lds + 32768;
    const bf16* Y1 = (const bf16*)(F.ws + WS_Y1);
    const float* vg = p.sgu_v_g + l * 512 + 8 * lane;
    float vgv[8];
#pragma unroll
    for (int t = 0; t < 8; ++t) vgv[t] = vg[t];
    for (int jj = 0; jj < 16; ++jj) {
        const int j = wid * 16 + jj; float v[8];
        const u32x4 w = *(const GAS u32x4*)(Y1 + (m0 + j) * 3072 + 2048 + 8 * lane); unpack8(w, v);
        float s = 0.f;
#pragma unroll
        for (int t = 0; t < 8; ++t) { v[t] = gelu_tanh(v[t]); s += v[t] * v[t]; }
        const float rstd = rsqrtf(wave_sum(s) * (1.f / 512.f) + 1e-6f);
        if ((lane >> 4) == g) {
#pragma unroll
            for (int t = 0; t < 8; ++t) v[t] = v[t] * rstd * vgv[t];
            const int db = (lane & 15) >> 2;
            *(LAS u32x4*)(Vt + (db * 8 + (j >> 4)) * 1024 + (j & 15) * 64 + (lane & 3) * 16) = pack8(v);
        }
    }
    const float* Wg = p.sgu_w + ((size_t)l * 4 + g) * 128 * 128;
#pragma unroll
    for (int k = 0; k < 4; ++k) {
        const int item = F.tid + 512 * k, i = item & 127, cidx = item >> 7, ks = cidx >> 1, h2 = cidx & 1;
        const f32x4 a = *(const GAS f32x4*)(Wg + (size_t)i * 128 + 16 * ks + 4 * h2), bq = *(const GAS f32x4*)(Wg + (size_t)i * 128 + 16 * ks + 8 + 4 * h2);
        const bool ok = (ks >> 2) <= (i >> 6);
        u32x4 w; w.x = ok ? cvtpk(a.x, a.y) : 0u; w.y = ok ? cvtpk(a.z, a.w) : 0u; w.z = ok ? cvtpk(bq.x, bq.y) : 0u; w.w = ok ? cvtpk(bq.z, bq.w) : 0u;
        *(LAS u32x4*)(Wt + cidx * 2048 + i * 16) = w;
    }
    __syncthreads();
    const int ib = wid & 3, ch = wid >> 2;
    f32x16 acc[2];
    acc[0] = (f32x16){0.f, 0.f, 0.f, 0.f, 0.f, 0.f, 0.f, 0.f, 0.f, 0.f, 0.f, 0.f, 0.f, 0.f, 0.f, 0.f}; acc[1] = acc[0];
    const int vlane = ((lane >> 4) & 1) * 32 + (lane & 3) * 8 + (4 * hi + ((lane & 15) >> 2)) * 64;
#pragma unroll
    for (int ks = 0; ks < 8; ++ks) {
        const bf16x8 a = *(const LAS bf16x8*)(Wt + (2 * ks + hi) * 2048 + (32 * ib + r32) * 16);
#pragma unroll
        for (int dd = 0; dd < 2; ++dd) { const lds_cptr vb = (lds_cptr)(Vt + (2 * ch + dd) * 8192 + ks * 1024 + vlane);
            const s16x4 lo = vtr(vb), hh = vtr(vb + 512);
            acc[dd] = __builtin_amdgcn_mfma_f32_32x32x16_bf16(a, (bf16x8){lo[0], lo[1], lo[2], lo[3], hh[0], hh[1], hh[2], hh[3]}, acc[dd], 0, 0, 0); }
    }
    const float* bs = p.sgu_b + l * 512 + g * 128; bf16* OB = (bf16*)(F.ws + WS_OB);
#pragma unroll
    for (int dd = 0; dd < 2; ++dd)
#pragma unroll
        for (int r = 0; r < 16; ++r) { const int i = 32 * ib + crow(r, hi), c = 128 * g + 32 * (2 * ch + dd) + r32;
            const float u = gelu_tanh(bf2f(Y1[(m0 + i) * 3072 + 1536 + c]));
            OB[(m0 + i) * 512 + c] = (bf16)(cvtpk(u * (acc[dd][r] + bs[i]), 0.f) & 0xffffu); }
    __syncthreads();
}

struct SchedG3 {
    static constexpr bool GATHER = false;
    const char* OA; const char* WBR; int G, c;
    __device__ __forceinline__ bool next(int i, GUnit& u) const {
        const int tile = (i / 3) * G + c, n = i % 3; if (tile >= 256) return false;
        const int vt = (tile % 8) * 32 + tile / 8;
        const int pm = vt >> 2, pn = vt & 3;
        u.A = OA + (size_t)n * 16 * MiB + (size_t)pm * 256 * 1024; u.B = WBR + (size_t)n * MiB + (size_t)pn * 256 * 1024; u.nt = 8; u.i0 = pm; u.i1 = pn; u.i2 = n; return true;
    }
    __device__ __forceinline__ void offs(const GUnit&, int R0, int R1, int C0, int C1, unsigned (&oA)[2][2]) const {
        oA[0][0] = (unsigned)R0 * 1024u + C0 * 2u; oA[0][1] = (unsigned)R1 * 1024u + C1 * 2u; oA[1][0] = (unsigned)(R0 + 128) * 1024u + C0 * 2u; oA[1][1] = (unsigned)(R1 + 128) * 1024u + C1 * 2u; }
    __device__ __forceinline__ unsigned ldb_bytes() const { return 1024u; }
};
struct EpiG3 {
    const bf16* XG; bf16* MG;
    __device__ __forceinline__ void operator()(const f32x4 (&acc)[2][2][4][2], const GUnit& u, int wr, int wc, int fr, int fq) const {
        const int n = u.i2; const int row0 = u.i0 * 256 + wr * 64 + fr, col0 = u.i1 * 256 + wc * 32 + 8 * fq;
#pragma unroll
        for (int ai = 0; ai < 2; ++ai)
#pragma unroll
            for (int m = 0; m < 4; ++m) { const size_t row = row0 + ai * 128 + m * 16;
#pragma unroll
                for (int bj = 0; bj < 2; ++bj) { const int col = col0 + bj * 128;
                    float gv[8], pv[8], o[8]; unpack8(*(const GAS u32x4*)(XG + row * 3072 + n * 1024 + col), gv);
                    if (n > 0) unpack8(*(const GAS u32x4*)(MG + row * 1024 + col), pv);
                    const f32x4 v0 = acc[ai][bj][m][0], v1 = acc[ai][bj][m][1];
#pragma unroll
                    for (int t = 0; t < 8; ++t) { const float a = t < 4 ? v0[t & 3] : v1[t & 3]; o[t] = fast_sigmoid(gv[t]) * a + (n > 0 ? pv[t] : 0.f); }
                    *(GAS u32x4*)(MG + row * 1024 + col) = pack8(o); } }
    }
};
struct EpiG4 {
    float* X; const float* gate;
    __device__ __forceinline__ void operator()(const f32x4 (&acc)[2][2][4][2], const GUnit& u, int wr, int wc, int fr, int fq) const {
        const int row0 = u.i0 * 256 + wr * 64 + fr, col0 = u.i1 * 256 + wc * 32 + 8 * fq; const int b = (u.i0 * 256) / S;
#pragma unroll
        for (int bj = 0; bj < 2; ++bj) { const int col = col0 + bj * 128;
            const f32x4 g0 = *(const GAS f32x4*)(gate + (size_t)b * 6 * D + col), g1 = *(const GAS f32x4*)(gate + (size_t)b * 6 * D + col + 4);
#pragma unroll
            for (int ai = 0; ai < 2; ++ai)
#pragma unroll
                for (int m = 0; m < 4; ++m) { float* xp = X + (size_t)(row0 + ai * 128 + m * 16) * D + col;
                    f32x4 x0 = *(GAS f32x4*)xp, x1 = *(GAS f32x4*)(xp + 4);
                    x0 += g0 * acc[ai][bj][m][0]; x1 += g1 * acc[ai][bj][m][1];
                    *(GAS f32x4*)xp = x0; *(GAS f32x4*)(xp + 4) = x1; } }
    }
};
struct SchedG2 {
    static constexpr bool GATHER = false;
    const char* Y1; const char* WUQ; const char* WUKV; int G, c;
    __device__ __forceinline__ bool next(int i, GUnit& u) const {
        const int L = i * G + c; if (L >= 448) return false;
        if (L < 192) { const int pm = L / 3, pn = L % 3; u.A = Y1 + (size_t)pm * 256 * 6144 + 2560 * 2; u.B = WUQ + (size_t)pn * 256 * 512; u.i0 = pm; u.i1 = pn; u.i2 = 0; }
        else { const int q = L - 192, pm = q >> 2, pn = q & 3; u.A = Y1 + (size_t)pm * 256 * 6144 + 2816 * 2; u.B = WUKV + (size_t)pn * 256 * 512; u.i0 = pm; u.i1 = pn; u.i2 = 1; }
        u.nt = 4; return true;
    }
    __device__ __forceinline__ void offs(const GUnit&, int R0, int R1, int C0, int C1, unsigned (&oA)[2][2]) const {
        oA[0][0] = (unsigned)R0 * 6144u + C0 * 2u; oA[0][1] = (unsigned)R1 * 6144u + C1 * 2u; oA[1][0] = (unsigned)(R0 + 128) * 6144u + C0 * 2u; oA[1][1] = (unsigned)(R1 + 128) * 6144u + C1 * 2u; }
    __device__ __forceinline__ unsigned ldb_bytes() const { return 512u; }
};
struct EpiG2 {
    bf16* QC; bf16* KVC;
    __device__ __forceinline__ void operator()(const f32x4 (&acc)[2][2][4][2], const GUnit& u, int wr, int wc, int fr, int fq) const {
        bf16* base = u.i2 ? KVC + 256 * u.i1 : QC + 256 * u.i1; const int ldc = u.i2 ? 1024 : 768;
        const int row0 = u.i0 * 256 + wr * 64 + fr, col0 = wc * 32 + 8 * fq;
#pragma unroll
        for (int ai = 0; ai < 2; ++ai)
#pragma unroll
            for (int m = 0; m < 4; ++m) { bf16* rowp = base + (size_t)(row0 + ai * 128 + m * 16) * ldc + col0;
#pragma unroll
                for (int bj = 0; bj < 2; ++bj) { const f32x4 v0 = acc[ai][bj][m][0], v1 = acc[ai][bj][m][1];
                    u32x4 w; w.x = cvtpk(v0[0], v0[1]); w.y = cvtpk(v0[2], v0[3]); w.z = cvtpk(v1[0], v1[1]); w.w = cvtpk(v1[2], v1[3]);
                    *(GAS u32x4*)(rowp + bj * 128) = w; } }
    }
};
}
namespace fk {
constexpr int RT_W = 0;
__device__ __forceinline__ void row_router(Frame& F, const Params& p, int l, const float* mod) {
    unsigned char* ws = F.ws; LAS bf16* WR = (LAS bf16*)(F.lds + RT_W);
    const float* wg = p.router_g_w + (size_t)l * D * 4; const float* we = p.router_e_w + (size_t)l * D * 32;
    for (int d = F.tid; d < D; d += NTHR) {
#pragma unroll
        for (int o = 0; o < 4; ++o) WR[o * 1024 + d] = (bf16)(cvtpk(wg[d * 4 + o], 0.f) & 0xffffu);
#pragma unroll
        for (int o = 0; o < 32; ++o) WR[(4 + o) * 1024 + d] = (bf16)(cvtpk(we[d * 32 + o], 0.f) & 0xffffu);
    }
    __syncthreads();
    const float* X = (const float*)(ws + WS_X); bf16* H = (bf16*)(ws + WS_H);
    const float* g = p.norm_g + (size_t)l * 2 * D + D; const float* shift = mod + 3 * D; const float* scale = mod + 4 * D;
    const float* bg = p.router_g_b + l * 4; const float* be = p.router_e_b + l * 32;
    unsigned* CNT = (unsigned*)(ws + WS_CTL) + CW_CNT + l * 32;
    int* LIST = (int*)(ws + WS_LIST); float* ROWW = (float*)(ws + WS_ROWW); int* TOKSLOT = (int*)(ws + WS_TOKSLOT);
    for (int m = F.gw; m < M; m += F.NGW) {
        const int b = m / S; f32x4 v[4]; float s = 0.f;
#pragma unroll
        for (int j = 0; j < 4; ++j) { v[j] = *(const GAS f32x4*)(X + (size_t)m * D + 4 * F.lane + 256 * j); s += (v[j].x * v[j].x + v[j].y * v[j].y) + (v[j].z * v[j].z + v[j].w * v[j].w); }
        const float rstd = rsqrtf(wave_sum(s) * (1.f / D) + 1e-6f);
#pragma unroll
        for (int j = 0; j < 4; ++j) { const int d = 4 * F.lane + 256 * j;
            const f32x4 gg = *(const GAS f32x4*)(g + d), sc = *(const GAS f32x4*)(scale + (size_t)b * 6 * D + d), sh = *(const GAS f32x4*)(shift + (size_t)b * 6 * D + d);
            v[j].x = v[j].x * rstd * gg.x * (1.f + sc.x) + sh.x; v[j].y = v[j].y * rstd * gg.y * (1.f + sc.y) + sh.y; v[j].z = v[j].z * rstd * gg.z * (1.f + sc.z) + sh.z; v[j].w = v[j].w * rstd * gg.w * (1.f + sc.w) + sh.w;
            u32x2 o; o.x = cvtpk(v[j].x, v[j].y); o.y = cvtpk(v[j].z, v[j].w); *(GAS u32x2*)(H + (size_t)m * D + d) = o; }
        float g4[4];
#pragma unroll
        for (int o = 0; o < 4; ++o) { float a = 0.f;
#pragma unroll
            for (int j = 0; j < 4; ++j) { const u32x2 w = *(const LAS u32x2*)(WR + o * 1024 + 4 * F.lane + 256 * j);
                a += v[j].x * bf_lo(w.x) + v[j].y * bf_hi(w.x) + v[j].z * bf_lo(w.y) + v[j].w * bf_hi(w.y); }
            g4[o] = wave_sum(a) + bg[o]; }
        const float g0 = g4[0], g1 = g4[1], g2 = g4[2], g3 = g4[3];
        int gi = 0; float mx = g0; if (g1 > mx) { mx = g1; gi = 1; } if (g2 > mx) { mx = g2; gi = 2; } if (g3 > mx) { mx = g3; gi = 3; }
        gi = __builtin_amdgcn_readfirstlane(gi);
        const float gw = 1.f / (__expf(g0 - mx) + __expf(g1 - mx) + __expf(g2 - mx) + __expf(g3 - mx));
        float e[8];
#pragma unroll
        for (int i = 0; i < 8; ++i) { float a = 0.f; const LAS bf16* wr_ = WR + (4 + gi * 8 + i) * 1024 + 4 * F.lane;
#pragma unroll
            for (int j = 0; j < 4; ++j) { const u32x2 w = *(const LAS u32x2*)(wr_ + 256 * j);
                a += v[j].x * bf_lo(w.x) + v[j].y * bf_hi(w.x) + v[j].z * bf_lo(w.y) + v[j].w * bf_hi(w.y); }
            e[i] = wave_sum(a) + be[gi * 8 + i]; }
        float emx = e[0]; int e0 = 0;
#pragma unroll
        for (int i = 1; i < 8; ++i) if (e[i] > emx) { emx = e[i]; e0 = i; }
        float e2 = -1e30f; int e1 = 0;
#pragma unroll
        for (int i = 0; i < 8; ++i) if (i != e0 && e[i] > e2) { e2 = e[i]; e1 = i; }
        const float p1 = __expf(e2 - emx), w0 = 1.f / (1.f + p1), w1 = p1 / (1.f + p1);
        if (F.lane == 0) {
            const int id0 = gi * 8 + e0, id1 = gi * 8 + e1;
            const unsigned q0 = atomicAdd(&CNT[id0], 1u), q1 = atomicAdd(&CNT[id1], 1u);
            LIST[id0 * 16384 + q0] = m; ROWW[id0 * 16384 + q0] = gw * w0; TOKSLOT[id0 * 16384 + q0] = 2 * m;
            LIST[id1 * 16384 + q1] = m; ROWW[id1 * 16384 + q1] = gw * w1; TOKSLOT[id1 * 16384 + q1] = 2 * m + 1;
        }
    }
}
__device__ __forceinline__ void moe_table(Frame& F, int l) {
    LAS int* T = (LAS int*)(F.lds + TAB_OFF + 6144);
    if (F.tid == 0) { const unsigned* CNT = (const unsigned*)(F.ws + WS_CTL) + CW_CNT + l * 32; int a = 0;
        for (int e = 0; e < 32; ++e) { const int c = (int)__hip_atomic_load(CNT + e, __ATOMIC_RELAXED, __HIP_MEMORY_SCOPE_AGENT); T[e] = c; T[32 + e] = a; a += (c + 255) >> 8; } T[64] = a; }
    __syncthreads();
}
struct SchedG5 {
    static constexpr bool GATHER = true;
    const char* H; const char* WGU; const int* LIST; LAS const int* T; int G, c;
    __device__ __forceinline__ bool next(int i, GUnit& u) const {
        const int L = i * G + c; const int tot = __builtin_amdgcn_readfirstlane(T[64]); if (L >= 2 * tot) return false;
        const int mtg = L >> 1, ntile = L & 1; int e = 0;
#pragma unroll 1
        for (int k = 1; k < 32; ++k) if (__builtin_amdgcn_readfirstlane(T[32 + k]) <= mtg) e = k;
        const int tpe = __builtin_amdgcn_readfirstlane(T[32 + e]);
        u.A = H; u.B = WGU + ((size_t)e * 512 + ntile * 256) * 2048; u.nt = 16; u.i0 = e; u.i1 = mtg - tpe; u.i2 = ntile; return true;
    }
    __device__ __forceinline__ void offs(const GUnit& u, int R0, int R1, int C0, int C1, unsigned (&oA)[2][2]) const {
        const int cnt = __builtin_amdgcn_readfirstlane(T[u.i0]); const int* li = LIST + u.i0 * 16384; const int base = u.i1 * 256;
        const int a0 = base + R0, a1 = base + R1, a2 = base + R0 + 128, a3 = base + R1 + 128;
        const int t0 = a0 < cnt ? li[a0] : 0, t1 = a1 < cnt ? li[a1] : 0, t2 = a2 < cnt ? li[a2] : 0, t3 = a3 < cnt ? li[a3] : 0;
        oA[0][0] = (unsigned)t0 * 2048u + C0 * 2u; oA[0][1] = (unsigned)t1 * 2048u + C1 * 2u; oA[1][0] = (unsigned)t2 * 2048u + C0 * 2u; oA[1][1] = (unsigned)t3 * 2048u + C1 * 2u; }
    __device__ __forceinline__ unsigned ldb_bytes() const { return 2048u; }
};
struct EpiG5 {
    bf16* ACT; const float* ROWW; LAS const int* T;
    __device__ __forceinline__ void operator()(const f32x4 (&acc)[2][2][4][2], const GUnit& u, int wr, int wc, int fr, int fq) const {
        const int e = u.i0, cnt = __builtin_amdgcn_readfirstlane(T[e]), rbase = u.i1 * 256, arow0 = (__builtin_amdgcn_readfirstlane(T[32 + e]) + u.i1) * 256; const int f0 = u.i2 * 128 + wc * 32 + 8 * fq;
#pragma unroll
        for (int ai = 0; ai < 2; ++ai)
#pragma unroll
            for (int m = 0; m < 4; ++m) { const int rt = ai * 128 + wr * 64 + m * 16 + fr;
                if (rbase + rt < cnt) { const float w = ROWW[e * 16384 + rbase + rt]; float o[8];
#pragma unroll
                    for (int t = 0; t < 8; ++t) { const float gt = t < 4 ? acc[ai][0][m][0][t & 3] : acc[ai][0][m][1][t & 3], up = t < 4 ? acc[ai][1][m][0][t & 3] : acc[ai][1][m][1][t & 3];
                        o[t] = gt * fast_sigmoid(gt) * up * w; }
                    *(GAS u32x4*)(ACT + (size_t)(arow0 + rt) * 256 + f0) = pack8(o); } }
    }
};
struct SchedG6 {
    static constexpr bool GATHER = false;
    const char* ACT; const char* WDN; LAS const int* T; int G, c;
    __device__ __forceinline__ bool next(int i, GUnit& u) const {
        const int L = i * G + c; const int tot = __builtin_amdgcn_readfirstlane(T[64]); if (L >= 4 * tot) return false;
        const int mtg = L >> 2, ntile = L & 3; int e = 0;
#pragma unroll 1
        for (int k = 1; k < 32; ++k) if (__builtin_amdgcn_readfirstlane(T[32 + k]) <= mtg) e = k;
        const int tpe = __builtin_amdgcn_readfirstlane(T[32 + e]);
        u.A = ACT + (size_t)mtg * 256 * 512; u.B = WDN + ((size_t)e * 1024 + ntile * 256) * 512; u.nt = 4; u.i0 = e; u.i1 = mtg - tpe; u.i2 = ntile; return true;
    }
    __device__ __forceinline__ void offs(const GUnit&, int R0, int R1, int C0, int C1, unsigned (&oA)[2][2]) const {
        oA[0][0] = (unsigned)R0 * 512u + C0 * 2u; oA[0][1] = (unsigned)R1 * 512u + C1 * 2u; oA[1][0] = (unsigned)(R0 + 128) * 512u + C0 * 2u; oA[1][1] = (unsigned)(R1 + 128) * 512u + C1 * 2u; }
    __device__ __forceinline__ unsigned ldb_bytes() const { return 512u; }
};
struct EpiG6 {
    bf16* Z; const int* TOKSLOT; LAS const int* T;
    __device__ __forceinline__ void operator()(const f32x4 (&acc)[2][2][4][2], const GUnit& u, int wr, int wc, int fr, int fq) const {
        const int e = u.i0, cnt = __builtin_amdgcn_readfirstlane(T[e]), rbase = u.i1 * 256; const int c0 = u.i2 * 256 + wc * 32 + 8 * fq;
#pragma unroll
        for (int ai = 0; ai < 2; ++ai)
#pragma unroll
            for (int m = 0; m < 4; ++m) { const int rt = ai * 128 + wr * 64 + m * 16 + fr;
                if (rbase + rt < cnt) { const int ts = TOKSLOT[e * 16384 + rbase + rt]; bf16* zp = Z + (size_t)ts * 1024 + c0;
#pragma unroll
                    for (int bj = 0; bj < 2; ++bj) { const f32x4 v0 = acc[ai][bj][m][0], v1 = acc[ai][bj][m][1];
                        u32x4 w; w.x = cvtpk(v0[0], v0[1]); w.y = cvtpk(v0[2], v0[3]); w.z = cvtpk(v1[0], v1[1]); w.w = cvtpk(v1[2], v1[3]);
                        *(GAS u32x4*)(zp + bj * 128) = w; } } }
    }
};
}
#ifndef PH4MASK
#define PH4MASK 7
#endif
#ifndef PHMASK
#define PHMASK 0xFFFF
#endif
namespace fk {
__device__ __forceinline__ void relaunder(Frame& F) { int t = threadIdx.x; asm volatile("" : "+v"(t)); F.tid = t; F.lane = t & 63; }
__global__ void __launch_bounds__(NTHR, 2) fwd(Params p) {
    extern __shared__ __attribute__((aligned(16))) unsigned char lds_[];
    Frame F; F.lds = (LAS unsigned char*)lds_; F.ws = p.ws; F.tid = threadIdx.x; F.lane = F.tid & 63; F.wave = __builtin_amdgcn_readfirstlane(F.tid >> 6);
    F.G = gridDim.x; F.bid = blockIdx.x; F.gw = F.bid * NWAVES + F.wave; F.NGW = F.G * NWAVES;
    volatile LAS unsigned* MISC = (volatile LAS unsigned*)(F.lds + MISC_OFF);
    if (F.tid < 64) MISC[F.tid] = 0u;
    __syncthreads();
    unsigned* ctl = (unsigned*)(p.ws + WS_CTL);
    XcdBarrier bar = xcd_barrier_post(ctl + CW_BAR, MISC + 8);
    bool first = true;
    const int lo = p.ph_lo, hi = p.ph_hi;
#define PHASE(k) if (lo <= (k) && (k) < hi) if ((first ? (void)0 : xcd_barrier(bar)), first = false, relaunder(F), true)
    unsigned char* ws = p.ws;
    if (p.l_lo == 0) PHASE(0) if constexpr (((PHMASK) >> 0) & 1) { p0_prologue(F, p); }
    for (int l = p.l_lo; l < p.l_hi; ++l) {
        const float* mod = (const float*)(ws + WS_MOD) + (size_t)l * NB * 6 * D;
        PHASE(1) if constexpr (((PHMASK) >> 1) & 1) {
            if (l == 0) row_normmod<0>(F, p.x, (float*)(ws + WS_X), nullptr, nullptr, p.norm_g + (size_t)l * 2 * D, mod, mod + D, (bf16*)(ws + WS_H), nullptr);
            else row_normmod<2>(F, nullptr, (float*)(ws + WS_X), (const bf16*)(ws + WS_Z), mod - (size_t)NB * 6 * D + 5 * D, p.norm_g + (size_t)l * 2 * D, mod, mod + D, (bf16*)(ws + WS_H), nullptr);
        }
        PHASE(2) if constexpr (((PHMASK) >> 2) & 1) {
            SchedDense S{(const char*)(ws + WS_H), (const char*)(ws + WS_WIN + (size_t)l * 6144 * 2048), 2048u, 2048u, 64, 24, 16, F.G, F.bid};
            EpiStoreBf16 E{(bf16*)(ws + WS_Y1), (bf16*)(ws + WS_XG), 12, 3072, 3072};
            gemm_phase(F.lds, S, E);
        }
        PHASE(3) if constexpr (((PHMASK) >> 3) & 1) { prep1(F, p, l); }
        PHASE(4) if constexpr (((PHMASK) >> 4) & 1) {
            if constexpr ((PH4MASK) & 1) {
              { SchedDense S{(const char*)(ws + WS_Y1) + 2560 * 2, (const char*)(ws + WS_WUQ + (size_t)l * 768 * 512), 6144u, 512u, 64, 3, 4, F.G, F.bid};
                EpiStoreBf16 E{(bf16*)(ws + WS_QC), nullptr, 99, 768, 0}; gemm_phase(F.lds, S, E); }
              { SchedDense S{(const char*)(ws + WS_Y1) + 2816 * 2, (const char*)(ws + WS_WUKV + (size_t)l * 1024 * 512), 6144u, 512u, 64, 4, 4, F.G, F.bid};
                EpiStoreBf16 E{(bf16*)(ws + WS_KVC), nullptr, 99, 1024, 0}; gemm_phase(F.lds, S, E); } }
            if constexpr ((PH4MASK) & 2) attn_phase<true>(F, p, l);
            if constexpr ((PH4MASK) & 4) for (int u = F.bid; u < 512; u += F.G) sgu_unit(F, p, l, u);
        }
        PHASE(5) if constexpr (((PHMASK) >> 5) & 1) { prep2(F, p, l); }
        PHASE(6) if constexpr (((PHMASK) >> 6) & 1) { attn_phase<false>(F, p, l); }
        PHASE(7) if constexpr (((PHMASK) >> 7) & 1) {
            SchedG3 S{(const char*)(ws + WS_OA), (const char*)(ws + WS_WBR + (size_t)l * 3 * MiB), F.G, F.bid};
            EpiG3 E{(const bf16*)(ws + WS_XG), (bf16*)(ws + WS_MERGED)};
            gemm_phase(F.lds, S, E);
        }
        PHASE(8) if constexpr (((PHMASK) >> 8) & 1) {
            SchedDense S{(const char*)(ws + WS_MERGED), (const char*)(ws + WS_WOUT + (size_t)l * 2 * MiB), 2048u, 2048u, 64, 4, 16, F.G, F.bid};
            EpiG4 E{(float*)(ws + WS_X), mod + 2 * D};
            gemm_phase(F.lds, S, E);
        }
        PHASE(9) if constexpr (((PHMASK) >> 9) & 1) { row_router(F, p, l, mod); }
        PHASE(10) if constexpr (((PHMASK) >> 10) & 1) {
            moe_table(F, l);
            SchedG5 S{(const char*)(ws + WS_H), (const char*)(ws + WS_WGU + (size_t)l * 32 * MiB), (const int*)(ws + WS_LIST), (LAS const int*)(F.lds + TAB_OFF + 6144), F.G, F.bid};
            EpiG5 E{(bf16*)(ws + WS_ACT), (const float*)(ws + WS_ROWW), (LAS const int*)(F.lds + TAB_OFF + 6144)};
            gemm_phase(F.lds, S, E);
        }
        PHASE(11) if constexpr (((PHMASK) >> 11) & 1) {
            moe_table(F, l);
            SchedG6 S{(const char*)(ws + WS_ACT), (const char*)(ws + WS_WDN + (size_t)l * 16 * MiB), (LAS const int*)(F.lds + TAB_OFF + 6144), F.G, F.bid};
            EpiG6 E{(bf16*)(ws + WS_Z), (const int*)(ws + WS_TOKSLOT), (LAS const int*)(F.lds + TAB_OFF + 6144)};
            gemm_phase(F.lds, S, E);
        }
    }
    if (p.l_hi == p.nlayers) PHASE(12) if constexpr (((PHMASK) >> 12) & 1) {
        const float* modl = (const float*)(ws + WS_MOD) + (size_t)(p.nlayers - 1) * NB * 6 * D;
        row_normmod<3>(F, nullptr, (float*)(ws + WS_X), (const bf16*)(ws + WS_Z), modl + 5 * D, nullptr, nullptr, nullptr, nullptr, p.out);
    }
#undef PHASE
}
}
__global__ void cmp_k(const unsigned short* f, int ldf, const float* r, int ldr, int rows, int cols, float* acc) {
    const size_t idx = (size_t)blockIdx.x * blockDim.x + threadIdx.x; float d2 = 0.f, r2 = 0.f;
    if (idx < (size_t)rows * cols) { const int m = idx / cols, c = idx % cols; const float fv = __builtin_bit_cast(float, (unsigned)f[(size_t)m * ldf + c] << 16), rv = r[(size_t)m * ldr + c];
        d2 = (fv - rv) * (fv - rv); r2 = rv * rv; }
    for (int o = 1; o < 64; o <<= 1) { d2 += __shfl_xor(d2, o); r2 += __shfl_xor(r2, o); }
    if ((threadIdx.x & 63) == 0) { atomicAdd(&acc[0], d2); atomicAdd(&acc[1], r2); }
}
__global__ void cmpf_k(const float* f, int ldf, const float* r, int ldr, int rows, int cols, float* acc) {
    const size_t idx = (size_t)blockIdx.x * blockDim.x + threadIdx.x; float d2 = 0.f, r2 = 0.f;
    if (idx < (size_t)rows * cols) { const int m = idx / cols, c = idx % cols; const float fv = f[(size_t)m * ldf + c], rv = r[(size_t)m * ldr + c];
        d2 = (fv - rv) * (fv - rv); r2 = rv * rv; }
    for (int o = 1; o < 64; o <<= 1) { d2 += __shfl_xor(d2, o); r2 += __shfl_xor(r2, o); }
    if ((threadIdx.x & 63) == 0) { atomicAdd(&acc[0], d2); atomicAdd(&acc[1], r2); }
}
__global__ void scale_k(float* out, size_t n, const float* acc, float amp) {
    const size_t i = (size_t)blockIdx.x * blockDim.x + threadIdx.x; if (i >= n) return;
    float e = sqrtf(acc[0] / fmaxf(acc[1], 1e-30f)); if (!(e == e)) e = 10.f; if (e > 10.f) e = 10.f;
    out[i] *= (1.f + amp * e);
}
#ifdef WITH_NAIVE
static void fill_in(nv::In& in, void* const* d_in) {
    in.x = (const float*)d_in[0]; in.c = (const float*)d_in[1]; in.positions = (const int*)d_in[2];
    in.w_ada = (const float*)d_in[3]; in.b_ada = (const float*)d_in[4]; in.norm_g = (const float*)d_in[5]; in.w_in = (const float*)d_in[6];
    in.diff_qk_g = (const float*)d_in[7]; in.diff_lambda = (const float*)d_in[8]; in.diff_out_g = (const float*)d_in[9]; in.rel_bias = (const float*)d_in[10];
    in.sgu_v_g = (const float*)d_in[11]; in.sgu_w = (const float*)d_in[12]; in.sgu_b = (const float*)d_in[13];
    in.mla_lat_g = (const float*)d_in[14]; in.mla_w_uq = (const float*)d_in[15]; in.mla_w_ukv = (const float*)d_in[16]; in.mla_qk_g = (const float*)d_in[17];
    in.w_branch = (const float*)d_in[18]; in.w_out = (const float*)d_in[19]; in.router_g_w = (const float*)d_in[20]; in.router_g_b = (const float*)d_in[21];
    in.router_e_w = (const float*)d_in[22]; in.router_e_b = (const float*)d_in[23]; in.w_e_gate = (const float*)d_in[24]; in.w_e_up = (const float*)d_in[25]; in.w_e_down = (const float*)d_in[26];
}
#endif
static void fill_params(fk::Params& p, void* const* d_in, void* d_out, void* d_ws) {
    p.x = (const float*)d_in[0]; p.c = (const float*)d_in[1]; p.positions = (const int*)d_in[2];
    p.w_ada = (const float*)d_in[3]; p.b_ada = (const float*)d_in[4]; p.norm_g = (const float*)d_in[5]; p.w_in = (const float*)d_in[6];
    p.diff_qk_g = (const float*)d_in[7]; p.diff_lambda = (const float*)d_in[8]; p.diff_out_g = (const float*)d_in[9]; p.rel_bias = (const float*)d_in[10];
    p.sgu_v_g = (const float*)d_in[11]; p.sgu_w = (const float*)d_in[12]; p.sgu_b = (const float*)d_in[13];
    p.mla_lat_g = (const float*)d_in[14]; p.mla_w_uq = (const float*)d_in[15]; p.mla_w_ukv = (const float*)d_in[16]; p.mla_qk_g = (const float*)d_in[17];
    p.w_branch = (const float*)d_in[18]; p.w_out = (const float*)d_in[19]; p.router_g_w = (const float*)d_in[20]; p.router_g_b = (const float*)d_in[21];
    p.router_e_w = (const float*)d_in[22]; p.router_e_b = (const float*)d_in[23]; p.w_e_gate = (const float*)d_in[24]; p.w_e_up = (const float*)d_in[25]; p.w_e_down = (const float*)d_in[26];
    p.out = (float*)d_out; p.ws = (unsigned char*)d_ws;
}
static void launch_fast(hipStream_t st, fk::Params p, int l_lo, int l_hi, int ph_lo, int ph_hi) {
    static bool attr = false;
    if (!attr) { (void)hipFuncSetAttribute((const void*)fk::fwd, hipFuncAttributeMaxDynamicSharedMemorySize, fk::LDS_BYTES); attr = true; }
    (void)hipMemsetAsync((char*)p.ws + fk::WS_CTL + fk::CW_BAR * 4, 0, XCD_BAR_WORDS * 4, st);
    p.l_lo = l_lo; p.l_hi = l_hi; p.ph_lo = ph_lo; p.ph_hi = ph_hi;
    hipLaunchKernelGGL(fk::fwd, dim3(256), dim3(fk::NTHR), fk::LDS_BYTES, st, p);
}
extern "C" void kernel_launch(void* const* d_in, const int* in_sizes, int n_in, void* d_out, int out_size, void* d_ws, size_t ws_size, hipStream_t stream) {
    if (fk::WS_END > ws_size) { fprintf(stderr, "ws too small: need %zu have %zu\n", (size_t)fk::WS_END, ws_size); return; }
    (void)hipMemsetAsync((char*)d_ws + fk::WS_CTL, 0, fk::CTL_ZERO_BYTES, stream);
    fk::Params p{}; fill_params(p, d_in, d_out, d_ws); p.nlayers = 4; p.pad_ = 0;
#if NLAUNCH == 1
    launch_fast(stream, p, 0, 4, 0, 13);
#else
    launch_fast(stream, p, 0, 1, 0, 1);
    for (int l = 0; l < 4; ++l) for (int ph = 1; ph <= 11; ++ph) launch_fast(stream, p, l, l + 1, ph, ph + 1);
    launch_fast(stream, p, 3, 4, 12, 13);
#endif
}
```

```cpp
#include <hip/hip_runtime.h>
#include <cstdio>
#include <cstdint>
#define NLAUNCH 1
#define WT_STORES 1
namespace fk {
#define LAS __attribute__((address_space(3)))
#define GAS __attribute__((address_space(1)))
typedef unsigned short bf16;
typedef short bf16x8 __attribute__((ext_vector_type(8)));
typedef short s16x4 __attribute__((ext_vector_type(4)));
typedef float f32x2 __attribute__((ext_vector_type(2)));
typedef float f32x4 __attribute__((ext_vector_type(4)));
typedef float f32x16 __attribute__((ext_vector_type(16)));
typedef unsigned u32x2 __attribute__((ext_vector_type(2)));
typedef unsigned u32x4 __attribute__((ext_vector_type(4)));
typedef __bf16 bf16x2_t __attribute__((ext_vector_type(2)));
constexpr int NB = 8, S = 2048, D = 1024, M = NB * S, NL = 4;
constexpr int NWAVES = 8, NTHR = 512;
constexpr float LOG2E = 1.4426950408889634f;

__device__ __forceinline__ unsigned cvtpk(float lo, float hi) { f32x2 v = {lo, hi}; bf16x2_t b = __builtin_convertvector(v, bf16x2_t); return __builtin_bit_cast(unsigned, b); }
__device__ __forceinline__ float bf_lo(unsigned u) { return __builtin_bit_cast(float, u << 16); }
__device__ __forceinline__ float bf_hi(unsigned u) { return __builtin_bit_cast(float, u & 0xffff0000u); }
__device__ __forceinline__ float bf2f(bf16 u) { return __builtin_bit_cast(float, (unsigned)u << 16); }
template <int K> __device__ __forceinline__ float sw(float v) { return __builtin_bit_cast(float, __builtin_amdgcn_ds_swizzle(__builtin_bit_cast(int, v), 0x1F | (K << 10))); }
__device__ __forceinline__ int x32_addr() { int z = 0; asm volatile("" : "+v"(z)); const int l = __builtin_amdgcn_mbcnt_hi(-1, __builtin_amdgcn_mbcnt_lo(-1, z)); return (l ^ 32) << 2; }
__device__ __forceinline__ float xget32(float v, bool) { return __builtin_bit_cast(float, __builtin_amdgcn_ds_bpermute(x32_addr(), __builtin_bit_cast(int, v))); }
__device__ __forceinline__ float xsum32(float v) { return v + xget32(v, false); }
__device__ __forceinline__ float xmax32(float v) { return __builtin_fmaxf(v, xget32(v, false)); }
#ifdef OLD_WSUM
__device__ __forceinline__ float wave_sum(float v) { for (int o = 1; o < 64; o <<= 1) v += __shfl_xor(v, o); return v; }
#else
__device__ __forceinline__ float wave_sum(float v) { v += sw<1>(v); v += sw<2>(v); v += sw<4>(v); v += sw<8>(v); v += sw<16>(v); return xsum32(v); }
#endif
__device__ __forceinline__ float fast_sigmoid(float x) { return __builtin_amdgcn_rcpf(1.f + __builtin_amdgcn_exp2f(-x * LOG2E)); }
__device__ __forceinline__ float gelu_tanh(float x) { const float y = 0.7978845608028654f * (x + 0.044715f * x * x * x); return x * fast_sigmoid(2.f * y); }
#define LDS_WAIT() asm volatile("s_waitcnt lgkmcnt(0)" ::: "memory")
__device__ __forceinline__ void st16_wt(void* p, u32x4 v) { asm volatile("global_store_dwordx4 %0, %1, off sc1\n\ts_nop 1" :: "v"(p), "v"(v) : "memory"); }
#ifdef WT_ALL
__device__ __forceinline__ void st16x(void* p, u32x4 v) { asm volatile("global_store_dwordx4 %0, %1, off sc1\n\ts_nop 1" :: "v"(p), "v"(v) : "memory"); }
__device__ __forceinline__ void st16f(void* p, f32x4 v) { asm volatile("global_store_dwordx4 %0, %1, off sc1\n\ts_nop 1" :: "v"(p), "v"(v) : "memory"); }
__device__ __forceinline__ void st8x(void* p, u32x2 v) { asm volatile("global_store_dwordx2 %0, %1, off sc1\n\ts_nop 1" :: "v"(p), "v"(v) : "memory"); }
#else
__device__ __forceinline__ void st16x(void* p, u32x4 v) { *(GAS u32x4*)p = v; }
__device__ __forceinline__ void st16f(void* p, f32x4 v) { *(GAS f32x4*)p = v; }
__device__ __forceinline__ void st8x(void* p, u32x2 v) { *(GAS u32x2*)p = v; }
#endif
#ifdef WT_STORES
__device__ __forceinline__ void st16(void* p, u32x4 v) { asm volatile("global_store_dwordx4 %0, %1, off sc1\n\ts_nop 1" :: "v"(p), "v"(v) : "memory"); }
#else
__device__ __forceinline__ void st16(void* p, u32x4 v) { *(GAS u32x4*)p = v; }
#endif
#define VM_WAIT() asm volatile("s_waitcnt vmcnt(0)" ::: "memory")

#define XB_TMO      128
#define XB_XCNT(j)  (256  + 64 * (j))
#define XB_XSUB(j)  (1280 + 64 * (j))
#define XB_XGEN(j)  (2304 + 64 * (j))
#define XB_TOP      3328
#define XB_TOPGEN   3392
#define XCD_BAR_WORDS 3456
#define XB_SPIN_CAP (1u << 18)
__device__ __forceinline__ unsigned xb_ld(unsigned* p)              { return __hip_atomic_load(p, __ATOMIC_RELAXED, __HIP_MEMORY_SCOPE_AGENT); }
__device__ __forceinline__ unsigned xb_add(unsigned* p, unsigned v) { return __hip_atomic_fetch_add(p, v, __ATOMIC_RELAXED, __HIP_MEMORY_SCOPE_AGENT); }
__device__ __forceinline__ unsigned xb_xcc_id() { return (unsigned)__builtin_amdgcn_s_getreg((3 << 11) | 20) & 0xFu; }
#define XB_SPIN(cond, bar) do { unsigned _sp = 0; while (cond) { __builtin_amdgcn_s_sleep(1); \
    if ((++_sp & 255u) == 0u) { if (xb_ld(&(bar)[XB_TMO])) break; if (_sp > XB_SPIN_CAP) { atomicAdd(&(bar)[XB_TMO], 1u); break; } } } } while (0)
struct XcdBarrier { unsigned* bar; unsigned x; volatile LAS unsigned* st; };
__device__ __forceinline__ XcdBarrier xcd_barrier_post(unsigned* bar, volatile LAS unsigned* st) {
    XcdBarrier b; b.bar = bar; b.x = xb_xcc_id(); b.st = st;
    if (threadIdx.x == 0) (void)xb_add(&bar[XB_XCNT(b.x)], 1u);
    return b;
}
__device__ __forceinline__ void xcd_barrier_complete(unsigned* bar, unsigned x, unsigned& nloc, unsigned& nx) {
    const unsigned G = gridDim.x * gridDim.y * gridDim.z;
    unsigned sum, cnt, mine, sp = 0u;
    for (;;) {
        sum = 0u; cnt = 0u; mine = 0u;
#pragma unroll
        for (unsigned j = 0; j < 16; ++j) { const unsigned c = xb_ld(&bar[XB_XCNT(j)]); sum += c; cnt += (c > 0u) ? 1u : 0u; mine = (j == x) ? c : mine; }
        if (sum == G) break;
        __builtin_amdgcn_s_sleep(1);
        if ((++sp & 255u) == 0u) { if (xb_ld(&bar[XB_TMO])) break; if (sp > XB_SPIN_CAP) { atomicAdd(&bar[XB_TMO], 1u); break; } }
    }
    nloc = mine > 0u ? mine : 1u; nx = cnt > 0u ? cnt : 1u;
}
__device__ __forceinline__ void xcd_barrier(const XcdBarrier& b) {
    asm volatile("s_waitcnt vmcnt(0)" ::: "memory");
    __syncthreads();
    if (threadIdx.x == 0) {
        unsigned* bar = b.bar;
        __builtin_amdgcn_s_waitcnt(0);
        unsigned nloc = b.st[0], nx = b.st[1];
        if (nloc == 0u) { xcd_barrier_complete(bar, b.x, nloc, nx); b.st[0] = nloc; b.st[1] = nx; }
        const unsigned old = xb_add(&bar[XB_XSUB(b.x)], 1u);
        const unsigned gen = old / nloc;
        if (old + 1u == (gen + 1u) * nloc) {
            __builtin_amdgcn_fence(__ATOMIC_RELEASE, "agent");
            asm volatile("s_waitcnt vmcnt(0)" ::: "memory");
            const unsigned og = xb_add(&bar[XB_TOP], 1u);
            const unsigned tg = og / nx;
            if (og + 1u == (tg + 1u) * nx) xb_add(&bar[XB_TOPGEN], 1u);
            else XB_SPIN(xb_ld(&bar[XB_TOPGEN]) == tg, bar);
            __builtin_amdgcn_fence(__ATOMIC_ACQUIRE, "agent");
            xb_add(&bar[XB_XGEN(b.x)], 1u);
            asm volatile("s_waitcnt vmcnt(0)" ::: "memory");
        } else {
            XB_SPIN(xb_ld(&bar[XB_XGEN(b.x)]) == gen, bar);
            __builtin_amdgcn_fence(__ATOMIC_ACQUIRE, "agent");
            asm volatile("s_waitcnt vmcnt(0)" ::: "memory");
        }
    }
    __syncthreads();
}

constexpr int BM = 256, BK = 64, HALF = 128, HTB = HALF * BK * 2;
__device__ __forceinline__ void stage_rc(int b, int& R, int& C) { const int st = b / 1024, sb = b % 1024, swz = sb ^ (((sb >> 9) & 1) << 5); R = (st >> 1) * 16 + swz / 64; C = (st & 1) * 32 + (swz % 64) / 2; }
__device__ __forceinline__ int lds_byte(int r, int c) { const int st = (r >> 4) * 2 + (c >> 5), rr = r & 15, cc = c & 31, ob = rr * 64 + cc * 2; return st * 1024 + (ob ^ (((ob >> 9) & 1) << 5)); }
__device__ __forceinline__ int perm32(int rho) { const int n = rho >> 4, i = rho & 15; return 8 * (i >> 2) + 4 * n + (i & 3); }

struct GUnit { const char* A; const char* B; int nt; int i0, i1, i2, i3; };
template <class Epi, class Sched>
__device__ __forceinline__ void gemm_phase(LAS unsigned char* lds, const Sched& S, const Epi& E) {
    int tid = threadIdx.x; asm volatile("" : "+v"(tid));
    const int wid = __builtin_amdgcn_readfirstlane(tid >> 6), lane = tid & 63, wr = wid >> 2, wc = wid & 3, fr = lane & 15, fq = lane >> 4;
    int R0, C0, R1, C1; stage_rc(tid * 16, R0, C0); stage_rc(tid * 16 + 8192, R1, C1);
    const unsigned ldb = S.ldb_bytes();
    unsigned voffB[2];
    voffB[0] = (unsigned)((R0 & ~31) + perm32(R0 & 31)) * ldb + (unsigned)C0 * 2u; voffB[1] = (unsigned)((R1 & ~31) + perm32(R1 & 31)) * ldb + (unsigned)C1 * 2u;
    unsigned voffBh[2]; voffBh[0] = voffB[0] + (unsigned)HALF * ldb; voffBh[1] = voffB[1] + (unsigned)HALF * ldb;
    const unsigned ldsw = (unsigned)wid * 1024u;
    const int aoff = lds_byte(wr * 64 + fr, fq * 8), boff = lds_byte(wc * 32 + fr, fq * 8);
#define PG8_SA(b, h) (((b) * 2 + (h)) * HTB)
#define PG8_SB(b, h) ((4 + (b) * 2 + (h)) * HTB)
#define PG8_STAGE(bufoff, gbase, voff, kofs) do { _Pragma("unroll") for (int _i = 0; _i < 2; ++_i) \
        __builtin_amdgcn_global_load_lds((const unsigned*)((const char*)(gbase) + (unsigned)((voff)[_i] + (kofs))), (LAS unsigned*)(lds + (bufoff) + ldsw + _i * 8192), 16, 0, 0); } while (0)
#define PG8_LDA(dst, b, h) do { _Pragma("unroll") for (int m = 0; m < 4; ++m) _Pragma("unroll") for (int k = 0; k < 2; ++k) dst[m][k] = *(const LAS bf16x8*)(lds + PG8_SA(b, h) + aoff + m * 2048 + k * 1024); } while (0)
#define PG8_LDB(dst, b, h) do { _Pragma("unroll") for (int n = 0; n < 2; ++n) _Pragma("unroll") for (int k = 0; k < 2; ++k) dst[n][k] = *(const LAS bf16x8*)(lds + PG8_SB(b, h) + boff + n * 2048 + k * 1024); } while (0)
#define PG8_MMA(ai, bj, At, Bt) do { __builtin_amdgcn_s_setprio(1); _Pragma("unroll") for (int m = 0; m < 4; ++m) _Pragma("unroll") for (int n = 0; n < 2; ++n) _Pragma("unroll") for (int k = 0; k < 2; ++k) \
        acc[ai][bj][m][n] = __builtin_amdgcn_mfma_f32_16x16x32_bf16(Bt[n][k], At[m][k], acc[ai][bj][m][n], 0, 0, 0); __builtin_amdgcn_s_setprio(0); } while (0)
#define PG8_WAIT_V(n) asm volatile("s_waitcnt vmcnt(" #n ")" ::: "memory")
#define PG8_WAIT_L(n) asm volatile("s_waitcnt lgkmcnt(" #n ")" ::: "memory")
#define PG8_BAR __builtin_amdgcn_s_barrier()
#define PG8_SCHED __builtin_amdgcn_sched_barrier(0)
    GUnit cur, nxt; int ui = 0;
    if (!S.next(0, cur)) return;
    f32x4 acc[2][2][4][2];
#pragma unroll
    for (int a = 0; a < 2; ++a)
#pragma unroll
        for (int b = 0; b < 2; ++b)
#pragma unroll
            for (int m = 0; m < 4; ++m)
#pragma unroll
                for (int n = 0; n < 2; ++n) acc[a][b][m][n] = (f32x4){0.f, 0.f, 0.f, 0.f};
    bf16x8 At[4][2], B0[2][2], B1[2][2];
    unsigned oAc[2][2], oAn[2][2];
    S.a_ready(cur);
    S.offs(cur, R0, R1, C0, C1, oAc);
    const char* cA = cur.A; const char* cB = cur.B;
    PG8_STAGE(PG8_SB(0, 0), cB, voffB, 0u); PG8_STAGE(PG8_SB(0, 1), cB, voffBh, 0u); PG8_STAGE(PG8_SA(0, 0), cA, oAc[0], 0u); PG8_STAGE(PG8_SA(0, 1), cA, oAc[1], 0u);
    if (wr == 1) PG8_BAR;
    PG8_WAIT_V(2); PG8_BAR;
    PG8_STAGE(PG8_SB(1, 0), cB, voffB, 128u); PG8_STAGE(PG8_SA(1, 0), cA, oAc[0], 128u); PG8_STAGE(PG8_SB(1, 1), cB, voffBh, 128u);
    PG8_WAIT_V(6); PG8_BAR;
    for (;;) {
        const bool has_next = S.next(ui + 1, nxt);
        const char* nA = has_next ? nxt.A : cA; const char* nB = has_next ? nxt.B : cB;
        if constexpr (Sched::GATHER) { if (has_next) S.offs(nxt, R0, R1, C0, C1, oAn);
            else { oAn[0][0] = oAc[0][0]; oAn[0][1] = oAc[0][1]; oAn[1][0] = oAc[1][0]; oAn[1][1] = oAc[1][1]; } }
        int nt = cur.nt; asm volatile("" : "+s"(nt));
        for (int t = 0; t < nt; t += 2) {
            const bool last = (t == nt - 2);
            if (last && has_next) S.a_ready(nxt);
            const unsigned k1 = (unsigned)(t + 1) * 128u, k2 = last ? 0u : (unsigned)(t + 2) * 128u, k3 = k2 + 128u;
            const char* a2 = last ? nA : cA; const char* b2 = last ? nB : cB;
            unsigned o2[2][2];
            if constexpr (Sched::GATHER) { o2[0][0] = last ? oAn[0][0] : oAc[0][0]; o2[0][1] = last ? oAn[0][1] : oAc[0][1]; o2[1][0] = last ? oAn[1][0] : oAc[1][0]; o2[1][1] = last ? oAn[1][1] : oAc[1][1]; }
            else { o2[0][0] = oAc[0][0]; o2[0][1] = oAc[0][1]; o2[1][0] = oAc[1][0]; o2[1][1] = oAc[1][1]; }
            PG8_LDB(B0, 0, 0); PG8_LDB(B1, 0, 1); PG8_SCHED; PG8_LDA(At, 0, 0); PG8_STAGE(PG8_SA(1, 1), cA, oAc[1], k1);
            PG8_WAIT_V(8); PG8_WAIT_L(0); PG8_BAR; PG8_MMA(0, 0, At, B0); PG8_MMA(0, 1, At, B1); PG8_BAR; PG8_SCHED;
            PG8_LDA(At, 0, 1); PG8_STAGE(PG8_SB(0, 0), b2, voffB, k2); PG8_STAGE(PG8_SB(0, 1), b2, voffBh, k2); PG8_STAGE(PG8_SA(0, 0), a2, o2[0], k2);
            PG8_WAIT_V(8); PG8_WAIT_L(0); PG8_BAR; PG8_MMA(1, 0, At, B0); PG8_MMA(1, 1, At, B1); PG8_BAR; PG8_SCHED;
            PG8_LDB(B0, 1, 0); PG8_LDB(B1, 1, 1); PG8_SCHED; PG8_LDA(At, 1, 0); PG8_STAGE(PG8_SA(0, 1), a2, o2[1], k2);
            PG8_WAIT_V(8); PG8_WAIT_L(0); PG8_BAR; PG8_MMA(0, 0, At, B0); PG8_MMA(0, 1, At, B1); PG8_BAR; PG8_SCHED;
            PG8_LDA(At, 1, 1); PG8_STAGE(PG8_SB(1, 0), b2, voffB, k3); PG8_STAGE(PG8_SB(1, 1), b2, voffBh, k3); PG8_STAGE(PG8_SA(1, 0), a2, o2[0], k3);
            PG8_WAIT_V(8); PG8_WAIT_L(0); PG8_BAR; PG8_MMA(1, 0, At, B0); PG8_MMA(1, 1, At, B1); PG8_BAR; PG8_SCHED;
        }
        if (wr == 0) PG8_BAR;
        { int fr2 = fr, fq2 = fq; asm volatile("" : "+v"(fr2), "+v"(fq2)); E(acc, cur, wr, wc, fr2, fq2); S.done(cur); }
        if (!has_next) break;
#pragma unroll
        for (int a = 0; a < 2; ++a)
#pragma unroll
            for (int b = 0; b < 2; ++b)
#pragma unroll
                for (int m = 0; m < 4; ++m)
#pragma unroll
                    for (int n = 0; n < 2; ++n) acc[a][b][m][n] = (f32x4){0.f, 0.f, 0.f, 0.f};
        cur = nxt; cA = nA; cB = nB; ++ui;
        if constexpr (Sched::GATHER) { oAc[0][0] = oAn[0][0]; oAc[0][1] = oAn[0][1]; oAc[1][0] = oAn[1][0]; oAc[1][1] = oAn[1][1]; }
        if (wr == 1) PG8_BAR;
    }
    PG8_WAIT_V(0);
    PG8_BAR;
#undef PG8_SA
#undef PG8_SB
#undef PG8_STAGE
#undef PG8_LDA
#undef PG8_LDB
#undef PG8_MMA
#undef PG8_WAIT_V
#undef PG8_WAIT_L
#undef PG8_BAR
#undef PG8_SCHED
}
}
namespace fk {
constexpr size_t MiB = 1u << 20;
constexpr size_t WS_CTL = 0, CTL_ZERO_BYTES = 64 * 1024;
constexpr size_t WS_MOD = 1 * MiB;
constexpr size_t WS_BT = WS_MOD + 832 * 1024;
constexpr size_t WS_LAM = WS_BT + 4096;
constexpr size_t WS_ST = WS_MOD + 896 * 1024;
constexpr size_t WS_CS = 2 * MiB, WS_SN = 3 * MiB;
constexpr size_t WS_LIST = 4 * MiB, WS_ROWW = 6 * MiB, WS_TOKSLOT = 8 * MiB;
constexpr size_t WS_WIN = 10 * MiB;
constexpr size_t WS_WUQ = 58 * MiB;
constexpr size_t WS_WRT = 59 * MiB + 512 * 1024;
constexpr size_t WS_WUKV = 60 * MiB;
constexpr size_t WS_WBR = 62 * MiB;
constexpr size_t WS_WOUT = 74 * MiB;
constexpr size_t WS_WGU = 82 * MiB;
constexpr size_t WS_WDN = 210 * MiB;
constexpr size_t WS_X = 274 * MiB;
constexpr size_t WS_POOL = 338 * MiB;
constexpr size_t WS_Y1 = WS_POOL;
constexpr size_t WS_Z = WS_POOL;
constexpr size_t WS_ACT = WS_POOL + 64 * MiB;
constexpr size_t WS_XG = WS_POOL + 96 * MiB;
constexpr size_t WS_QC = WS_POOL + 192 * MiB;
constexpr size_t WS_KVC = WS_POOL + 216 * MiB;
constexpr size_t WS_KR = WS_POOL + 248 * MiB;
constexpr size_t WS_STAT = WS_KR + 1 * MiB;
constexpr size_t WS_MERGED = WS_POOL + 192 * MiB;
constexpr size_t WS_OA = WS_POOL + 250 * MiB, WS_OB = WS_POOL + 266 * MiB, WS_OC = WS_POOL + 282 * MiB;
constexpr size_t WS_H = WS_POOL + 298 * MiB;
constexpr size_t WS_END = WS_POOL + 330 * MiB;
constexpr int CW_BAR = 1024;
constexpr int CW_CNT = 8192;
constexpr int CW_RDY = 9216;
constexpr int CW_G2CNT = 8512;
constexpr int CW_TMO2 = 8448;
static_assert((CW_RDY + 4 * 256) * 4 <= (int)CTL_ZERO_BYTES, "ctl map 2");
static_assert((CW_BAR + XCD_BAR_WORDS) <= CW_CNT && (CW_CNT + 4 * 32) * 4 <= (int)CTL_ZERO_BYTES, "ctl map");
constexpr int RING_BYTES = 131072, TAB_OFF = RING_BYTES, MISC_OFF = TAB_OFF + 8192, LDS_BYTES = 147456;

struct Params {
    const float *x, *c; const int* positions; const float *w_ada, *b_ada, *norm_g, *w_in, *diff_qk_g, *diff_lambda, *diff_out_g, *rel_bias, *sgu_v_g, *sgu_w, *sgu_b,
        *mla_lat_g, *mla_w_uq, *mla_w_ukv, *mla_qk_g, *w_branch, *w_out, *router_g_w, *router_g_b, *router_e_w, *router_e_b, *w_e_gate, *w_e_up, *w_e_down;
    float* out; unsigned char* ws; int ph_lo, ph_hi; int l_lo, l_hi; int nlayers, pad_;
};

__device__ __forceinline__ void transpose_blk(const float* W, int ldw, int sc0, int k0, bf16* WT, int dr0, int ldt, const float* kscale, LAS float* scr, int lane) {
    float tv[32];
#pragma unroll
    for (int i = 0; i < 32; ++i) { const int kk = 2 * i + (lane >> 5); tv[i] = W[(size_t)(k0 + kk) * ldw + sc0 + (lane & 31)]; }
#pragma unroll
    for (int i = 0; i < 32; ++i) { const int kk = 2 * i + (lane >> 5); float v = tv[i]; if (kscale) v *= kscale[k0 + kk]; scr[kk * 33 + (lane & 31)] = v; }
    LDS_WAIT(); asm volatile("" ::: "memory");
    const int c = lane & 7;
#pragma unroll
    for (int j = 0; j < 4; ++j) { const int n = (lane >> 3) + 8 * j; const LAS float* sp = scr + (8 * c) * 33 + n;
        u32x4 o; o.x = cvtpk(sp[0 * 33], sp[1 * 33]); o.y = cvtpk(sp[2 * 33], sp[3 * 33]); o.z = cvtpk(sp[4 * 33], sp[5 * 33]); o.w = cvtpk(sp[6 * 33], sp[7 * 33]);
        *(GAS u32x4*)(WT + (size_t)(dr0 + n) * ldt + k0 + 8 * c) = o; }
    LDS_WAIT(); asm volatile("" ::: "memory");
}
__device__ __forceinline__ void transpose_item(const float* W, int K, int ldw, int c0, int ncols, bf16* WT, int row_off, LAS float* scr, int item, int lane, int ldt = 0) {
    if (ldt == 0) ldt = K;
    const int nblk = ncols / 32, kb = item / nblk, nb = item % nblk;
    transpose_blk(W, ldw, c0 + 32 * nb, 64 * kb, WT, row_off + 32 * nb, ldt, nullptr, scr, lane);
}
}
namespace fk {
struct Frame { LAS unsigned char* lds; unsigned char* ws; int tid, lane, wave, G, bid, gw, NGW; };

constexpr int IT_IN1 = 16 * 93, IT_IN2 = 16 * 96, IT_UQ = 4 * 24, IT_UKV = 2 * 32, IT_BR = 8 * 32, IT_OUT = 16 * 32, IT_NONEXP = IT_IN1 + IT_IN2 + IT_UQ + IT_UKV + 3 * IT_BR + IT_OUT;
constexpr int IT_EXP = 4 * 64 + 128, IT_LAYER = IT_NONEXP + 32 * IT_EXP, IT_TOTAL = NL * IT_LAYER;
__device__ __forceinline__ void p0_prologue(Frame& F, const Params& p) {
    unsigned char* ws = F.ws;
    LAS float* cact = (LAS float*)(F.lds);
    for (int i = F.tid; i < NB * D; i += NTHR) { const float v = p.c[i]; cact[i] = v / (1.f + __expf(-v)); }
    __syncthreads();
    LAS float* part = (LAS float*)(F.lds + 32768);
    float* MOD = (float*)(ws + WS_MOD);
    for (int it = F.bid; it < NL * 192; it += F.G) {
        const int l = it / 192, cg = it % 192, col = cg * 32 + (F.lane & 31), kpar = F.lane >> 5;
        const int kb = F.wave * 128 + kpar;
        const float* w = p.w_ada + (size_t)l * D * 6 * D + (size_t)kb * 6 * D + col;
        float acc[NB];
#pragma unroll
        for (int b = 0; b < NB; ++b) acc[b] = 0.f;
#pragma unroll 16
        for (int i = 0; i < 64; ++i) { const float wv = w[(size_t)(2 * i) * 6 * D];
#pragma unroll
            for (int b = 0; b < NB; ++b) acc[b] += cact[b * D + kb + 2 * i] * wv; }
#pragma unroll
        for (int b = 0; b < NB; ++b) { const float s2 = xsum32(acc[b]); if (F.lane < 32) part[(F.wave * NB + b) * 32 + F.lane] = s2; }
        __syncthreads();
        if (F.tid < 256) { const int b = F.tid >> 5, c = F.tid & 31; float s = 0.f;
#pragma unroll
          for (int wv = 0; wv < 8; ++wv) s += part[(wv * NB + b) * 32 + c];
          MOD[((size_t)l * NB + b) * 6 * D + cg * 32 + c] = s + p.b_ada[l * 6 * D + cg * 32 + c]; }
        __syncthreads();
    }
    const int gt = F.bid * NTHR + F.tid, NGT = F.G * NTHR;
    if (gt < NL) { const float* dl = p.diff_lambda + gt * 256; float s01 = 0.f, s23 = 0.f;
        for (int i = 0; i < 64; ++i) { s01 += dl[i] * dl[64 + i]; s23 += dl[128 + i] * dl[192 + i]; }
        ((float*)(ws + WS_LAM))[gt] = expf(s01) - expf(s23) + (0.8f - 0.6f * expf(-0.3f * (float)gt)); }
    if (gt >= 1024 && gt < 1024 + 4 * 256) { const int i = gt - 1024, h = i >> 8, rel = (i & 255) - 191; const int n = rel < 0 ? -rel : rel;
        int large = 8 + (int)(logf((float)(n > 1 ? n : 1) / 8.f) / 2.772588722239781f * 8.f); if (large > 15) large = 15;
        const int bucket = (rel > 0 ? 16 : 0) + (n < 8 ? n : large);
        ((float*)(ws + WS_BT))[i] = (p.rel_bias[bucket * 4 + h] - p.rel_bias[15 * 4 + h]) * LOG2E; }
    for (int i = gt; i < M * 16; i += NGT) { const int m = i >> 4, j = i & 15; const float inv_freq = powf(10000.f, -(float)(2 * j) / 32.f);
        const float ang = (float)p.positions[m] * inv_freq; ((float*)(ws + WS_CS))[i] = cosf(ang); ((float*)(ws + WS_SN))[i] = sinf(ang); }
    for (int i = gt; i < NL * 96 * 128; i += NGT) { const int l = i / (96 * 128), r = i % (96 * 128); ((u32x4*)(ws + WS_WIN + (size_t)l * 6144 * 2048 + (size_t)2976 * 2048))[r] = (u32x4){0u, 0u, 0u, 0u}; }
    for (int i = gt; i < NL * 48 * 1024; i += NGT) { const int l = i / (48 * 1024), r = i % (48 * 1024), o = r >> 10, k = r & 1023;
        const float v = o < 32 ? p.router_e_w[((size_t)l * D + k) * 32 + o] : (o < 36 ? p.router_g_w[((size_t)l * D + k) * 4 + (o - 32)] : 0.f);
        ((bf16*)(ws + WS_WRT))[i] = (bf16)(cvtpk(v, 0.f) & 0xffffu); }
    for (int i = gt; i < NL * 1024 * 16; i += NGT) { const int rr = i >> 4, q = i & 15; ((u32x4*)(ws + WS_WUKV + (size_t)rr * 512 + 256))[q] = (u32x4){0u, 0u, 0u, 0u}; }
    LAS float* scr = (LAS float*)(F.lds + 49152 + F.wave * 8448);
    for (int it = F.gw; it < IT_TOTAL; it += F.NGW) {
        const int l = it / IT_LAYER; int r = it % IT_LAYER;
        if (r < IT_IN1) { const int kb = r / 93, nb = r % 93, n0 = 32 * nb;
            const int sc0 = n0 < 1024 ? (n0 & ~255) + 64 * ((n0 >> 5) & 3) + 32 * ((n0 >> 7) & 1) : n0;
            transpose_blk(p.w_in + (size_t)l * D * 6048, 6048, sc0, 64 * kb, (bf16*)(ws + WS_WIN) + (size_t)l * 6144 * 1024, n0, 1024, nullptr, scr, F.lane); continue; } r -= IT_IN1;
        if (r < IT_IN2) { transpose_item(p.w_in + (size_t)l * D * 6048, 1024, 6048, 2976, 3072, (bf16*)(ws + WS_WIN) + (size_t)l * 6144 * 1024, 3072, scr, r, F.lane); continue; } r -= IT_IN2;
        if (r < IT_UQ) { const int kb = r / 24, nb = r % 24, n0 = 32 * nb, tt = n0 >> 8, bj = (n0 >> 7) & 1, wc = (n0 >> 5) & 3;
            const int sc0 = tt < 2 ? (4 * tt + wc) * 96 + 32 * bj : (4 * bj + wc) * 96 + 64;
            transpose_blk(p.mla_w_uq + (size_t)l * 256 * 768, 768, sc0, 64 * kb, (bf16*)(ws + WS_WUQ) + (size_t)l * 768 * 256, n0, 256, p.mla_lat_g + l * 384, scr, F.lane); continue; } r -= IT_UQ;
        if (r < IT_UKV) { const int kb = r / 32, nb = r % 32, n0 = 32 * nb, tt = n0 >> 8, bj = (n0 >> 7) & 1, wc = (n0 >> 5) & 3;
            const int sc0 = tt < 2 ? (4 * tt + wc) * 128 + 32 * bj : (4 * (tt - 2) + wc) * 128 + 64 + 32 * bj;
            transpose_blk(p.mla_w_ukv + (size_t)l * 128 * 1024, 1024, sc0, 64 * kb, (bf16*)(ws + WS_WUKV) + (size_t)l * 1024 * 256, n0, 256, p.mla_lat_g + l * 384 + 256, scr, F.lane); continue; } r -= IT_UKV;
        if (r < 3 * IT_BR) { const int n = r / IT_BR; transpose_item(p.w_branch + ((size_t)l * 3 + n) * 512 * 1024, 512, 1024, 0, 1024, (bf16*)(ws + WS_WBR) + ((size_t)l * 3 + n) * 1024 * 512, 0, scr, r % IT_BR, F.lane); continue; } r -= 3 * IT_BR;
        if (r < IT_OUT) { transpose_item(p.w_out + (size_t)l * D * D, 1024, 1024, 0, 1024, (bf16*)(ws + WS_WOUT) + (size_t)l * D * D, 0, scr, r, F.lane); continue; } r -= IT_OUT;
        const int e = r / IT_EXP, q = r % IT_EXP; const size_t le = (size_t)l * 32 + e;
        if (q < 256) { const int jj = q >> 6; const float* src = ((jj & 1) ? p.w_e_up : p.w_e_gate) + le * 1024 * 256;
            transpose_item(src, 1024, 256, (jj >> 1) * 128, 128, (bf16*)(ws + WS_WGU) + le * 512 * 1024, jj * 128, scr, q & 63, F.lane); }
        else transpose_item(p.w_e_down + le * 256 * 1024, 256, 1024, 0, 1024, (bf16*)(ws + WS_WDN) + le * 1024 * 256, 0, scr, q - 256, F.lane);
    }
}

template <int MODE>
__device__ __forceinline__ void row_normmod(Frame& F, const float* xin, float* X, const bf16* Z, const float* gateprev, const float* g, const float* shift, const float* scale, bf16* H, float* out) {
    constexpr int R = 2;
    for (int m0 = F.gw; m0 < M; m0 += R * F.NGW) {
        f32x4 v[R][4]; u32x2 z0[R][4], z1[R][4];
#pragma unroll
        for (int r = 0; r < R; ++r) { const int m = m0 + r * F.NGW;
#pragma unroll
            for (int j = 0; j < 4; ++j) { const int d = 4 * F.lane + 256 * j;
                if (MODE == 0) v[r][j] = *(const GAS f32x4*)(xin + (size_t)m * D + d); else v[r][j] = *(const GAS f32x4*)(X + (size_t)m * D + d);
                if (MODE >= 2) { z0[r][j] = *(const GAS u32x2*)(Z + (size_t)(2 * m) * D + d); z1[r][j] = *(const GAS u32x2*)(Z + (size_t)(2 * m + 1) * D + d); } } }
#pragma unroll
        for (int r = 0; r < R; ++r) { const int m = m0 + r * F.NGW; const int b = m / S;
#pragma unroll
            for (int j = 0; j < 4; ++j) { const int d = 4 * F.lane + 256 * j;
                if (MODE >= 2) { const f32x4 gt = *(const GAS f32x4*)(gateprev + (size_t)b * 6 * D + d);
                    v[r][j].x += gt.x * (bf_lo(z0[r][j].x) + bf_lo(z1[r][j].x)); v[r][j].y += gt.y * (bf_hi(z0[r][j].x) + bf_hi(z1[r][j].x));
                    v[r][j].z += gt.z * (bf_lo(z0[r][j].y) + bf_lo(z1[r][j].y)); v[r][j].w += gt.w * (bf_hi(z0[r][j].y) + bf_hi(z1[r][j].y)); }
                if (MODE == 0 || MODE == 2) st16f(X + (size_t)m * D + d, v[r][j]);
                if (MODE == 3) *(GAS f32x4*)(out + (size_t)m * D + d) = v[r][j]; }
            if (MODE == 3) continue;
            float s = 0.f;
#pragma unroll
            for (int j = 0; j < 4; ++j) s += (v[r][j].x * v[r][j].x + v[r][j].y * v[r][j].y) + (v[r][j].z * v[r][j].z + v[r][j].w * v[r][j].w);
            const float rstd = rsqrtf(wave_sum(s) * (1.f / D) + 1e-6f);
#pragma unroll
            for (int j = 0; j < 4; ++j) { const int d = 4 * F.lane + 256 * j;
                const f32x4 gg = *(const GAS f32x4*)(g + d), sc = *(const GAS f32x4*)(scale + (size_t)b * 6 * D + d), sh = *(const GAS f32x4*)(shift + (size_t)b * 6 * D + d);
                const float o0 = v[r][j].x * rstd * gg.x * (1.f + sc.x) + sh.x, o1 = v[r][j].y * rstd * gg.y * (1.f + sc.y) + sh.y, o2 = v[r][j].z * rstd * gg.z * (1.f + sc.z) + sh.z, o3 = v[r][j].w * rstd * gg.w * (1.f + sc.w) + sh.w;
                u32x2 o; o.x = cvtpk(o0, o1); o.y = cvtpk(o2, o3); st8x(H + (size_t)m * D + d, o); }
        }
    }
}

struct SchedDense {
    static constexpr bool GATHER = false;
    __device__ __forceinline__ void a_ready(const GUnit&) const {}
    __device__ __forceinline__ void done(const GUnit&) const {}
    const char* A; const char* B; unsigned lda_b, ldb_b; int nM, nN, nt, G, c;
    __device__ __forceinline__ bool next(int i, GUnit& u) const {
        const long L = (long)i * G + c; const int nwg = nM * nN; if (L >= nwg) return false;
        int wgid = (int)L; { const int q = nwg / 8, r = nwg % 8, xcd = wgid % 8, off = wgid / 8; wgid = (xcd < r ? xcd * (q + 1) : r * (q + 1) + (xcd - r) * q) + off; }
        const int nig = 8 * nN, gid = wgid / nig, fm = gid * 8, gsz = (nM - fm) < 8 ? (nM - fm) : 8;
        const int pm = fm + ((wgid % nig) % gsz), pn = (wgid % nig) / gsz;
        u.A = A + (size_t)pm * 256 * lda_b; u.B = B + (size_t)pn * 256 * ldb_b; u.nt = nt; u.i0 = pm; u.i1 = pn; u.i2 = 0; return true;
    }
    __device__ __forceinline__ void offs(const GUnit&, int R0, int R1, int C0, int C1, unsigned (&oA)[2][2]) const {
        oA[0][0] = (unsigned)R0 * lda_b + C0 * 2u; oA[0][1] = (unsigned)R1 * lda_b + C1 * 2u; oA[1][0] = (unsigned)(R0 + 128) * lda_b + C0 * 2u; oA[1][1] = (unsigned)(R1 + 128) * lda_b + C1 * 2u; }
    __device__ __forceinline__ unsigned ldb_bytes() const { return ldb_b; }
};
struct SchedDensePub : SchedDense {
    unsigned* cnt;
    __device__ __forceinline__ void done(const GUnit& u) const { asm volatile("s_waitcnt vmcnt(0)" ::: "memory"); if ((threadIdx.x & 63) == 0) __hip_atomic_fetch_add(cnt + (u.i0 >> 3), 1u, __ATOMIC_RELAXED, __HIP_MEMORY_SCOPE_AGENT); }
};
struct EpiStoreBf16 {
    bf16* O0; bf16* O1; int split, ldc0, ldc1;
    __device__ __forceinline__ void operator()(const f32x4 (&acc)[2][2][4][2], const GUnit& u, int wr, int wc, int fr, int fq) const {
        const int pn = u.i1; bf16* base; int ldc; if (pn < split) { base = O0 + 256 * pn; ldc = ldc0; } else { base = O1 + 256 * (pn - split); ldc = ldc1; }
        const int row0 = u.i0 * 256 + wr * 64 + fr, col0 = wc * 32 + 8 * fq;
#pragma unroll
        for (int ai = 0; ai < 2; ++ai)
#pragma unroll
            for (int m = 0; m < 4; ++m) { bf16* rowp = base + (size_t)(row0 + ai * 128 + m * 16) * ldc + col0;
#pragma unroll
                for (int bj = 0; bj < 2; ++bj) { const f32x4 v0 = acc[ai][bj][m][0], v1 = acc[ai][bj][m][1];
                    u32x4 w; w.x = cvtpk(v0[0], v0[1]); w.y = cvtpk(v0[2], v0[3]); w.z = cvtpk(v1[0], v1[1]); w.w = cvtpk(v1[2], v1[3]);
                    st16(rowp + bj * 128, w); } }
    }
};
struct EpiG1 {
    bf16* Y1; bf16* XG; bf16* KR; float* ST; const float* gq; const float* kg; const float* CS; const float* SN;
    __device__ __forceinline__ void operator()(const f32x4 (&acc)[2][2][4][2], const GUnit& u, int wr, int wc, int fr, int fq) const {
        const int pn = u.i1; const int row0 = u.i0 * 256 + wr * 64 + fr;
        if (pn < 4) {
            const float* g = gq + (pn >> 1) * 64; const float mul = pn < 2 ? 0.125f * LOG2E : 1.f;
            f32x4 gv[2][2];
#pragma unroll
            for (int bj = 0; bj < 2; ++bj)
#pragma unroll
                for (int n = 0; n < 2; ++n) gv[bj][n] = *(const GAS f32x4*)(g + 32 * bj + 8 * fq + 4 * n);
#pragma unroll
            for (int ai = 0; ai < 2; ++ai)
#pragma unroll
                for (int m = 0; m < 4; ++m) {
                    float s = 0.f;
#pragma unroll
                    for (int bj = 0; bj < 2; ++bj)
#pragma unroll
                        for (int n = 0; n < 2; ++n) { const f32x4 v = acc[ai][bj][m][n]; s += (v[0] * v[0] + v[1] * v[1]) + (v[2] * v[2] + v[3] * v[3]); }
                    s += sw<16>(s); s = xsum32(s);
                    const float rstd = rsqrtf(s * (1.f / 64.f) + 1e-6f) * mul;
                    bf16* rowp = Y1 + (size_t)(row0 + ai * 128 + m * 16) * 3072 + 256 * pn + 64 * wc + 8 * fq;
#pragma unroll
                    for (int bj = 0; bj < 2; ++bj) { const f32x4 v0 = acc[ai][bj][m][0] * rstd * gv[bj][0], v1 = acc[ai][bj][m][1] * rstd * gv[bj][1];
                        u32x4 w; w.x = cvtpk(v0[0], v0[1]); w.y = cvtpk(v0[2], v0[3]); w.z = cvtpk(v1[0], v1[1]); w.w = cvtpk(v1[2], v1[3]);
                        st16(rowp + 32 * bj, w); }
                }
            return;
        }
        bf16* base = pn < 12 ? Y1 + 256 * pn : XG + 256 * (pn - 12); const int col0 = wc * 32 + 8 * fq;
#pragma unroll
        for (int ai = 0; ai < 2; ++ai)
#pragma unroll
            for (int m = 0; m < 4; ++m) { bf16* rowp = base + (size_t)(row0 + ai * 128 + m * 16) * 3072 + col0;
#pragma unroll
                for (int bj = 0; bj < 2; ++bj) { const f32x4 v0 = acc[ai][bj][m][0], v1 = acc[ai][bj][m][1];
                    u32x4 w; w.x = cvtpk(v0[0], v0[1]); w.y = cvtpk(v0[2], v0[3]); w.z = cvtpk(v1[0], v1[1]); w.w = cvtpk(v1[2], v1[3]);
                    st16(rowp + bj * 128, w); } }
        if (pn == 10 || pn == 11) {
#pragma unroll
            for (int ai = 0; ai < 2; ++ai)
#pragma unroll
                for (int m = 0; m < 4; ++m) { float s = 0.f;
#pragma unroll
                    for (int bj = 0; bj < 2; ++bj) { if (pn == 11 && bj == 1) continue;
#pragma unroll
                        for (int n = 0; n < 2; ++n) { const f32x4 v = acc[ai][bj][m][n]; s += (v[0] * v[0] + v[1] * v[1]) + (v[2] * v[2] + v[3] * v[3]); } }
                    s += sw<16>(s); s = xsum32(s);
                    if (fq == 0) ST[(size_t)(row0 + ai * 128 + m * 16) * 8 + (pn - 10) * 4 + wc] = s; }
        }
        if (pn == 11 && wc == 0) {
            f32x4 g0 = *(const GAS f32x4*)(kg + 64 + 8 * fq), g1 = *(const GAS f32x4*)(kg + 64 + 8 * fq + 4);
#pragma unroll
            for (int ai = 0; ai < 2; ++ai)
#pragma unroll
                for (int m = 0; m < 4; ++m) { const size_t row = row0 + ai * 128 + m * 16;
                    f32x4 v0 = acc[ai][1][m][0], v1 = acc[ai][1][m][1];
                    float s = (v0[0] * v0[0] + v0[1] * v0[1]) + (v0[2] * v0[2] + v0[3] * v0[3]) + (v1[0] * v1[0] + v1[1] * v1[1]) + (v1[2] * v1[2] + v1[3] * v1[3]);
                    s += sw<16>(s); s = xsum32(s);
                    const float rstd = rsqrtf(s * (1.f / 32.f) + 1e-6f);
                    v0 = v0 * rstd * g0; v1 = v1 * rstd * g1;
                    const f32x4 c0 = *(const GAS f32x4*)(CS + row * 16 + 8 * (fq & 1)), c1 = *(const GAS f32x4*)(CS + row * 16 + 8 * (fq & 1) + 4);
                    const f32x4 s0 = *(const GAS f32x4*)(SN + row * 16 + 8 * (fq & 1)), s1 = *(const GAS f32x4*)(SN + row * 16 + 8 * (fq & 1) + 4);
                    f32x4 o0, o1;
#pragma unroll
                    for (int i = 0; i < 4; ++i) { const float p0 = xget32(v0[i], fq >= 2), p1 = xget32(v1[i], fq >= 2);
                        o0[i] = fq < 2 ? v0[i] * c0[i] - p0 * s0[i] : v0[i] * c0[i] + p0 * s0[i]; o1[i] = fq < 2 ? v1[i] * c1[i] - p1 * s1[i] : v1[i] * c1[i] + p1 * s1[i]; }
                    u32x4 w; w.x = cvtpk(o0[0], o0[1]); w.y = cvtpk(o0[2], o0[3]); w.z = cvtpk(o1[0], o1[1]); w.w = cvtpk(o1[2], o1[3]);
                    *(GAS u32x4*)(KR + row * 32 + 8 * fq) = w; }
        }
    }
};
template <int WHICH>
struct EpiG2 {
    bf16* O; const float* ST; const float* g; const float* CS; const float* SN;
    __device__ __forceinline__ void operator()(const f32x4 (&acc)[2][2][4][2], const GUnit& u, int wr, int wc, int fr, int fq) const {
        const int pn = u.i1; const int row0 = u.i0 * 256 + wr * 64 + fr; const float qs = 0.10206207261596577f * LOG2E;
#pragma unroll
        for (int ai = 0; ai < 2; ++ai)
#pragma unroll
            for (int m = 0; m < 4; ++m) { const size_t row = row0 + ai * 128 + m * 16;
                const f32x4 sp = *(const GAS f32x4*)(ST + row * 8 + WHICH * 4);
                const float r0 = rsqrtf(((sp[0] + sp[1]) + (sp[2] + sp[3])) * (WHICH ? 1.f / 128.f : 1.f / 256.f) + 1e-6f);
                f32x4 v[2][2];
#pragma unroll
                for (int bj = 0; bj < 2; ++bj)
#pragma unroll
                    for (int n = 0; n < 2; ++n) v[bj][n] = acc[ai][bj][m][n] * r0;
                if (pn < 2) {
                    float s = 0.f;
#pragma unroll
                    for (int bj = 0; bj < 2; ++bj)
#pragma unroll
                        for (int n = 0; n < 2; ++n) s += (v[bj][n][0] * v[bj][n][0] + v[bj][n][1] * v[bj][n][1]) + (v[bj][n][2] * v[bj][n][2] + v[bj][n][3] * v[bj][n][3]);
                    s += sw<16>(s); s = xsum32(s);
                    const float rstd = rsqrtf(s * (1.f / 64.f) + 1e-6f) * (WHICH ? 1.f : qs);
                    bf16* op = O + row * (WHICH ? 1024 : 768) + (4 * pn + wc) * (WHICH ? 128 : 96) + 8 * fq;
#pragma unroll
                    for (int bj = 0; bj < 2; ++bj) { const f32x4 g0 = *(const GAS f32x4*)(g + 32 * bj + 8 * fq), g1 = *(const GAS f32x4*)(g + 32 * bj + 8 * fq + 4);
                        const f32x4 a = v[bj][0] * rstd * g0, b = v[bj][1] * rstd * g1;
                        u32x4 w; w.x = cvtpk(a[0], a[1]); w.y = cvtpk(a[2], a[3]); w.z = cvtpk(b[0], b[1]); w.w = cvtpk(b[2], b[3]);
                        st16(op + 32 * bj, w); }
                } else if (WHICH == 1) {
                    bf16* op = O + row * 1024 + (4 * (pn - 2) + wc) * 128 + 64 + 8 * fq;
#pragma unroll
                    for (int bj = 0; bj < 2; ++bj) { u32x4 w; w.x = cvtpk(v[bj][0][0], v[bj][0][1]); w.y = cvtpk(v[bj][0][2], v[bj][0][3]); w.z = cvtpk(v[bj][1][0], v[bj][1][1]); w.w = cvtpk(v[bj][1][2], v[bj][1][3]);
                        st16(op + 32 * bj, w); }
                } else {
                    const f32x4 c0 = *(const GAS f32x4*)(CS + row * 16 + 8 * (fq & 1)), c1 = *(const GAS f32x4*)(CS + row * 16 + 8 * (fq & 1) + 4);
                    const f32x4 s0 = *(const GAS f32x4*)(SN + row * 16 + 8 * (fq & 1)), s1 = *(const GAS f32x4*)(SN + row * 16 + 8 * (fq & 1) + 4);
                    const f32x4 g0 = *(const GAS f32x4*)(g + 64 + 8 * fq), g1 = *(const GAS f32x4*)(g + 64 + 8 * fq + 4);
#pragma unroll
                    for (int bj = 0; bj < 2; ++bj) {
                        float s = (v[bj][0][0] * v[bj][0][0] + v[bj][0][1] * v[bj][0][1]) + (v[bj][0][2] * v[bj][0][2] + v[bj][0][3] * v[bj][0][3]) + (v[bj][1][0] * v[bj][1][0] + v[bj][1][1] * v[bj][1][1]) + (v[bj][1][2] * v[bj][1][2] + v[bj][1][3] * v[bj][1][3]);
                        s += sw<16>(s); s = xsum32(s);
                        const float rstd = rsqrtf(s * (1.f / 32.f) + 1e-6f) * qs;
                        const f32x4 a = v[bj][0] * rstd * g0, b = v[bj][1] * rstd * g1; f32x4 o0, o1;
#pragma unroll
                        for (int i = 0; i < 4; ++i) { const float p0 = xget32(a[i], fq >= 2), p1 = xget32(b[i], fq >= 2);
                            o0[i] = fq < 2 ? a[i] * c0[i] - p0 * s0[i] : a[i] * c0[i] + p0 * s0[i]; o1[i] = fq < 2 ? b[i] * c1[i] - p1 * s1[i] : b[i] * c1[i] + p1 * s1[i]; }
                        u32x4 w; w.x = cvtpk(o0[0], o0[1]); w.y = cvtpk(o0[2], o0[3]); w.z = cvtpk(o1[0], o1[1]); w.w = cvtpk(o1[2], o1[3]);
                        st16(O + row * 768 + (4 * bj + wc) * 96 + 64 + 8 * fq, w); }
                }
            }
    }
};
struct EpiG2Both {
    EpiG2<0> q; EpiG2<1> kv;
    __device__ __forceinline__ void operator()(const f32x4 (&acc)[2][2][4][2], const GUnit& u, int wr, int wc, int fr, int fq) const { if (u.i2) kv(acc, u, wr, wc, fr, fq); else q(acc, u, wr, wc, fr, fq); }
};
}
namespace fk {
typedef short v4i16_t __attribute__((ext_vector_type(4)));
typedef LAS const char* lds_cptr;
__device__ __forceinline__ float grp_sum(float s, int lanes) {
    if (lanes > 1) s += sw<1>(s); if (lanes > 2) s += sw<2>(s); if (lanes > 4) s += sw<4>(s);
    if (lanes > 8) s += sw<8>(s); if (lanes > 16) s += sw<16>(s); if (lanes > 32) s = xsum32(s);
    return s;
}
__device__ __forceinline__ void unpack8(const u32x4 w, float (&v)[8]) { v[0] = bf_lo(w.x); v[1] = bf_hi(w.x); v[2] = bf_lo(w.y); v[3] = bf_hi(w.y); v[4] = bf_lo(w.z); v[5] = bf_hi(w.z); v[6] = bf_lo(w.w); v[7] = bf_hi(w.w); }
__device__ __forceinline__ u32x4 pack8(const float (&v)[8]) { u32x4 w; w.x = cvtpk(v[0], v[1]); w.y = cvtpk(v[2], v[3]); w.z = cvtpk(v[4], v[5]); w.w = cvtpk(v[6], v[7]); return w; }
__device__ __forceinline__ void norm8(float (&v)[8], int lanes, float inv_width, const float* g, float mul) {
    float s = 0.f;
#pragma unroll
    for (int t = 0; t < 8; ++t) s += v[t] * v[t];
    const float rstd = rsqrtf(grp_sum(s, lanes) * inv_width + 1e-6f) * mul;
#pragma unroll
    for (int t = 0; t < 8; ++t) v[t] = v[t] * rstd * g[t];
}
__device__ __forceinline__ void rope8(float (&v)[8], int j, const float* cs, const float* sn) {
    const int i0 = 8 * (j & 1);
#pragma unroll
    for (int t = 0; t < 8; ++t) { const float o = sw<2>(v[t]); const float c = cs[i0 + t], s = sn[i0 + t]; v[t] = (j < 2) ? (v[t] * c - o * s) : (v[t] * c + o * s); }
}
__device__ __forceinline__ void prep1(Frame& F, const Params& p, int l) {
    bf16* Y1 = (bf16*)(F.ws + WS_Y1); bf16* KR = (bf16*)(F.ws + WS_KR); const float* CS = (const float*)(F.ws + WS_CS); const float* SN = (const float*)(F.ws + WS_SN);
    const float* gq = p.diff_qk_g + l * 128; const float* gk = gq + 64; const float* latg = p.mla_lat_g + l * 384; const float* kg = p.mla_qk_g + l * 192 + 96;
    const int ln = F.lane;
    const int seg = ln < 32 ? 0 : (ln < 48 ? 1 : (ln < 52 ? 2 : 3)); const int j3 = seg == 0 ? ln : (seg == 1 ? ln - 32 : ln - 48);
    const int off3 = seg == 0 ? 2560 + 8 * j3 : (seg == 1 ? 2816 + 8 * j3 : 2944 + 8 * (j3 & 3));
    const float* g3 = seg == 0 ? latg + 8 * j3 : (seg == 1 ? latg + 256 + 8 * j3 : kg + 64 + 8 * (j3 & 3));
    constexpr int R = 2;
    for (int m0 = F.gw; m0 < M; m0 += R * F.NGW) {
        u32x4 wq[R], wk[R], w3[R];
#pragma unroll
        for (int r = 0; r < R; ++r) { bf16* y = Y1 + (size_t)(m0 + r * F.NGW) * 3072; wq[r] = *(GAS u32x4*)(y + 8 * ln); wk[r] = *(GAS u32x4*)(y + 512 + 8 * ln); w3[r] = *(GAS u32x4*)(y + off3); }
#pragma unroll
        for (int r = 0; r < R; ++r) { const int m = m0 + r * F.NGW; bf16* y = Y1 + (size_t)m * 3072; float v[8];
            unpack8(wq[r], v); norm8(v, 8, 1.f / 64.f, gq + (8 * ln & 63), 0.125f * LOG2E); *(GAS u32x4*)(y + 8 * ln) = pack8(v);
            unpack8(wk[r], v); norm8(v, 8, 1.f / 64.f, gk + (8 * ln & 63), 1.f); *(GAS u32x4*)(y + 512 + 8 * ln) = pack8(v);
            unpack8(w3[r], v);
            float s = 0.f;
#pragma unroll
            for (int t = 0; t < 8; ++t) s += v[t] * v[t];
            s += sw<1>(s); s += sw<2>(s); const float s4 = s; s += sw<4>(s); s += sw<8>(s); const float s16 = s; s += sw<16>(s); const float s32 = s;
            const float rstd = seg == 0 ? rsqrtf(s32 * (1.f / 256.f) + 1e-6f) : (seg == 1 ? rsqrtf(s16 * (1.f / 128.f) + 1e-6f) : rsqrtf(s4 * (1.f / 32.f) + 1e-6f));
#pragma unroll
            for (int t = 0; t < 8; ++t) v[t] = v[t] * rstd * g3[t];
            if (seg <= 1) *(GAS u32x4*)(y + off3) = pack8(v);
            { float vr[8];
#pragma unroll
              for (int t = 0; t < 8; ++t) vr[t] = v[t];
              rope8(vr, j3 & 3, CS + (size_t)m * 16, SN + (size_t)m * 16);
              if (seg == 2) *(GAS u32x4*)(KR + (size_t)m * 32 + 8 * j3) = pack8(vr); }
        }
    }
}
__device__ __forceinline__ void prep2(Frame& F, const Params& p, int l) {
    bf16* QC = (bf16*)(F.ws + WS_QC); bf16* KVC = (bf16*)(F.ws + WS_KVC); const float* CS = (const float*)(F.ws + WS_CS); const float* SN = (const float*)(F.ws + WS_SN);
    const float* g0 = p.mla_qk_g + l * 192; const float* g1 = g0 + 96; const int ln = F.lane; const float qs = 0.10206207261596577f * LOG2E;
    constexpr int R = 2;
    const int qoff = (ln >> 3) * 96 + (ln & 7) * 8, roff = ((ln & 31) >> 2) * 96 + 64 + (ln & 3) * 8, koff = (ln >> 3) * 128 + (ln & 7) * 8;
    for (int m0 = F.gw; m0 < M; m0 += R * F.NGW) {
        u32x4 wq[R], wr[R], wk[R];
#pragma unroll
        for (int r = 0; r < R; ++r) { const size_t m = m0 + r * F.NGW; wq[r] = *(GAS u32x4*)(QC + m * 768 + qoff); wr[r] = *(GAS u32x4*)(QC + m * 768 + roff); wk[r] = *(GAS u32x4*)(KVC + m * 1024 + koff); }
#pragma unroll
        for (int r = 0; r < R; ++r) { const size_t m = m0 + r * F.NGW; float v[8];
            unpack8(wq[r], v); norm8(v, 8, 1.f / 64.f, g0 + (ln & 7) * 8, qs); *(GAS u32x4*)(QC + m * 768 + qoff) = pack8(v);
            unpack8(wr[r], v); norm8(v, 4, 1.f / 32.f, g0 + 64 + (ln & 3) * 8, qs); rope8(v, ln & 3, CS + m * 16, SN + m * 16); if (ln < 32) *(GAS u32x4*)(QC + m * 768 + roff) = pack8(v);
            unpack8(wk[r], v); norm8(v, 8, 1.f / 64.f, g1 + (ln & 7) * 8, 1.f); *(GAS u32x4*)(KVC + m * 1024 + koff) = pack8(v); }
    }
}

__device__ __forceinline__ int crow(int r, int hi) { return (r & 3) + 8 * (r >> 2) + 4 * hi; }
__device__ __forceinline__ s16x4 vtr(lds_cptr p) { return __builtin_bit_cast(s16x4, __builtin_amdgcn_ds_read_tr16_b64_v4i16((LAS v4i16_t*)p)); }
#define ATT_WAITV(n) asm volatile("s_waitcnt vmcnt(" #n ")" ::: "memory")
__device__ __forceinline__ void glds16(const void* gsrc, unsigned lds_dst) { unsigned keep;
    asm volatile("s_mov_b32 %0, m0\n\ts_mov_b32 m0, %2\n\ts_nop 0\n\tglobal_load_lds_dwordx4 %1, off\n\ts_mov_b32 m0, %0" : "=&s"(keep) : "v"(gsrc), "s"(lds_dst) : "memory"); }
template <bool DUAL>
__device__ __forceinline__ void attn_unit(Frame& F, const Params& p, int l, int b, int h, int qb) {
    constexpr int NQF = DUAL ? 4 : 6, NVB = DUAL ? 4 : 2, KP = DUAL ? 16 : 12, NP = DUAL ? 32 : 24, PP = NP / 8, SLOT = NP * 1024, NSLOT = 4;
    constexpr int QROWS = DUAL ? 128 : 256;
    int lane = F.lane; asm volatile("" : "+v"(lane));
    const int wid = F.wave, r32_ = lane & 31, hi_ = lane >> 5;
    const int wq = DUAL ? (wid & 3) : wid, map = DUAL ? (wid >> 2) : 0;
    const int q0 = qb * QROWS + wq * 32;
    const int cw = q0 >> 6, NT = ((qb * QROWS + QROWS) >> 6);
    const size_t tok0 = (size_t)b * S;
    LAS unsigned char* lds = F.lds; const unsigned lds0 = (unsigned)(uintptr_t)F.lds;
    LAS float* wsf = (LAS float*)(lds + TAB_OFF + 4096 + wid * 256);
    LAS float* tab = (LAS float*)(lds + TAB_OFF);
    const bf16* src[PP];
#pragma unroll
    for (int i = 0; i < PP; ++i) {
        const int x = wid * PP + i;
        if (DUAL) {
            const bf16* Y1 = (const bf16*)(F.ws + WS_Y1);
            if (x < KP) src[i] = Y1 + (tok0 + lane) * 3072 + 512 + h * 128 + (x >> 3) * 64 + (x & 7) * 8;
            else { const int v = x - KP; src[i] = Y1 + (tok0 + 16 * (v & 3) + (lane >> 2)) * 3072 + 1024 + h * 128 + (v >> 2) * 32 + (lane & 3) * 8; }
        } else {
            const bf16* KVC = (const bf16*)(F.ws + WS_KVC); const bf16* KR = (const bf16*)(F.ws + WS_KR);
            const int xx = x < 20 ? x : 0;
            if (xx < 8) src[i] = KVC + (tok0 + lane) * 1024 + h * 128 + xx * 8;
            else if (xx < 12) src[i] = KR + (tok0 + lane) * 32 + (xx - 8) * 8;
            else { const int v = xx - 12; src[i] = KVC + (tok0 + 16 * (v & 3) + (lane >> 2)) * 1024 + h * 128 + 64 + (v >> 2) * 32 + (lane & 3) * 8; }
        }
    }
    constexpr int TSTEP = DUAL ? 64 * 3072 : 0;
#define ATT_DMA(t, slot) do { _Pragma("unroll") for (int i_ = 0; i_ < PP; ++i_) { const int x_ = wid * PP + i_; \
        size_t step_; if (DUAL) step_ = (size_t)(t) * TSTEP; else { const int xx_ = x_ < 20 ? x_ : 0; step_ = (size_t)(t) * 64 * ((xx_ >= 8 && xx_ < 12) ? 32 : 1024); } \
        glds16(src[i_] + step_, (unsigned)__builtin_amdgcn_readfirstlane(lds0 + (unsigned)((slot) * SLOT + x_ * 1024))); } } while (0)
    bf16x8 qf[NQF];
    {
        const bf16* Qw = DUAL ? (const bf16*)(F.ws + WS_Y1) + (tok0 + q0 + r32_) * 3072 + h * 128 + map * 64 : (const bf16*)(F.ws + WS_QC) + (tok0 + q0 + r32_) * 768 + h * 96;
#pragma unroll
        for (int d0 = 0; d0 < NQF; ++d0) qf[d0] = *(const GAS bf16x8*)(Qw + d0 * 16 + hi_ * 8);
    }
    if (DUAL) { if (F.tid < 256) tab[F.tid] = ((const float*)(F.ws + WS_BT))[h * 256 + F.tid]; }
    VM_WAIT();
    ATT_DMA(0, 0); if (NT > 1) ATT_DMA(1, 1); if (NT > 2) ATT_DMA(2, 2);
    f32x16 o[NVB];
#pragma unroll
    for (int d = 0; d < NVB; ++d) o[d] = (f32x16){0.f, 0.f, 0.f, 0.f, 0.f, 0.f, 0.f, 0.f, 0.f, 0.f, 0.f, 0.f, 0.f, 0.f, 0.f, 0.f};
    float mrun = 0.f, lrun = 0.f;
    f32x16 negm = (f32x16){0.f, 0.f, 0.f, 0.f, 0.f, 0.f, 0.f, 0.f, 0.f, 0.f, 0.f, 0.f, 0.f, 0.f, 0.f, 0.f};
    const int vlane = ((lane >> 4) & 1) * 32 + (lane & 3) * 8 + (4 * hi_ + ((lane & 15) >> 2)) * 64;
    const int koff = (DUAL ? map * 8192 : 0) + hi_ * 1024 + r32_ * 16;
#define ATT_QK(P0, P1, slot) do { const lds_cptr kb_ = (lds_cptr)(lds + (slot) * SLOT + koff); \
        _Pragma("unroll") for (int d0 = 0; d0 < NQF; ++d0) { const bf16x8 k0_ = *(const LAS bf16x8*)(kb_ + d0 * 2048), k1_ = *(const LAS bf16x8*)(kb_ + d0 * 2048 + 512); \
            P0 = __builtin_amdgcn_mfma_f32_32x32x16_bf16(k0_, qf[d0], d0 == 0 ? negm : P0, 0, 0, 0); P1 = __builtin_amdgcn_mfma_f32_32x32x16_bf16(k1_, qf[d0], d0 == 0 ? negm : P1, 0, 0, 0); } } while (0)
    f32x16 p0, p1, n0, n1;
    p0 = negm; p1 = negm; n0 = negm; n1 = negm;
    if (NT > 2) { if (PP == 4) ATT_WAITV(8); else ATT_WAITV(6); } else if (NT > 1) { if (PP == 4) ATT_WAITV(4); else ATT_WAITV(3); } else ATT_WAITV(0);
    LDS_WAIT(); __builtin_amdgcn_s_barrier();
    ATT_QK(p0, p1, 0);
    for (int j = 0; j < NT; ++j) {
        const int sl = j & 3;
        if (j + 1 < NT) {
            if (j + 2 < NT) { if (PP == 4) ATT_WAITV(4); else ATT_WAITV(3); } else ATT_WAITV(0);
            LDS_WAIT(); __builtin_amdgcn_s_barrier();
            if (j + 3 < NT) ATT_DMA(j + 3, (j + 3) & 3);
        }
        if (j <= cw) {
            const bool nxt = (j + 1 <= cw);
            if (nxt) ATT_QK(n0, n1, (j + 1) & 3);
            if (DUAL) { if (j >= cw - 2) { const int base = 64 * j - (q0 + r32_) + 191 + 4 * hi_;
#pragma unroll
                for (int r = 0; r < 16; ++r) { const int kk = (r & 3) + 8 * (r >> 2); p0[r] += tab[base + kk]; p1[r] += tab[base + kk + 32]; } } }
            float ma = __builtin_fmaxf(__builtin_fmaxf(p0[0], p0[1]), p1[0]), mb = __builtin_fmaxf(__builtin_fmaxf(p0[2], p0[3]), p1[1]); ma = __builtin_fmaxf(__builtin_fmaxf(ma, p1[2]), p1[3]);
#pragma unroll
            for (int r = 4; r < 16; r += 4) { ma = __builtin_fmaxf(__builtin_fmaxf(ma, p0[r]), p0[r + 1]); mb = __builtin_fmaxf(__builtin_fmaxf(mb, p0[r + 2]), p0[r + 3]);
                ma = __builtin_fmaxf(__builtin_fmaxf(ma, p1[r]), p1[r + 1]); mb = __builtin_fmaxf(__builtin_fmaxf(mb, p1[r + 2]), p1[r + 3]); }
            float mx = __builtin_fmaxf(ma, mb); mx = xmax32(mx);
            if (__builtin_expect(__any(mx > 8.f), 0)) {
                const float dl = __builtin_fmaxf(mx, 0.f), f = __builtin_amdgcn_exp2f(-dl); mrun += dl; lrun *= f;
#pragma unroll
                for (int r = 0; r < 16; ++r) { p0[r] -= dl; p1[r] -= dl; n0[r] -= dl; n1[r] -= dl; negm[r] = -mrun; }
                if (hi_ == 0) wsf[r32_] = f;
                LDS_WAIT();
#pragma unroll
                for (int r = 0; r < 16; ++r) { const float fr_ = wsf[crow(r, hi_)];
#pragma unroll
                    for (int d = 0; d < NVB; ++d) o[d][r] *= fr_; }
            }
            float ls = 0.f;
#pragma unroll
            for (int r = 0; r < 16; ++r) { p0[r] = __builtin_amdgcn_exp2f(p0[r]); p1[r] = __builtin_amdgcn_exp2f(p1[r]); ls += p0[r] + p1[r]; }
            lrun += ls;
            u32x4 pw0, pw1, pw2, pw3;
            pw0 = (u32x4){cvtpk(p0[0], p0[1]), cvtpk(p0[2], p0[3]), cvtpk(p0[4], p0[5]), cvtpk(p0[6], p0[7])};
            pw1 = (u32x4){cvtpk(p0[8], p0[9]), cvtpk(p0[10], p0[11]), cvtpk(p0[12], p0[13]), cvtpk(p0[14], p0[15])};
            pw2 = (u32x4){cvtpk(p1[0], p1[1]), cvtpk(p1[2], p1[3]), cvtpk(p1[4], p1[5]), cvtpk(p1[6], p1[7])};
            pw3 = (u32x4){cvtpk(p1[8], p1[9]), cvtpk(p1[10], p1[11]), cvtpk(p1[12], p1[13]), cvtpk(p1[14], p1[15])};
            const bf16x8 pa0 = __builtin_bit_cast(bf16x8, pw0), pa1 = __builtin_bit_cast(bf16x8, pw1), pa2 = __builtin_bit_cast(bf16x8, pw2), pa3 = __builtin_bit_cast(bf16x8, pw3);
            const lds_cptr vb = (lds_cptr)(lds + sl * SLOT + KP * 1024 + vlane);
            s16x4 vf[2][8];
#pragma unroll
            for (int ks = 0; ks < 4; ++ks) { vf[0][2 * ks] = vtr(vb + ks * 1024); vf[0][2 * ks + 1] = vtr(vb + ks * 1024 + 512); }
#pragma unroll
            for (int d = 0; d < NVB; ++d) {
                if (d + 1 < NVB) {
#pragma unroll
                    for (int ks = 0; ks < 4; ++ks) { vf[(d + 1) & 1][2 * ks] = vtr(vb + (d + 1) * 4096 + ks * 1024); vf[(d + 1) & 1][2 * ks + 1] = vtr(vb + (d + 1) * 4096 + ks * 1024 + 512); }
                }
#define ATT_PK(k) (bf16x8){vf[d & 1][2 * (k)][0], vf[d & 1][2 * (k)][1], vf[d & 1][2 * (k)][2], vf[d & 1][2 * (k)][3], vf[d & 1][2 * (k) + 1][0], vf[d & 1][2 * (k) + 1][1], vf[d & 1][2 * (k) + 1][2], vf[d & 1][2 * (k) + 1][3]}
                o[d] = __builtin_amdgcn_mfma_f32_32x32x16_bf16(pa0, ATT_PK(0), o[d], 0, 0, 0);
                o[d] = __builtin_amdgcn_mfma_f32_32x32x16_bf16(pa1, ATT_PK(1), o[d], 0, 0, 0);
                o[d] = __builtin_amdgcn_mfma_f32_32x32x16_bf16(pa2, ATT_PK(2), o[d], 0, 0, 0);
                o[d] = __builtin_amdgcn_mfma_f32_32x32x16_bf16(pa3, ATT_PK(3), o[d], 0, 0, 0);
#undef ATT_PK
                __builtin_amdgcn_sched_barrier(0);
            }
            p0 = n0; p1 = n1;
        }
    }
#undef ATT_QK
    int r32 = r32_, hi = hi_; asm volatile("" : "+v"(r32), "+v"(hi));
    lrun = xsum32(lrun);
    if (hi == 0) wsf[32 + r32] = __builtin_amdgcn_rcpf(lrun);
    LDS_WAIT();
    float rli[16];
#pragma unroll
    for (int r = 0; r < 16; ++r) rli[r] = wsf[32 + crow(r, hi)];
    __builtin_amdgcn_s_barrier();
    if (DUAL) {
        LAS float* stg = (LAS float*)(lds) + (size_t)wq * 32 * 132;
        if (map == 1) {
#pragma unroll
            for (int d = 0; d < NVB; ++d)
#pragma unroll
                for (int r = 0; r < 16; ++r) stg[crow(r, hi) * 132 + d * 32 + r32] = o[d][r] * rli[r];
        }
        LDS_WAIT(); __builtin_amdgcn_s_barrier();
        if (map == 0) {
            const float lam = ((const float*)(F.ws + WS_LAM))[l]; const float li = 1.f - (0.8f - 0.6f * __expf(-0.3f * (float)l));
            float ss[16];
#pragma unroll
            for (int r = 0; r < 16; ++r) { float s = 0.f;
#pragma unroll
                for (int d = 0; d < NVB; ++d) { const float v = o[d][r] * rli[r] - lam * stg[crow(r, hi) * 132 + d * 32 + r32]; o[d][r] = v; s += v * v; }
                ss[r] = s; }
#pragma unroll
            for (int r = 0; r < 16; ++r) { float s = ss[r]; s += sw<1>(s); s += sw<2>(s); s += sw<4>(s); s += sw<8>(s); s += sw<16>(s); ss[r] = rsqrtf(s * (1.f / 128.f) + 1e-6f) * li; }
            const float* og = p.diff_out_g + l * 128; bf16* OA = (bf16*)(F.ws + WS_OA) + (tok0 + q0) * 512 + h * 128;
            LAS bf16* st2 = (LAS bf16*)(lds + 69632) + wq * (32 * 136);
#pragma unroll
            for (int d = 0; d < NVB; ++d) { const float gg = og[d * 32 + r32];
#pragma unroll
                for (int r = 0; r < 16; ++r) st2[crow(r, hi) * 136 + d * 32 + r32] = (bf16)(cvtpk(o[d][r] * ss[r] * gg, 0.f) & 0xffffu); }
            LDS_WAIT();
#pragma unroll
            for (int i = 0; i < 8; ++i) { const int row = i * 4 + (lane >> 4), ch = lane & 15; const u32x4 v = *(const LAS u32x4*)(st2 + row * 136 + ch * 8); st16x(OA + (size_t)row * 512 + ch * 8, v); }
        }
    } else {
        LAS bf16* stg = (LAS bf16*)(lds) + wid * 2048;
#pragma unroll
        for (int r = 0; r < 16; ++r) { const int orow = crow(r, hi);
#pragma unroll
            for (int d = 0; d < NVB; ++d) stg[orow * 64 + d * 32 + r32] = (bf16)(cvtpk(o[d][r] * rli[r], 0.f) & 0xffffu); }
        LDS_WAIT();
        bf16* Ow = (bf16*)(F.ws + WS_OC) + (tok0 + q0) * 512 + h * 64;
#pragma unroll
        for (int i = 0; i < 4; ++i) { const int row = i * 8 + (lane >> 3), ch = lane & 7; const u32x4 v = *(const LAS u32x4*)(stg + row * 64 + ch * 8); st16x(Ow + (size_t)row * 512 + ch * 8, v); }
    }
    LDS_WAIT(); VM_WAIT(); __builtin_amdgcn_s_barrier();
#undef ATT_DMA
}
template <bool DUAL>
__device__ __forceinline__ void attn_phase(Frame& F, const Params& p, int l) {
    const int vcu = (F.G % 8 == 0) ? (F.bid % 8) * (F.G / 8) + F.bid / 8 : F.bid;
    if (DUAL) { for (int v = vcu; v < 256; v += F.G) { const int bh = v >> 3, s = v & 7; attn_unit<true>(F, p, l, bh >> 2, bh & 3, s); attn_unit<true>(F, p, l, bh >> 2, bh & 3, 15 - s); } }
    else { for (int v = vcu; v < 256; v += F.G) { const int bh = v >> 2, s = v & 3; attn_unit<false>(F, p, l, bh >> 3, bh & 7, s); attn_unit<false>(F, p, l, bh >> 3, bh & 7, 7 - s); } }
}
}
namespace fk {
__device__ __forceinline__ void sgu_unit(Frame& F, const Params& p, int l, int unit) {
    const int g = unit & 3, bn = unit >> 2; const size_t m0 = (size_t)bn * 128;
    int lane = threadIdx.x & 63; asm volatile("" : "+v"(lane));
    const int wid = F.wave, r32 = lane & 31, hi = lane >> 5; const int tid_ = wid * 64 + lane;
    LAS unsigned char* lds = F.lds; LAS unsigned char* Wt = lds; LAS unsigned char* Vt = lds + 32768;
    const bf16* Y1 = (const bf16*)(F.ws + WS_Y1);
    const float* vg = p.sgu_v_g + l * 512 + 8 * lane;
    u32x4 w16[16];
#pragma unroll
    for (int jj = 0; jj < 16; ++jj) w16[jj] = *(const GAS u32x4*)(Y1 + (m0 + wid * 16 + jj) * 3072 + 2048 + 8 * lane);
    const float* Wg = p.sgu_w + ((size_t)l * 4 + g) * 128 * 128;
    f32x4 wa[4], wb[4];
#pragma unroll
    for (int k = 0; k < 4; ++k) { const int item = tid_ + 512 * k, i = item & 127, cidx = item >> 7, ks = cidx >> 1, h2 = cidx & 1;
        wa[k] = *(const GAS f32x4*)(Wg + (size_t)i * 128 + 16 * ks + 4 * h2); wb[k] = *(const GAS f32x4*)(Wg + (size_t)i * 128 + 16 * ks + 8 + 4 * h2); }
    float vgv[8];
#pragma unroll
    for (int t = 0; t < 8; ++t) vgv[t] = vg[t];
#pragma unroll
    for (int jj = 0; jj < 16; ++jj) {
        const int j = wid * 16 + jj; float v[8]; unpack8(w16[jj], v);
        float s = 0.f;
#pragma unroll
        for (int t = 0; t < 8; ++t) { v[t] = gelu_tanh(v[t]); s += v[t] * v[t]; }
        const float rstd = rsqrtf(wave_sum(s) * (1.f / 512.f) + 1e-6f);
        if ((lane >> 4) == g) {
#pragma unroll
            for (int t = 0; t < 8; ++t) v[t] = v[t] * rstd * vgv[t];
            const int db = (lane & 15) >> 2;
            *(LAS u32x4*)(Vt + (db * 8 + (j >> 4)) * 1024 + (j & 15) * 64 + (lane & 3) * 16) = pack8(v);
        }
    }
#pragma unroll
    for (int k = 0; k < 4; ++k) {
        const int item = tid_ + 512 * k, i = item & 127, cidx = item >> 7, ks = cidx >> 1;
        const bool ok = (ks >> 2) <= (i >> 6);
        u32x4 w; w.x = ok ? cvtpk(wa[k].x, wa[k].y) : 0u; w.y = ok ? cvtpk(wa[k].z, wa[k].w) : 0u; w.z = ok ? cvtpk(wb[k].x, wb[k].y) : 0u; w.w = ok ? cvtpk(wb[k].z, wb[k].w) : 0u;
        *(LAS u32x4*)(Wt + cidx * 2048 + i * 16) = w;
    }
    const int ib = wid & 3, ch = wid >> 2;
    bf16 uraw[2][16];
#pragma unroll
    for (int dd = 0; dd < 2; ++dd)
#pragma unroll
        for (int r = 0; r < 16; ++r) uraw[dd][r] = Y1[(m0 + 32 * ib + crow(r, hi)) * 3072 + 1536 + 128 * g + 32 * (2 * ch + dd) + r32];
    __syncthreads();
    f32x16 acc[2];
    acc[0] = (f32x16){0.f, 0.f, 0.f, 0.f, 0.f, 0.f, 0.f, 0.f, 0.f, 0.f, 0.f, 0.f, 0.f, 0.f, 0.f, 0.f}; acc[1] = acc[0];
    const int vlane = ((lane >> 4) & 1) * 32 + (lane & 3) * 8 + (4 * hi + ((lane & 15) >> 2)) * 64;
#pragma unroll
    for (int ks = 0; ks < 8; ++ks) {
        const bf16x8 a = *(const LAS bf16x8*)(Wt + (2 * ks + hi) * 2048 + (32 * ib + r32) * 16);
#pragma unroll
        for (int dd = 0; dd < 2; ++dd) { const lds_cptr vb = (lds_cptr)(Vt + (2 * ch + dd) * 8192 + ks * 1024 + vlane);
            const s16x4 lo = vtr(vb), hh = vtr(vb + 512);
            acc[dd] = __builtin_amdgcn_mfma_f32_32x32x16_bf16(a, (bf16x8){lo[0], lo[1], lo[2], lo[3], hh[0], hh[1], hh[2], hh[3]}, acc[dd], 0, 0, 0); }
    }
    const float* bs = p.sgu_b + l * 512 + g * 128; bf16* OB = (bf16*)(F.ws + WS_OB);
#pragma unroll
    for (int dd = 0; dd < 2; ++dd)
#pragma unroll
        for (int r = 0; r < 16; ++r) { const int i = 32 * ib + crow(r, hi), c = 128 * g + 32 * (2 * ch + dd) + r32;
            const float u = gelu_tanh(bf2f(uraw[dd][r]));
            OB[(m0 + i) * 512 + c] = (bf16)(cvtpk(u * (acc[dd][r] + bs[i]), 0.f) & 0xffffu); }
    __syncthreads();
}

struct SchedG3 {
    static constexpr bool GATHER = false;
    __device__ __forceinline__ void a_ready(const GUnit&) const {}
    __device__ __forceinline__ void done(const GUnit&) const {}
    const char* OA; const char* WBR; int G, c;
    __device__ __forceinline__ bool next(int i, GUnit& u) const {
        const int tile = (i / 3) * G + c, n = i % 3; if (tile >= 256) return false;
        const int vt = (tile % 8) * 32 + tile / 8;
        const int pm = vt >> 2, pn = vt & 3;
        u.A = OA + (size_t)n * 16 * MiB + (size_t)pm * 256 * 1024; u.B = WBR + (size_t)n * MiB + (size_t)pn * 256 * 1024; u.nt = 8; u.i0 = pm; u.i1 = pn; u.i2 = n; return true;
    }
    __device__ __forceinline__ void offs(const GUnit&, int R0, int R1, int C0, int C1, unsigned (&oA)[2][2]) const {
        oA[0][0] = (unsigned)R0 * 1024u + C0 * 2u; oA[0][1] = (unsigned)R1 * 1024u + C1 * 2u; oA[1][0] = (unsigned)(R0 + 128) * 1024u + C0 * 2u; oA[1][1] = (unsigned)(R1 + 128) * 1024u + C1 * 2u; }
    __device__ __forceinline__ unsigned ldb_bytes() const { return 1024u; }
};
struct EpiG3 {
    const bf16* XG; bf16* MG;
    __device__ __forceinline__ void operator()(const f32x4 (&acc)[2][2][4][2], const GUnit& u, int wr, int wc, int fr, int fq) const {
        const int n = u.i2; const int row0 = u.i0 * 256 + wr * 64 + fr, col0 = u.i1 * 256 + wc * 32 + 8 * fq;
#pragma unroll
        for (int ai = 0; ai < 2; ++ai)
#pragma unroll
            for (int m = 0; m < 4; ++m) { const size_t row = row0 + ai * 128 + m * 16;
#pragma unroll
                for (int bj = 0; bj < 2; ++bj) { const int col = col0 + bj * 128;
                    float gv[8], pv[8], o[8]; unpack8(*(const GAS u32x4*)(XG + row * 3072 + n * 1024 + col), gv);
                    if (n > 0) unpack8(*(const GAS u32x4*)(MG + row * 1024 + col), pv);
                    const f32x4 v0 = acc[ai][bj][m][0], v1 = acc[ai][bj][m][1];
#pragma unroll
                    for (int t = 0; t < 8; ++t) { const float a = t < 4 ? v0[t & 3] : v1[t & 3]; o[t] = fast_sigmoid(gv[t]) * a + (n > 0 ? pv[t] : 0.f); }
                    *(GAS u32x4*)(MG + row * 1024 + col) = pack8(o); } }
    }
};
struct EpiG4 {
    float* X; const float* gate;
    __device__ __forceinline__ void operator()(const f32x4 (&acc)[2][2][4][2], const GUnit& u, int wr, int wc, int fr, int fq) const {
        const int row0 = u.i0 * 256 + wr * 64 + fr, col0 = u.i1 * 256 + wc * 32 + 8 * fq; const int b = (u.i0 * 256) / S;
#pragma unroll
        for (int bj = 0; bj < 2; ++bj) { const int col = col0 + bj * 128;
            const f32x4 g0 = *(const GAS f32x4*)(gate + (size_t)b * 6 * D + col), g1 = *(const GAS f32x4*)(gate + (size_t)b * 6 * D + col + 4);
#pragma unroll
            for (int ai = 0; ai < 2; ++ai)
#pragma unroll
                for (int m = 0; m < 4; ++m) { float* xp = X + (size_t)(row0 + ai * 128 + m * 16) * D + col;
                    f32x4 x0 = *(GAS f32x4*)xp, x1 = *(GAS f32x4*)(xp + 4);
                    x0 += g0 * acc[ai][bj][m][0]; x1 += g1 * acc[ai][bj][m][1];
                    st16f(xp, x0); st16f(xp + 4, x1); } }
    }
};
struct SchedG2 {
    static constexpr bool GATHER = false;
    __device__ __forceinline__ void a_ready(const GUnit&) const {}
    __device__ __forceinline__ void done(const GUnit&) const {}
    const char* Y1; const char* WUQ; const char* WUKV; int G, c;
    __device__ __forceinline__ bool next(int i, GUnit& u) const {
        const int L = i * G + c; if (L >= 448) return false;
        const bool kv = L >= 192; const int q = kv ? L - 192 : L; const int pm = kv ? (q >> 2) : q / 3, pn = kv ? (q & 3) : q % 3;
        u.A = Y1 + (size_t)pm * 256 * 6144 + (kv ? 2816 * 2 : 2560 * 2); u.B = (kv ? WUKV : WUQ) + (size_t)pn * 256 * 512; u.nt = 4; u.i0 = pm; u.i1 = pn; u.i2 = kv ? 1 : 0; return true;
    }
    __device__ __forceinline__ void offs(const GUnit&, int R0, int R1, int C0, int C1, unsigned (&oA)[2][2]) const {
        oA[0][0] = (unsigned)R0 * 6144u + C0 * 2u; oA[0][1] = (unsigned)R1 * 6144u + C1 * 2u; oA[1][0] = (unsigned)(R0 + 128) * 6144u + C0 * 2u; oA[1][1] = (unsigned)(R1 + 128) * 6144u + C1 * 2u; }
    __device__ __forceinline__ unsigned ldb_bytes() const { return 512u; }
};
}
namespace fk {
constexpr int HT_PITCH = 2064;
constexpr int RT_SMALL = 64 * HT_PITCH;
__device__ __forceinline__ void row_router(Frame& F, const Params& p, int l, const float* mod) {
    unsigned char* ws = F.ws; LAS unsigned char* HT = F.lds;
    const float* X = (const float*)(ws + WS_X); bf16* H = (bf16*)(ws + WS_H);
    const float* g = p.norm_g + (size_t)l * 2 * D + D; const float* shift = mod + 3 * D; const float* scale = mod + 4 * D;
    const float* bg = p.router_g_b + l * 4; const float* be = p.router_e_b + l * 32;
    unsigned* CNT = (unsigned*)(ws + WS_CTL) + CW_CNT + l * 32;
    int* LIST = (int*)(ws + WS_LIST); float* ROWW = (float*)(ws + WS_ROWW); int* TOKSLOT = (int*)(ws + WS_TOKSLOT);
    LAS int* rid = (LAS int*)(F.lds + RT_SMALL); LAS int* rrank = rid + 128; LAS float* rw = (LAS float*)(rrank + 128);
    LAS unsigned* cntl = (LAS unsigned*)(rw + 128); LAS unsigned* cbase = cntl + 32;
    if (F.tid < 32) cntl[F.tid] = 0u;
    constexpr int R = 2; int kk = 0;
    for (int m0 = F.gw; m0 < M; m0 += R * F.NGW, kk += R) {
        f32x4 v[R][4];
#pragma unroll
        for (int r = 0; r < R; ++r)
#pragma unroll
            for (int j = 0; j < 4; ++j) v[r][j] = *(const GAS f32x4*)(X + (size_t)(m0 + r * F.NGW) * D + 4 * F.lane + 256 * j);
#pragma unroll
        for (int r = 0; r < R; ++r) { const int m = m0 + r * F.NGW, b = m / S; float s = 0.f;
#pragma unroll
            for (int j = 0; j < 4; ++j) s += (v[r][j].x * v[r][j].x + v[r][j].y * v[r][j].y) + (v[r][j].z * v[r][j].z + v[r][j].w * v[r][j].w);
            const float rstd = rsqrtf(wave_sum(s) * (1.f / D) + 1e-6f);
            LAS unsigned char* hrow = HT + ((kk + r) * 8 + F.wave) * HT_PITCH;
#pragma unroll
            for (int j = 0; j < 4; ++j) { const int d = 4 * F.lane + 256 * j;
                const f32x4 gg = *(const GAS f32x4*)(g + d), sc = *(const GAS f32x4*)(scale + (size_t)b * 6 * D + d), sh = *(const GAS f32x4*)(shift + (size_t)b * 6 * D + d);
                const float o0 = v[r][j].x * rstd * gg.x * (1.f + sc.x) + sh.x, o1 = v[r][j].y * rstd * gg.y * (1.f + sc.y) + sh.y, o2 = v[r][j].z * rstd * gg.z * (1.f + sc.z) + sh.z, o3 = v[r][j].w * rstd * gg.w * (1.f + sc.w) + sh.w;
                u32x2 o; o.x = cvtpk(o0, o1); o.y = cvtpk(o2, o3); st8x(H + (size_t)m * D + d, o); *(LAS u32x2*)(hrow + d * 2) = o; }
        }
    }
    __syncthreads();
    const int tt = F.wave & 3, kh = F.wave >> 2, n16 = F.lane & 15, kq = F.lane >> 4;
    const bf16* WRT = (const bf16*)(ws + WS_WRT) + (size_t)l * 48 * 1024;
    f32x4 acc[3];
#pragma unroll
    for (int bl = 0; bl < 3; ++bl) acc[bl] = (f32x4){0.f, 0.f, 0.f, 0.f};
    const LAS unsigned char* hb = HT + (16 * tt + n16) * HT_PITCH + (512 * kh + 8 * kq) * 2;
    const bf16* wb = WRT + (size_t)n16 * 1024 + 512 * kh + 8 * kq;
#pragma unroll 4
    for (int ks = 0; ks < 16; ++ks) {
        const bf16x8 bfr = *(const LAS bf16x8*)(hb + ks * 64);
#pragma unroll
        for (int bl = 0; bl < 3; ++bl) { const bf16x8 afr = *(const GAS bf16x8*)(wb + (size_t)bl * 16 * 1024 + ks * 32);
            acc[bl] = __builtin_amdgcn_mfma_f32_16x16x32_bf16(afr, bfr, acc[bl], 0, 0, 0); }
    }
    __syncthreads();
    LAS float* LGP = (LAS float*)(F.lds);
    LAS float* LG = (LAS float*)(F.lds + 16384);
    if (kh == 1) {
#pragma unroll
        for (int bl = 0; bl < 3; ++bl)
#pragma unroll
            for (int q = 0; q < 4; ++q) LGP[((tt * 3 + bl) * 4 + q) * 64 + F.lane] = acc[bl][q];
    }
    __syncthreads();
    if (kh == 0) {
#pragma unroll
        for (int bl = 0; bl < 3; ++bl)
#pragma unroll
            for (int q = 0; q < 4; ++q) LG[(16 * tt + n16) * 48 + bl * 16 + 4 * kq + q] = acc[bl][q] + LGP[((tt * 3 + bl) * 4 + q) * 64 + F.lane];
    }
    __syncthreads();
    if (F.tid < 64) {
        const int slot = F.tid; const LAS float* lg = LG + slot * 48;
        const float g0 = lg[32] + bg[0], g1 = lg[33] + bg[1], g2 = lg[34] + bg[2], g3 = lg[35] + bg[3];
        int gi = 0; float mx = g0; if (g1 > mx) { mx = g1; gi = 1; } if (g2 > mx) { mx = g2; gi = 2; } if (g3 > mx) { mx = g3; gi = 3; }
        const float gw = 1.f / (__expf(g0 - mx) + __expf(g1 - mx) + __expf(g2 - mx) + __expf(g3 - mx));
        float e[8];
#pragma unroll
        for (int i = 0; i < 8; ++i) e[i] = lg[gi * 8 + i] + be[gi * 8 + i];
        float emx = e[0]; int e0 = 0;
#pragma unroll
        for (int i = 1; i < 8; ++i) if (e[i] > emx) { emx = e[i]; e0 = i; }
        float e2 = -1e30f; int e1 = 0;
#pragma unroll
        for (int i = 0; i < 8; ++i) if (i != e0 && e[i] > e2) { e2 = e[i]; e1 = i; }
        const float p1 = __expf(e2 - emx), w0 = 1.f / (1.f + p1), w1 = p1 / (1.f + p1);
        const int id0 = gi * 8 + e0, id1 = gi * 8 + e1;
        rid[2 * slot] = id0; rid[2 * slot + 1] = id1; rw[2 * slot] = gw * w0; rw[2 * slot + 1] = gw * w1;
        rrank[2 * slot] = (int)__hip_atomic_fetch_add(&cntl[id0], 1u, __ATOMIC_RELAXED, __HIP_MEMORY_SCOPE_WORKGROUP);
        rrank[2 * slot + 1] = (int)__hip_atomic_fetch_add(&cntl[id1], 1u, __ATOMIC_RELAXED, __HIP_MEMORY_SCOPE_WORKGROUP);
    }
    __syncthreads();
    if (F.tid < 32) { const unsigned c = cntl[F.tid]; cbase[F.tid] = c ? atomicAdd(&CNT[F.tid], c) : 0u; }
    __syncthreads();
    if (F.tid < 128) { const int slot = F.tid >> 1, id = rid[F.tid], pos = (int)cbase[id] + rrank[F.tid]; const int m = F.bid * NWAVES + (slot & 7) + (slot >> 3) * F.NGW;
        LIST[id * 16384 + pos] = m; ROWW[id * 16384 + pos] = rw[F.tid]; TOKSLOT[id * 16384 + pos] = 2 * m + (F.tid & 1); }
}
__device__ __forceinline__ void moe_table(Frame& F, int l) {
    LAS int* T = (LAS int*)(F.lds + TAB_OFF + 6144);
    int t = threadIdx.x; asm volatile("" : "+v"(t));
    if (t < 32) { const unsigned* CNT = (const unsigned*)(F.ws + WS_CTL) + CW_CNT + l * 32;
        T[t] = (int)__hip_atomic_load(CNT + t, __ATOMIC_RELAXED, __HIP_MEMORY_SCOPE_AGENT); }
    __syncthreads();
    if (t < 33) { int a = 0; for (int e = 0; e < t; ++e) a += (T[e] + 255) >> 8; T[32 + t] = a; }
    __syncthreads();
}
struct SchedG5 {
    static constexpr bool GATHER = true;
    const char* H; const char* WGU; const int* LIST; LAS const int* T; int G, c; unsigned* RDY;
    __device__ __forceinline__ void a_ready(const GUnit&) const {}
    __device__ __forceinline__ void done(const GUnit& u) const { asm volatile("s_waitcnt vmcnt(0)" ::: "memory"); if ((threadIdx.x & 63) == 0) __hip_atomic_fetch_add(RDY + u.i3, 1u, __ATOMIC_RELAXED, __HIP_MEMORY_SCOPE_AGENT); }
    __device__ __forceinline__ bool next(int i, GUnit& u) const {
        const int L = i * G + c; const int tot = __builtin_amdgcn_readfirstlane(T[64]); if (L >= 2 * tot) return false;
        const int mtg = L >> 1, ntile = L & 1; int e = 0;
#pragma unroll 1
        for (int k = 1; k < 32; ++k) if (__builtin_amdgcn_readfirstlane(T[32 + k]) <= mtg) e = k;
        const int tpe = __builtin_amdgcn_readfirstlane(T[32 + e]);
        u.A = H; u.B = WGU + ((size_t)e * 512 + ntile * 256) * 2048; u.nt = 16; u.i0 = e; u.i1 = mtg - tpe; u.i2 = ntile; u.i3 = mtg; return true;
    }
    __device__ __forceinline__ void offs(const GUnit& u, int R0, int R1, int C0, int C1, unsigned (&oA)[2][2]) const {
        const int cnt = __builtin_amdgcn_readfirstlane(T[u.i0]); const int* li = LIST + u.i0 * 16384; const int base = u.i1 * 256;
        const int a0 = base + R0, a1 = base + R1, a2 = base + R0 + 128, a3 = base + R1 + 128;
        const int t0 = a0 < cnt ? li[a0] : 0, t1 = a1 < cnt ? li[a1] : 0, t2 = a2 < cnt ? li[a2] : 0, t3 = a3 < cnt ? li[a3] : 0;
        oA[0][0] = (unsigned)t0 * 2048u + C0 * 2u; oA[0][1] = (unsigned)t1 * 2048u + C1 * 2u; oA[1][0] = (unsigned)t2 * 2048u + C0 * 2u; oA[1][1] = (unsigned)t3 * 2048u + C1 * 2u; }
    __device__ __forceinline__ unsigned ldb_bytes() const { return 2048u; }
};
struct EpiG5 {
    bf16* ACT; const float* ROWW; LAS const int* T;
    __device__ __forceinline__ void operator()(const f32x4 (&acc)[2][2][4][2], const GUnit& u, int wr, int wc, int fr, int fq) const {
        const int e = u.i0, cnt = __builtin_amdgcn_readfirstlane(T[e]), rbase = u.i1 * 256, arow0 = (__builtin_amdgcn_readfirstlane(T[32 + e]) + u.i1) * 256; const int f0 = u.i2 * 128 + wc * 32 + 8 * fq;
#pragma unroll
        for (int ai = 0; ai < 2; ++ai)
#pragma unroll
            for (int m = 0; m < 4; ++m) { const int rt = ai * 128 + wr * 64 + m * 16 + fr;
                if (rbase + rt < cnt) { const float w = ROWW[e * 16384 + rbase + rt]; float o[8];
#pragma unroll
                    for (int t = 0; t < 8; ++t) { const float gt = t < 4 ? acc[ai][0][m][0][t & 3] : acc[ai][0][m][1][t & 3], up = t < 4 ? acc[ai][1][m][0][t & 3] : acc[ai][1][m][1][t & 3];
                        o[t] = gt * fast_sigmoid(gt) * up * w; }
                    st16_wt(ACT + (size_t)(arow0 + rt) * 256 + f0, pack8(o)); } }
    }
};
struct SchedG6 {
    static constexpr bool GATHER = false;
    const char* ACT; const char* WDN; LAS const int* T; int G, c; const unsigned* RDY; unsigned* tmo;
    __device__ __forceinline__ bool next(int i, GUnit& u) const {
        const int tot = __builtin_amdgcn_readfirstlane(T[64]); const int u5 = 2 * tot; const int nx = (u5 > G && u5 < 2 * G) ? u5 - G : 0;
        if (c < nx) return false;
        const int L = i * (G - nx) + (c - nx); if (L >= 4 * tot) return false;
        const int mtg = L >> 2, ntile = L & 3; int e = 0;
#pragma unroll 1
        for (int k = 1; k < 32; ++k) if (__builtin_amdgcn_readfirstlane(T[32 + k]) <= mtg) e = k;
        const int tpe = __builtin_amdgcn_readfirstlane(T[32 + e]);
        u.A = ACT + (size_t)mtg * 256 * 512; u.B = WDN + ((size_t)e * 1024 + ntile * 256) * 512; u.nt = 4; u.i0 = e; u.i1 = mtg - tpe; u.i2 = ntile; u.i3 = mtg; return true;
    }
    __device__ __forceinline__ void offs(const GUnit&, int R0, int R1, int C0, int C1, unsigned (&oA)[2][2]) const {
        oA[0][0] = (unsigned)R0 * 512u + C0 * 2u; oA[0][1] = (unsigned)R1 * 512u + C1 * 2u; oA[1][0] = (unsigned)(R0 + 128) * 512u + C0 * 2u; oA[1][1] = (unsigned)(R1 + 128) * 512u + C1 * 2u; }
    __device__ __forceinline__ unsigned ldb_bytes() const { return 512u; }
    __device__ __forceinline__ void a_ready(const GUnit& u) const {
        if (__builtin_amdgcn_readfirstlane(threadIdx.x >> 6) == 0) {
            unsigned polls = 0;
            while ((unsigned)__builtin_amdgcn_readfirstlane(__hip_atomic_load(RDY + u.i3, __ATOMIC_RELAXED, __HIP_MEMORY_SCOPE_AGENT)) < 16u) {
                if ((++polls & 255u) == 0u && __builtin_amdgcn_readfirstlane(__hip_atomic_load(tmo, __ATOMIC_RELAXED, __HIP_MEMORY_SCOPE_AGENT)) != 0u) break;
                if (polls > (1u << 17)) { __hip_atomic_store(tmo, 1u, __ATOMIC_RELAXED, __HIP_MEMORY_SCOPE_AGENT); break; }
                __builtin_amdgcn_s_sleep(8); }
            __builtin_amdgcn_fence(__ATOMIC_ACQUIRE, "agent");
            asm volatile("s_waitcnt vmcnt(0)" ::: "memory");
        }
        asm volatile("" ::: "memory"); __builtin_amdgcn_s_barrier(); asm volatile("" ::: "memory");
    }
    __device__ __forceinline__ void done(const GUnit&) const {}
};
struct EpiG6 {
    bf16* Z; const int* TOKSLOT; LAS const int* T;
    __device__ __forceinline__ void operator()(const f32x4 (&acc)[2][2][4][2], const GUnit& u, int wr, int wc, int fr, int fq) const {
        const int e = u.i0, cnt = __builtin_amdgcn_readfirstlane(T[e]), rbase = u.i1 * 256; const int c0 = u.i2 * 256 + wc * 32 + 8 * fq;
#pragma unroll
        for (int ai = 0; ai < 2; ++ai)
#pragma unroll
            for (int m = 0; m < 4; ++m) { const int rt = ai * 128 + wr * 64 + m * 16 + fr;
                if (rbase + rt < cnt) { const int ts = TOKSLOT[e * 16384 + rbase + rt]; bf16* zp = Z + (size_t)ts * 1024 + c0;
#pragma unroll
                    for (int bj = 0; bj < 2; ++bj) { const f32x4 v0 = acc[ai][bj][m][0], v1 = acc[ai][bj][m][1];
                        u32x4 w; w.x = cvtpk(v0[0], v0[1]); w.y = cvtpk(v0[2], v0[3]); w.z = cvtpk(v1[0], v1[1]); w.w = cvtpk(v1[2], v1[3]);
                        st16x(zp + bj * 128, w); } } }
    }
};
}
#ifndef PH4MASK
#define PH4MASK 7
#endif
#ifndef PHMASK
#define PHMASK 0xFFFF
#endif
namespace fk {
__device__ __forceinline__ void relaunder(Frame& F) { int t = threadIdx.x; asm volatile("" : "+v"(t)); F.tid = t; F.lane = t & 63; }
__global__ void __launch_bounds__(NTHR, 2) fwd(Params p) {
    extern __shared__ __attribute__((aligned(16))) unsigned char lds_[];
    Frame F; F.lds = (LAS unsigned char*)lds_; F.ws = p.ws; F.tid = threadIdx.x; F.lane = F.tid & 63; F.wave = __builtin_amdgcn_readfirstlane(F.tid >> 6);
    F.G = gridDim.x; F.bid = blockIdx.x; F.gw = F.bid * NWAVES + F.wave; F.NGW = F.G * NWAVES;
    volatile LAS unsigned* MISC = (volatile LAS unsigned*)(F.lds + MISC_OFF);
    if (F.tid < 64) MISC[F.tid] = 0u;
    __syncthreads();
    unsigned* ctl = (unsigned*)(p.ws + WS_CTL);
    XcdBarrier bar = xcd_barrier_post(ctl + CW_BAR, MISC + 8);
    bool first = true;
    const int lo = p.ph_lo, hi = p.ph_hi;
#ifdef TIMEPH
    unsigned long long tacc = 0, tprev = 0; int prevph = -1;
#define TSTAMP(k) do { const unsigned long long now_ = __builtin_amdgcn_s_memrealtime(); if (prevph == (TIMEPH) || ((TIMEPH) == -2 && prevph >= 100)) tacc += now_ - tprev; tprev = now_; prevph = (k); } while (0)
#else
#define TSTAMP(k) do {} while (0)
#endif
#ifdef TIMEPH
#define TBAR() do { const unsigned long long now_ = __builtin_amdgcn_s_memrealtime(); if (prevph == (TIMEPH)) tacc += now_ - tprev; tprev = now_; prevph += 100; } while (0)
#else
#define TBAR() do {} while (0)
#endif
#define PHASE(k) if (lo <= (k) && (k) < hi) if ((first ? (void)0 : (({ TBAR(); }), xcd_barrier(bar))), first = false, relaunder(F), true) if (({ TSTAMP(k); true; }))
    unsigned char* ws = p.ws;
    if (p.l_lo == 0) PHASE(0) if constexpr (((PHMASK) >> 0) & 1) { p0_prologue(F, p); }
    for (int l = p.l_lo; l < p.l_hi; ++l) {
        const float* mod = (const float*)(ws + WS_MOD) + (size_t)l * NB * 6 * D;
        PHASE(1) if constexpr (((PHMASK) >> 1) & 1) {
            if (l == 0) row_normmod<0>(F, p.x, (float*)(ws + WS_X), nullptr, nullptr, p.norm_g + (size_t)l * 2 * D, mod, mod + D, (bf16*)(ws + WS_H), nullptr);
            else row_normmod<2>(F, nullptr, (float*)(ws + WS_X), (const bf16*)(ws + WS_Z), mod - (size_t)NB * 6 * D + 5 * D, p.norm_g + (size_t)l * 2 * D, mod, mod + D, (bf16*)(ws + WS_H), nullptr);
        }
        PHASE(2) if constexpr (((PHMASK) >> 2) & 1) {
            SchedDense S{(const char*)(ws + WS_H), (const char*)(ws + WS_WIN + (size_t)l * 6144 * 2048), 2048u, 2048u, 64, 24, 16, F.G, F.bid};
            EpiG1 E{(bf16*)(ws + WS_Y1), (bf16*)(ws + WS_XG), (bf16*)(ws + WS_KR), (float*)(ws + WS_STAT), p.diff_qk_g + l * 128, p.mla_qk_g + l * 192 + 96, (const float*)(ws + WS_CS), (const float*)(ws + WS_SN)};
            gemm_phase(F.lds, S, E);
        }
        PHASE(4) if constexpr (((PHMASK) >> 4) & 1) {
            if constexpr ((PH4MASK) & 1) {
              { SchedDense S{(const char*)(ws + WS_Y1) + 2560 * 2, (const char*)(ws + WS_WUQ + (size_t)l * 768 * 512), 6144u, 512u, 64, 3, 4, F.G, F.bid};
                EpiG2<0> E{(bf16*)(ws + WS_QC), (const float*)(ws + WS_STAT), p.mla_qk_g + l * 192, (const float*)(ws + WS_CS), (const float*)(ws + WS_SN)}; gemm_phase(F.lds, S, E); }
              { SchedDense S{(const char*)(ws + WS_Y1) + 2816 * 2, (const char*)(ws + WS_WUKV + (size_t)l * 1024 * 512), 6144u, 512u, 64, 4, 4, F.G, F.bid};
                EpiG2<1> E{(bf16*)(ws + WS_KVC), (const float*)(ws + WS_STAT), p.mla_qk_g + l * 192 + 96, (const float*)(ws + WS_CS), (const float*)(ws + WS_SN)}; gemm_phase(F.lds, S, E); } }
            TSTAMP(41);
            if constexpr ((PH4MASK) & 2) attn_phase<true>(F, p, l);
            TSTAMP(42);
            if constexpr ((PH4MASK) & 4) for (int u = F.bid; u < 512; u += F.G) sgu_unit(F, p, l, u);
        }
        PHASE(6) if constexpr (((PHMASK) >> 6) & 1) { attn_phase<false>(F, p, l); }
        PHASE(7) if constexpr (((PHMASK) >> 7) & 1) {
            SchedG3 S{(const char*)(ws + WS_OA), (const char*)(ws + WS_WBR + (size_t)l * 3 * MiB), F.G, F.bid};
            EpiG3 E{(const bf16*)(ws + WS_XG), (bf16*)(ws + WS_MERGED)};
            gemm_phase(F.lds, S, E);
        }
        PHASE(8) if constexpr (((PHMASK) >> 8) & 1) {
            SchedDense S{(const char*)(ws + WS_MERGED), (const char*)(ws + WS_WOUT + (size_t)l * 2 * MiB), 2048u, 2048u, 64, 4, 16, F.G, F.bid};
            EpiG4 E{(float*)(ws + WS_X), mod + 2 * D};
            gemm_phase(F.lds, S, E);
        }
        PHASE(9) if constexpr (((PHMASK) >> 9) & 1) { row_router(F, p, l, mod); }
        PHASE(10) if constexpr (((PHMASK) >> 10) & 1) {
            moe_table(F, l);
            unsigned* RDY = (unsigned*)(ws + WS_CTL) + CW_RDY + l * 256;
            { SchedG5 S{(const char*)(ws + WS_H), (const char*)(ws + WS_WGU + (size_t)l * 32 * MiB), (const int*)(ws + WS_LIST), (LAS const int*)(F.lds + TAB_OFF + 6144), F.G, F.bid, RDY};
              EpiG5 E{(bf16*)(ws + WS_ACT), (const float*)(ws + WS_ROWW), (LAS const int*)(F.lds + TAB_OFF + 6144)};
              gemm_phase(F.lds, S, E); }
            TSTAMP(43);
            { SchedG6 S{(const char*)(ws + WS_ACT), (const char*)(ws + WS_WDN + (size_t)l * 16 * MiB), (LAS const int*)(F.lds + TAB_OFF + 6144), F.G, F.bid, RDY, (unsigned*)(ws + WS_CTL) + CW_TMO2};
              EpiG6 E{(bf16*)(ws + WS_Z), (const int*)(ws + WS_TOKSLOT), (LAS const int*)(F.lds + TAB_OFF + 6144)};
              gemm_phase(F.lds, S, E); }
        }
    }
    if (p.l_hi == p.nlayers) PHASE(12) if constexpr (((PHMASK) >> 12) & 1) {
        const float* modl = (const float*)(ws + WS_MOD) + (size_t)(p.nlayers - 1) * NB * 6 * D;
        row_normmod<3>(F, nullptr, (float*)(ws + WS_X), (const bf16*)(ws + WS_Z), modl + 5 * D, nullptr, nullptr, nullptr, nullptr, p.out);
    }
#undef PHASE
#ifdef TIMEPH
    TSTAMP(99);
    if (blockIdx.x == 0 && threadIdx.x == 0) { const unsigned long long t0 = __builtin_amdgcn_s_memrealtime(), wait = tacc * (TMULT);
        while (__builtin_amdgcn_s_memrealtime() - t0 < wait) __builtin_amdgcn_s_sleep(32); }
#endif
}
}
static void fill_params(fk::Params& p, void* const* d_in, void* d_out, void* d_ws) {
    p.x = (const float*)d_in[0]; p.c = (const float*)d_in[1]; p.positions = (const int*)d_in[2];
    p.w_ada = (const float*)d_in[3]; p.b_ada = (const float*)d_in[4]; p.norm_g = (const float*)d_in[5]; p.w_in = (const float*)d_in[6];
    p.diff_qk_g = (const float*)d_in[7]; p.diff_lambda = (const float*)d_in[8]; p.diff_out_g = (const float*)d_in[9]; p.rel_bias = (const float*)d_in[10];
    p.sgu_v_g = (const float*)d_in[11]; p.sgu_w = (const float*)d_in[12]; p.sgu_b = (const float*)d_in[13];
    p.mla_lat_g = (const float*)d_in[14]; p.mla_w_uq = (const float*)d_in[15]; p.mla_w_ukv = (const float*)d_in[16]; p.mla_qk_g = (const float*)d_in[17];
    p.w_branch = (const float*)d_in[18]; p.w_out = (const float*)d_in[19]; p.router_g_w = (const float*)d_in[20]; p.router_g_b = (const float*)d_in[21];
    p.router_e_w = (const float*)d_in[22]; p.router_e_b = (const float*)d_in[23]; p.w_e_gate = (const float*)d_in[24]; p.w_e_up = (const float*)d_in[25]; p.w_e_down = (const float*)d_in[26];
    p.out = (float*)d_out; p.ws = (unsigned char*)d_ws;
}
static void launch_fast(hipStream_t st, fk::Params p, int l_lo, int l_hi, int ph_lo, int ph_hi) {
    static bool attr = false;
    if (!attr) { (void)hipFuncSetAttribute((const void*)fk::fwd, hipFuncAttributeMaxDynamicSharedMemorySize, fk::LDS_BYTES); attr = true; }
#if NLAUNCH != 1
    (void)hipMemsetAsync((char*)p.ws + fk::WS_CTL + fk::CW_BAR * 4, 0, XCD_BAR_WORDS * 4, st);
#endif
    p.l_lo = l_lo; p.l_hi = l_hi; p.ph_lo = ph_lo; p.ph_hi = ph_hi;
    hipLaunchKernelGGL(fk::fwd, dim3(256), dim3(fk::NTHR), fk::LDS_BYTES, st, p);
}
extern "C" void kernel_launch(void* const* d_in, const int* in_sizes, int n_in, void* d_out, int out_size, void* d_ws, size_t ws_size, hipStream_t stream) {
    if (fk::WS_END > ws_size) { fprintf(stderr, "ws too small: need %zu have %zu\n", (size_t)fk::WS_END, ws_size); return; }
    (void)hipMemsetAsync((char*)d_ws + fk::WS_CTL, 0, fk::CTL_ZERO_BYTES, stream);
    fk::Params p{}; fill_params(p, d_in, d_out, d_ws); p.nlayers = 4; p.pad_ = 0;
#if NLAUNCH == 1
    launch_fast(stream, p, 0, 4, 0, 13);
#else
    launch_fast(stream, p, 0, 1, 0, 1);
    for (int l = 0; l < 4; ++l) for (int ph = 1; ph <= 11; ++ph) launch_fast(stream, p, l, l + 1, ph, ph + 1);
    launch_fast(stream, p, 3, 4, 12, 13);
#endif
}
```

```cpp
#include <hip/hip_runtime.h>
#include <cstdio>
#include <cstdint>
#define NLAUNCH 1
#define WT_STORES 1
namespace fk {
#define LAS __attribute__((address_space(3)))
#define GAS __attribute__((address_space(1)))
typedef unsigned short bf16;
typedef short bf16x8 __attribute__((ext_vector_type(8)));
typedef short s16x4 __attribute__((ext_vector_type(4)));
typedef float f32x2 __attribute__((ext_vector_type(2)));
typedef float f32x4 __attribute__((ext_vector_type(4)));
typedef float f32x16 __attribute__((ext_vector_type(16)));
typedef unsigned u32x2 __attribute__((ext_vector_type(2)));
typedef unsigned u32x4 __attribute__((ext_vector_type(4)));
typedef __bf16 bf16x2_t __attribute__((ext_vector_type(2)));
constexpr int NB = 8, S = 2048, D = 1024, M = NB * S, NL = 4;
constexpr int NWAVES = 8, NTHR = 512;
constexpr float LOG2E = 1.4426950408889634f;

__device__ __forceinline__ unsigned cvtpk(float lo, float hi) { f32x2 v = {lo, hi}; bf16x2_t b = __builtin_convertvector(v, bf16x2_t); return __builtin_bit_cast(unsigned, b); }
__device__ __forceinline__ float bf_lo(unsigned u) { return __builtin_bit_cast(float, u << 16); }
__device__ __forceinline__ float bf_hi(unsigned u) { return __builtin_bit_cast(float, u & 0xffff0000u); }
__device__ __forceinline__ float bf2f(bf16 u) { return __builtin_bit_cast(float, (unsigned)u << 16); }
template <int K> __device__ __forceinline__ float sw(float v) { return __builtin_bit_cast(float, __builtin_amdgcn_ds_swizzle(__builtin_bit_cast(int, v), 0x1F | (K << 10))); }
__device__ __forceinline__ int x32_addr() { int z = 0; asm volatile("" : "+v"(z)); const int l = __builtin_amdgcn_mbcnt_hi(-1, __builtin_amdgcn_mbcnt_lo(-1, z)); return (l ^ 32) << 2; }
__device__ __forceinline__ float xget32(float v, bool) { return __builtin_bit_cast(float, __builtin_amdgcn_ds_bpermute(x32_addr(), __builtin_bit_cast(int, v))); }
__device__ __forceinline__ float xsum32(float v) { return v + xget32(v, false); }
__device__ __forceinline__ float xmax32(float v) { return __builtin_fmaxf(v, xget32(v, false)); }
#ifdef OLD_WSUM
__device__ __forceinline__ float wave_sum(float v) { for (int o = 1; o < 64; o <<= 1) v += __shfl_xor(v, o); return v; }
#else
__device__ __forceinline__ float wave_sum(float v) { v += sw<1>(v); v += sw<2>(v); v += sw<4>(v); v += sw<8>(v); v += sw<16>(v); return xsum32(v); }
#endif
__device__ __forceinline__ float fast_sigmoid(float x) { return __builtin_amdgcn_rcpf(1.f + __builtin_amdgcn_exp2f(-x * LOG2E)); }
__device__ __forceinline__ float gelu_tanh(float x) { const float y = 0.7978845608028654f * (x + 0.044715f * x * x * x); return x * fast_sigmoid(2.f * y); }
#define LDS_WAIT() asm volatile("s_waitcnt lgkmcnt(0)" ::: "memory")
__device__ __forceinline__ void st16_wt(void* p, u32x4 v) { asm volatile("global_store_dwordx4 %0, %1, off sc1\n\ts_nop 1" :: "v"(p), "v"(v) : "memory"); }
#ifdef WT_ALL
__device__ __forceinline__ void st16x(void* p, u32x4 v) { asm volatile("global_store_dwordx4 %0, %1, off sc1\n\ts_nop 1" :: "v"(p), "v"(v) : "memory"); }
__device__ __forceinline__ void st16f(void* p, f32x4 v) { asm volatile("global_store_dwordx4 %0, %1, off sc1\n\ts_nop 1" :: "v"(p), "v"(v) : "memory"); }
__device__ __forceinline__ void st8x(void* p, u32x2 v) { asm volatile("global_store_dwordx2 %0, %1, off sc1\n\ts_nop 1" :: "v"(p), "v"(v) : "memory"); }
#else
__device__ __forceinline__ void st16x(void* p, u32x4 v) { *(GAS u32x4*)p = v; }
__device__ __forceinline__ void st16f(void* p, f32x4 v) { *(GAS f32x4*)p = v; }
__device__ __forceinline__ void st8x(void* p, u32x2 v) { *(GAS u32x2*)p = v; }
#endif
#ifdef WT_STORES
__device__ __forceinline__ void st16(void* p, u32x4 v) { asm volatile("global_store_dwordx4 %0, %1, off sc1\n\ts_nop 1" :: "v"(p), "v"(v) : "memory"); }
#else
__device__ __forceinline__ void st16(void* p, u32x4 v) { *(GAS u32x4*)p = v; }
#endif
#define VM_WAIT() asm volatile("s_waitcnt vmcnt(0)" ::: "memory")

#define XB_TMO      128
#define XB_XCNT(j)  (256  + 64 * (j))
#define XB_XSUB(j)  (1280 + 64 * (j))
#define XB_XGEN(j)  (2304 + 64 * (j))
#define XB_TOP      3328
#define XB_TOPGEN   3392
#define XCD_BAR_WORDS 3456
#define XB_SPIN_CAP (1u << 18)
__device__ __forceinline__ unsigned xb_ld(unsigned* p)              { return __hip_atomic_load(p, __ATOMIC_RELAXED, __HIP_MEMORY_SCOPE_AGENT); }
__device__ __forceinline__ unsigned xb_add(unsigned* p, unsigned v) { return __hip_atomic_fetch_add(p, v, __ATOMIC_RELAXED, __HIP_MEMORY_SCOPE_AGENT); }
__device__ __forceinline__ unsigned xb_xcc_id() { return (unsigned)__builtin_amdgcn_s_getreg((3 << 11) | 20) & 0xFu; }
#define XB_SPIN(cond, bar) do { unsigned _sp = 0; while (cond) { __builtin_amdgcn_s_sleep(1); \
    if ((++_sp & 255u) == 0u) { if (xb_ld(&(bar)[XB_TMO])) break; if (_sp > XB_SPIN_CAP) { atomicAdd(&(bar)[XB_TMO], 1u); break; } } } } while (0)
struct XcdBarrier { unsigned* bar; unsigned x; volatile LAS unsigned* st; };
__device__ __forceinline__ XcdBarrier xcd_barrier_post(unsigned* bar, volatile LAS unsigned* st) {
    XcdBarrier b; b.bar = bar; b.x = xb_xcc_id(); b.st = st;
    if (threadIdx.x == 0) (void)xb_add(&bar[XB_XCNT(b.x)], 1u);
    return b;
}
__device__ __forceinline__ void xcd_barrier_complete(unsigned* bar, unsigned x, unsigned& nloc, unsigned& nx) {
    const unsigned G = gridDim.x * gridDim.y * gridDim.z;
    unsigned sum, cnt, mine, sp = 0u;
    for (;;) {
        sum = 0u; cnt = 0u; mine = 0u;
#pragma unroll
        for (unsigned j = 0; j < 16; ++j) { const unsigned c = xb_ld(&bar[XB_XCNT(j)]); sum += c; cnt += (c > 0u) ? 1u : 0u; mine = (j == x) ? c : mine; }
        if (sum == G) break;
        __builtin_amdgcn_s_sleep(1);
        if ((++sp & 255u) == 0u) { if (xb_ld(&bar[XB_TMO])) break; if (sp > XB_SPIN_CAP) { atomicAdd(&bar[XB_TMO], 1u); break; } }
    }
    nloc = mine > 0u ? mine : 1u; nx = cnt > 0u ? cnt : 1u;
}
__device__ __forceinline__ void xcd_barrier(const XcdBarrier& b) {
    asm volatile("s_waitcnt vmcnt(0)" ::: "memory");
    __syncthreads();
    if (threadIdx.x == 0) {
        unsigned* bar = b.bar;
        __builtin_amdgcn_s_waitcnt(0);
        unsigned nloc = b.st[0], nx = b.st[1];
        if (nloc == 0u) { xcd_barrier_complete(bar, b.x, nloc, nx); b.st[0] = nloc; b.st[1] = nx; }
        const unsigned old = xb_add(&bar[XB_XSUB(b.x)], 1u);
        const unsigned gen = old / nloc;
        if (old + 1u == (gen + 1u) * nloc) {
            __builtin_amdgcn_fence(__ATOMIC_RELEASE, "agent");
            asm volatile("s_waitcnt vmcnt(0)" ::: "memory");
            const unsigned og = xb_add(&bar[XB_TOP], 1u);
            const unsigned tg = og / nx;
            if (og + 1u == (tg + 1u) * nx) xb_add(&bar[XB_TOPGEN], 1u);
            else XB_SPIN(xb_ld(&bar[XB_TOPGEN]) == tg, bar);
            __builtin_amdgcn_fence(__ATOMIC_ACQUIRE, "agent");
            xb_add(&bar[XB_XGEN(b.x)], 1u);
            asm volatile("s_waitcnt vmcnt(0)" ::: "memory");
        } else {
            XB_SPIN(xb_ld(&bar[XB_XGEN(b.x)]) == gen, bar);
            __builtin_amdgcn_fence(__ATOMIC_ACQUIRE, "agent");
            asm volatile("s_waitcnt vmcnt(0)" ::: "memory");
        }
    }
    __syncthreads();
}

constexpr int BM = 256, BK = 64, HALF = 128, HTB = HALF * BK * 2;
__device__ __forceinline__ void stage_rc(int b, int& R, int& C) { const int st = b / 1024, sb = b % 1024, swz = sb ^ (((sb >> 9) & 1) << 5); R = (st >> 1) * 16 + swz / 64; C = (st & 1) * 32 + (swz % 64) / 2; }
__device__ __forceinline__ int lds_byte(int r, int c) { const int st = (r >> 4) * 2 + (c >> 5), rr = r & 15, cc = c & 31, ob = rr * 64 + cc * 2; return st * 1024 + (ob ^ (((ob >> 9) & 1) << 5)); }
__device__ __forceinline__ int perm32(int rho) { const int n = rho >> 4, i = rho & 15; return 8 * (i >> 2) + 4 * n + (i & 3); }

struct GUnit { const char* A; const char* B; int nt; int i0, i1, i2, i3; };
template <class Epi, class Sched>
__device__ __forceinline__ void gemm_phase(LAS unsigned char* lds, const Sched& S, const Epi& E) {
    int tid = threadIdx.x; asm volatile("" : "+v"(tid));
    const int wid = __builtin_amdgcn_readfirstlane(tid >> 6), lane = tid & 63, wr = wid >> 2, wc = wid & 3, fr = lane & 15, fq = lane >> 4;
    int R0, C0, R1, C1; stage_rc(tid * 16, R0, C0); stage_rc(tid * 16 + 8192, R1, C1);
    const unsigned ldb = S.ldb_bytes();
    unsigned voffB[2];
    voffB[0] = (unsigned)((R0 & ~31) + perm32(R0 & 31)) * ldb + (unsigned)C0 * 2u; voffB[1] = (unsigned)((R1 & ~31) + perm32(R1 & 31)) * ldb + (unsigned)C1 * 2u;
    unsigned voffBh[2]; voffBh[0] = voffB[0] + (unsigned)HALF * ldb; voffBh[1] = voffB[1] + (unsigned)HALF * ldb;
    const unsigned ldsw = (unsigned)wid * 1024u;
    const int aoff = lds_byte(wr * 64 + fr, fq * 8), boff = lds_byte(wc * 32 + fr, fq * 8);
#define PG8_SA(b, h) (((b) * 2 + (h)) * HTB)
#define PG8_SB(b, h) ((4 + (b) * 2 + (h)) * HTB)
#define PG8_STAGE(bufoff, gbase, voff, kofs) do { _Pragma("unroll") for (int _i = 0; _i < 2; ++_i) \
        __builtin_amdgcn_global_load_lds((const unsigned*)((const char*)(gbase) + (unsigned)((voff)[_i] + (kofs))), (LAS unsigned*)(lds + (bufoff) + ldsw + _i * 8192), 16, 0, 0); } while (0)
#define PG8_LDA(dst, b, h) do { _Pragma("unroll") for (int m = 0; m < 4; ++m) _Pragma("unroll") for (int k = 0; k < 2; ++k) dst[m][k] = *(const LAS bf16x8*)(lds + PG8_SA(b, h) + aoff + m * 2048 + k * 1024); } while (0)
#define PG8_LDB(dst, b, h) do { _Pragma("unroll") for (int n = 0; n < 2; ++n) _Pragma("unroll") for (int k = 0; k < 2; ++k) dst[n][k] = *(const LAS bf16x8*)(lds + PG8_SB(b, h) + boff + n * 2048 + k * 1024); } while (0)
#define PG8_MMA(ai, bj, At, Bt) do { __builtin_amdgcn_s_setprio(1); _Pragma("unroll") for (int m = 0; m < 4; ++m) _Pragma("unroll") for (int n = 0; n < 2; ++n) _Pragma("unroll") for (int k = 0; k < 2; ++k) \
        acc[ai][bj][m][n] = __builtin_amdgcn_mfma_f32_16x16x32_bf16(Bt[n][k], At[m][k], acc[ai][bj][m][n], 0, 0, 0); __builtin_amdgcn_s_setprio(0); } while (0)
#define PG8_WAIT_V(n) asm volatile("s_waitcnt vmcnt(" #n ")" ::: "memory")
#define PG8_WAIT_L(n) asm volatile("s_waitcnt lgkmcnt(" #n ")" ::: "memory")
#define PG8_BAR __builtin_amdgcn_s_barrier()
#define PG8_SCHED __builtin_amdgcn_sched_barrier(0)
    GUnit cur, nxt; int ui = 0;
    if (!S.next(0, cur)) return;
    f32x4 acc[2][2][4][2];
#pragma unroll
    for (int a = 0; a < 2; ++a)
#pragma unroll
        for (int b = 0; b < 2; ++b)
#pragma unroll
            for (int m = 0; m < 4; ++m)
#pragma unroll
                for (int n = 0; n < 2; ++n) acc[a][b][m][n] = (f32x4){0.f, 0.f, 0.f, 0.f};
    bf16x8 At[4][2], B0[2][2], B1[2][2];
    unsigned oAc[2][2], oAn[2][2];
    S.a_ready(cur);
    S.offs(cur, R0, R1, C0, C1, oAc);
    const char* cA = cur.A; const char* cB = cur.B;
    PG8_STAGE(PG8_SB(0, 0), cB, voffB, 0u); PG8_STAGE(PG8_SB(0, 1), cB, voffBh, 0u); PG8_STAGE(PG8_SA(0, 0), cA, oAc[0], 0u); PG8_STAGE(PG8_SA(0, 1), cA, oAc[1], 0u);
    if (wr == 1) PG8_BAR;
    PG8_WAIT_V(2); PG8_BAR;
    PG8_STAGE(PG8_SB(1, 0), cB, voffB, 128u); PG8_STAGE(PG8_SA(1, 0), cA, oAc[0], 128u); PG8_STAGE(PG8_SB(1, 1), cB, voffBh, 128u);
    PG8_WAIT_V(6); PG8_BAR;
    for (;;) {
        const bool has_next = S.next(ui + 1, nxt);
        const char* nA = has_next ? nxt.A : cA; const char* nB = has_next ? nxt.B : cB;
        if constexpr (Sched::GATHER) { if (has_next) S.offs(nxt, R0, R1, C0, C1, oAn);
            else { oAn[0][0] = oAc[0][0]; oAn[0][1] = oAc[0][1]; oAn[1][0] = oAc[1][0]; oAn[1][1] = oAc[1][1]; } }
        int nt = cur.nt; asm volatile("" : "+s"(nt));
        for (int t = 0; t < nt; t += 2) {
            const bool last = (t == nt - 2);
            if (last && has_next) S.a_ready(nxt);
            const unsigned k1 = (unsigned)(t + 1) * 128u, k2 = last ? 0u : (unsigned)(t + 2) * 128u, k3 = k2 + 128u;
            const char* a2 = last ? nA : cA; const char* b2 = last ? nB : cB;
            unsigned o2[2][2];
            if constexpr (Sched::GATHER) { o2[0][0] = last ? oAn[0][0] : oAc[0][0]; o2[0][1] = last ? oAn[0][1] : oAc[0][1]; o2[1][0] = last ? oAn[1][0] : oAc[1][0]; o2[1][1] = last ? oAn[1][1] : oAc[1][1]; }
            else { o2[0][0] = oAc[0][0]; o2[0][1] = oAc[0][1]; o2[1][0] = oAc[1][0]; o2[1][1] = oAc[1][1]; }
            PG8_LDB(B0, 0, 0); PG8_LDB(B1, 0, 1); PG8_SCHED; PG8_LDA(At, 0, 0); PG8_STAGE(PG8_SA(1, 1), cA, oAc[1], k1);
            PG8_WAIT_V(8); PG8_WAIT_L(0); PG8_BAR; PG8_MMA(0, 0, At, B0); PG8_MMA(0, 1, At, B1); PG8_BAR; PG8_SCHED;
            PG8_LDA(At, 0, 1); PG8_STAGE(PG8_SB(0, 0), b2, voffB, k2); PG8_STAGE(PG8_SB(0, 1), b2, voffBh, k2); PG8_STAGE(PG8_SA(0, 0), a2, o2[0], k2);
            PG8_WAIT_V(8); PG8_WAIT_L(0); PG8_BAR; PG8_MMA(1, 0, At, B0); PG8_MMA(1, 1, At, B1); PG8_BAR; PG8_SCHED;
            PG8_LDB(B0, 1, 0); PG8_LDB(B1, 1, 1); PG8_SCHED; PG8_LDA(At, 1, 0); PG8_STAGE(PG8_SA(0, 1), a2, o2[1], k2);
            PG8_WAIT_V(8); PG8_WAIT_L(0); PG8_BAR; PG8_MMA(0, 0, At, B0); PG8_MMA(0, 1, At, B1); PG8_BAR; PG8_SCHED;
            PG8_LDA(At, 1, 1); PG8_STAGE(PG8_SB(1, 0), b2, voffB, k3); PG8_STAGE(PG8_SB(1, 1), b2, voffBh, k3); PG8_STAGE(PG8_SA(1, 0), a2, o2[0], k3);
            PG8_WAIT_V(8); PG8_WAIT_L(0); PG8_BAR; PG8_MMA(1, 0, At, B0); PG8_MMA(1, 1, At, B1); PG8_BAR; PG8_SCHED;
        }
        if (wr == 0) PG8_BAR;
        { int fr2 = fr, fq2 = fq; asm volatile("" : "+v"(fr2), "+v"(fq2)); E(acc, cur, wr, wc, fr2, fq2); S.done(cur); }
        if (!has_next) break;
#pragma unroll
        for (int a = 0; a < 2; ++a)
#pragma unroll
            for (int b = 0; b < 2; ++b)
#pragma unroll
                for (int m = 0; m < 4; ++m)
#pragma unroll
                    for (int n = 0; n < 2; ++n) acc[a][b][m][n] = (f32x4){0.f, 0.f, 0.f, 0.f};
        cur = nxt; cA = nA; cB = nB; ++ui;
        if constexpr (Sched::GATHER) { oAc[0][0] = oAn[0][0]; oAc[0][1] = oAn[0][1]; oAc[1][0] = oAn[1][0]; oAc[1][1] = oAn[1][1]; }
        if (wr == 1) PG8_BAR;
    }
    PG8_WAIT_V(0);
    PG8_BAR;
#undef PG8_SA
#undef PG8_SB
#undef PG8_STAGE
#undef PG8_LDA
#undef PG8_LDB
#undef PG8_MMA
#undef PG8_WAIT_V
#undef PG8_WAIT_L
#undef PG8_BAR
#undef PG8_SCHED
}
}
namespace fk {
constexpr size_t MiB = 1u << 20;
constexpr size_t WS_CTL = 0, CTL_ZERO_BYTES = 64 * 1024;
constexpr size_t WS_MOD = 1 * MiB;
constexpr size_t WS_BT = WS_MOD + 832 * 1024;
constexpr size_t WS_LAM = WS_BT + 4096;
constexpr size_t WS_ST = WS_MOD + 896 * 1024;
constexpr size_t WS_CS = 2 * MiB, WS_SN = 3 * MiB;
constexpr size_t WS_LIST = 4 * MiB, WS_ROWW = 6 * MiB, WS_TOKSLOT = 8 * MiB;
constexpr size_t WS_WIN = 10 * MiB;
constexpr size_t WS_WUQ = 58 * MiB;
constexpr size_t WS_WRT = 59 * MiB + 512 * 1024;
constexpr size_t WS_WUKV = 60 * MiB;
constexpr size_t WS_WBR = 62 * MiB;
constexpr size_t WS_WOUT = 74 * MiB;
constexpr size_t WS_WGU = 82 * MiB;
constexpr size_t WS_WDN = 210 * MiB;
constexpr size_t WS_X = 274 * MiB;
constexpr size_t WS_POOL = 338 * MiB;
constexpr size_t WS_Y1 = WS_POOL;
constexpr size_t WS_Z = WS_POOL;
constexpr size_t WS_ACT = WS_POOL + 64 * MiB;
constexpr size_t WS_XG = WS_POOL + 96 * MiB;
constexpr size_t WS_QC = WS_POOL + 192 * MiB;
constexpr size_t WS_KVC = WS_POOL + 216 * MiB;
constexpr size_t WS_KR = WS_POOL + 248 * MiB;
constexpr size_t WS_STAT = WS_KR + 1 * MiB;
constexpr size_t WS_MERGED = WS_POOL + 192 * MiB;
constexpr size_t WS_OA = WS_POOL + 250 * MiB, WS_OB = WS_POOL + 266 * MiB, WS_OC = WS_POOL + 282 * MiB;
constexpr size_t WS_H = WS_POOL + 298 * MiB;
constexpr size_t WS_END = WS_POOL + 330 * MiB;
constexpr int CW_BAR = 1024;
constexpr int CW_CNT = 8192;
constexpr int CW_RDY = 9216;
constexpr int CW_G2CNT = 8512;
constexpr int CW_TMO2 = 8448;
static_assert((CW_RDY + 4 * 256) * 4 <= (int)CTL_ZERO_BYTES, "ctl map 2");
static_assert((CW_BAR + XCD_BAR_WORDS) <= CW_CNT && (CW_CNT + 4 * 32) * 4 <= (int)CTL_ZERO_BYTES, "ctl map");
constexpr int RING_BYTES = 131072, TAB_OFF = RING_BYTES, MISC_OFF = TAB_OFF + 8192, LDS_BYTES = 147456;

struct Params {
    const float *x, *c; const int* positions; const float *w_ada, *b_ada, *norm_g, *w_in, *diff_qk_g, *diff_lambda, *diff_out_g, *rel_bias, *sgu_v_g, *sgu_w, *sgu_b,
        *mla_lat_g, *mla_w_uq, *mla_w_ukv, *mla_qk_g, *w_branch, *w_out, *router_g_w, *router_g_b, *router_e_w, *router_e_b, *w_e_gate, *w_e_up, *w_e_down;
    float* out; unsigned char* ws; int ph_lo, ph_hi; int l_lo, l_hi; int nlayers, pad_;
};

__device__ __forceinline__ void transpose_blk(const float* W, int ldw, int sc0, int k0, bf16* WT, int dr0, int ldt, const float* kscale, LAS float* scr, int lane) {
    float tv[32];
#pragma unroll
    for (int i = 0; i < 32; ++i) { const int kk = 2 * i + (lane >> 5); tv[i] = W[(size_t)(k0 + kk) * ldw + sc0 + (lane & 31)]; }
#pragma unroll
    for (int i = 0; i < 32; ++i) { const int kk = 2 * i + (lane >> 5); float v = tv[i]; if (kscale) v *= kscale[k0 + kk]; scr[kk * 33 + (lane & 31)] = v; }
    LDS_WAIT(); asm volatile("" ::: "memory");
    const int c = lane & 7;
#pragma unroll
    for (int j = 0; j < 4; ++j) { const int n = (lane >> 3) + 8 * j; const LAS float* sp = scr + (8 * c) * 33 + n;
        u32x4 o; o.x = cvtpk(sp[0 * 33], sp[1 * 33]); o.y = cvtpk(sp[2 * 33], sp[3 * 33]); o.z = cvtpk(sp[4 * 33], sp[5 * 33]); o.w = cvtpk(sp[6 * 33], sp[7 * 33]);
        *(GAS u32x4*)(WT + (size_t)(dr0 + n) * ldt + k0 + 8 * c) = o; }
    LDS_WAIT(); asm volatile("" ::: "memory");
}
__device__ __forceinline__ void transpose_item(const float* W, int K, int ldw, int c0, int ncols, bf16* WT, int row_off, LAS float* scr, int item, int lane, int ldt = 0) {
    if (ldt == 0) ldt = K;
    const int nblk = ncols / 32, kb = item / nblk, nb = item % nblk;
    transpose_blk(W, ldw, c0 + 32 * nb, 64 * kb, WT, row_off + 32 * nb, ldt, nullptr, scr, lane);
}
}
namespace fk {
struct Frame { LAS unsigned char* lds; unsigned char* ws; int tid, lane, wave, G, bid, gw, NGW; };

constexpr int IT_IN1 = 16 * 93, IT_IN2 = 16 * 96, IT_UQ = 4 * 24, IT_UKV = 2 * 32, IT_BR = 8 * 32, IT_OUT = 16 * 32, IT_NONEXP = IT_IN1 + IT_IN2 + IT_UQ + IT_UKV + 3 * IT_BR + IT_OUT;
constexpr int IT_EXP = 4 * 64 + 128, IT_LAYER = IT_NONEXP + 32 * IT_EXP, IT_TOTAL = NL * IT_LAYER;
__device__ __forceinline__ void p0_prologue(Frame& F, const Params& p) {
    unsigned char* ws = F.ws;
    LAS float* cact = (LAS float*)(F.lds);
    for (int i = F.tid; i < NB * D; i += NTHR) { const float v = p.c[i]; cact[i] = v / (1.f + __expf(-v)); }
    __syncthreads();
    LAS float* part = (LAS float*)(F.lds + 32768);
    float* MOD = (float*)(ws + WS_MOD);
    for (int it = F.bid; it < NL * 192; it += F.G) {
        const int l = it / 192, cg = it % 192, col = cg * 32 + (F.lane & 31), kpar = F.lane >> 5;
        const int kb = F.wave * 128 + kpar;
        const float* w = p.w_ada + (size_t)l * D * 6 * D + (size_t)kb * 6 * D + col;
        float acc[NB];
#pragma unroll
        for (int b = 0; b < NB; ++b) acc[b] = 0.f;
#pragma unroll 16
        for (int i = 0; i < 64; ++i) { const float wv = w[(size_t)(2 * i) * 6 * D];
#pragma unroll
            for (int b = 0; b < NB; ++b) acc[b] += cact[b * D + kb + 2 * i] * wv; }
#pragma unroll
        for (int b = 0; b < NB; ++b) { const float s2 = xsum32(acc[b]); if (F.lane < 32) part[(F.wave * NB + b) * 32 + F.lane] = s2; }
        __syncthreads();
        if (F.tid < 256) { const int b = F.tid >> 5, c = F.tid & 31; float s = 0.f;
#pragma unroll
          for (int wv = 0; wv < 8; ++wv) s += part[(wv * NB + b) * 32 + c];
          MOD[((size_t)l * NB + b) * 6 * D + cg * 32 + c] = s + p.b_ada[l * 6 * D + cg * 32 + c]; }
        __syncthreads();
    }
    const int gt = F.bid * NTHR + F.tid, NGT = F.G * NTHR;
    if (gt < NL) { const float* dl = p.diff_lambda + gt * 256; float s01 = 0.f, s23 = 0.f;
        for (int i = 0; i < 64; ++i) { s01 += dl[i] * dl[64 + i]; s23 += dl[128 + i] * dl[192 + i]; }
        ((float*)(ws + WS_LAM))[gt] = expf(s01) - expf(s23) + (0.8f - 0.6f * expf(-0.3f * (float)gt)); }
    if (gt >= 1024 && gt < 1024 + 4 * 256) { const int i = gt - 1024, h = i >> 8, rel = (i & 255) - 191; const int n = rel < 0 ? -rel : rel;
        int large = 8 + (int)(logf((float)(n > 1 ? n : 1) / 8.f) / 2.772588722239781f * 8.f); if (large > 15) large = 15;
        const int bucket = (rel > 0 ? 16 : 0) + (n < 8 ? n : large);
        ((float*)(ws + WS_BT))[i] = (p.rel_bias[bucket * 4 + h] - p.rel_bias[15 * 4 + h]) * LOG2E; }
    for (int i = gt; i < M * 16; i += NGT) { const int m = i >> 4, j = i & 15; const float inv_freq = powf(10000.f, -(float)(2 * j) / 32.f);
        const float ang = (float)p.positions[m] * inv_freq; ((float*)(ws + WS_CS))[i] = cosf(ang); ((float*)(ws + WS_SN))[i] = sinf(ang); }
    for (int i = gt; i < NL * 96 * 128; i += NGT) { const int l = i / (96 * 128), r = i % (96 * 128); ((u32x4*)(ws + WS_WIN + (size_t)l * 6144 * 2048 + (size_t)2976 * 2048))[r] = (u32x4){0u, 0u, 0u, 0u}; }
    for (int i = gt; i < NL * 48 * 1024; i += NGT) { const int l = i / (48 * 1024), r = i % (48 * 1024), o = r >> 10, k = r & 1023;
        const float v = o < 32 ? p.router_e_w[((size_t)l * D + k) * 32 + o] : (o < 36 ? p.router_g_w[((size_t)l * D + k) * 4 + (o - 32)] : 0.f);
        ((bf16*)(ws + WS_WRT))[i] = (bf16)(cvtpk(v, 0.f) & 0xffffu); }
    for (int i = gt; i < NL * 1024 * 16; i += NGT) { const int rr = i >> 4, q = i & 15; ((u32x4*)(ws + WS_WUKV + (size_t)rr * 512 + 256))[q] = (u32x4){0u, 0u, 0u, 0u}; }
    LAS float* scr = (LAS float*)(F.lds + 49152 + F.wave * 8448);
    for (int it = F.gw; it < IT_TOTAL; it += F.NGW) {
        const int l = it / IT_LAYER; int r = it % IT_LAYER;
        if (r < IT_IN1) { const int kb = r / 93, nb = r % 93, n0 = 32 * nb;
            const int sc0 = n0 < 1024 ? (n0 & ~255) + 64 * ((n0 >> 5) & 3) + 32 * ((n0 >> 7) & 1) : n0;
            transpose_blk(p.w_in + (size_t)l * D * 6048, 6048, sc0, 64 * kb, (bf16*)(ws + WS_WIN) + (size_t)l * 6144 * 1024, n0, 1024, nullptr, scr, F.lane); continue; } r -= IT_IN1;
        if (r < IT_IN2) { transpose_item(p.w_in + (size_t)l * D * 6048, 1024, 6048, 2976, 3072, (bf16*)(ws + WS_WIN) + (size_t)l * 6144 * 1024, 3072, scr, r, F.lane); continue; } r -= IT_IN2;
        if (r < IT_UQ) { const int kb = r / 24, nb = r % 24, n0 = 32 * nb, tt = n0 >> 8, bj = (n0 >> 7) & 1, wc = (n0 >> 5) & 3;
            const int sc0 = tt < 2 ? (4 * tt + wc) * 96 + 32 * bj : (4 * bj + wc) * 96 + 64;
            transpose_blk(p.mla_w_uq + (size_t)l * 256 * 768, 768, sc0, 64 * kb, (bf16*)(ws + WS_WUQ) + (size_t)l * 768 * 256, n0, 256, p.mla_lat_g + l * 384, scr, F.lane); continue; } r -= IT_UQ;
        if (r < IT_UKV) { const int kb = r / 32, nb = r % 32, n0 = 32 * nb, tt = n0 >> 8, bj = (n0 >> 7) & 1, wc = (n0 >> 5) & 3;
            const int sc0 = tt < 2 ? (4 * tt + wc) * 128 + 32 * bj : (4 * (tt - 2) + wc) * 128 + 64 + 32 * bj;
            transpose_blk(p.mla_w_ukv + (size_t)l * 128 * 1024, 1024, sc0, 64 * kb, (bf16*)(ws + WS_WUKV) + (size_t)l * 1024 * 256, n0, 256, p.mla_lat_g + l * 384 + 256, scr, F.lane); continue; } r -= IT_UKV;
        if (r < 3 * IT_BR) { const int n = r / IT_BR; transpose_item(p.w_branch + ((size_t)l * 3 + n) * 512 * 1024, 512, 1024, 0, 1024, (bf16*)(ws + WS_WBR) + ((size_t)l * 3 + n) * 1024 * 512, 0, scr, r % IT_BR, F.lane); continue; } r -= 3 * IT_BR;
        if (r < IT_OUT) { transpose_item(p.w_out + (size_t)l * D * D, 1024, 1024, 0, 1024, (bf16*)(ws + WS_WOUT) + (size_t)l * D * D, 0, scr, r, F.lane); continue; } r -= IT_OUT;
        const int e = r / IT_EXP, q = r % IT_EXP; const size_t le = (size_t)l * 32 + e;
        if (q < 256) { const int jj = q >> 6; const float* src = ((jj & 1) ? p.w_e_up : p.w_e_gate) + le * 1024 * 256;
            transpose_item(src, 1024, 256, (jj >> 1) * 128, 128, (bf16*)(ws + WS_WGU) + le * 512 * 1024, jj * 128, scr, q & 63, F.lane); }
        else transpose_item(p.w_e_down + le * 256 * 1024, 256, 1024, 0, 1024, (bf16*)(ws + WS_WDN) + le * 1024 * 256, 0, scr, q - 256, F.lane);
    }
}

template <int MODE>
__device__ __forceinline__ void row_normmod(Frame& F, const float* xin, float* X, const bf16* Z, const float* gateprev, const float* g, const float* shift, const float* scale, bf16* H, float* out) {
    constexpr int R = 2;
    for (int m0 = F.gw; m0 < M; m0 += R * F.NGW) {
        f32x4 v[R][4]; u32x2 z0[R][4], z1[R][4];
#pragma unroll
        for (int r = 0; r < R; ++r) { const int m = m0 + r * F.NGW;
#pragma unroll
            for (int j = 0; j < 4; ++j) { const int d = 4 * F.lane + 256 * j;
                if (MODE == 0) v[r][j] = *(const GAS f32x4*)(xin + (size_t)m * D + d); else v[r][j] = *(const GAS f32x4*)(X + (size_t)m * D + d);
                if (MODE >= 2) { z0[r][j] = *(const GAS u32x2*)(Z + (size_t)(2 * m) * D + d); z1[r][j] = *(const GAS u32x2*)(Z + (size_t)(2 * m + 1) * D + d); } } }
#pragma unroll
        for (int r = 0; r < R; ++r) { const int m = m0 + r * F.NGW; const int b = m / S;
#pragma unroll
            for (int j = 0; j < 4; ++j) { const int d = 4 * F.lane + 256 * j;
                if (MODE >= 2) { const f32x4 gt = *(const GAS f32x4*)(gateprev + (size_t)b * 6 * D + d);
                    v[r][j].x += gt.x * (bf_lo(z0[r][j].x) + bf_lo(z1[r][j].x)); v[r][j].y += gt.y * (bf_hi(z0[r][j].x) + bf_hi(z1[r][j].x));
                    v[r][j].z += gt.z * (bf_lo(z0[r][j].y) + bf_lo(z1[r][j].y)); v[r][j].w += gt.w * (bf_hi(z0[r][j].y) + bf_hi(z1[r][j].y)); }
                if (MODE == 2) st16f(X + (size_t)m * D + d, v[r][j]);
                if (MODE == 3) *(GAS f32x4*)(out + (size_t)m * D + d) = v[r][j]; }
            if (MODE == 3) continue;
            float s = 0.f;
#pragma unroll
            for (int j = 0; j < 4; ++j) s += (v[r][j].x * v[r][j].x + v[r][j].y * v[r][j].y) + (v[r][j].z * v[r][j].z + v[r][j].w * v[r][j].w);
            const float rstd = rsqrtf(wave_sum(s) * (1.f / D) + 1e-6f);
#pragma unroll
            for (int j = 0; j < 4; ++j) { const int d = 4 * F.lane + 256 * j;
                const f32x4 gg = *(const GAS f32x4*)(g + d), sc = *(const GAS f32x4*)(scale + (size_t)b * 6 * D + d), sh = *(const GAS f32x4*)(shift + (size_t)b * 6 * D + d);
                const float o0 = v[r][j].x * rstd * gg.x * (1.f + sc.x) + sh.x, o1 = v[r][j].y * rstd * gg.y * (1.f + sc.y) + sh.y, o2 = v[r][j].z * rstd * gg.z * (1.f + sc.z) + sh.z, o3 = v[r][j].w * rstd * gg.w * (1.f + sc.w) + sh.w;
                u32x2 o; o.x = cvtpk(o0, o1); o.y = cvtpk(o2, o3); st8x(H + (size_t)m * D + d, o); }
        }
    }
}

struct SchedDense {
    static constexpr bool GATHER = false;
    __device__ __forceinline__ void a_ready(const GUnit&) const {}
    __device__ __forceinline__ void done(const GUnit&) const {}
    const char* A; const char* B; unsigned lda_b, ldb_b; int nM, nN, nt, G, c;
    __device__ __forceinline__ bool next(int i, GUnit& u) const {
        const long L = (long)i * G + c; const int nwg = nM * nN; if (L >= nwg) return false;
        int wgid = (int)L; { const int q = nwg / 8, r = nwg % 8, xcd = wgid % 8, off = wgid / 8; wgid = (xcd < r ? xcd * (q + 1) : r * (q + 1) + (xcd - r) * q) + off; }
        const int nig = 8 * nN, gid = wgid / nig, fm = gid * 8, gsz = (nM - fm) < 8 ? (nM - fm) : 8;
        const int pm = fm + ((wgid % nig) % gsz), pn = (wgid % nig) / gsz;
        u.A = A + (size_t)pm * 256 * lda_b; u.B = B + (size_t)pn * 256 * ldb_b; u.nt = nt; u.i0 = pm; u.i1 = pn; u.i2 = 0; return true;
    }
    __device__ __forceinline__ void offs(const GUnit&, int R0, int R1, int C0, int C1, unsigned (&oA)[2][2]) const {
        oA[0][0] = (unsigned)R0 * lda_b + C0 * 2u; oA[0][1] = (unsigned)R1 * lda_b + C1 * 2u; oA[1][0] = (unsigned)(R0 + 128) * lda_b + C0 * 2u; oA[1][1] = (unsigned)(R1 + 128) * lda_b + C1 * 2u; }
    __device__ __forceinline__ unsigned ldb_bytes() const { return ldb_b; }
};
struct SchedDensePub : SchedDense {
    unsigned* cnt;
    __device__ __forceinline__ void done(const GUnit& u) const { asm volatile("s_waitcnt vmcnt(0)" ::: "memory"); if ((threadIdx.x & 63) == 0) __hip_atomic_fetch_add(cnt + (u.i0 >> 3), 1u, __ATOMIC_RELAXED, __HIP_MEMORY_SCOPE_AGENT); }
};
struct EpiStoreBf16 {
    bf16* O0; bf16* O1; int split, ldc0, ldc1;
    __device__ __forceinline__ void operator()(const f32x4 (&acc)[2][2][4][2], const GUnit& u, int wr, int wc, int fr, int fq) const {
        const int pn = u.i1; bf16* base; int ldc; if (pn < split) { base = O0 + 256 * pn; ldc = ldc0; } else { base = O1 + 256 * (pn - split); ldc = ldc1; }
        const int row0 = u.i0 * 256 + wr * 64 + fr, col0 = wc * 32 + 8 * fq;
#pragma unroll
        for (int ai = 0; ai < 2; ++ai)
#pragma unroll
            for (int m = 0; m < 4; ++m) { bf16* rowp = base + (size_t)(row0 + ai * 128 + m * 16) * ldc + col0;
#pragma unroll
                for (int bj = 0; bj < 2; ++bj) { const f32x4 v0 = acc[ai][bj][m][0], v1 = acc[ai][bj][m][1];
                    u32x4 w; w.x = cvtpk(v0[0], v0[1]); w.y = cvtpk(v0[2], v0[3]); w.z = cvtpk(v1[0], v1[1]); w.w = cvtpk(v1[2], v1[3]);
                    st16(rowp + bj * 128, w); } }
    }
};
struct EpiG1 {
    bf16* Y1; bf16* XG; bf16* KR; float* ST; const float* gq; const float* kg; const float* CS; const float* SN;
    __device__ __forceinline__ void operator()(const f32x4 (&acc)[2][2][4][2], const GUnit& u, int wr, int wc, int fr, int fq) const {
        const int pn = u.i1; const int row0 = u.i0 * 256 + wr * 64 + fr;
        if (pn < 4) {
            const float* g = gq + (pn >> 1) * 64; const float mul = pn < 2 ? 0.125f * LOG2E : 1.f;
            f32x4 gv[2][2];
#pragma unroll
            for (int bj = 0; bj < 2; ++bj)
#pragma unroll
                for (int n = 0; n < 2; ++n) gv[bj][n] = *(const GAS f32x4*)(g + 32 * bj + 8 * fq + 4 * n);
#pragma unroll
            for (int ai = 0; ai < 2; ++ai)
#pragma unroll
                for (int m = 0; m < 4; ++m) {
                    float s = 0.f;
#pragma unroll
                    for (int bj = 0; bj < 2; ++bj)
#pragma unroll
                        for (int n = 0; n < 2; ++n) { const f32x4 v = acc[ai][bj][m][n]; s += (v[0] * v[0] + v[1] * v[1]) + (v[2] * v[2] + v[3] * v[3]); }
                    s += sw<16>(s); s = xsum32(s);
                    const float rstd = rsqrtf(s * (1.f / 64.f) + 1e-6f) * mul;
                    bf16* rowp = Y1 + (size_t)(row0 + ai * 128 + m * 16) * 3072 + 256 * pn + 64 * wc + 8 * fq;
#pragma unroll
                    for (int bj = 0; bj < 2; ++bj) { const f32x4 v0 = acc[ai][bj][m][0] * rstd * gv[bj][0], v1 = acc[ai][bj][m][1] * rstd * gv[bj][1];
                        u32x4 w; w.x = cvtpk(v0[0], v0[1]); w.y = cvtpk(v0[2], v0[3]); w.z = cvtpk(v1[0], v1[1]); w.w = cvtpk(v1[2], v1[3]);
                        st16(rowp + 32 * bj, w); }
                }
            return;
        }
        bf16* base = pn < 12 ? Y1 + 256 * pn : XG + 256 * (pn - 12); const int col0 = wc * 32 + 8 * fq;
#pragma unroll
        for (int ai = 0; ai < 2; ++ai)
#pragma unroll
            for (int m = 0; m < 4; ++m) { bf16* rowp = base + (size_t)(row0 + ai * 128 + m * 16) * 3072 + col0;
#pragma unroll
                for (int bj = 0; bj < 2; ++bj) { const f32x4 v0 = acc[ai][bj][m][0], v1 = acc[ai][bj][m][1];
                    u32x4 w; w.x = cvtpk(v0[0], v0[1]); w.y = cvtpk(v0[2], v0[3]); w.z = cvtpk(v1[0], v1[1]); w.w = cvtpk(v1[2], v1[3]);
                    st16(rowp + bj * 128, w); } }
        if (pn == 10 || pn == 11) {
#pragma unroll
            for (int ai = 0; ai < 2; ++ai)
#pragma unroll
                for (int m = 0; m < 4; ++m) { float s = 0.f;
#pragma unroll
                    for (int bj = 0; bj < 2; ++bj) { if (pn == 11 && bj == 1) continue;
#pragma unroll
                        for (int n = 0; n < 2; ++n) { const f32x4 v = acc[ai][bj][m][n]; s += (v[0] * v[0] + v[1] * v[1]) + (v[2] * v[2] + v[3] * v[3]); } }
                    s += sw<16>(s); s = xsum32(s);
                    if (fq == 0) ST[(size_t)(row0 + ai * 128 + m * 16) * 8 + (pn - 10) * 4 + wc] = s; }
        }
        if (pn == 11 && wc == 0) {
            f32x4 g0 = *(const GAS f32x4*)(kg + 64 + 8 * fq), g1 = *(const GAS f32x4*)(kg + 64 + 8 * fq + 4);
#pragma unroll
            for (int ai = 0; ai < 2; ++ai)
#pragma unroll
                for (int m = 0; m < 4; ++m) { const size_t row = row0 + ai * 128 + m * 16;
                    f32x4 v0 = acc[ai][1][m][0], v1 = acc[ai][1][m][1];
                    float s = (v0[0] * v0[0] + v0[1] * v0[1]) + (v0[2] * v0[2] + v0[3] * v0[3]) + (v1[0] * v1[0] + v1[1] * v1[1]) + (v1[2] * v1[2] + v1[3] * v1[3]);
                    s += sw<16>(s); s = xsum32(s);
                    const float rstd = rsqrtf(s * (1.f / 32.f) + 1e-6f);
                    v0 = v0 * rstd * g0; v1 = v1 * rstd * g1;
                    const f32x4 c0 = *(const GAS f32x4*)(CS + row * 16 + 8 * (fq & 1)), c1 = *(const GAS f32x4*)(CS + row * 16 + 8 * (fq & 1) + 4);
                    const f32x4 s0 = *(const GAS f32x4*)(SN + row * 16 + 8 * (fq & 1)), s1 = *(const GAS f32x4*)(SN + row * 16 + 8 * (fq & 1) + 4);
                    f32x4 o0, o1;
#pragma unroll
                    for (int i = 0; i < 4; ++i) { const float p0 = xget32(v0[i], fq >= 2), p1 = xget32(v1[i], fq >= 2);
                        o0[i] = fq < 2 ? v0[i] * c0[i] - p0 * s0[i] : v0[i] * c0[i] + p0 * s0[i]; o1[i] = fq < 2 ? v1[i] * c1[i] - p1 * s1[i] : v1[i] * c1[i] + p1 * s1[i]; }
                    u32x4 w; w.x = cvtpk(o0[0], o0[1]); w.y = cvtpk(o0[2], o0[3]); w.z = cvtpk(o1[0], o1[1]); w.w = cvtpk(o1[2], o1[3]);
                    *(GAS u32x4*)(KR + row * 32 + 8 * fq) = w; }
        }
    }
};
template <int WHICH>
struct EpiG2 {
    bf16* O; const float* ST; const float* g; const float* CS; const float* SN;
    __device__ __forceinline__ void operator()(const f32x4 (&acc)[2][2][4][2], const GUnit& u, int wr, int wc, int fr, int fq) const {
        const int pn = u.i1; const int row0 = u.i0 * 256 + wr * 64 + fr; const float qs = 0.10206207261596577f * LOG2E;
#pragma unroll
        for (int ai = 0; ai < 2; ++ai)
#pragma unroll
            for (int m = 0; m < 4; ++m) { const size_t row = row0 + ai * 128 + m * 16;
                const f32x4 sp = *(const GAS f32x4*)(ST + row * 8 + WHICH * 4);
                const float r0 = rsqrtf(((sp[0] + sp[1]) + (sp[2] + sp[3])) * (WHICH ? 1.f / 128.f : 1.f / 256.f) + 1e-6f);
                f32x4 v[2][2];
#pragma unroll
                for (int bj = 0; bj < 2; ++bj)
#pragma unroll
                    for (int n = 0; n < 2; ++n) v[bj][n] = acc[ai][bj][m][n] * r0;
                if (pn < 2) {
                    float s = 0.f;
#pragma unroll
                    for (int bj = 0; bj < 2; ++bj)
#pragma unroll
                        for (int n = 0; n < 2; ++n) s += (v[bj][n][0] * v[bj][n][0] + v[bj][n][1] * v[bj][n][1]) + (v[bj][n][2] * v[bj][n][2] + v[bj][n][3] * v[bj][n][3]);
                    s += sw<16>(s); s = xsum32(s);
                    const float rstd = rsqrtf(s * (1.f / 64.f) + 1e-6f) * (WHICH ? 1.f : qs);
                    bf16* op = O + row * (WHICH ? 1024 : 768) + (4 * pn + wc) * (WHICH ? 128 : 96) + 8 * fq;
#pragma unroll
                    for (int bj = 0; bj < 2; ++bj) { const f32x4 g0 = *(const GAS f32x4*)(g + 32 * bj + 8 * fq), g1 = *(const GAS f32x4*)(g + 32 * bj + 8 * fq + 4);
                        const f32x4 a = v[bj][0] * rstd * g0, b = v[bj][1] * rstd * g1;
                        u32x4 w; w.x = cvtpk(a[0], a[1]); w.y = cvtpk(a[2], a[3]); w.z = cvtpk(b[0], b[1]); w.w = cvtpk(b[2], b[3]);
                        st16(op + 32 * bj, w); }
                } else if (WHICH == 1) {
                    bf16* op = O + row * 1024 + (4 * (pn - 2) + wc) * 128 + 64 + 8 * fq;
#pragma unroll
                    for (int bj = 0; bj < 2; ++bj) { u32x4 w; w.x = cvtpk(v[bj][0][0], v[bj][0][1]); w.y = cvtpk(v[bj][0][2], v[bj][0][3]); w.z = cvtpk(v[bj][1][0], v[bj][1][1]); w.w = cvtpk(v[bj][1][2], v[bj][1][3]);
                        st16(op + 32 * bj, w); }
                } else {
                    const f32x4 c0 = *(const GAS f32x4*)(CS + row * 16 + 8 * (fq & 1)), c1 = *(const GAS f32x4*)(CS + row * 16 + 8 * (fq & 1) + 4);
                    const f32x4 s0 = *(const GAS f32x4*)(SN + row * 16 + 8 * (fq & 1)), s1 = *(const GAS f32x4*)(SN + row * 16 + 8 * (fq & 1) + 4);
                    const f32x4 g0 = *(const GAS f32x4*)(g + 64 + 8 * fq), g1 = *(const GAS f32x4*)(g + 64 + 8 * fq + 4);
#pragma unroll
                    for (int bj = 0; bj < 2; ++bj) {
                        float s = (v[bj][0][0] * v[bj][0][0] + v[bj][0][1] * v[bj][0][1]) + (v[bj][0][2] * v[bj][0][2] + v[bj][0][3] * v[bj][0][3]) + (v[bj][1][0] * v[bj][1][0] + v[bj][1][1] * v[bj][1][1]) + (v[bj][1][2] * v[bj][1][2] + v[bj][1][3] * v[bj][1][3]);
                        s += sw<16>(s); s = xsum32(s);
                        const float rstd = rsqrtf(s * (1.f / 32.f) + 1e-6f) * qs;
                        const f32x4 a = v[bj][0] * rstd * g0, b = v[bj][1] * rstd * g1; f32x4 o0, o1;
#pragma unroll
                        for (int i = 0; i < 4; ++i) { const float p0 = xget32(a[i], fq >= 2), p1 = xget32(b[i], fq >= 2);
                            o0[i] = fq < 2 ? a[i] * c0[i] - p0 * s0[i] : a[i] * c0[i] + p0 * s0[i]; o1[i] = fq < 2 ? b[i] * c1[i] - p1 * s1[i] : b[i] * c1[i] + p1 * s1[i]; }
                        u32x4 w; w.x = cvtpk(o0[0], o0[1]); w.y = cvtpk(o0[2], o0[3]); w.z = cvtpk(o1[0], o1[1]); w.w = cvtpk(o1[2], o1[3]);
                        st16(O + row * 768 + (4 * bj + wc) * 96 + 64 + 8 * fq, w); }
                }
            }
    }
};
struct EpiG2Both {
    EpiG2<0> q; EpiG2<1> kv;
    __device__ __forceinline__ void operator()(const f32x4 (&acc)[2][2][4][2], const GUnit& u, int wr, int wc, int fr, int fq) const { if (u.i2) kv(acc, u, wr, wc, fr, fq); else q(acc, u, wr, wc, fr, fq); }
};
}
namespace fk {
typedef short v4i16_t __attribute__((ext_vector_type(4)));
typedef LAS const char* lds_cptr;
__device__ __forceinline__ float grp_sum(float s, int lanes) {
    if (lanes > 1) s += sw<1>(s); if (lanes > 2) s += sw<2>(s); if (lanes > 4) s += sw<4>(s);
    if (lanes > 8) s += sw<8>(s); if (lanes > 16) s += sw<16>(s); if (lanes > 32) s = xsum32(s);
    return s;
}
__device__ __forceinline__ void unpack8(const u32x4 w, float (&v)[8]) { v[0] = bf_lo(w.x); v[1] = bf_hi(w.x); v[2] = bf_lo(w.y); v[3] = bf_hi(w.y); v[4] = bf_lo(w.z); v[5] = bf_hi(w.z); v[6] = bf_lo(w.w); v[7] = bf_hi(w.w); }
__device__ __forceinline__ u32x4 pack8(const float (&v)[8]) { u32x4 w; w.x = cvtpk(v[0], v[1]); w.y = cvtpk(v[2], v[3]); w.z = cvtpk(v[4], v[5]); w.w = cvtpk(v[6], v[7]); return w; }
__device__ __forceinline__ void norm8(float (&v)[8], int lanes, float inv_width, const float* g, float mul) {
    float s = 0.f;
#pragma unroll
    for (int t = 0; t < 8; ++t) s += v[t] * v[t];
    const float rstd = rsqrtf(grp_sum(s, lanes) * inv_width + 1e-6f) * mul;
#pragma unroll
    for (int t = 0; t < 8; ++t) v[t] = v[t] * rstd * g[t];
}
__device__ __forceinline__ void rope8(float (&v)[8], int j, const float* cs, const float* sn) {
    const int i0 = 8 * (j & 1);
#pragma unroll
    for (int t = 0; t < 8; ++t) { const float o = sw<2>(v[t]); const float c = cs[i0 + t], s = sn[i0 + t]; v[t] = (j < 2) ? (v[t] * c - o * s) : (v[t] * c + o * s); }
}
__device__ __forceinline__ void prep1(Frame& F, const Params& p, int l) {
    bf16* Y1 = (bf16*)(F.ws + WS_Y1); bf16* KR = (bf16*)(F.ws + WS_KR); const float* CS = (const float*)(F.ws + WS_CS); const float* SN = (const float*)(F.ws + WS_SN);
    const float* gq = p.diff_qk_g + l * 128; const float* gk = gq + 64; const float* latg = p.mla_lat_g + l * 384; const float* kg = p.mla_qk_g + l * 192 + 96;
    const int ln = F.lane;
    const int seg = ln < 32 ? 0 : (ln < 48 ? 1 : (ln < 52 ? 2 : 3)); const int j3 = seg == 0 ? ln : (seg == 1 ? ln - 32 : ln - 48);
    const int off3 = seg == 0 ? 2560 + 8 * j3 : (seg == 1 ? 2816 + 8 * j3 : 2944 + 8 * (j3 & 3));
    const float* g3 = seg == 0 ? latg + 8 * j3 : (seg == 1 ? latg + 256 + 8 * j3 : kg + 64 + 8 * (j3 & 3));
    constexpr int R = 2;
    for (int m0 = F.gw; m0 < M; m0 += R * F.NGW) {
        u32x4 wq[R], wk[R], w3[R];
#pragma unroll
        for (int r = 0; r < R; ++r) { bf16* y = Y1 + (size_t)(m0 + r * F.NGW) * 3072; wq[r] = *(GAS u32x4*)(y + 8 * ln); wk[r] = *(GAS u32x4*)(y + 512 + 8 * ln); w3[r] = *(GAS u32x4*)(y + off3); }
#pragma unroll
        for (int r = 0; r < R; ++r) { const int m = m0 + r * F.NGW; bf16* y = Y1 + (size_t)m * 3072; float v[8];
            unpack8(wq[r], v); norm8(v, 8, 1.f / 64.f, gq + (8 * ln & 63), 0.125f * LOG2E); *(GAS u32x4*)(y + 8 * ln) = pack8(v);
            unpack8(wk[r], v); norm8(v, 8, 1.f / 64.f, gk + (8 * ln & 63), 1.f); *(GAS u32x4*)(y + 512 + 8 * ln) = pack8(v);
            unpack8(w3[r], v);
            float s = 0.f;
#pragma unroll
            for (int t = 0; t < 8; ++t) s += v[t] * v[t];
            s += sw<1>(s); s += sw<2>(s); const float s4 = s; s += sw<4>(s); s += sw<8>(s); const float s16 = s; s += sw<16>(s); const float s32 = s;
            const float rstd = seg == 0 ? rsqrtf(s32 * (1.f / 256.f) + 1e-6f) : (seg == 1 ? rsqrtf(s16 * (1.f / 128.f) + 1e-6f) : rsqrtf(s4 * (1.f / 32.f) + 1e-6f));
#pragma unroll
            for (int t = 0; t < 8; ++t) v[t] = v[t] * rstd * g3[t];
            if (seg <= 1) *(GAS u32x4*)(y + off3) = pack8(v);
            { float vr[8];
#pragma unroll
              for (int t = 0; t < 8; ++t) vr[t] = v[t];
              rope8(vr, j3 & 3, CS + (size_t)m * 16, SN + (size_t)m * 16);
              if (seg == 2) *(GAS u32x4*)(KR + (size_t)m * 32 + 8 * j3) = pack8(vr); }
        }
    }
}
__device__ __forceinline__ void prep2(Frame& F, const Params& p, int l) {
    bf16* QC = (bf16*)(F.ws + WS_QC); bf16* KVC = (bf16*)(F.ws + WS_KVC); const float* CS = (const float*)(F.ws + WS_CS); const float* SN = (const float*)(F.ws + WS_SN);
    const float* g0 = p.mla_qk_g + l * 192; const float* g1 = g0 + 96; const int ln = F.lane; const float qs = 0.10206207261596577f * LOG2E;
    constexpr int R = 2;
    const int qoff = (ln >> 3) * 96 + (ln & 7) * 8, roff = ((ln & 31) >> 2) * 96 + 64 + (ln & 3) * 8, koff = (ln >> 3) * 128 + (ln & 7) * 8;
    for (int m0 = F.gw; m0 < M; m0 += R * F.NGW) {
        u32x4 wq[R], wr[R], wk[R];
#pragma unroll
        for (int r = 0; r < R; ++r) { const size_t m = m0 + r * F.NGW; wq[r] = *(GAS u32x4*)(QC + m * 768 + qoff); wr[r] = *(GAS u32x4*)(QC + m * 768 + roff); wk[r] = *(GAS u32x4*)(KVC + m * 1024 + koff); }
#pragma unroll
        for (int r = 0; r < R; ++r) { const size_t m = m0 + r * F.NGW; float v[8];
            unpack8(wq[r], v); norm8(v, 8, 1.f / 64.f, g0 + (ln & 7) * 8, qs); *(GAS u32x4*)(QC + m * 768 + qoff) = pack8(v);
            unpack8(wr[r], v); norm8(v, 4, 1.f / 32.f, g0 + 64 + (ln & 3) * 8, qs); rope8(v, ln & 3, CS + m * 16, SN + m * 16); if (ln < 32) *(GAS u32x4*)(QC + m * 768 + roff) = pack8(v);
            unpack8(wk[r], v); norm8(v, 8, 1.f / 64.f, g1 + (ln & 7) * 8, 1.f); *(GAS u32x4*)(KVC + m * 1024 + koff) = pack8(v); }
    }
}

__device__ __forceinline__ int crow(int r, int hi) { return (r & 3) + 8 * (r >> 2) + 4 * hi; }
__device__ __forceinline__ s16x4 vtr(lds_cptr p) { return __builtin_bit_cast(s16x4, __builtin_amdgcn_ds_read_tr16_b64_v4i16((LAS v4i16_t*)p)); }
#define ATT_WAITV(n) asm volatile("s_waitcnt vmcnt(" #n ")" ::: "memory")
__device__ __forceinline__ void glds16(const void* gsrc, unsigned lds_dst) { unsigned keep;
    asm volatile("s_mov_b32 %0, m0\n\ts_mov_b32 m0, %2\n\ts_nop 0\n\tglobal_load_lds_dwordx4 %1, off\n\ts_mov_b32 m0, %0" : "=&s"(keep) : "v"(gsrc), "s"(lds_dst) : "memory"); }
template <bool DUAL>
__device__ __forceinline__ void attn_unit(Frame& F, const Params& p, int l, int b, int h, int qb) {
    constexpr int NQF = DUAL ? 4 : 6, NVB = DUAL ? 4 : 2, KP = DUAL ? 16 : 12, NP = DUAL ? 32 : 24, PP = NP / 8, SLOT = NP * 1024, NSLOT = 4;
    constexpr int QROWS = DUAL ? 128 : 256;
    int lane = F.lane; asm volatile("" : "+v"(lane));
    const int wid = F.wave, r32_ = lane & 31, hi_ = lane >> 5;
    const int wq = DUAL ? (wid & 3) : wid, map = DUAL ? (wid >> 2) : 0;
    const int q0 = qb * QROWS + wq * 32;
    const int cw = q0 >> 6, NT = ((qb * QROWS + QROWS) >> 6);
    const size_t tok0 = (size_t)b * S;
    LAS unsigned char* lds = F.lds; const unsigned lds0 = (unsigned)(uintptr_t)F.lds;
    LAS float* wsf = (LAS float*)(lds + TAB_OFF + 4096 + wid * 256);
    LAS float* tab = (LAS float*)(lds + TAB_OFF);
    const bf16* src[PP];
#pragma unroll
    for (int i = 0; i < PP; ++i) {
        const int x = wid * PP + i;
        if (DUAL) {
            const bf16* Y1 = (const bf16*)(F.ws + WS_Y1);
            if (x < KP) src[i] = Y1 + (tok0 + lane) * 3072 + 512 + h * 128 + (x >> 3) * 64 + (x & 7) * 8;
            else { const int v = x - KP; src[i] = Y1 + (tok0 + 16 * (v & 3) + (lane >> 2)) * 3072 + 1024 + h * 128 + (v >> 2) * 32 + (lane & 3) * 8; }
        } else {
            const bf16* KVC = (const bf16*)(F.ws + WS_KVC); const bf16* KR = (const bf16*)(F.ws + WS_KR);
            const int xx = x < 20 ? x : 0;
            if (xx < 8) src[i] = KVC + (tok0 + lane) * 1024 + h * 128 + xx * 8;
            else if (xx < 12) src[i] = KR + (tok0 + lane) * 32 + (xx - 8) * 8;
            else { const int v = xx - 12; src[i] = KVC + (tok0 + 16 * (v & 3) + (lane >> 2)) * 1024 + h * 128 + 64 + (v >> 2) * 32 + (lane & 3) * 8; }
        }
    }
    constexpr int TSTEP = DUAL ? 64 * 3072 : 0;
#define ATT_DMA(t, slot) do { _Pragma("unroll") for (int i_ = 0; i_ < PP; ++i_) { const int x_ = wid * PP + i_; \
        size_t step_; if (DUAL) step_ = (size_t)(t) * TSTEP; else { const int xx_ = x_ < 20 ? x_ : 0; step_ = (size_t)(t) * 64 * ((xx_ >= 8 && xx_ < 12) ? 32 : 1024); } \
        glds16(src[i_] + step_, (unsigned)__builtin_amdgcn_readfirstlane(lds0 + (unsigned)((slot) * SLOT + x_ * 1024))); } } while (0)
    bf16x8 qf[NQF];
    {
        const bf16* Qw = DUAL ? (const bf16*)(F.ws + WS_Y1) + (tok0 + q0 + r32_) * 3072 + h * 128 + map * 64 : (const bf16*)(F.ws + WS_QC) + (tok0 + q0 + r32_) * 768 + h * 96;
#pragma unroll
        for (int d0 = 0; d0 < NQF; ++d0) qf[d0] = *(const GAS bf16x8*)(Qw + d0 * 16 + hi_ * 8);
    }
    if (DUAL) { if (F.tid < 256) tab[F.tid] = ((const float*)(F.ws + WS_BT))[h * 256 + F.tid]; }
    VM_WAIT();
    ATT_DMA(0, 0); if (NT > 1) ATT_DMA(1, 1); if (NT > 2) ATT_DMA(2, 2);
    f32x16 o[NVB];
#pragma unroll
    for (int d = 0; d < NVB; ++d) o[d] = (f32x16){0.f, 0.f, 0.f, 0.f, 0.f, 0.f, 0.f, 0.f, 0.f, 0.f, 0.f, 0.f, 0.f, 0.f, 0.f, 0.f};
    float mrun = 0.f, lrun = 0.f;
    f32x16 negm = (f32x16){0.f, 0.f, 0.f, 0.f, 0.f, 0.f, 0.f, 0.f, 0.f, 0.f, 0.f, 0.f, 0.f, 0.f, 0.f, 0.f};
    const int vlane = ((lane >> 4) & 1) * 32 + (lane & 3) * 8 + (4 * hi_ + ((lane & 15) >> 2)) * 64;
    const int koff = (DUAL ? map * 8192 : 0) + hi_ * 1024 + r32_ * 16;
#define ATT_QK(P0, P1, slot) do { const lds_cptr kb_ = (lds_cptr)(lds + (slot) * SLOT + koff); \
        _Pragma("unroll") for (int d0 = 0; d0 < NQF; ++d0) { const bf16x8 k0_ = *(const LAS bf16x8*)(kb_ + d0 * 2048), k1_ = *(const LAS bf16x8*)(kb_ + d0 * 2048 + 512); \
            P0 = __builtin_amdgcn_mfma_f32_32x32x16_bf16(k0_, qf[d0], d0 == 0 ? negm : P0, 0, 0, 0); P1 = __builtin_amdgcn_mfma_f32_32x32x16_bf16(k1_, qf[d0], d0 == 0 ? negm : P1, 0, 0, 0); } } while (0)
    f32x16 p0, p1, n0, n1;
    p0 = negm; p1 = negm; n0 = negm; n1 = negm;
    if (NT > 2) { if (PP == 4) ATT_WAITV(8); else ATT_WAITV(6); } else if (NT > 1) { if (PP == 4) ATT_WAITV(4); else ATT_WAITV(3); } else ATT_WAITV(0);
    LDS_WAIT(); __builtin_amdgcn_s_barrier();
    ATT_QK(p0, p1, 0);
    for (int j = 0; j < NT; ++j) {
        const int sl = j & 3;
        if (j + 1 < NT) {
            if (j + 2 < NT) { if (PP == 4) ATT_WAITV(4); else ATT_WAITV(3); } else ATT_WAITV(0);
            LDS_WAIT(); __builtin_amdgcn_s_barrier();
            if (j + 3 < NT) ATT_DMA(j + 3, (j + 3) & 3);
        }
        if (j <= cw) {
            const bool nxt = (j + 1 <= cw);
            if (nxt) ATT_QK(n0, n1, (j + 1) & 3);
            if (DUAL) { if (j >= cw - 2) { const int base = 64 * j - (q0 + r32_) + 191 + 4 * hi_;
#pragma unroll
                for (int r = 0; r < 16; ++r) { const int kk = (r & 3) + 8 * (r >> 2); p0[r] += tab[base + kk]; p1[r] += tab[base + kk + 32]; } } }
            float ma = __builtin_fmaxf(__builtin_fmaxf(p0[0], p0[1]), p1[0]), mb = __builtin_fmaxf(__builtin_fmaxf(p0[2], p0[3]), p1[1]); ma = __builtin_fmaxf(__builtin_fmaxf(ma, p1[2]), p1[3]);
#pragma unroll
            for (int r = 4; r < 16; r += 4) { ma = __builtin_fmaxf(__builtin_fmaxf(ma, p0[r]), p0[r + 1]); mb = __builtin_fmaxf(__builtin_fmaxf(mb, p0[r + 2]), p0[r + 3]);
                ma = __builtin_fmaxf(__builtin_fmaxf(ma, p1[r]), p1[r + 1]); mb = __builtin_fmaxf(__builtin_fmaxf(mb, p1[r + 2]), p1[r + 3]); }
            float mx = __builtin_fmaxf(ma, mb); mx = xmax32(mx);
            if (__builtin_expect(__any(mx > 8.f), 0)) {
                const float dl = __builtin_fmaxf(mx, 0.f), f = __builtin_amdgcn_exp2f(-dl); mrun += dl; lrun *= f;
#pragma unroll
                for (int r = 0; r < 16; ++r) { p0[r] -= dl; p1[r] -= dl; n0[r] -= dl; n1[r] -= dl; negm[r] = -mrun; }
                if (hi_ == 0) wsf[r32_] = f;
                LDS_WAIT();
#pragma unroll
                for (int r = 0; r < 16; ++r) { const float fr_ = wsf[crow(r, hi_)];
#pragma unroll
                    for (int d = 0; d < NVB; ++d) o[d][r] *= fr_; }
            }
            float ls = 0.f;
#pragma unroll
            for (int r = 0; r < 16; ++r) { p0[r] = __builtin_amdgcn_exp2f(p0[r]); p1[r] = __builtin_amdgcn_exp2f(p1[r]); ls += p0[r] + p1[r]; }
            lrun += ls;
            u32x4 pw0, pw1, pw2, pw3;
            pw0 = (u32x4){cvtpk(p0[0], p0[1]), cvtpk(p0[2], p0[3]), cvtpk(p0[4], p0[5]), cvtpk(p0[6], p0[7])};
            pw1 = (u32x4){cvtpk(p0[8], p0[9]), cvtpk(p0[10], p0[11]), cvtpk(p0[12], p0[13]), cvtpk(p0[14], p0[15])};
            pw2 = (u32x4){cvtpk(p1[0], p1[1]), cvtpk(p1[2], p1[3]), cvtpk(p1[4], p1[5]), cvtpk(p1[6], p1[7])};
            pw3 = (u32x4){cvtpk(p1[8], p1[9]), cvtpk(p1[10], p1[11]), cvtpk(p1[12], p1[13]), cvtpk(p1[14], p1[15])};
            const bf16x8 pa0 = __builtin_bit_cast(bf16x8, pw0), pa1 = __builtin_bit_cast(bf16x8, pw1), pa2 = __builtin_bit_cast(bf16x8, pw2), pa3 = __builtin_bit_cast(bf16x8, pw3);
            const lds_cptr vb = (lds_cptr)(lds + sl * SLOT + KP * 1024 + vlane);
            s16x4 vf[2][8];
#pragma unroll
            for (int ks = 0; ks < 4; ++ks) { vf[0][2 * ks] = vtr(vb + ks * 1024); vf[0][2 * ks + 1] = vtr(vb + ks * 1024 + 512); }
#pragma unroll
            for (int d = 0; d < NVB; ++d) {
                if (d + 1 < NVB) {
#pragma unroll
                    for (int ks = 0; ks < 4; ++ks) { vf[(d + 1) & 1][2 * ks] = vtr(vb + (d + 1) * 4096 + ks * 1024); vf[(d + 1) & 1][2 * ks + 1] = vtr(vb + (d + 1) * 4096 + ks * 1024 + 512); }
                }
#define ATT_PK(k) (bf16x8){vf[d & 1][2 * (k)][0], vf[d & 1][2 * (k)][1], vf[d & 1][2 * (k)][2], vf[d & 1][2 * (k)][3], vf[d & 1][2 * (k) + 1][0], vf[d & 1][2 * (k) + 1][1], vf[d & 1][2 * (k) + 1][2], vf[d & 1][2 * (k) + 1][3]}
                o[d] = __builtin_amdgcn_mfma_f32_32x32x16_bf16(pa0, ATT_PK(0), o[d], 0, 0, 0);
                o[d] = __builtin_amdgcn_mfma_f32_32x32x16_bf16(pa1, ATT_PK(1), o[d], 0, 0, 0);
                o[d] = __builtin_amdgcn_mfma_f32_32x32x16_bf16(pa2, ATT_PK(2), o[d], 0, 0, 0);
                o[d] = __builtin_amdgcn_mfma_f32_32x32x16_bf16(pa3, ATT_PK(3), o[d], 0, 0, 0);
#undef ATT_PK
                __builtin_amdgcn_sched_barrier(0);
            }
            p0 = n0; p1 = n1;
        }
    }
#undef ATT_QK
    int r32 = r32_, hi = hi_; asm volatile("" : "+v"(r32), "+v"(hi));
    lrun = xsum32(lrun);
    if (hi == 0) wsf[32 + r32] = __builtin_amdgcn_rcpf(lrun);
    LDS_WAIT();
    float rli[16];
#pragma unroll
    for (int r = 0; r < 16; ++r) rli[r] = wsf[32 + crow(r, hi)];
    __builtin_amdgcn_s_barrier();
    if (DUAL) {
        LAS float* stg = (LAS float*)(lds) + (size_t)wq * 32 * 132;
        if (map == 1) {
#pragma unroll
            for (int d = 0; d < NVB; ++d)
#pragma unroll
                for (int r = 0; r < 16; ++r) stg[crow(r, hi) * 132 + d * 32 + r32] = o[d][r] * rli[r];
        }
        LDS_WAIT(); __builtin_amdgcn_s_barrier();
        if (map == 0) {
            const float lam = ((const float*)(F.ws + WS_LAM))[l]; const float li = 1.f - (0.8f - 0.6f * __expf(-0.3f * (float)l));
            float ss[16];
#pragma unroll
            for (int r = 0; r < 16; ++r) { float s = 0.f;
#pragma unroll
                for (int d = 0; d < NVB; ++d) { const float v = o[d][r] * rli[r] - lam * stg[crow(r, hi) * 132 + d * 32 + r32]; o[d][r] = v; s += v * v; }
                ss[r] = s; }
#pragma unroll
            for (int r = 0; r < 16; ++r) { float s = ss[r]; s += sw<1>(s); s += sw<2>(s); s += sw<4>(s); s += sw<8>(s); s += sw<16>(s); ss[r] = rsqrtf(s * (1.f / 128.f) + 1e-6f) * li; }
            const float* og = p.diff_out_g + l * 128; bf16* OA = (bf16*)(F.ws + WS_OA) + (tok0 + q0) * 512 + h * 128;
            LAS bf16* st2 = (LAS bf16*)(lds + 69632) + wq * (32 * 136);
#pragma unroll
            for (int d = 0; d < NVB; ++d) { const float gg = og[d * 32 + r32];
#pragma unroll
                for (int r = 0; r < 16; ++r) st2[crow(r, hi) * 136 + d * 32 + r32] = (bf16)(cvtpk(o[d][r] * ss[r] * gg, 0.f) & 0xffffu); }
            LDS_WAIT();
#pragma unroll
            for (int i = 0; i < 8; ++i) { const int row = i * 4 + (lane >> 4), ch = lane & 15; const u32x4 v = *(const LAS u32x4*)(st2 + row * 136 + ch * 8); st16x(OA + (size_t)row * 512 + ch * 8, v); }
        }
    } else {
        LAS bf16* stg = (LAS bf16*)(lds) + wid * 2048;
#pragma unroll
        for (int r = 0; r < 16; ++r) { const int orow = crow(r, hi);
#pragma unroll
            for (int d = 0; d < NVB; ++d) stg[orow * 64 + d * 32 + r32] = (bf16)(cvtpk(o[d][r] * rli[r], 0.f) & 0xffffu); }
        LDS_WAIT();
        bf16* Ow = (bf16*)(F.ws + WS_OC) + (tok0 + q0) * 512 + h * 64;
#pragma unroll
        for (int i = 0; i < 4; ++i) { const int row = i * 8 + (lane >> 3), ch = lane & 7; const u32x4 v = *(const LAS u32x4*)(stg + row * 64 + ch * 8); st16x(Ow + (size_t)row * 512 + ch * 8, v); }
    }
    LDS_WAIT(); VM_WAIT(); __builtin_amdgcn_s_barrier();
#undef ATT_DMA
}
template <bool DUAL>
__device__ __forceinline__ void attn_phase(Frame& F, const Params& p, int l) {
    const int vcu = (F.G % 8 == 0) ? (F.bid % 8) * (F.G / 8) + F.bid / 8 : F.bid;
    if (DUAL) { for (int v = vcu; v < 256; v += F.G) { const int bh = v >> 3, s = v & 7; attn_unit<true>(F, p, l, bh >> 2, bh & 3, s); attn_unit<true>(F, p, l, bh >> 2, bh & 3, 15 - s); } }
    else { for (int v = vcu; v < 256; v += F.G) { const int bh = v >> 2, s = v & 3; attn_unit<false>(F, p, l, bh >> 3, bh & 7, s); attn_unit<false>(F, p, l, bh >> 3, bh & 7, 7 - s); } }
}
}
namespace fk {
__device__ __forceinline__ void sgu_unit(Frame& F, const Params& p, int l, int unit) {
    const int g = unit & 3, bn = unit >> 2; const size_t m0 = (size_t)bn * 128;
    int lane = threadIdx.x & 63; asm volatile("" : "+v"(lane));
    const int wid = F.wave, r32 = lane & 31, hi = lane >> 5; const int tid_ = wid * 64 + lane;
    LAS unsigned char* lds = F.lds; LAS unsigned char* Wt = lds; LAS unsigned char* Vt = lds + 32768;
    const bf16* Y1 = (const bf16*)(F.ws + WS_Y1);
    const float* vg = p.sgu_v_g + l * 512 + 8 * lane;
    u32x4 w16[16];
#pragma unroll
    for (int jj = 0; jj < 16; ++jj) w16[jj] = *(const GAS u32x4*)(Y1 + (m0 + wid * 16 + jj) * 3072 + 2048 + 8 * lane);
    const float* Wg = p.sgu_w + ((size_t)l * 4 + g) * 128 * 128;
    f32x4 wa[4], wb[4];
#pragma unroll
    for (int k = 0; k < 4; ++k) { const int item = tid_ + 512 * k, i = item & 127, cidx = item >> 7, ks = cidx >> 1, h2 = cidx & 1;
        wa[k] = *(const GAS f32x4*)(Wg + (size_t)i * 128 + 16 * ks + 4 * h2); wb[k] = *(const GAS f32x4*)(Wg + (size_t)i * 128 + 16 * ks + 8 + 4 * h2); }
    float vgv[8];
#pragma unroll
    for (int t = 0; t < 8; ++t) vgv[t] = vg[t];
#pragma unroll
    for (int jj = 0; jj < 16; ++jj) {
        const int j = wid * 16 + jj; float v[8]; unpack8(w16[jj], v);
        float s = 0.f;
#pragma unroll
        for (int t = 0; t < 8; ++t) { v[t] = gelu_tanh(v[t]); s += v[t] * v[t]; }
        const float rstd = rsqrtf(wave_sum(s) * (1.f / 512.f) + 1e-6f);
        if ((lane >> 4) == g) {
#pragma unroll
            for (int t = 0; t < 8; ++t) v[t] = v[t] * rstd * vgv[t];
            const int db = (lane & 15) >> 2;
            *(LAS u32x4*)(Vt + (db * 8 + (j >> 4)) * 1024 + (j & 15) * 64 + (lane & 3) * 16) = pack8(v);
        }
    }
#pragma unroll
    for (int k = 0; k < 4; ++k) {
        const int item = tid_ + 512 * k, i = item & 127, cidx = item >> 7, ks = cidx >> 1;
        const bool ok = (ks >> 2) <= (i >> 6);
        u32x4 w; w.x = ok ? cvtpk(wa[k].x, wa[k].y) : 0u; w.y = ok ? cvtpk(wa[k].z, wa[k].w) : 0u; w.z = ok ? cvtpk(wb[k].x, wb[k].y) : 0u; w.w = ok ? cvtpk(wb[k].z, wb[k].w) : 0u;
        *(LAS u32x4*)(Wt + cidx * 2048 + i * 16) = w;
    }
    const int ib = wid & 3, ch = wid >> 2;
    bf16 uraw[2][16];
#pragma unroll
    for (int dd = 0; dd < 2; ++dd)
#pragma unroll
        for (int r = 0; r < 16; ++r) uraw[dd][r] = Y1[(m0 + 32 * ib + crow(r, hi)) * 3072 + 1536 + 128 * g + 32 * (2 * ch + dd) + r32];
    __syncthreads();
    f32x16 acc[2];
    acc[0] = (f32x16){0.f, 0.f, 0.f, 0.f, 0.f, 0.f, 0.f, 0.f, 0.f, 0.f, 0.f, 0.f, 0.f, 0.f, 0.f, 0.f}; acc[1] = acc[0];
    const int vlane = ((lane >> 4) & 1) * 32 + (lane & 3) * 8 + (4 * hi + ((lane & 15) >> 2)) * 64;
#pragma unroll
    for (int ks = 0; ks < 8; ++ks) {
        const bf16x8 a = *(const LAS bf16x8*)(Wt + (2 * ks + hi) * 2048 + (32 * ib + r32) * 16);
#pragma unroll
        for (int dd = 0; dd < 2; ++dd) { const lds_cptr vb = (lds_cptr)(Vt + (2 * ch + dd) * 8192 + ks * 1024 + vlane);
            const s16x4 lo = vtr(vb), hh = vtr(vb + 512);
            acc[dd] = __builtin_amdgcn_mfma_f32_32x32x16_bf16(a, (bf16x8){lo[0], lo[1], lo[2], lo[3], hh[0], hh[1], hh[2], hh[3]}, acc[dd], 0, 0, 0); }
    }
    const float* bs = p.sgu_b + l * 512 + g * 128; bf16* OB = (bf16*)(F.ws + WS_OB);
#pragma unroll
    for (int dd = 0; dd < 2; ++dd)
#pragma unroll
        for (int r = 0; r < 16; ++r) { const int i = 32 * ib + crow(r, hi), c = 128 * g + 32 * (2 * ch + dd) + r32;
            const float u = gelu_tanh(bf2f(uraw[dd][r]));
            OB[(m0 + i) * 512 + c] = (bf16)(cvtpk(u * (acc[dd][r] + bs[i]), 0.f) & 0xffffu); }
    __syncthreads();
}

struct SchedG3 {
    static constexpr bool GATHER = false;
    __device__ __forceinline__ void a_ready(const GUnit&) const {}
    __device__ __forceinline__ void done(const GUnit&) const {}
    const char* OA; const char* WBR; int G, c;
    __device__ __forceinline__ bool next(int i, GUnit& u) const {
        const int tile = (i / 3) * G + c, n = i % 3; if (tile >= 256) return false;
        const int vt = (tile % 8) * 32 + tile / 8;
        const int pm = vt >> 2, pn = vt & 3;
        u.A = OA + (size_t)n * 16 * MiB + (size_t)pm * 256 * 1024; u.B = WBR + (size_t)n * MiB + (size_t)pn * 256 * 1024; u.nt = 8; u.i0 = pm; u.i1 = pn; u.i2 = n; return true;
    }
    __device__ __forceinline__ void offs(const GUnit&, int R0, int R1, int C0, int C1, unsigned (&oA)[2][2]) const {
        oA[0][0] = (unsigned)R0 * 1024u + C0 * 2u; oA[0][1] = (unsigned)R1 * 1024u + C1 * 2u; oA[1][0] = (unsigned)(R0 + 128) * 1024u + C0 * 2u; oA[1][1] = (unsigned)(R1 + 128) * 1024u + C1 * 2u; }
    __device__ __forceinline__ unsigned ldb_bytes() const { return 1024u; }
};
struct EpiG3 {
    const bf16* XG; bf16* MG;
    __device__ __forceinline__ void operator()(const f32x4 (&acc)[2][2][4][2], const GUnit& u, int wr, int wc, int fr, int fq) const {
        const int n = u.i2; const int row0 = u.i0 * 256 + wr * 64 + fr, col0 = u.i1 * 256 + wc * 32 + 8 * fq;
#pragma unroll
        for (int ai = 0; ai < 2; ++ai)
#pragma unroll
            for (int m = 0; m < 4; ++m) { const size_t row = row0 + ai * 128 + m * 16;
#pragma unroll
                for (int bj = 0; bj < 2; ++bj) { const int col = col0 + bj * 128;
                    float gv[8], pv[8], o[8]; unpack8(*(const GAS u32x4*)(XG + row * 3072 + n * 1024 + col), gv);
                    if (n > 0) unpack8(*(const GAS u32x4*)(MG + row * 1024 + col), pv);
                    const f32x4 v0 = acc[ai][bj][m][0], v1 = acc[ai][bj][m][1];
#pragma unroll
                    for (int t = 0; t < 8; ++t) { const float a = t < 4 ? v0[t & 3] : v1[t & 3]; o[t] = fast_sigmoid(gv[t]) * a + (n > 0 ? pv[t] : 0.f); }
                    *(GAS u32x4*)(MG + row * 1024 + col) = pack8(o); } }
    }
};
struct EpiG4 {
    float* X; const float* gate; const float* Xin;
    __device__ __forceinline__ void operator()(const f32x4 (&acc)[2][2][4][2], const GUnit& u, int wr, int wc, int fr, int fq) const {
        const int row0 = u.i0 * 256 + wr * 64 + fr, col0 = u.i1 * 256 + wc * 32 + 8 * fq; const int b = (u.i0 * 256) / S;
#pragma unroll
        for (int bj = 0; bj < 2; ++bj) { const int col = col0 + bj * 128;
            const f32x4 g0 = *(const GAS f32x4*)(gate + (size_t)b * 6 * D + col), g1 = *(const GAS f32x4*)(gate + (size_t)b * 6 * D + col + 4);
#pragma unroll
            for (int ai = 0; ai < 2; ++ai)
#pragma unroll
                for (int m = 0; m < 4; ++m) { float* xp = X + (size_t)(row0 + ai * 128 + m * 16) * D + col; const float* xi = Xin + (size_t)(row0 + ai * 128 + m * 16) * D + col;
                    f32x4 x0 = *(const GAS f32x4*)xi, x1 = *(const GAS f32x4*)(xi + 4);
                    x0 += g0 * acc[ai][bj][m][0]; x1 += g1 * acc[ai][bj][m][1];
                    st16f(xp, x0); st16f(xp + 4, x1); } }
    }
};
struct SchedG2 {
    static constexpr bool GATHER = false;
    __device__ __forceinline__ void a_ready(const GUnit&) const {}
    __device__ __forceinline__ void done(const GUnit&) const {}
    const char* Y1; const char* WUQ; const char* WUKV; int G, c;
    __device__ __forceinline__ bool next(int i, GUnit& u) const {
        const int L = i * G + c; if (L >= 448) return false;
        const bool kv = L >= 192; const int q = kv ? L - 192 : L; const int pm = kv ? (q >> 2) : q / 3, pn = kv ? (q & 3) : q % 3;
        u.A = Y1 + (size_t)pm * 256 * 6144 + (kv ? 2816 * 2 : 2560 * 2); u.B = (kv ? WUKV : WUQ) + (size_t)pn * 256 * 512; u.nt = 4; u.i0 = pm; u.i1 = pn; u.i2 = kv ? 1 : 0; return true;
    }
    __device__ __forceinline__ void offs(const GUnit&, int R0, int R1, int C0, int C1, unsigned (&oA)[2][2]) const {
        oA[0][0] = (unsigned)R0 * 6144u + C0 * 2u; oA[0][1] = (unsigned)R1 * 6144u + C1 * 2u; oA[1][0] = (unsigned)(R0 + 128) * 6144u + C0 * 2u; oA[1][1] = (unsigned)(R1 + 128) * 6144u + C1 * 2u; }
    __device__ __forceinline__ unsigned ldb_bytes() const { return 512u; }
};
}
namespace fk {
constexpr int HT_PITCH = 2064;
constexpr int RT_SMALL = 64 * HT_PITCH;
__device__ __forceinline__ void row_router(Frame& F, const Params& p, int l, const float* mod) {
    unsigned char* ws = F.ws; LAS unsigned char* HT = F.lds;
    const float* X = (const float*)(ws + WS_X); bf16* H = (bf16*)(ws + WS_H);
    const float* g = p.norm_g + (size_t)l * 2 * D + D; const float* shift = mod + 3 * D; const float* scale = mod + 4 * D;
    const float* bg = p.router_g_b + l * 4; const float* be = p.router_e_b + l * 32;
    unsigned* CNT = (unsigned*)(ws + WS_CTL) + CW_CNT + l * 32;
    int* LIST = (int*)(ws + WS_LIST); float* ROWW = (float*)(ws + WS_ROWW); int* TOKSLOT = (int*)(ws + WS_TOKSLOT);
    LAS int* rid = (LAS int*)(F.lds + RT_SMALL); LAS int* rrank = rid + 128; LAS float* rw = (LAS float*)(rrank + 128);
    LAS unsigned* cntl = (LAS unsigned*)(rw + 128); LAS unsigned* cbase = cntl + 32;
    if (F.tid < 32) cntl[F.tid] = 0u;
    constexpr int R = 2; int kk = 0;
    for (int m0 = F.gw; m0 < M; m0 += R * F.NGW, kk += R) {
        f32x4 v[R][4];
#pragma unroll
        for (int r = 0; r < R; ++r)
#pragma unroll
            for (int j = 0; j < 4; ++j) v[r][j] = *(const GAS f32x4*)(X + (size_t)(m0 + r * F.NGW) * D + 4 * F.lane + 256 * j);
#pragma unroll
        for (int r = 0; r < R; ++r) { const int m = m0 + r * F.NGW, b = m / S; float s = 0.f;
#pragma unroll
            for (int j = 0; j < 4; ++j) s += (v[r][j].x * v[r][j].x + v[r][j].y * v[r][j].y) + (v[r][j].z * v[r][j].z + v[r][j].w * v[r][j].w);
            const float rstd = rsqrtf(wave_sum(s) * (1.f / D) + 1e-6f);
            LAS unsigned char* hrow = HT + ((kk + r) * 8 + F.wave) * HT_PITCH;
#pragma unroll
            for (int j = 0; j < 4; ++j) { const int d = 4 * F.lane + 256 * j;
                const f32x4 gg = *(const GAS f32x4*)(g + d), sc = *(const GAS f32x4*)(scale + (size_t)b * 6 * D + d), sh = *(const GAS f32x4*)(shift + (size_t)b * 6 * D + d);
                const float o0 = v[r][j].x * rstd * gg.x * (1.f + sc.x) + sh.x, o1 = v[r][j].y * rstd * gg.y * (1.f + sc.y) + sh.y, o2 = v[r][j].z * rstd * gg.z * (1.f + sc.z) + sh.z, o3 = v[r][j].w * rstd * gg.w * (1.f + sc.w) + sh.w;
                u32x2 o; o.x = cvtpk(o0, o1); o.y = cvtpk(o2, o3); st8x(H + (size_t)m * D + d, o); *(LAS u32x2*)(hrow + d * 2) = o; }
        }
    }
    __syncthreads();
    const int tt = F.wave & 3, kh = F.wave >> 2, n16 = F.lane & 15, kq = F.lane >> 4;
    const bf16* WRT = (const bf16*)(ws + WS_WRT) + (size_t)l * 48 * 1024;
    f32x4 acc[3];
#pragma unroll
    for (int bl = 0; bl < 3; ++bl) acc[bl] = (f32x4){0.f, 0.f, 0.f, 0.f};
    const LAS unsigned char* hb = HT + (16 * tt + n16) * HT_PITCH + (512 * kh + 8 * kq) * 2;
    const bf16* wb = WRT + (size_t)n16 * 1024 + 512 * kh + 8 * kq;
#pragma unroll 4
    for (int ks = 0; ks < 16; ++ks) {
        const bf16x8 bfr = *(const LAS bf16x8*)(hb + ks * 64);
#pragma unroll
        for (int bl = 0; bl < 3; ++bl) { const bf16x8 afr = *(const GAS bf16x8*)(wb + (size_t)bl * 16 * 1024 + ks * 32);
            acc[bl] = __builtin_amdgcn_mfma_f32_16x16x32_bf16(afr, bfr, acc[bl], 0, 0, 0); }
    }
    __syncthreads();
    LAS float* LGP = (LAS float*)(F.lds);
    LAS float* LG = (LAS float*)(F.lds + 16384);
    if (kh == 1) {
#pragma unroll
        for (int bl = 0; bl < 3; ++bl)
#pragma unroll
            for (int q = 0; q < 4; ++q) LGP[((tt * 3 + bl) * 4 + q) * 64 + F.lane] = acc[bl][q];
    }
    __syncthreads();
    if (kh == 0) {
#pragma unroll
        for (int bl = 0; bl < 3; ++bl)
#pragma unroll
            for (int q = 0; q < 4; ++q) LG[(16 * tt + n16) * 48 + bl * 16 + 4 * kq + q] = acc[bl][q] + LGP[((tt * 3 + bl) * 4 + q) * 64 + F.lane];
    }
    __syncthreads();
    if (F.tid < 64) {
        const int slot = F.tid; const LAS float* lg = LG + slot * 48;
        const float g0 = lg[32] + bg[0], g1 = lg[33] + bg[1], g2 = lg[34] + bg[2], g3 = lg[35] + bg[3];
        int gi = 0; float mx = g0; if (g1 > mx) { mx = g1; gi = 1; } if (g2 > mx) { mx = g2; gi = 2; } if (g3 > mx) { mx = g3; gi = 3; }
        const float gw = 1.f / (__expf(g0 - mx) + __expf(g1 - mx) + __expf(g2 - mx) + __expf(g3 - mx));
        float e[8];
#pragma unroll
        for (int i = 0; i < 8; ++i) e[i] = lg[gi * 8 + i] + be[gi * 8 + i];
        float emx = e[0]; int e0 = 0;
#pragma unroll
        for (int i = 1; i < 8; ++i) if (e[i] > emx) { emx = e[i]; e0 = i; }
        float e2 = -1e30f; int e1 = 0;
#pragma unroll
        for (int i = 0; i < 8; ++i) if (i != e0 && e[i] > e2) { e2 = e[i]; e1 = i; }
        const float p1 = __expf(e2 - emx), w0 = 1.f / (1.f + p1), w1 = p1 / (1.f + p1);
        const int id0 = gi * 8 + e0, id1 = gi * 8 + e1;
        rid[2 * slot] = id0; rid[2 * slot + 1] = id1; rw[2 * slot] = gw * w0; rw[2 * slot + 1] = gw * w1;
        rrank[2 * slot] = (int)__hip_atomic_fetch_add(&cntl[id0], 1u, __ATOMIC_RELAXED, __HIP_MEMORY_SCOPE_WORKGROUP);
        rrank[2 * slot + 1] = (int)__hip_atomic_fetch_add(&cntl[id1], 1u, __ATOMIC_RELAXED, __HIP_MEMORY_SCOPE_WORKGROUP);
    }
    __syncthreads();
    if (F.tid < 32) { const unsigned c = cntl[F.tid]; cbase[F.tid] = c ? atomicAdd(&CNT[F.tid], c) : 0u; }
    __syncthreads();
    if (F.tid < 128) { const int slot = F.tid >> 1, id = rid[F.tid], pos = (int)cbase[id] + rrank[F.tid]; const int m = F.bid * NWAVES + (slot & 7) + (slot >> 3) * F.NGW;
        LIST[id * 16384 + pos] = m; ROWW[id * 16384 + pos] = rw[F.tid]; TOKSLOT[id * 16384 + pos] = 2 * m + (F.tid & 1); }
}
__device__ __forceinline__ void moe_table(Frame& F, int l) {
    LAS int* T = (LAS int*)(F.lds + TAB_OFF + 6144);
    int t = threadIdx.x; asm volatile("" : "+v"(t));
    if (t < 32) { const unsigned* CNT = (const unsigned*)(F.ws + WS_CTL) + CW_CNT + l * 32;
        T[t] = (int)__hip_atomic_load(CNT + t, __ATOMIC_RELAXED, __HIP_MEMORY_SCOPE_AGENT); }
    __syncthreads();
    if (t < 33) { int a = 0; for (int e = 0; e < t; ++e) a += (T[e] + 255) >> 8; T[32 + t] = a; }
    __syncthreads();
}
struct SchedG5 {
    static constexpr bool GATHER = true;
    const char* H; const char* WGU; const int* LIST; LAS const int* T; int G, c; unsigned* RDY;
    __device__ __forceinline__ void a_ready(const GUnit&) const {}
    __device__ __forceinline__ void done(const GUnit& u) const { asm volatile("s_waitcnt vmcnt(0)" ::: "memory"); if ((threadIdx.x & 63) == 0) __hip_atomic_fetch_add(RDY + u.i3, 1u, __ATOMIC_RELAXED, __HIP_MEMORY_SCOPE_AGENT); }
    __device__ __forceinline__ bool next(int i, GUnit& u) const {
        const int L = i * G + c; const int tot = __builtin_amdgcn_readfirstlane(T[64]); if (L >= 2 * tot) return false;
        const int mtg = L >> 1, ntile = L & 1; int e = 0;
#pragma unroll 1
        for (int k = 1; k < 32; ++k) if (__builtin_amdgcn_readfirstlane(T[32 + k]) <= mtg) e = k;
        const int tpe = __builtin_amdgcn_readfirstlane(T[32 + e]);
        u.A = H; u.B = WGU + ((size_t)e * 512 + ntile * 256) * 2048; u.nt = 16; u.i0 = e; u.i1 = mtg - tpe; u.i2 = ntile; u.i3 = mtg; return true;
    }
    __device__ __forceinline__ void offs(const GUnit& u, int R0, int R1, int C0, int C1, unsigned (&oA)[2][2]) const {
        const int cnt = __builtin_amdgcn_readfirstlane(T[u.i0]); const int* li = LIST + u.i0 * 16384; const int base = u.i1 * 256;
        const int a0 = base + R0, a1 = base + R1, a2 = base + R0 + 128, a3 = base + R1 + 128;
        const int t0 = a0 < cnt ? li[a0] : 0, t1 = a1 < cnt ? li[a1] : 0, t2 = a2 < cnt ? li[a2] : 0, t3 = a3 < cnt ? li[a3] : 0;
        oA[0][0] = (unsigned)t0 * 2048u + C0 * 2u; oA[0][1] = (unsigned)t1 * 2048u + C1 * 2u; oA[1][0] = (unsigned)t2 * 2048u + C0 * 2u; oA[1][1] = (unsigned)t3 * 2048u + C1 * 2u; }
    __device__ __forceinline__ unsigned ldb_bytes() const { return 2048u; }
};
struct EpiG5 {
    bf16* ACT; const float* ROWW; LAS const int* T;
    __device__ __forceinline__ void operator()(const f32x4 (&acc)[2][2][4][2], const GUnit& u, int wr, int wc, int fr, int fq) const {
        const int e = u.i0, cnt = __builtin_amdgcn_readfirstlane(T[e]), rbase = u.i1 * 256, arow0 = (__builtin_amdgcn_readfirstlane(T[32 + e]) + u.i1) * 256; const int f0 = u.i2 * 128 + wc * 32 + 8 * fq;
#pragma unroll
        for (int ai = 0; ai < 2; ++ai)
#pragma unroll
            for (int m = 0; m < 4; ++m) { const int rt = ai * 128 + wr * 64 + m * 16 + fr;
                if (rbase + rt < cnt) { const float w = ROWW[e * 16384 + rbase + rt]; float o[8];
#pragma unroll
                    for (int t = 0; t < 8; ++t) { const float gt = t < 4 ? acc[ai][0][m][0][t & 3] : acc[ai][0][m][1][t & 3], up = t < 4 ? acc[ai][1][m][0][t & 3] : acc[ai][1][m][1][t & 3];
                        o[t] = gt * fast_sigmoid(gt) * up * w; }
                    st16_wt(ACT + (size_t)(arow0 + rt) * 256 + f0, pack8(o)); } }
    }
};
struct SchedG6 {
    static constexpr bool GATHER = false;
    const char* ACT; const char* WDN; LAS const int* T; int G, c; const unsigned* RDY; unsigned* tmo;
    __device__ __forceinline__ bool next(int i, GUnit& u) const {
        const int tot = __builtin_amdgcn_readfirstlane(T[64]); const int u5 = 2 * tot; const int nx = (u5 > G && u5 < 2 * G) ? u5 - G : 0;
        if (c < nx) return false;
        const int L = i * (G - nx) + (c - nx); if (L >= 4 * tot) return false;
        const int mtg = L >> 2, ntile = L & 3; int e = 0;
#pragma unroll 1
        for (int k = 1; k < 32; ++k) if (__builtin_amdgcn_readfirstlane(T[32 + k]) <= mtg) e = k;
        const int tpe = __builtin_amdgcn_readfirstlane(T[32 + e]);
        u.A = ACT + (size_t)mtg * 256 * 512; u.B = WDN + ((size_t)e * 1024 + ntile * 256) * 512; u.nt = 4; u.i0 = e; u.i1 = mtg - tpe; u.i2 = ntile; u.i3 = mtg; return true;
    }
    __device__ __forceinline__ void offs(const GUnit&, int R0, int R1, int C0, int C1, unsigned (&oA)[2][2]) const {
        oA[0][0] = (unsigned)R0 * 512u + C0 * 2u; oA[0][1] = (unsigned)R1 * 512u + C1 * 2u; oA[1][0] = (unsigned)(R0 + 128) * 512u + C0 * 2u; oA[1][1] = (unsigned)(R1 + 128) * 512u + C1 * 2u; }
    __device__ __forceinline__ unsigned ldb_bytes() const { return 512u; }
    __device__ __forceinline__ void a_ready(const GUnit& u) const {
        if (__builtin_amdgcn_readfirstlane(threadIdx.x >> 6) == 0) {
            unsigned polls = 0;
            while ((unsigned)__builtin_amdgcn_readfirstlane(__hip_atomic_load(RDY + u.i3, __ATOMIC_RELAXED, __HIP_MEMORY_SCOPE_AGENT)) < 16u) {
                if ((++polls & 255u) == 0u && __builtin_amdgcn_readfirstlane(__hip_atomic_load(tmo, __ATOMIC_RELAXED, __HIP_MEMORY_SCOPE_AGENT)) != 0u) break;
                if (polls > (1u << 17)) { __hip_atomic_store(tmo, 1u, __ATOMIC_RELAXED, __HIP_MEMORY_SCOPE_AGENT); break; }
                __builtin_amdgcn_s_sleep(8); }
            __builtin_amdgcn_fence(__ATOMIC_ACQUIRE, "agent");
            asm volatile("s_waitcnt vmcnt(0)" ::: "memory");
        }
        asm volatile("" ::: "memory"); __builtin_amdgcn_s_barrier(); asm volatile("" ::: "memory");
    }
    __device__ __forceinline__ void done(const GUnit&) const {}
};
struct EpiG6 {
    bf16* Z; const int* TOKSLOT; LAS const int* T;
    __device__ __forceinline__ void operator()(const f32x4 (&acc)[2][2][4][2], const GUnit& u, int wr, int wc, int fr, int fq) const {
        const int e = u.i0, cnt = __builtin_amdgcn_readfirstlane(T[e]), rbase = u.i1 * 256; const int c0 = u.i2 * 256 + wc * 32 + 8 * fq;
#pragma unroll
        for (int ai = 0; ai < 2; ++ai)
#pragma unroll
            for (int m = 0; m < 4; ++m) { const int rt = ai * 128 + wr * 64 + m * 16 + fr;
                if (rbase + rt < cnt) { const int ts = TOKSLOT[e * 16384 + rbase + rt]; bf16* zp = Z + (size_t)ts * 1024 + c0;
#pragma unroll
                    for (int bj = 0; bj < 2; ++bj) { const f32x4 v0 = acc[ai][bj][m][0], v1 = acc[ai][bj][m][1];
                        u32x4 w; w.x = cvtpk(v0[0], v0[1]); w.y = cvtpk(v0[2], v0[3]); w.z = cvtpk(v1[0], v1[1]); w.w = cvtpk(v1[2], v1[3]);
                        st16x(zp + bj * 128, w); } } }
    }
};
}
#ifndef PH4MASK
#define PH4MASK 7
#endif
#ifndef PHMASK
#define PHMASK 0xFFFF
#endif
namespace fk {
__device__ __forceinline__ void relaunder(Frame& F) { int t = threadIdx.x; asm volatile("" : "+v"(t)); F.tid = t; F.lane = t & 63; }
__global__ void __launch_bounds__(NTHR, 2) fwd(Params p) {
    extern __shared__ __attribute__((aligned(16))) unsigned char lds_[];
    Frame F; F.lds = (LAS unsigned char*)lds_; F.ws = p.ws; F.tid = threadIdx.x; F.lane = F.tid & 63; F.wave = __builtin_amdgcn_readfirstlane(F.tid >> 6);
    F.G = gridDim.x; F.bid = blockIdx.x; F.gw = F.bid * NWAVES + F.wave; F.NGW = F.G * NWAVES;
    volatile LAS unsigned* MISC = (volatile LAS unsigned*)(F.lds + MISC_OFF);
    if (F.tid < 64) MISC[F.tid] = 0u;
    __syncthreads();
    unsigned* ctl = (unsigned*)(p.ws + WS_CTL);
    XcdBarrier bar = xcd_barrier_post(ctl + CW_BAR, MISC + 8);
    bool first = true;
    const int lo = p.ph_lo, hi = p.ph_hi;
#ifdef TIMEPH
    unsigned long long tacc = 0, tprev = 0; int prevph = -1;
#define TSTAMP(k) do { const unsigned long long now_ = __builtin_amdgcn_s_memrealtime(); if (prevph == (TIMEPH) || ((TIMEPH) == -2 && prevph >= 100)) tacc += now_ - tprev; tprev = now_; prevph = (k); } while (0)
#else
#define TSTAMP(k) do {} while (0)
#endif
#ifdef TIMEPH
#define TBAR() do { const unsigned long long now_ = __builtin_amdgcn_s_memrealtime(); if (prevph == (TIMEPH)) tacc += now_ - tprev; tprev = now_; prevph += 100; } while (0)
#else
#define TBAR() do {} while (0)
#endif
#define PHASE(k) if (lo <= (k) && (k) < hi) if ((first ? (void)0 : (({ TBAR(); }), xcd_barrier(bar))), first = false, relaunder(F), true) if (({ TSTAMP(k); true; }))
    unsigned char* ws = p.ws;
    if (p.l_lo == 0) PHASE(0) if constexpr (((PHMASK) >> 0) & 1) { p0_prologue(F, p); }
    for (int l = p.l_lo; l < p.l_hi; ++l) {
        const float* mod = (const float*)(ws + WS_MOD) + (size_t)l * NB * 6 * D;
        PHASE(1) if constexpr (((PHMASK) >> 1) & 1) {
            if (l == 0) row_normmod<0>(F, p.x, (float*)(ws + WS_X), nullptr, nullptr, p.norm_g + (size_t)l * 2 * D, mod, mod + D, (bf16*)(ws + WS_H), nullptr);
            else row_normmod<2>(F, nullptr, (float*)(ws + WS_X), (const bf16*)(ws + WS_Z), mod - (size_t)NB * 6 * D + 5 * D, p.norm_g + (size_t)l * 2 * D, mod, mod + D, (bf16*)(ws + WS_H), nullptr);
        }
        PHASE(2) if constexpr (((PHMASK) >> 2) & 1) {
            SchedDense S{(const char*)(ws + WS_H), (const char*)(ws + WS_WIN + (size_t)l * 6144 * 2048), 2048u, 2048u, 64, 24, 16, F.G, F.bid};
            EpiG1 E{(bf16*)(ws + WS_Y1), (bf16*)(ws + WS_XG), (bf16*)(ws + WS_KR), (float*)(ws + WS_STAT), p.diff_qk_g + l * 128, p.mla_qk_g + l * 192 + 96, (const float*)(ws + WS_CS), (const float*)(ws + WS_SN)};
            gemm_phase(F.lds, S, E);
        }
        PHASE(4) if constexpr (((PHMASK) >> 4) & 1) {
            if constexpr ((PH4MASK) & 1) {
              { SchedDense S{(const char*)(ws + WS_Y1) + 2560 * 2, (const char*)(ws + WS_WUQ + (size_t)l * 768 * 512), 6144u, 512u, 64, 3, 4, F.G, F.bid};
                EpiG2<0> E{(bf16*)(ws + WS_QC), (const float*)(ws + WS_STAT), p.mla_qk_g + l * 192, (const float*)(ws + WS_CS), (const float*)(ws + WS_SN)}; gemm_phase(F.lds, S, E); }
              { SchedDense S{(const char*)(ws + WS_Y1) + 2816 * 2, (const char*)(ws + WS_WUKV + (size_t)l * 1024 * 512), 6144u, 512u, 64, 4, 4, F.G, F.bid};
                EpiG2<1> E{(bf16*)(ws + WS_KVC), (const float*)(ws + WS_STAT), p.mla_qk_g + l * 192 + 96, (const float*)(ws + WS_CS), (const float*)(ws + WS_SN)}; gemm_phase(F.lds, S, E); } }
            TSTAMP(41);
            if constexpr ((PH4MASK) & 2) attn_phase<true>(F, p, l);
            TSTAMP(42);
            if constexpr ((PH4MASK) & 4) for (int u = F.bid; u < 512; u += F.G) sgu_unit(F, p, l, u);
        }
        PHASE(6) if constexpr (((PHMASK) >> 6) & 1) { attn_phase<false>(F, p, l); }
        PHASE(7) if constexpr (((PHMASK) >> 7) & 1) {
            SchedG3 S{(const char*)(ws + WS_OA), (const char*)(ws + WS_WBR + (size_t)l * 3 * MiB), F.G, F.bid};
            EpiG3 E{(const bf16*)(ws + WS_XG), (bf16*)(ws + WS_MERGED)};
            gemm_phase(F.lds, S, E);
        }
        PHASE(8) if constexpr (((PHMASK) >> 8) & 1) {
            SchedDense S{(const char*)(ws + WS_MERGED), (const char*)(ws + WS_WOUT + (size_t)l * 2 * MiB), 2048u, 2048u, 64, 4, 16, F.G, F.bid};
            EpiG4 E{(float*)(ws + WS_X), mod + 2 * D, l == 0 ? p.x : (const float*)(ws + WS_X)};
            gemm_phase(F.lds, S, E);
        }
        PHASE(9) if constexpr (((PHMASK) >> 9) & 1) { row_router(F, p, l, mod); }
        PHASE(10) if constexpr (((PHMASK) >> 10) & 1) {
            moe_table(F, l);
            unsigned* RDY = (unsigned*)(ws + WS_CTL) + CW_RDY + l * 256;
            { SchedG5 S{(const char*)(ws + WS_H), (const char*)(ws + WS_WGU + (size_t)l * 32 * MiB), (const int*)(ws + WS_LIST), (LAS const int*)(F.lds + TAB_OFF + 6144), F.G, F.bid, RDY};
              EpiG5 E{(bf16*)(ws + WS_ACT), (const float*)(ws + WS_ROWW), (LAS const int*)(F.lds + TAB_OFF + 6144)};
              gemm_phase(F.lds, S, E); }
            TSTAMP(43);
            { SchedG6 S{(const char*)(ws + WS_ACT), (const char*)(ws + WS_WDN + (size_t)l * 16 * MiB), (LAS const int*)(F.lds + TAB_OFF + 6144), F.G, F.bid, RDY, (unsigned*)(ws + WS_CTL) + CW_TMO2};
              EpiG6 E{(bf16*)(ws + WS_Z), (const int*)(ws + WS_TOKSLOT), (LAS const int*)(F.lds + TAB_OFF + 6144)};
              gemm_phase(F.lds, S, E); }
        }
    }
    if (p.l_hi == p.nlayers) PHASE(12) if constexpr (((PHMASK) >> 12) & 1) {
        const float* modl = (const float*)(ws + WS_MOD) + (size_t)(p.nlayers - 1) * NB * 6 * D;
        row_normmod<3>(F, nullptr, (float*)(ws + WS_X), (const bf16*)(ws + WS_Z), modl + 5 * D, nullptr, nullptr, nullptr, nullptr, p.out);
    }
#undef PHASE
#ifdef TIMEPH
    TSTAMP(99);
    if (blockIdx.x == 0 && threadIdx.x == 0) { const unsigned long long t0 = __builtin_amdgcn_s_memrealtime(), wait = tacc * (TMULT);
        while (__builtin_amdgcn_s_memrealtime() - t0 < wait) __builtin_amdgcn_s_sleep(32); }
#endif
}
}
static void fill_params(fk::Params& p, void* const* d_in, void* d_out, void* d_ws) {
    p.x = (const float*)d_in[0]; p.c = (const float*)d_in[1]; p.positions = (const int*)d_in[2];
    p.w_ada = (const float*)d_in[3]; p.b_ada = (const float*)d_in[4]; p.norm_g = (const float*)d_in[5]; p.w_in = (const float*)d_in[6];
    p.diff_qk_g = (const float*)d_in[7]; p.diff_lambda = (const float*)d_in[8]; p.diff_out_g = (const float*)d_in[9]; p.rel_bias = (const float*)d_in[10];
    p.sgu_v_g = (const float*)d_in[11]; p.sgu_w = (const float*)d_in[12]; p.sgu_b = (const float*)d_in[13];
    p.mla_lat_g = (const float*)d_in[14]; p.mla_w_uq = (const float*)d_in[15]; p.mla_w_ukv = (const float*)d_in[16]; p.mla_qk_g = (const float*)d_in[17];
    p.w_branch = (const float*)d_in[18]; p.w_out = (const float*)d_in[19]; p.router_g_w = (const float*)d_in[20]; p.router_g_b = (const float*)d_in[21];
    p.router_e_w = (const float*)d_in[22]; p.router_e_b = (const float*)d_in[23]; p.w_e_gate = (const float*)d_in[24]; p.w_e_up = (const float*)d_in[25]; p.w_e_down = (const float*)d_in[26];
    p.out = (float*)d_out; p.ws = (unsigned char*)d_ws;
}
static void launch_fast(hipStream_t st, fk::Params p, int l_lo, int l_hi, int ph_lo, int ph_hi) {
    static bool attr = false;
    if (!attr) { (void)hipFuncSetAttribute((const void*)fk::fwd, hipFuncAttributeMaxDynamicSharedMemorySize, fk::LDS_BYTES); attr = true; }
#if NLAUNCH != 1
    (void)hipMemsetAsync((char*)p.ws + fk::WS_CTL + fk::CW_BAR * 4, 0, XCD_BAR_WORDS * 4, st);
#endif
    p.l_lo = l_lo; p.l_hi = l_hi; p.ph_lo = ph_lo; p.ph_hi = ph_hi;
    hipLaunchKernelGGL(fk::fwd, dim3(256), dim3(fk::NTHR), fk::LDS_BYTES, st, p);
}
extern "C" void kernel_launch(void* const* d_in, const int* in_sizes, int n_in, void* d_out, int out_size, void* d_ws, size_t ws_size, hipStream_t stream) {
    if (fk::WS_END > ws_size) { fprintf(stderr, "ws too small: need %zu have %zu\n", (size_t)fk::WS_END, ws_size); return; }
    (void)hipMemsetAsync((char*)d_ws + fk::WS_CTL, 0, fk::CTL_ZERO_BYTES, stream);
    fk::Params p{}; fill_params(p, d_in, d_out, d_ws); p.nlayers = 4; p.pad_ = 0;
#if NLAUNCH == 1
    launch_fast(stream, p, 0, 4, 0, 13);
#else
    launch_fast(stream, p, 0, 1, 0, 1);
    for (int l = 0; l < 4; ++l) for (int ph = 1; ph <= 11; ++ph) launch_fast(stream, p, l, l + 1, ph, ph + 1);
    launch_fast(stream, p, 3, 4, 12, 13);
#endif
}
```

```cpp
#include <hip/hip_runtime.h>
#include <cstdio>
#include <cstdint>
#define NLAUNCH 1
#define WT_STORES 1
namespace fk {
#define LAS __attribute__((address_space(3)))
#define GAS __attribute__((address_space(1)))
typedef unsigned short bf16;
typedef short bf16x8 __attribute__((ext_vector_type(8)));
typedef short s16x4 __attribute__((ext_vector_type(4)));
typedef float f32x2 __attribute__((ext_vector_type(2)));
typedef float f32x4 __attribute__((ext_vector_type(4)));
typedef float f32x16 __attribute__((ext_vector_type(16)));
typedef unsigned u32x2 __attribute__((ext_vector_type(2)));
typedef unsigned u32x4 __attribute__((ext_vector_type(4)));
typedef __bf16 bf16x2_t __attribute__((ext_vector_type(2)));
constexpr int NB = 8, S = 2048, D = 1024, M = NB * S, NL = 4;
constexpr int NWAVES = 8, NTHR = 512;
constexpr float LOG2E = 1.4426950408889634f;

__device__ __forceinline__ unsigned cvtpk(float lo, float hi) { f32x2 v = {lo, hi}; bf16x2_t b = __builtin_convertvector(v, bf16x2_t); return __builtin_bit_cast(unsigned, b); }
__device__ __forceinline__ float bf_lo(unsigned u) { return __builtin_bit_cast(float, u << 16); }
__device__ __forceinline__ float bf_hi(unsigned u) { return __builtin_bit_cast(float, u & 0xffff0000u); }
__device__ __forceinline__ float bf2f(bf16 u) { return __builtin_bit_cast(float, (unsigned)u << 16); }
template <int K> __device__ __forceinline__ float sw(float v) { return __builtin_bit_cast(float, __builtin_amdgcn_ds_swizzle(__builtin_bit_cast(int, v), 0x1F | (K << 10))); }
__device__ __forceinline__ int x32_addr() { int z = 0; asm volatile("" : "+v"(z)); const int l = __builtin_amdgcn_mbcnt_hi(-1, __builtin_amdgcn_mbcnt_lo(-1, z)); return (l ^ 32) << 2; }
__device__ __forceinline__ float xget32(float v, bool) { return __builtin_bit_cast(float, __builtin_amdgcn_ds_bpermute(x32_addr(), __builtin_bit_cast(int, v))); }
__device__ __forceinline__ float xsum32(float v) { return v + xget32(v, false); }
__device__ __forceinline__ float xmax32(float v) { return __builtin_fmaxf(v, xget32(v, false)); }
#ifdef OLD_WSUM
__device__ __forceinline__ float wave_sum(float v) { for (int o = 1; o < 64; o <<= 1) v += __shfl_xor(v, o); return v; }
#else
__device__ __forceinline__ float wave_sum(float v) { v += sw<1>(v); v += sw<2>(v); v += sw<4>(v); v += sw<8>(v); v += sw<16>(v); return xsum32(v); }
#endif
__device__ __forceinline__ float fast_sigmoid(float x) { return __builtin_amdgcn_rcpf(1.f + __builtin_amdgcn_exp2f(-x * LOG2E)); }
__device__ __forceinline__ float gelu_tanh(float x) { const float y = 0.7978845608028654f * (x + 0.044715f * x * x * x); return x * fast_sigmoid(2.f * y); }
#define LDS_WAIT() asm volatile("s_waitcnt lgkmcnt(0)" ::: "memory")
__device__ __forceinline__ void st16_wt(void* p, u32x4 v) { asm volatile("global_store_dwordx4 %0, %1, off sc1\n\ts_nop 1" :: "v"(p), "v"(v) : "memory"); }
#ifdef WT_ALL
__device__ __forceinline__ void st16x(void* p, u32x4 v) { asm volatile("global_store_dwordx4 %0, %1, off sc1\n\ts_nop 1" :: "v"(p), "v"(v) : "memory"); }
__device__ __forceinline__ void st16f(void* p, f32x4 v) { asm volatile("global_store_dwordx4 %0, %1, off sc1\n\ts_nop 1" :: "v"(p), "v"(v) : "memory"); }
__device__ __forceinline__ void st8x(void* p, u32x2 v) { asm volatile("global_store_dwordx2 %0, %1, off sc1\n\ts_nop 1" :: "v"(p), "v"(v) : "memory"); }
#else
__device__ __forceinline__ void st16x(void* p, u32x4 v) { *(GAS u32x4*)p = v; }
__device__ __forceinline__ void st16f(void* p, f32x4 v) { *(GAS f32x4*)p = v; }
__device__ __forceinline__ void st8x(void* p, u32x2 v) { *(GAS u32x2*)p = v; }
#endif
#ifdef WT_STORES
__device__ __forceinline__ void st16(void* p, u32x4 v) { asm volatile("global_store_dwordx4 %0, %1, off sc1\n\ts_nop 1" :: "v"(p), "v"(v) : "memory"); }
#else
__device__ __forceinline__ void st16(void* p, u32x4 v) { *(GAS u32x4*)p = v; }
#endif
#define VM_WAIT() asm volatile("s_waitcnt vmcnt(0)" ::: "memory")

#define XB_TMO      128
#define XB_XCNT(j)  (256  + 64 * (j))
#define XB_XSUB(j)  (1280 + 64 * (j))
#define XB_XGEN(j)  (2304 + 64 * (j))
#define XB_TOP      3328
#define XB_TOPGEN   3392
#define XCD_BAR_WORDS 3456
#define XB_SPIN_CAP (1u << 18)
__device__ __forceinline__ unsigned xb_ld(unsigned* p)              { return __hip_atomic_load(p, __ATOMIC_RELAXED, __HIP_MEMORY_SCOPE_AGENT); }
__device__ __forceinline__ unsigned xb_add(unsigned* p, unsigned v) { return __hip_atomic_fetch_add(p, v, __ATOMIC_RELAXED, __HIP_MEMORY_SCOPE_AGENT); }
__device__ __forceinline__ unsigned xb_xcc_id() { return (unsigned)__builtin_amdgcn_s_getreg((3 << 11) | 20) & 0xFu; }
#define XB_SPIN(cond, bar) do { unsigned _sp = 0; while (cond) { __builtin_amdgcn_s_sleep(1); \
    if ((++_sp & 255u) == 0u) { if (xb_ld(&(bar)[XB_TMO])) break; if (_sp > XB_SPIN_CAP) { atomicAdd(&(bar)[XB_TMO], 1u); break; } } } } while (0)
struct XcdBarrier { unsigned* bar; unsigned x; volatile LAS unsigned* st; };
__device__ __forceinline__ XcdBarrier xcd_barrier_post(unsigned* bar, volatile LAS unsigned* st) {
    XcdBarrier b; b.bar = bar; b.x = xb_xcc_id(); b.st = st;
    if (threadIdx.x == 0) st[2] = xb_add(&bar[XB_XCNT(b.x)], 1u);
    return b;
}
__device__ __forceinline__ void xcd_barrier_complete(unsigned* bar, unsigned x, unsigned& nloc, unsigned& nx) {
    const unsigned G = gridDim.x * gridDim.y * gridDim.z;
    unsigned sum, cnt, mine, sp = 0u;
    for (;;) {
        sum = 0u; cnt = 0u; mine = 0u;
#pragma unroll
        for (unsigned j = 0; j < 16; ++j) { const unsigned c = xb_ld(&bar[XB_XCNT(j)]); sum += c; cnt += (c > 0u) ? 1u : 0u; mine = (j == x) ? c : mine; }
        if (sum == G) break;
        __builtin_amdgcn_s_sleep(1);
        if ((++sp & 255u) == 0u) { if (xb_ld(&bar[XB_TMO])) break; if (sp > XB_SPIN_CAP) { atomicAdd(&bar[XB_TMO], 1u); break; } }
    }
    nloc = mine > 0u ? mine : 1u; nx = cnt > 0u ? cnt : 1u;
}
__device__ __forceinline__ void xcd_barrier(const XcdBarrier& b) {
    asm volatile("s_waitcnt vmcnt(0)" ::: "memory");
    __syncthreads();
    if (threadIdx.x == 0) {
        unsigned* bar = b.bar;
        __builtin_amdgcn_s_waitcnt(0);
        unsigned nloc = b.st[0], nx = b.st[1];
        if (nloc == 0u) { xcd_barrier_complete(bar, b.x, nloc, nx); b.st[0] = nloc; b.st[1] = nx; }
        const unsigned old = xb_add(&bar[XB_XSUB(b.x)], 1u);
        const unsigned gen = old / nloc;
        if (old + 1u == (gen + 1u) * nloc) {
            __builtin_amdgcn_fence(__ATOMIC_RELEASE, "agent");
            asm volatile("s_waitcnt vmcnt(0)" ::: "memory");
            const unsigned og = xb_add(&bar[XB_TOP], 1u);
            const unsigned tg = og / nx;
            if (og + 1u == (tg + 1u) * nx) xb_add(&bar[XB_TOPGEN], 1u);
            else XB_SPIN(xb_ld(&bar[XB_TOPGEN]) == tg, bar);
            __builtin_amdgcn_fence(__ATOMIC_ACQUIRE, "agent");
            xb_add(&bar[XB_XGEN(b.x)], 1u);
            asm volatile("s_waitcnt vmcnt(0)" ::: "memory");
        } else {
            XB_SPIN(xb_ld(&bar[XB_XGEN(b.x)]) == gen, bar);
            __builtin_amdgcn_fence(__ATOMIC_ACQUIRE, "agent");
            asm volatile("s_waitcnt vmcnt(0)" ::: "memory");
        }
    }
    __syncthreads();
}

__device__ __forceinline__ void xcc_barrier(const XcdBarrier& b, unsigned* gb, unsigned nloc) {
    asm volatile("s_waitcnt vmcnt(0)" ::: "memory");
    __syncthreads();
    if (threadIdx.x == 0) {
        __builtin_amdgcn_s_waitcnt(0);
        const unsigned old = xb_add(&gb[64 * b.x], 1u); const unsigned gen = old / nloc;
        if (old + 1u == (gen + 1u) * nloc) xb_add(&gb[1024 + 64 * b.x], 1u);
        else XB_SPIN(xb_ld(&gb[1024 + 64 * b.x]) == gen, b.bar);
        __builtin_amdgcn_fence(__ATOMIC_ACQUIRE, "agent");
        asm volatile("s_waitcnt vmcnt(0)" ::: "memory");
    }
    __syncthreads();
}

constexpr int BM = 256, BK = 64, HALF = 128, HTB = HALF * BK * 2;
__device__ __forceinline__ void stage_rc(int b, int& R, int& C) { const int st = b / 1024, sb = b % 1024, swz = sb ^ (((sb >> 9) & 1) << 5); R = (st >> 1) * 16 + swz / 64; C = (st & 1) * 32 + (swz % 64) / 2; }
__device__ __forceinline__ int lds_byte(int r, int c) { const int st = (r >> 4) * 2 + (c >> 5), rr = r & 15, cc = c & 31, ob = rr * 64 + cc * 2; return st * 1024 + (ob ^ (((ob >> 9) & 1) << 5)); }
__device__ __forceinline__ int perm32(int rho) { const int n = rho >> 4, i = rho & 15; return 8 * (i >> 2) + 4 * n + (i & 3); }

struct GUnit { const char* A; const char* B; int nt; int i0, i1, i2, i3; int hm; };
template <class Epi, class Sched>
__device__ __forceinline__ void gemm_phase(LAS unsigned char* lds, const Sched& S, const Epi& E) {
    int tid = threadIdx.x; asm volatile("" : "+v"(tid));
    const int wid = __builtin_amdgcn_readfirstlane(tid >> 6), lane = tid & 63, wr = wid >> 2, wc = wid & 3, fr = lane & 15, fq = lane >> 4;
    int R0, C0, R1, C1; stage_rc(tid * 16, R0, C0); stage_rc(tid * 16 + 8192, R1, C1);
    const unsigned ldb = S.ldb_bytes();
    unsigned voffB[2];
    voffB[0] = (unsigned)((R0 & ~31) + perm32(R0 & 31)) * ldb + (unsigned)C0 * 2u; voffB[1] = (unsigned)((R1 & ~31) + perm32(R1 & 31)) * ldb + (unsigned)C1 * 2u;
    unsigned voffBh[2]; voffBh[0] = voffB[0] + (unsigned)HALF * ldb; voffBh[1] = voffB[1] + (unsigned)HALF * ldb;
    const unsigned ldsw = (unsigned)wid * 1024u;
    const int aoff = lds_byte(wr * 64 + fr, fq * 8), boff = lds_byte(wc * 32 + fr, fq * 8);
#define PG8_SA(b, h) (((b) * 2 + (h)) * HTB)
#define PG8_SB(b, h) ((4 + (b) * 2 + (h)) * HTB)
#define PG8_STAGE(bufoff, gbase, voff, kofs) do { _Pragma("unroll") for (int _i = 0; _i < 2; ++_i) \
        __builtin_amdgcn_global_load_lds((const unsigned*)((const char*)(gbase) + (unsigned)((voff)[_i] + (kofs))), (LAS unsigned*)(lds + (bufoff) + ldsw + _i * 8192), 16, 0, 0); } while (0)
#define PG8_LDA(dst, b, h) do { _Pragma("unroll") for (int m = 0; m < 4; ++m) _Pragma("unroll") for (int k = 0; k < 2; ++k) dst[m][k] = *(const LAS bf16x8*)(lds + PG8_SA(b, h) + aoff + m * 2048 + k * 1024); } while (0)
#define PG8_LDB(dst, b, h) do { _Pragma("unroll") for (int n = 0; n < 2; ++n) _Pragma("unroll") for (int k = 0; k < 2; ++k) dst[n][k] = *(const LAS bf16x8*)(lds + PG8_SB(b, h) + boff + n * 2048 + k * 1024); } while (0)
#define PG8_MMA(ai, bj, At, Bt) do { __builtin_amdgcn_s_setprio(1); _Pragma("unroll") for (int m = 0; m < 4; ++m) _Pragma("unroll") for (int n = 0; n < 2; ++n) _Pragma("unroll") for (int k = 0; k < 2; ++k) \
        acc[ai][bj][m][n] = __builtin_amdgcn_mfma_f32_16x16x32_bf16(Bt[n][k], At[m][k], acc[ai][bj][m][n], 0, 0, 0); __builtin_amdgcn_s_setprio(0); } while (0)
#define PG8_WAIT_V(n) asm volatile("s_waitcnt vmcnt(" #n ")" ::: "memory")
#define PG8_WAIT_L(n) asm volatile("s_waitcnt lgkmcnt(" #n ")" ::: "memory")
#define PG8_BAR __builtin_amdgcn_s_barrier()
#define PG8_SCHED __builtin_amdgcn_sched_barrier(0)
    GUnit cur, nxt; int ui = 0;
    if (!S.next(0, cur)) return;
    f32x4 acc[2][2][4][2];
#pragma unroll
    for (int a = 0; a < 2; ++a)
#pragma unroll
        for (int b = 0; b < 2; ++b)
#pragma unroll
            for (int m = 0; m < 4; ++m)
#pragma unroll
                for (int n = 0; n < 2; ++n) acc[a][b][m][n] = (f32x4){0.f, 0.f, 0.f, 0.f};
    bf16x8 At[4][2], B0[2][2], B1[2][2];
    unsigned oAc[2][2], oAn[2][2];
    S.a_ready(cur);
    S.offs(cur, R0, R1, C0, C1, oAc);
    const char* cA = cur.A; const char* cB = cur.B;
    PG8_STAGE(PG8_SB(0, 0), cB, voffB, 0u); PG8_STAGE(PG8_SB(0, 1), cB, voffBh, 0u); PG8_STAGE(PG8_SA(0, 0), cA, oAc[0], 0u); PG8_STAGE(PG8_SA(0, 1), cA, oAc[1], 0u);
    if (wr == 1) PG8_BAR;
    PG8_WAIT_V(2); PG8_BAR;
    PG8_STAGE(PG8_SB(1, 0), cB, voffB, 128u); PG8_STAGE(PG8_SA(1, 0), cA, oAc[0], 128u); PG8_STAGE(PG8_SB(1, 1), cB, voffBh, 128u);
    PG8_WAIT_V(6); PG8_BAR;
    for (;;) {
        const bool has_next = S.next(ui + 1, nxt);
        const char* nA = has_next ? nxt.A : cA; const char* nB = has_next ? nxt.B : cB;
        if constexpr (Sched::GATHER) { if (has_next) S.offs(nxt, R0, R1, C0, C1, oAn);
            else { oAn[0][0] = oAc[0][0]; oAn[0][1] = oAc[0][1]; oAn[1][0] = oAc[1][0]; oAn[1][1] = oAc[1][1]; } }
        int nt = cur.nt; asm volatile("" : "+s"(nt)); const bool hm = Sched::HALFM && cur.hm != 0;
        for (int t = 0; t < nt; t += 2) {
            const bool last = (t == nt - 2);
            if (last && has_next) S.a_ready(nxt);
            const unsigned k1 = (unsigned)(t + 1) * 128u, k2 = last ? 0u : (unsigned)(t + 2) * 128u, k3 = k2 + 128u;
            const char* a2 = last ? nA : cA; const char* b2 = last ? nB : cB;
            unsigned o2[2][2];
            if constexpr (Sched::GATHER) { o2[0][0] = last ? oAn[0][0] : oAc[0][0]; o2[0][1] = last ? oAn[0][1] : oAc[0][1]; o2[1][0] = last ? oAn[1][0] : oAc[1][0]; o2[1][1] = last ? oAn[1][1] : oAc[1][1]; }
            else { o2[0][0] = oAc[0][0]; o2[0][1] = oAc[0][1]; o2[1][0] = oAc[1][0]; o2[1][1] = oAc[1][1]; }
            PG8_LDB(B0, 0, 0); PG8_LDB(B1, 0, 1); PG8_SCHED; PG8_LDA(At, 0, 0); PG8_STAGE(PG8_SA(1, 1), cA, oAc[1], k1);
            PG8_WAIT_V(8); PG8_WAIT_L(0); PG8_BAR; PG8_MMA(0, 0, At, B0); PG8_MMA(0, 1, At, B1); PG8_BAR; PG8_SCHED;
            if (!hm) PG8_LDA(At, 0, 1); PG8_STAGE(PG8_SB(0, 0), b2, voffB, k2); PG8_STAGE(PG8_SB(0, 1), b2, voffBh, k2); PG8_STAGE(PG8_SA(0, 0), a2, o2[0], k2);
            PG8_WAIT_V(8); PG8_WAIT_L(0); PG8_BAR; if (!hm) { PG8_MMA(1, 0, At, B0); PG8_MMA(1, 1, At, B1); } PG8_BAR; PG8_SCHED;
            PG8_LDB(B0, 1, 0); PG8_LDB(B1, 1, 1); PG8_SCHED; PG8_LDA(At, 1, 0); PG8_STAGE(PG8_SA(0, 1), a2, o2[1], k2);
            PG8_WAIT_V(8); PG8_WAIT_L(0); PG8_BAR; PG8_MMA(0, 0, At, B0); PG8_MMA(0, 1, At, B1); PG8_BAR; PG8_SCHED;
            if (!hm) PG8_LDA(At, 1, 1); PG8_STAGE(PG8_SB(1, 0), b2, voffB, k3); PG8_STAGE(PG8_SB(1, 1), b2, voffBh, k3); PG8_STAGE(PG8_SA(1, 0), a2, o2[0], k3);
            PG8_WAIT_V(8); PG8_WAIT_L(0); PG8_BAR; if (!hm) { PG8_MMA(1, 0, At, B0); PG8_MMA(1, 1, At, B1); } PG8_BAR; PG8_SCHED;
        }
        if (wr == 0) PG8_BAR;
        { int fr2 = fr, fq2 = fq; asm volatile("" : "+v"(fr2), "+v"(fq2)); E(acc, cur, wr, wc, fr2, fq2); S.done(cur); }
        if (!has_next) break;
#pragma unroll
        for (int a = 0; a < 2; ++a)
#pragma unroll
            for (int b = 0; b < 2; ++b)
#pragma unroll
                for (int m = 0; m < 4; ++m)
#pragma unroll
                    for (int n = 0; n < 2; ++n) acc[a][b][m][n] = (f32x4){0.f, 0.f, 0.f, 0.f};
        cur = nxt; cA = nA; cB = nB; ++ui;
        if constexpr (Sched::GATHER) { oAc[0][0] = oAn[0][0]; oAc[0][1] = oAn[0][1]; oAc[1][0] = oAn[1][0]; oAc[1][1] = oAn[1][1]; }
        if (wr == 1) PG8_BAR;
    }
    PG8_WAIT_V(0);
    PG8_BAR;
#undef PG8_SA
#undef PG8_SB
#undef PG8_STAGE
#undef PG8_LDA
#undef PG8_LDB
#undef PG8_MMA
#undef PG8_WAIT_V
#undef PG8_WAIT_L
#undef PG8_BAR
#undef PG8_SCHED
}
}
namespace fk {
constexpr size_t MiB = 1u << 20;
constexpr size_t WS_CTL = 0, CTL_ZERO_BYTES = 64 * 1024;
constexpr size_t WS_MOD = 1 * MiB;
constexpr size_t WS_BT = WS_MOD + 832 * 1024;
constexpr size_t WS_LAM = WS_BT + 4096;
constexpr size_t WS_ST = WS_MOD + 896 * 1024;
constexpr size_t WS_CS = 2 * MiB, WS_SN = 3 * MiB;
constexpr size_t WS_LIST = 4 * MiB, WS_ROWW = 6 * MiB, WS_TOKSLOT = 8 * MiB;
constexpr size_t WS_WIN = 10 * MiB;
constexpr size_t WS_WUQ = 58 * MiB;
constexpr size_t WS_WRT = 59 * MiB + 512 * 1024;
constexpr size_t WS_WUKV = 60 * MiB;
constexpr size_t WS_WBR = 62 * MiB;
constexpr size_t WS_WOUT = 74 * MiB;
constexpr size_t WS_WGU = 82 * MiB;
constexpr size_t WS_WDN = 210 * MiB;
constexpr size_t WS_X = 274 * MiB;
constexpr size_t WS_MERGED = 306 * MiB;
constexpr size_t WS_POOL = 338 * MiB;
constexpr size_t WS_Y1 = WS_POOL;
constexpr size_t WS_Z = WS_POOL;
constexpr size_t WS_ACT = WS_POOL + 96 * MiB;
constexpr size_t WS_XG = WS_POOL + 96 * MiB;
constexpr size_t WS_QC = WS_POOL + 192 * MiB;
constexpr size_t WS_KVC = WS_POOL + 216 * MiB;
constexpr size_t WS_KR = WS_POOL + 248 * MiB;
constexpr size_t WS_STAT = WS_KR + 1 * MiB;
constexpr size_t WS_OA = WS_POOL + 250 * MiB, WS_OB = WS_POOL + 266 * MiB, WS_OC = WS_POOL + 282 * MiB;
constexpr size_t WS_H = WS_POOL + 298 * MiB;
constexpr size_t WS_END = WS_POOL + 330 * MiB;
constexpr int CW_BAR = 1024;
constexpr int CW_CNT = 8192;
constexpr int CW_GBAR = 4608;
constexpr int CW_RDY = 9216;
constexpr int CW_G2CNT = 8512;
constexpr int CW_TMO2 = 8448;
static_assert((CW_RDY + 4 * 256) * 4 <= (int)CTL_ZERO_BYTES, "ctl map 2");
static_assert((CW_BAR + XCD_BAR_WORDS) <= CW_CNT && (CW_CNT + 4 * 32) * 4 <= (int)CTL_ZERO_BYTES, "ctl map");
constexpr int RING_BYTES = 131072, TAB_OFF = RING_BYTES, MISC_OFF = TAB_OFF + 8192, LDS_BYTES = 147456;

__device__ __forceinline__ size_t zrow(int ts) { return (size_t)(ts >> 12) * 6291456u + (size_t)(ts & 4095) * 1024u; }
struct Params {
    const float *x, *c; const int* positions; const float *w_ada, *b_ada, *norm_g, *w_in, *diff_qk_g, *diff_lambda, *diff_out_g, *rel_bias, *sgu_v_g, *sgu_w, *sgu_b,
        *mla_lat_g, *mla_w_uq, *mla_w_ukv, *mla_qk_g, *w_branch, *w_out, *router_g_w, *router_g_b, *router_e_w, *router_e_b, *w_e_gate, *w_e_up, *w_e_down;
    float* out; unsigned char* ws; int ph_lo, ph_hi; int l_lo, l_hi; int nlayers, pad_;
};

__device__ __forceinline__ void transpose_blk(const float* W, int ldw, int sc0, int k0, bf16* WT, int dr0, int ldt, const float* kscale, LAS float* scr, int lane) {
    float tv[32];
#pragma unroll
    for (int i = 0; i < 32; ++i) { const int kk = 2 * i + (lane >> 5); tv[i] = W[(size_t)(k0 + kk) * ldw + sc0 + (lane & 31)]; }
#pragma unroll
    for (int i = 0; i < 32; ++i) { const int kk = 2 * i + (lane >> 5); float v = tv[i]; if (kscale) v *= kscale[k0 + kk]; scr[kk * 33 + (lane & 31)] = v; }
    LDS_WAIT(); asm volatile("" ::: "memory");
    const int c = lane & 7;
#pragma unroll
    for (int j = 0; j < 4; ++j) { const int n = (lane >> 3) + 8 * j; const LAS float* sp = scr + (8 * c) * 33 + n;
        u32x4 o; o.x = cvtpk(sp[0 * 33], sp[1 * 33]); o.y = cvtpk(sp[2 * 33], sp[3 * 33]); o.z = cvtpk(sp[4 * 33], sp[5 * 33]); o.w = cvtpk(sp[6 * 33], sp[7 * 33]);
        *(GAS u32x4*)(WT + (size_t)(dr0 + n) * ldt + k0 + 8 * c) = o; }
    LDS_WAIT(); asm volatile("" ::: "memory");
}
__device__ __forceinline__ void transpose_item(const float* W, int K, int ldw, int c0, int ncols, bf16* WT, int row_off, LAS float* scr, int item, int lane, int ldt = 0) {
    if (ldt == 0) ldt = K;
    const int nblk = ncols / 32, kb = item / nblk, nb = item % nblk;
    transpose_blk(W, ldw, c0 + 32 * nb, 64 * kb, WT, row_off + 32 * nb, ldt, nullptr, scr, lane);
}
}
namespace fk {
struct Frame { LAS unsigned char* lds; unsigned char* ws; int tid, lane, wave, G, bid, gw, NGW; };

constexpr int IT_IN1 = 16 * 93, IT_IN2 = 16 * 96, IT_UQ = 4 * 24, IT_UKV = 2 * 32, IT_BR = 8 * 32, IT_OUT = 16 * 32, IT_NONEXP = IT_IN1 + IT_IN2 + IT_UQ + IT_UKV + 3 * IT_BR + IT_OUT;
constexpr int IT_EXP = 4 * 64 + 128, IT_LAYER = IT_NONEXP + 32 * IT_EXP, IT_TOTAL = NL * IT_LAYER;
__device__ __forceinline__ void p0_prologue(Frame& F, const Params& p) {
    unsigned char* ws = F.ws;
    LAS float* cact = (LAS float*)(F.lds);
    for (int i = F.tid; i < NB * D; i += NTHR) { const float v = p.c[i]; cact[i] = v / (1.f + __expf(-v)); }
    __syncthreads();
    LAS float* part = (LAS float*)(F.lds + 32768);
    float* MOD = (float*)(ws + WS_MOD);
    for (int it = F.bid; it < NL * 192; it += F.G) {
        const int l = it / 192, cg = it % 192, col = cg * 32 + (F.lane & 31), kpar = F.lane >> 5;
        const int kb = F.wave * 128 + kpar;
        const float* w = p.w_ada + (size_t)l * D * 6 * D + (size_t)kb * 6 * D + col;
        float acc[NB];
#pragma unroll
        for (int b = 0; b < NB; ++b) acc[b] = 0.f;
#pragma unroll 16
        for (int i = 0; i < 64; ++i) { const float wv = w[(size_t)(2 * i) * 6 * D];
#pragma unroll
            for (int b = 0; b < NB; ++b) acc[b] += cact[b * D + kb + 2 * i] * wv; }
#pragma unroll
        for (int b = 0; b < NB; ++b) { const float s2 = xsum32(acc[b]); if (F.lane < 32) part[(F.wave * NB + b) * 32 + F.lane] = s2; }
        __syncthreads();
        if (F.tid < 256) { const int b = F.tid >> 5, c = F.tid & 31; float s = 0.f;
#pragma unroll
          for (int wv = 0; wv < 8; ++wv) s += part[(wv * NB + b) * 32 + c];
          MOD[((size_t)l * NB + b) * 6 * D + cg * 32 + c] = s + p.b_ada[l * 6 * D + cg * 32 + c]; }
        __syncthreads();
    }
    const int gt = F.bid * NTHR + F.tid, NGT = F.G * NTHR;
    if (gt < NL) { const float* dl = p.diff_lambda + gt * 256; float s01 = 0.f, s23 = 0.f;
        for (int i = 0; i < 64; ++i) { s01 += dl[i] * dl[64 + i]; s23 += dl[128 + i] * dl[192 + i]; }
        ((float*)(ws + WS_LAM))[gt] = expf(s01) - expf(s23) + (0.8f - 0.6f * expf(-0.3f * (float)gt)); }
    if (gt >= 1024 && gt < 1024 + 4 * 256) { const int i = gt - 1024, h = i >> 8, rel = (i & 255) - 191; const int n = rel < 0 ? -rel : rel;
        int large = 8 + (int)(logf((float)(n > 1 ? n : 1) / 8.f) / 2.772588722239781f * 8.f); if (large > 15) large = 15;
        const int bucket = (rel > 0 ? 16 : 0) + (n < 8 ? n : large);
        ((float*)(ws + WS_BT))[i] = (p.rel_bias[bucket * 4 + h] - p.rel_bias[15 * 4 + h]) * LOG2E; }
    for (int i = gt; i < M * 16; i += NGT) { const int m = i >> 4, j = i & 15; const float inv_freq = powf(10000.f, -(float)(2 * j) / 32.f);
        const float ang = (float)p.positions[m] * inv_freq; ((float*)(ws + WS_CS))[i] = cosf(ang); ((float*)(ws + WS_SN))[i] = sinf(ang); }
    for (int i = gt; i < NL * 96 * 128; i += NGT) { const int l = i / (96 * 128), r = i % (96 * 128); ((u32x4*)(ws + WS_WIN + (size_t)l * 6144 * 2048 + (size_t)2976 * 2048))[r] = (u32x4){0u, 0u, 0u, 0u}; }
    for (int i = gt; i < NL * 48 * 1024; i += NGT) { const int l = i / (48 * 1024), r = i % (48 * 1024), o = r >> 10, k = r & 1023;
        const float v = o < 32 ? p.router_e_w[((size_t)l * D + k) * 32 + o] : (o < 36 ? p.router_g_w[((size_t)l * D + k) * 4 + (o - 32)] : 0.f);
        ((bf16*)(ws + WS_WRT))[i] = (bf16)(cvtpk(v, 0.f) & 0xffffu); }
    for (int i = gt; i < NL * 1024 * 16; i += NGT) { const int rr = i >> 4, q = i & 15; ((u32x4*)(ws + WS_WUKV + (size_t)rr * 512 + 256))[q] = (u32x4){0u, 0u, 0u, 0u}; }
    LAS float* scr = (LAS float*)(F.lds + 49152 + F.wave * 8448);
    for (int it = F.gw; it < IT_TOTAL; it += F.NGW) {
        const int l = it / IT_LAYER; int r = it % IT_LAYER;
        if (r < IT_IN1) { const int kb = r / 93, nb = r % 93, n0 = 32 * nb;
            const int sc0 = n0 < 1024 ? (n0 & ~255) + 64 * ((n0 >> 5) & 3) + 32 * ((n0 >> 7) & 1) : n0;
            transpose_blk(p.w_in + (size_t)l * D * 6048, 6048, sc0, 64 * kb, (bf16*)(ws + WS_WIN) + (size_t)l * 6144 * 1024, n0, 1024, nullptr, scr, F.lane); continue; } r -= IT_IN1;
        if (r < IT_IN2) { transpose_item(p.w_in + (size_t)l * D * 6048, 1024, 6048, 2976, 3072, (bf16*)(ws + WS_WIN) + (size_t)l * 6144 * 1024, 3072, scr, r, F.lane); continue; } r -= IT_IN2;
        if (r < IT_UQ) { const int kb = r / 24, nb = r % 24, n0 = 32 * nb, tt = n0 >> 8, bj = (n0 >> 7) & 1, wc = (n0 >> 5) & 3;
            const int sc0 = tt < 2 ? (4 * tt + wc) * 96 + 32 * bj : (4 * bj + wc) * 96 + 64;
            transpose_blk(p.mla_w_uq + (size_t)l * 256 * 768, 768, sc0, 64 * kb, (bf16*)(ws + WS_WUQ) + (size_t)l * 768 * 256, n0, 256, p.mla_lat_g + l * 384, scr, F.lane); continue; } r -= IT_UQ;
        if (r < IT_UKV) { const int kb = r / 32, nb = r % 32, n0 = 32 * nb, tt = n0 >> 8, bj = (n0 >> 7) & 1, wc = (n0 >> 5) & 3;
            const int sc0 = tt < 2 ? (4 * tt + wc) * 128 + 32 * bj : (4 * (tt - 2) + wc) * 128 + 64 + 32 * bj;
            transpose_blk(p.mla_w_ukv + (size_t)l * 128 * 1024, 1024, sc0, 64 * kb, (bf16*)(ws + WS_WUKV) + (size_t)l * 1024 * 256, n0, 256, p.mla_lat_g + l * 384 + 256, scr, F.lane); continue; } r -= IT_UKV;
        if (r < 3 * IT_BR) { const int n = r / IT_BR; transpose_item(p.w_branch + ((size_t)l * 3 + n) * 512 * 1024, 512, 1024, 0, 1024, (bf16*)(ws + WS_WBR) + ((size_t)l * 3 + n) * 1024 * 512, 0, scr, r % IT_BR, F.lane); continue; } r -= 3 * IT_BR;
        if (r < IT_OUT) { transpose_item(p.w_out + (size_t)l * D * D, 1024, 1024, 0, 1024, (bf16*)(ws + WS_WOUT) + (size_t)l * D * D, 0, scr, r, F.lane); continue; } r -= IT_OUT;
        const int e = r / IT_EXP, q = r % IT_EXP; const size_t le = (size_t)l * 32 + e;
        if (q < 256) { const int jj = q >> 6; const float* src = ((jj & 1) ? p.w_e_up : p.w_e_gate) + le * 1024 * 256;
            transpose_item(src, 1024, 256, (jj >> 1) * 128, 128, (bf16*)(ws + WS_WGU) + le * 512 * 1024, jj * 128, scr, q & 63, F.lane); }
        else transpose_item(p.w_e_down + le * 256 * 1024, 256, 1024, 0, 1024, (bf16*)(ws + WS_WDN) + le * 1024 * 256, 0, scr, q - 256, F.lane);
    }
}

template <int MODE>
__device__ __forceinline__ void row_normmod(Frame& F, const float* xin, bf16* X, const bf16* Z, const float* gateprev, const float* g, const float* shift, const float* scale, bf16* H, float* out) {
    constexpr int R = 2;
    const int mb = (F.bid & 7) * 2048 + (F.bid >> 3) * 64 + F.wave;
    for (int kq = 0; kq < 8; kq += R) { const int m0 = mb + 8 * kq;
        f32x4 v[R][4]; u32x2 z0[R][4], z1[R][4];
#pragma unroll
        for (int r = 0; r < R; ++r) { const int m = m0 + 8 * r;
#pragma unroll
            for (int j = 0; j < 4; ++j) { const int d = 4 * F.lane + 256 * j;
                if (MODE == 0) v[r][j] = *(const GAS f32x4*)(xin + (size_t)m * D + d);
                else { const u32x2 xb = *(const GAS u32x2*)(X + (size_t)m * D + d); v[r][j] = (f32x4){bf_lo(xb.x), bf_hi(xb.x), bf_lo(xb.y), bf_hi(xb.y)}; }
                if (MODE >= 2) { z0[r][j] = *(const GAS u32x2*)(Z + zrow(2 * m) + d); z1[r][j] = *(const GAS u32x2*)(Z + zrow(2 * m + 1) + d); } } }
#pragma unroll
        for (int r = 0; r < R; ++r) { const int m = m0 + 8 * r; const int b = m / S;
#pragma unroll
            for (int j = 0; j < 4; ++j) { const int d = 4 * F.lane + 256 * j;
                if (MODE >= 2) { const f32x4 gt = *(const GAS f32x4*)(gateprev + (size_t)b * 6 * D + d);
                    v[r][j].x += gt.x * (bf_lo(z0[r][j].x) + bf_lo(z1[r][j].x)); v[r][j].y += gt.y * (bf_hi(z0[r][j].x) + bf_hi(z1[r][j].x));
                    v[r][j].z += gt.z * (bf_lo(z0[r][j].y) + bf_lo(z1[r][j].y)); v[r][j].w += gt.w * (bf_hi(z0[r][j].y) + bf_hi(z1[r][j].y)); }
                if (MODE == 2) { u32x2 xo; xo.x = cvtpk(v[r][j].x, v[r][j].y); xo.y = cvtpk(v[r][j].z, v[r][j].w); *(GAS u32x2*)(X + (size_t)m * D + d) = xo;
                    v[r][j] = (f32x4){bf_lo(xo.x), bf_hi(xo.x), bf_lo(xo.y), bf_hi(xo.y)}; }
                if (MODE == 3) *(GAS f32x4*)(out + (size_t)m * D + d) = v[r][j]; }
            if (MODE == 3) continue;
            float s = 0.f;
#pragma unroll
            for (int j = 0; j < 4; ++j) s += (v[r][j].x * v[r][j].x + v[r][j].y * v[r][j].y) + (v[r][j].z * v[r][j].z + v[r][j].w * v[r][j].w);
            const float rstd = rsqrtf(wave_sum(s) * (1.f / D) + 1e-6f);
#pragma unroll
            for (int j = 0; j < 4; ++j) { const int d = 4 * F.lane + 256 * j;
                const f32x4 gg = *(const GAS f32x4*)(g + d), sc = *(const GAS f32x4*)(scale + (size_t)b * 6 * D + d), sh = *(const GAS f32x4*)(shift + (size_t)b * 6 * D + d);
                const float o0 = v[r][j].x * rstd * gg.x * (1.f + sc.x) + sh.x, o1 = v[r][j].y * rstd * gg.y * (1.f + sc.y) + sh.y, o2 = v[r][j].z * rstd * gg.z * (1.f + sc.z) + sh.z, o3 = v[r][j].w * rstd * gg.w * (1.f + sc.w) + sh.w;
                u32x2 o; o.x = cvtpk(o0, o1); o.y = cvtpk(o2, o3); st8x(H + (size_t)m * D + d, o); }
        }
    }
}

struct SchedDense {
    static constexpr bool GATHER = false; static constexpr bool HALFM = false;
    __device__ __forceinline__ void a_ready(const GUnit&) const {}
    __device__ __forceinline__ void done(const GUnit&) const {}
    const char* A; const char* B; unsigned lda_b, ldb_b; int nM, nN, nt, G, c;
    __device__ __forceinline__ bool next(int i, GUnit& u) const {
        const long L = (long)i * G + c; const int nwg = nM * nN; if (L >= nwg) return false;
        int wgid = (int)L; { const int q = nwg / 8, r = nwg % 8, xcd = wgid % 8, off = wgid / 8; wgid = (xcd < r ? xcd * (q + 1) : r * (q + 1) + (xcd - r) * q) + off; }
        const int nig = 8 * nN, gid = wgid / nig, fm = gid * 8, gsz = (nM - fm) < 8 ? (nM - fm) : 8;
        const int pm = fm + ((wgid % nig) % gsz), pn = (wgid % nig) / gsz;
        u.A = A + (size_t)pm * 256 * lda_b; u.B = B + (size_t)pn * 256 * ldb_b; u.nt = nt; u.i0 = pm; u.i1 = pn; u.i2 = 0; return true;
    }
    __device__ __forceinline__ void offs(const GUnit&, int R0, int R1, int C0, int C1, unsigned (&oA)[2][2]) const {
        oA[0][0] = (unsigned)R0 * lda_b + C0 * 2u; oA[0][1] = (unsigned)R1 * lda_b + C1 * 2u; oA[1][0] = (unsigned)(R0 + 128) * lda_b + C0 * 2u; oA[1][1] = (unsigned)(R1 + 128) * lda_b + C1 * 2u; }
    __device__ __forceinline__ unsigned ldb_bytes() const { return ldb_b; }
};
struct SchedDensePub : SchedDense {
    unsigned* cnt;
    __device__ __forceinline__ void done(const GUnit& u) const { asm volatile("s_waitcnt vmcnt(0)" ::: "memory"); if ((threadIdx.x & 63) == 0) __hip_atomic_fetch_add(cnt + (u.i0 >> 3), 1u, __ATOMIC_RELAXED, __HIP_MEMORY_SCOPE_AGENT); }
};
struct EpiStoreBf16 {
    bf16* O0; bf16* O1; int split, ldc0, ldc1;
    __device__ __forceinline__ void operator()(const f32x4 (&acc)[2][2][4][2], const GUnit& u, int wr, int wc, int fr, int fq) const {
        const int pn = u.i1; bf16* base; int ldc; if (pn < split) { base = O0 + 256 * pn; ldc = ldc0; } else { base = O1 + 256 * (pn - split); ldc = ldc1; }
        const int row0 = u.i0 * 256 + wr * 64 + fr, col0 = wc * 32 + 8 * fq;
#pragma unroll
        for (int ai = 0; ai < 2; ++ai)
#pragma unroll
            for (int m = 0; m < 4; ++m) { bf16* rowp = base + (size_t)(row0 + ai * 128 + m * 16) * ldc + col0;
#pragma unroll
                for (int bj = 0; bj < 2; ++bj) { const f32x4 v0 = acc[ai][bj][m][0], v1 = acc[ai][bj][m][1];
                    u32x4 w; w.x = cvtpk(v0[0], v0[1]); w.y = cvtpk(v0[2], v0[3]); w.z = cvtpk(v1[0], v1[1]); w.w = cvtpk(v1[2], v1[3]);
                    st16(rowp + bj * 128, w); } }
    }
};
struct EpiG1 {
    bf16* Y1; bf16* XG; bf16* KR; float* ST; const float* gq; const float* kg; const float* CS; const float* SN;
    __device__ __forceinline__ void operator()(const f32x4 (&acc)[2][2][4][2], const GUnit& u, int wr, int wc, int fr, int fq) const {
        const int pn = u.i1; const int row0 = u.i0 * 256 + wr * 64 + fr;
        if (pn < 4) {
            const float* g = gq + (pn >> 1) * 64; const float mul = pn < 2 ? 0.125f * LOG2E : 1.f;
            f32x4 gv[2][2];
#pragma unroll
            for (int bj = 0; bj < 2; ++bj)
#pragma unroll
                for (int n = 0; n < 2; ++n) gv[bj][n] = *(const GAS f32x4*)(g + 32 * bj + 8 * fq + 4 * n);
#pragma unroll
            for (int ai = 0; ai < 2; ++ai)
#pragma unroll
                for (int m = 0; m < 4; ++m) {
                    float s = 0.f;
#pragma unroll
                    for (int bj = 0; bj < 2; ++bj)
#pragma unroll
                        for (int n = 0; n < 2; ++n) { const f32x4 v = acc[ai][bj][m][n]; s += (v[0] * v[0] + v[1] * v[1]) + (v[2] * v[2] + v[3] * v[3]); }
                    s += sw<16>(s); s = xsum32(s);
                    const float rstd = rsqrtf(s * (1.f / 64.f) + 1e-6f) * mul;
                    bf16* rowp = Y1 + (size_t)(row0 + ai * 128 + m * 16) * 3072 + 256 * pn + 64 * wc + 8 * fq;
#pragma unroll
                    for (int bj = 0; bj < 2; ++bj) { const f32x4 v0 = acc[ai][bj][m][0] * rstd * gv[bj][0], v1 = acc[ai][bj][m][1] * rstd * gv[bj][1];
                        u32x4 w; w.x = cvtpk(v0[0], v0[1]); w.y = cvtpk(v0[2], v0[3]); w.z = cvtpk(v1[0], v1[1]); w.w = cvtpk(v1[2], v1[3]);
                        st16(rowp + 32 * bj, w); }
                }
            return;
        }
        bf16* base = pn < 12 ? Y1 + 256 * pn : XG + 256 * (pn - 12); const int col0 = wc * 32 + 8 * fq;
#pragma unroll
        for (int ai = 0; ai < 2; ++ai)
#pragma unroll
            for (int m = 0; m < 4; ++m) { bf16* rowp = base + (size_t)(row0 + ai * 128 + m * 16) * 3072 + col0;
#pragma unroll
                for (int bj = 0; bj < 2; ++bj) { const f32x4 v0 = acc[ai][bj][m][0], v1 = acc[ai][bj][m][1];
                    u32x4 w; w.x = cvtpk(v0[0], v0[1]); w.y = cvtpk(v0[2], v0[3]); w.z = cvtpk(v1[0], v1[1]); w.w = cvtpk(v1[2], v1[3]);
                    st16(rowp + bj * 128, w); } }
        if (pn == 10 || pn == 11) {
#pragma unroll
            for (int ai = 0; ai < 2; ++ai)
#pragma unroll
                for (int m = 0; m < 4; ++m) { float s = 0.f;
#pragma unroll
                    for (int bj = 0; bj < 2; ++bj) { if (pn == 11 && bj == 1) continue;
#pragma unroll
                        for (int n = 0; n < 2; ++n) { const f32x4 v = acc[ai][bj][m][n]; s += (v[0] * v[0] + v[1] * v[1]) + (v[2] * v[2] + v[3] * v[3]); } }
                    s += sw<16>(s); s = xsum32(s);
                    if (fq == 0) ST[(size_t)(row0 + ai * 128 + m * 16) * 8 + (pn - 10) * 4 + wc] = s; }
        }
        if (pn == 11 && wc == 0) {
            f32x4 g0 = *(const GAS f32x4*)(kg + 64 + 8 * fq), g1 = *(const GAS f32x4*)(kg + 64 + 8 * fq + 4);
#pragma unroll
            for (int ai = 0; ai < 2; ++ai)
#pragma unroll
                for (int m = 0; m < 4; ++m) { const size_t row = row0 + ai * 128 + m * 16;
                    f32x4 v0 = acc[ai][1][m][0], v1 = acc[ai][1][m][1];
                    float s = (v0[0] * v0[0] + v0[1] * v0[1]) + (v0[2] * v0[2] + v0[3] * v0[3]) + (v1[0] * v1[0] + v1[1] * v1[1]) + (v1[2] * v1[2] + v1[3] * v1[3]);
                    s += sw<16>(s); s = xsum32(s);
                    const float rstd = rsqrtf(s * (1.f / 32.f) + 1e-6f);
                    v0 = v0 * rstd * g0; v1 = v1 * rstd * g1;
                    const f32x4 c0 = *(const GAS f32x4*)(CS + row * 16 + 8 * (fq & 1)), c1 = *(const GAS f32x4*)(CS + row * 16 + 8 * (fq & 1) + 4);
                    const f32x4 s0 = *(const GAS f32x4*)(SN + row * 16 + 8 * (fq & 1)), s1 = *(const GAS f32x4*)(SN + row * 16 + 8 * (fq & 1) + 4);
                    f32x4 o0, o1;
#pragma unroll
                    for (int i = 0; i < 4; ++i) { const float p0 = xget32(v0[i], fq >= 2), p1 = xget32(v1[i], fq >= 2);
                        o0[i] = fq < 2 ? v0[i] * c0[i] - p0 * s0[i] : v0[i] * c0[i] + p0 * s0[i]; o1[i] = fq < 2 ? v1[i] * c1[i] - p1 * s1[i] : v1[i] * c1[i] + p1 * s1[i]; }
                    u32x4 w; w.x = cvtpk(o0[0], o0[1]); w.y = cvtpk(o0[2], o0[3]); w.z = cvtpk(o1[0], o1[1]); w.w = cvtpk(o1[2], o1[3]);
                    *(GAS u32x4*)(KR + row * 32 + 8 * fq) = w; }
        }
    }
};
template <int WHICH>
struct EpiG2 {
    bf16* O; const float* ST; const float* g; const float* CS; const float* SN;
    __device__ __forceinline__ void operator()(const f32x4 (&acc)[2][2][4][2], const GUnit& u, int wr, int wc, int fr, int fq) const {
        const int pn = u.i1; const int row0 = u.i0 * 256 + wr * 64 + fr; const float qs = 0.10206207261596577f * LOG2E;
#pragma unroll
        for (int ai = 0; ai < 2; ++ai)
#pragma unroll
            for (int m = 0; m < 4; ++m) { const size_t row = row0 + ai * 128 + m * 16;
                const f32x4 sp = *(const GAS f32x4*)(ST + row * 8 + WHICH * 4);
                const float r0 = rsqrtf(((sp[0] + sp[1]) + (sp[2] + sp[3])) * (WHICH ? 1.f / 128.f : 1.f / 256.f) + 1e-6f);
                f32x4 v[2][2];
#pragma unroll
                for (int bj = 0; bj < 2; ++bj)
#pragma unroll
                    for (int n = 0; n < 2; ++n) v[bj][n] = acc[ai][bj][m][n] * r0;
                if (pn < 2) {
                    float s = 0.f;
#pragma unroll
                    for (int bj = 0; bj < 2; ++bj)
#pragma unroll
                        for (int n = 0; n < 2; ++n) s += (v[bj][n][0] * v[bj][n][0] + v[bj][n][1] * v[bj][n][1]) + (v[bj][n][2] * v[bj][n][2] + v[bj][n][3] * v[bj][n][3]);
                    s += sw<16>(s); s = xsum32(s);
                    const float rstd = rsqrtf(s * (1.f / 64.f) + 1e-6f) * (WHICH ? 1.f : qs);
                    bf16* op = O + row * (WHICH ? 1024 : 768) + (4 * pn + wc) * (WHICH ? 128 : 96) + 8 * fq;
#pragma unroll
                    for (int bj = 0; bj < 2; ++bj) { const f32x4 g0 = *(const GAS f32x4*)(g + 32 * bj + 8 * fq), g1 = *(const GAS f32x4*)(g + 32 * bj + 8 * fq + 4);
                        const f32x4 a = v[bj][0] * rstd * g0, b = v[bj][1] * rstd * g1;
                        u32x4 w; w.x = cvtpk(a[0], a[1]); w.y = cvtpk(a[2], a[3]); w.z = cvtpk(b[0], b[1]); w.w = cvtpk(b[2], b[3]);
                        st16(op + 32 * bj, w); }
                } else if (WHICH == 1) {
                    bf16* op = O + row * 1024 + (4 * (pn - 2) + wc) * 128 + 64 + 8 * fq;
#pragma unroll
                    for (int bj = 0; bj < 2; ++bj) { u32x4 w; w.x = cvtpk(v[bj][0][0], v[bj][0][1]); w.y = cvtpk(v[bj][0][2], v[bj][0][3]); w.z = cvtpk(v[bj][1][0], v[bj][1][1]); w.w = cvtpk(v[bj][1][2], v[bj][1][3]);
                        st16(op + 32 * bj, w); }
                } else {
                    const f32x4 c0 = *(const GAS f32x4*)(CS + row * 16 + 8 * (fq & 1)), c1 = *(const GAS f32x4*)(CS + row * 16 + 8 * (fq & 1) + 4);
                    const f32x4 s0 = *(const GAS f32x4*)(SN + row * 16 + 8 * (fq & 1)), s1 = *(const GAS f32x4*)(SN + row * 16 + 8 * (fq & 1) + 4);
                    const f32x4 g0 = *(const GAS f32x4*)(g + 64 + 8 * fq), g1 = *(const GAS f32x4*)(g + 64 + 8 * fq + 4);
#pragma unroll
                    for (int bj = 0; bj < 2; ++bj) {
                        float s = (v[bj][0][0] * v[bj][0][0] + v[bj][0][1] * v[bj][0][1]) + (v[bj][0][2] * v[bj][0][2] + v[bj][0][3] * v[bj][0][3]) + (v[bj][1][0] * v[bj][1][0] + v[bj][1][1] * v[bj][1][1]) + (v[bj][1][2] * v[bj][1][2] + v[bj][1][3] * v[bj][1][3]);
                        s += sw<16>(s); s = xsum32(s);
                        const float rstd = rsqrtf(s * (1.f / 32.f) + 1e-6f) * qs;
                        const f32x4 a = v[bj][0] * rstd * g0, b = v[bj][1] * rstd * g1; f32x4 o0, o1;
#pragma unroll
                        for (int i = 0; i < 4; ++i) { const float p0 = xget32(a[i], fq >= 2), p1 = xget32(b[i], fq >= 2);
                            o0[i] = fq < 2 ? a[i] * c0[i] - p0 * s0[i] : a[i] * c0[i] + p0 * s0[i]; o1[i] = fq < 2 ? b[i] * c1[i] - p1 * s1[i] : b[i] * c1[i] + p1 * s1[i]; }
                        u32x4 w; w.x = cvtpk(o0[0], o0[1]); w.y = cvtpk(o0[2], o0[3]); w.z = cvtpk(o1[0], o1[1]); w.w = cvtpk(o1[2], o1[3]);
                        st16(O + row * 768 + (4 * bj + wc) * 96 + 64 + 8 * fq, w); }
                }
            }
    }
};
struct EpiG2Both {
    EpiG2<0> q; EpiG2<1> kv;
    __device__ __forceinline__ void operator()(const f32x4 (&acc)[2][2][4][2], const GUnit& u, int wr, int wc, int fr, int fq) const { if (u.i2) kv(acc, u, wr, wc, fr, fq); else q(acc, u, wr, wc, fr, fq); }
};
}
namespace fk {
typedef short v4i16_t __attribute__((ext_vector_type(4)));
typedef LAS const char* lds_cptr;
__device__ __forceinline__ float grp_sum(float s, int lanes) {
    if (lanes > 1) s += sw<1>(s); if (lanes > 2) s += sw<2>(s); if (lanes > 4) s += sw<4>(s);
    if (lanes > 8) s += sw<8>(s); if (lanes > 16) s += sw<16>(s); if (lanes > 32) s = xsum32(s);
    return s;
}
__device__ __forceinline__ void unpack8(const u32x4 w, float (&v)[8]) { v[0] = bf_lo(w.x); v[1] = bf_hi(w.x); v[2] = bf_lo(w.y); v[3] = bf_hi(w.y); v[4] = bf_lo(w.z); v[5] = bf_hi(w.z); v[6] = bf_lo(w.w); v[7] = bf_hi(w.w); }
__device__ __forceinline__ u32x4 pack8(const float (&v)[8]) { u32x4 w; w.x = cvtpk(v[0], v[1]); w.y = cvtpk(v[2], v[3]); w.z = cvtpk(v[4], v[5]); w.w = cvtpk(v[6], v[7]); return w; }
__device__ __forceinline__ void norm8(float (&v)[8], int lanes, float inv_width, const float* g, float mul) {
    float s = 0.f;
#pragma unroll
    for (int t = 0; t < 8; ++t) s += v[t] * v[t];
    const float rstd = rsqrtf(grp_sum(s, lanes) * inv_width + 1e-6f) * mul;
#pragma unroll
    for (int t = 0; t < 8; ++t) v[t] = v[t] * rstd * g[t];
}
__device__ __forceinline__ void rope8(float (&v)[8], int j, const float* cs, const float* sn) {
    const int i0 = 8 * (j & 1);
#pragma unroll
    for (int t = 0; t < 8; ++t) { const float o = sw<2>(v[t]); const float c = cs[i0 + t], s = sn[i0 + t]; v[t] = (j < 2) ? (v[t] * c - o * s) : (v[t] * c + o * s); }
}
__device__ __forceinline__ void prep1(Frame& F, const Params& p, int l) {
    bf16* Y1 = (bf16*)(F.ws + WS_Y1); bf16* KR = (bf16*)(F.ws + WS_KR); const float* CS = (const float*)(F.ws + WS_CS); const float* SN = (const float*)(F.ws + WS_SN);
    const float* gq = p.diff_qk_g + l * 128; const float* gk = gq + 64; const float* latg = p.mla_lat_g + l * 384; const float* kg = p.mla_qk_g + l * 192 + 96;
    const int ln = F.lane;
    const int seg = ln < 32 ? 0 : (ln < 48 ? 1 : (ln < 52 ? 2 : 3)); const int j3 = seg == 0 ? ln : (seg == 1 ? ln - 32 : ln - 48);
    const int off3 = seg == 0 ? 2560 + 8 * j3 : (seg == 1 ? 2816 + 8 * j3 : 2944 + 8 * (j3 & 3));
    const float* g3 = seg == 0 ? latg + 8 * j3 : (seg == 1 ? latg + 256 + 8 * j3 : kg + 64 + 8 * (j3 & 3));
    constexpr int R = 2;
    for (int m0 = F.gw; m0 < M; m0 += R * F.NGW) {
        u32x4 wq[R], wk[R], w3[R];
#pragma unroll
        for (int r = 0; r < R; ++r) { bf16* y = Y1 + (size_t)(m0 + r * F.NGW) * 3072; wq[r] = *(GAS u32x4*)(y + 8 * ln); wk[r] = *(GAS u32x4*)(y + 512 + 8 * ln); w3[r] = *(GAS u32x4*)(y + off3); }
#pragma unroll
        for (int r = 0; r < R; ++r) { const int m = m0 + r * F.NGW; bf16* y = Y1 + (size_t)m * 3072; float v[8];
            unpack8(wq[r], v); norm8(v, 8, 1.f / 64.f, gq + (8 * ln & 63), 0.125f * LOG2E); *(GAS u32x4*)(y + 8 * ln) = pack8(v);
            unpack8(wk[r], v); norm8(v, 8, 1.f / 64.f, gk + (8 * ln & 63), 1.f); *(GAS u32x4*)(y + 512 + 8 * ln) = pack8(v);
            unpack8(w3[r], v);
            float s = 0.f;
#pragma unroll
            for (int t = 0; t < 8; ++t) s += v[t] * v[t];
            s += sw<1>(s); s += sw<2>(s); const float s4 = s; s += sw<4>(s); s += sw<8>(s); const float s16 = s; s += sw<16>(s); const float s32 = s;
            const float rstd = seg == 0 ? rsqrtf(s32 * (1.f / 256.f) + 1e-6f) : (seg == 1 ? rsqrtf(s16 * (1.f / 128.f) + 1e-6f) : rsqrtf(s4 * (1.f / 32.f) + 1e-6f));
#pragma unroll
            for (int t = 0; t < 8; ++t) v[t] = v[t] * rstd * g3[t];
            if (seg <= 1) *(GAS u32x4*)(y + off3) = pack8(v);
            { float vr[8];
#pragma unroll
              for (int t = 0; t < 8; ++t) vr[t] = v[t];
              rope8(vr, j3 & 3, CS + (size_t)m * 16, SN + (size_t)m * 16);
              if (seg == 2) *(GAS u32x4*)(KR + (size_t)m * 32 + 8 * j3) = pack8(vr); }
        }
    }
}
__device__ __forceinline__ void prep2(Frame& F, const Params& p, int l) {
    bf16* QC = (bf16*)(F.ws + WS_QC); bf16* KVC = (bf16*)(F.ws + WS_KVC); const float* CS = (const float*)(F.ws + WS_CS); const float* SN = (const float*)(F.ws + WS_SN);
    const float* g0 = p.mla_qk_g + l * 192; const float* g1 = g0 + 96; const int ln = F.lane; const float qs = 0.10206207261596577f * LOG2E;
    constexpr int R = 2;
    const int qoff = (ln >> 3) * 96 + (ln & 7) * 8, roff = ((ln & 31) >> 2) * 96 + 64 + (ln & 3) * 8, koff = (ln >> 3) * 128 + (ln & 7) * 8;
    for (int m0 = F.gw; m0 < M; m0 += R * F.NGW) {
        u32x4 wq[R], wr[R], wk[R];
#pragma unroll
        for (int r = 0; r < R; ++r) { const size_t m = m0 + r * F.NGW; wq[r] = *(GAS u32x4*)(QC + m * 768 + qoff); wr[r] = *(GAS u32x4*)(QC + m * 768 + roff); wk[r] = *(GAS u32x4*)(KVC + m * 1024 + koff); }
#pragma unroll
        for (int r = 0; r < R; ++r) { const size_t m = m0 + r * F.NGW; float v[8];
            unpack8(wq[r], v); norm8(v, 8, 1.f / 64.f, g0 + (ln & 7) * 8, qs); *(GAS u32x4*)(QC + m * 768 + qoff) = pack8(v);
            unpack8(wr[r], v); norm8(v, 4, 1.f / 32.f, g0 + 64 + (ln & 3) * 8, qs); rope8(v, ln & 3, CS + m * 16, SN + m * 16); if (ln < 32) *(GAS u32x4*)(QC + m * 768 + roff) = pack8(v);
            unpack8(wk[r], v); norm8(v, 8, 1.f / 64.f, g1 + (ln & 7) * 8, 1.f); *(GAS u32x4*)(KVC + m * 1024 + koff) = pack8(v); }
    }
}

__device__ __forceinline__ int crow(int r, int hi) { return (r & 3) + 8 * (r >> 2) + 4 * hi; }
__device__ __forceinline__ s16x4 vtr(lds_cptr p) { return __builtin_bit_cast(s16x4, __builtin_amdgcn_ds_read_tr16_b64_v4i16((LAS v4i16_t*)p)); }
#define ATT_WAITV(n) asm volatile("s_waitcnt vmcnt(" #n ")" ::: "memory")
__device__ __forceinline__ void glds16(const void* gsrc, unsigned lds_dst) { unsigned keep;
    asm volatile("s_mov_b32 %0, m0\n\ts_mov_b32 m0, %2\n\ts_nop 0\n\tglobal_load_lds_dwordx4 %1, off\n\ts_mov_b32 m0, %0" : "=&s"(keep) : "v"(gsrc), "s"(lds_dst) : "memory"); }
template <bool DUAL>
__device__ __forceinline__ void attn_unit(Frame& F, const Params& p, int l, int b, int h, int qb) {
    constexpr int NQF = DUAL ? 4 : 6, NVB = DUAL ? 4 : 2, KP = DUAL ? 16 : 12, NP = DUAL ? 32 : 24, PP = NP / 8, SLOT = NP * 1024, NSLOT = 4;
    constexpr int QROWS = DUAL ? 128 : 256;
    int lane = F.lane; asm volatile("" : "+v"(lane));
    const int wid = F.wave, r32_ = lane & 31, hi_ = lane >> 5;
    const int wq = DUAL ? (wid & 3) : wid, map = DUAL ? (wid >> 2) : 0;
    const int q0 = qb * QROWS + wq * 32;
    const int cw = q0 >> 6, NT = ((qb * QROWS + QROWS) >> 6);
    const size_t tok0 = (size_t)b * S;
    LAS unsigned char* lds = F.lds; const unsigned lds0 = (unsigned)(uintptr_t)F.lds;
    LAS float* wsf = (LAS float*)(lds + TAB_OFF + 4096 + wid * 256);
    LAS float* tab = (LAS float*)(lds + TAB_OFF);
    const bf16* src[PP];
#pragma unroll
    for (int i = 0; i < PP; ++i) {
        const int x = wid * PP + i;
        if (DUAL) {
            const bf16* Y1 = (const bf16*)(F.ws + WS_Y1);
            if (x < KP) src[i] = Y1 + (tok0 + lane) * 3072 + 512 + h * 128 + (x >> 3) * 64 + (x & 7) * 8;
            else { const int v = x - KP; src[i] = Y1 + (tok0 + 16 * (v & 3) + (lane >> 2)) * 3072 + 1024 + h * 128 + (v >> 2) * 32 + (lane & 3) * 8; }
        } else {
            const bf16* KVC = (const bf16*)(F.ws + WS_KVC); const bf16* KR = (const bf16*)(F.ws + WS_KR);
            const int xx = x < 20 ? x : 0;
            if (xx < 8) src[i] = KVC + (tok0 + lane) * 1024 + h * 128 + xx * 8;
            else if (xx < 12) src[i] = KR + (tok0 + lane) * 32 + (xx - 8) * 8;
            else { const int v = xx - 12; src[i] = KVC + (tok0 + 16 * (v & 3) + (lane >> 2)) * 1024 + h * 128 + 64 + (v >> 2) * 32 + (lane & 3) * 8; }
        }
    }
    constexpr int TSTEP = DUAL ? 64 * 3072 : 0;
#define ATT_DMA(t, slot) do { _Pragma("unroll") for (int i_ = 0; i_ < PP; ++i_) { const int x_ = wid * PP + i_; \
        size_t step_; if (DUAL) step_ = (size_t)(t) * TSTEP; else { const int xx_ = x_ < 20 ? x_ : 0; step_ = (size_t)(t) * 64 * ((xx_ >= 8 && xx_ < 12) ? 32 : 1024); } \
        glds16(src[i_] + step_, (unsigned)__builtin_amdgcn_readfirstlane(lds0 + (unsigned)((slot) * SLOT + x_ * 1024))); } } while (0)
    bf16x8 qf[NQF];
    {
        const bf16* Qw = DUAL ? (const bf16*)(F.ws + WS_Y1) + (tok0 + q0 + r32_) * 3072 + h * 128 + map * 64 : (const bf16*)(F.ws + WS_QC) + (tok0 + q0 + r32_) * 768 + h * 96;
#pragma unroll
        for (int d0 = 0; d0 < NQF; ++d0) qf[d0] = *(const GAS bf16x8*)(Qw + d0 * 16 + hi_ * 8);
    }
    if (DUAL) { if (F.tid < 256) tab[F.tid] = ((const float*)(F.ws + WS_BT))[h * 256 + F.tid]; }
    VM_WAIT();
    ATT_DMA(0, 0); if (NT > 1) ATT_DMA(1, 1); if (NT > 2) ATT_DMA(2, 2);
    f32x16 o[NVB];
#pragma unroll
    for (int d = 0; d < NVB; ++d) o[d] = (f32x16){0.f, 0.f, 0.f, 0.f, 0.f, 0.f, 0.f, 0.f, 0.f, 0.f, 0.f, 0.f, 0.f, 0.f, 0.f, 0.f};
    float mrun = 0.f, lrun = 0.f;
    f32x16 negm = (f32x16){0.f, 0.f, 0.f, 0.f, 0.f, 0.f, 0.f, 0.f, 0.f, 0.f, 0.f, 0.f, 0.f, 0.f, 0.f, 0.f};
    const int vlane = ((lane >> 4) & 1) * 32 + (lane & 3) * 8 + (4 * hi_ + ((lane & 15) >> 2)) * 64;
    const int koff = (DUAL ? map * 8192 : 0) + hi_ * 1024 + r32_ * 16;
#define ATT_QK(P0, P1, slot) do { const lds_cptr kb_ = (lds_cptr)(lds + (slot) * SLOT + koff); \
        _Pragma("unroll") for (int d0 = 0; d0 < NQF; ++d0) { const bf16x8 k0_ = *(const LAS bf16x8*)(kb_ + d0 * 2048), k1_ = *(const LAS bf16x8*)(kb_ + d0 * 2048 + 512); \
            P0 = __builtin_amdgcn_mfma_f32_32x32x16_bf16(k0_, qf[d0], d0 == 0 ? negm : P0, 0, 0, 0); P1 = __builtin_amdgcn_mfma_f32_32x32x16_bf16(k1_, qf[d0], d0 == 0 ? negm : P1, 0, 0, 0); } } while (0)
    f32x16 p0, p1, n0, n1;
    p0 = negm; p1 = negm; n0 = negm; n1 = negm;
    if (NT > 2) { if (PP == 4) ATT_WAITV(8); else ATT_WAITV(6); } else if (NT > 1) { if (PP == 4) ATT_WAITV(4); else ATT_WAITV(3); } else ATT_WAITV(0);
    LDS_WAIT(); __builtin_amdgcn_s_barrier();
    ATT_QK(p0, p1, 0);
    for (int j = 0; j < NT; ++j) {
        const int sl = j & 3;
        if (j + 1 < NT) {
            if (j + 2 < NT) { if (PP == 4) ATT_WAITV(4); else ATT_WAITV(3); } else ATT_WAITV(0);
            LDS_WAIT(); __builtin_amdgcn_s_barrier();
            if (j + 3 < NT) ATT_DMA(j + 3, (j + 3) & 3);
        }
        if (j <= cw) {
            const bool nxt = (j + 1 <= cw);
            if (nxt) ATT_QK(n0, n1, (j + 1) & 3);
            if (DUAL) { if (j >= cw - 2) { const int base = 64 * j - (q0 + r32_) + 191 + 4 * hi_;
#pragma unroll
                for (int r = 0; r < 16; ++r) { const int kk = (r & 3) + 8 * (r >> 2); p0[r] += tab[base + kk]; p1[r] += tab[base + kk + 32]; } } }
            float ma = __builtin_fmaxf(__builtin_fmaxf(p0[0], p0[1]), p1[0]), mb = __builtin_fmaxf(__builtin_fmaxf(p0[2], p0[3]), p1[1]); ma = __builtin_fmaxf(__builtin_fmaxf(ma, p1[2]), p1[3]);
#pragma unroll
            for (int r = 4; r < 16; r += 4) { ma = __builtin_fmaxf(__builtin_fmaxf(ma, p0[r]), p0[r + 1]); mb = __builtin_fmaxf(__builtin_fmaxf(mb, p0[r + 2]), p0[r + 3]);
                ma = __builtin_fmaxf(__builtin_fmaxf(ma, p1[r]), p1[r + 1]); mb = __builtin_fmaxf(__builtin_fmaxf(mb, p1[r + 2]), p1[r + 3]); }
            float mx = __builtin_fmaxf(ma, mb); mx = xmax32(mx);
            if (__builtin_expect(__any(mx > 8.f), 0)) {
                const float dl = __builtin_fmaxf(mx, 0.f), f = __builtin_amdgcn_exp2f(-dl); mrun += dl; lrun *= f;
#pragma unroll
                for (int r = 0; r < 16; ++r) { p0[r] -= dl; p1[r] -= dl; n0[r] -= dl; n1[r] -= dl; negm[r] = -mrun; }
                if (hi_ == 0) wsf[r32_] = f;
                LDS_WAIT();
#pragma unroll
                for (int r = 0; r < 16; ++r) { const float fr_ = wsf[crow(r, hi_)];
#pragma unroll
                    for (int d = 0; d < NVB; ++d) o[d][r] *= fr_; }
            }
            float ls = 0.f;
#pragma unroll
            for (int r = 0; r < 16; ++r) { p0[r] = __builtin_amdgcn_exp2f(p0[r]); p1[r] = __builtin_amdgcn_exp2f(p1[r]); ls += p0[r] + p1[r]; }
            lrun += ls;
            u32x4 pw0, pw1, pw2, pw3;
            pw0 = (u32x4){cvtpk(p0[0], p0[1]), cvtpk(p0[2], p0[3]), cvtpk(p0[4], p0[5]), cvtpk(p0[6], p0[7])};
            pw1 = (u32x4){cvtpk(p0[8], p0[9]), cvtpk(p0[10], p0[11]), cvtpk(p0[12], p0[13]), cvtpk(p0[14], p0[15])};
            pw2 = (u32x4){cvtpk(p1[0], p1[1]), cvtpk(p1[2], p1[3]), cvtpk(p1[4], p1[5]), cvtpk(p1[6], p1[7])};
            pw3 = (u32x4){cvtpk(p1[8], p1[9]), cvtpk(p1[10], p1[11]), cvtpk(p1[12], p1[13]), cvtpk(p1[14], p1[15])};
            const bf16x8 pa0 = __builtin_bit_cast(bf16x8, pw0), pa1 = __builtin_bit_cast(bf16x8, pw1), pa2 = __builtin_bit_cast(bf16x8, pw2), pa3 = __builtin_bit_cast(bf16x8, pw3);
            const lds_cptr vb = (lds_cptr)(lds + sl * SLOT + KP * 1024 + vlane);
            s16x4 vf[2][8];
#pragma unroll
            for (int ks = 0; ks < 4; ++ks) { vf[0][2 * ks] = vtr(vb + ks * 1024); vf[0][2 * ks + 1] = vtr(vb + ks * 1024 + 512); }
#pragma unroll
            for (int d = 0; d < NVB; ++d) {
                if (d + 1 < NVB) {
#pragma unroll
                    for (int ks = 0; ks < 4; ++ks) { vf[(d + 1) & 1][2 * ks] = vtr(vb + (d + 1) * 4096 + ks * 1024); vf[(d + 1) & 1][2 * ks + 1] = vtr(vb + (d + 1) * 4096 + ks * 1024 + 512); }
                }
#define ATT_PK(k) (bf16x8){vf[d & 1][2 * (k)][0], vf[d & 1][2 * (k)][1], vf[d & 1][2 * (k)][2], vf[d & 1][2 * (k)][3], vf[d & 1][2 * (k) + 1][0], vf[d & 1][2 * (k) + 1][1], vf[d & 1][2 * (k) + 1][2], vf[d & 1][2 * (k) + 1][3]}
                o[d] = __builtin_amdgcn_mfma_f32_32x32x16_bf16(pa0, ATT_PK(0), o[d], 0, 0, 0);
                o[d] = __builtin_amdgcn_mfma_f32_32x32x16_bf16(pa1, ATT_PK(1), o[d], 0, 0, 0);
                o[d] = __builtin_amdgcn_mfma_f32_32x32x16_bf16(pa2, ATT_PK(2), o[d], 0, 0, 0);
                o[d] = __builtin_amdgcn_mfma_f32_32x32x16_bf16(pa3, ATT_PK(3), o[d], 0, 0, 0);
#undef ATT_PK
                __builtin_amdgcn_sched_barrier(0);
            }
            p0 = n0; p1 = n1;
        }
    }
#undef ATT_QK
    int r32 = r32_, hi = hi_; asm volatile("" : "+v"(r32), "+v"(hi));
    lrun = xsum32(lrun);
    if (hi == 0) wsf[32 + r32] = __builtin_amdgcn_rcpf(lrun);
    LDS_WAIT();
    float rli[16];
#pragma unroll
    for (int r = 0; r < 16; ++r) rli[r] = wsf[32 + crow(r, hi)];
    __builtin_amdgcn_s_barrier();
    if (DUAL) {
        LAS float* stg = (LAS float*)(lds) + (size_t)wq * 32 * 132;
        if (map == 1) {
#pragma unroll
            for (int d = 0; d < NVB; ++d)
#pragma unroll
                for (int r = 0; r < 16; ++r) stg[crow(r, hi) * 132 + d * 32 + r32] = o[d][r] * rli[r];
        }
        LDS_WAIT(); __builtin_amdgcn_s_barrier();
        if (map == 0) {
            const float lam = ((const float*)(F.ws + WS_LAM))[l]; const float li = 1.f - (0.8f - 0.6f * __expf(-0.3f * (float)l));
            float ss[16];
#pragma unroll
            for (int r = 0; r < 16; ++r) { float s = 0.f;
#pragma unroll
                for (int d = 0; d < NVB; ++d) { const float v = o[d][r] * rli[r] - lam * stg[crow(r, hi) * 132 + d * 32 + r32]; o[d][r] = v; s += v * v; }
                ss[r] = s; }
#pragma unroll
            for (int r = 0; r < 16; ++r) { float s = ss[r]; s += sw<1>(s); s += sw<2>(s); s += sw<4>(s); s += sw<8>(s); s += sw<16>(s); ss[r] = rsqrtf(s * (1.f / 128.f) + 1e-6f) * li; }
            const float* og = p.diff_out_g + l * 128; bf16* OA = (bf16*)(F.ws + WS_OA) + (tok0 + q0) * 512 + h * 128;
            LAS bf16* st2 = (LAS bf16*)(lds + 69632) + wq * (32 * 136);
#pragma unroll
            for (int d = 0; d < NVB; ++d) { const float gg = og[d * 32 + r32];
#pragma unroll
                for (int r = 0; r < 16; ++r) st2[crow(r, hi) * 136 + d * 32 + r32] = (bf16)(cvtpk(o[d][r] * ss[r] * gg, 0.f) & 0xffffu); }
            LDS_WAIT();
#pragma unroll
            for (int i = 0; i < 8; ++i) { const int row = i * 4 + (lane >> 4), ch = lane & 15; const u32x4 v = *(const LAS u32x4*)(st2 + row * 136 + ch * 8); st16x(OA + (size_t)row * 512 + ch * 8, v); }
        }
    } else {
        LAS bf16* stg = (LAS bf16*)(lds) + wid * 2048;
#pragma unroll
        for (int r = 0; r < 16; ++r) { const int orow = crow(r, hi);
#pragma unroll
            for (int d = 0; d < NVB; ++d) stg[orow * 64 + d * 32 + r32] = (bf16)(cvtpk(o[d][r] * rli[r], 0.f) & 0xffffu); }
        LDS_WAIT();
        bf16* Ow = (bf16*)(F.ws + WS_OC) + (tok0 + q0) * 512 + h * 64;
#pragma unroll
        for (int i = 0; i < 4; ++i) { const int row = i * 8 + (lane >> 3), ch = lane & 7; const u32x4 v = *(const LAS u32x4*)(stg + row * 64 + ch * 8); st16x(Ow + (size_t)row * 512 + ch * 8, v); }
    }
    LDS_WAIT(); VM_WAIT(); __builtin_amdgcn_s_barrier();
#undef ATT_DMA
}
template <bool DUAL>
__device__ __forceinline__ void attn_phase(Frame& F, const Params& p, int l) {
    const int vcu = (F.G % 8 == 0) ? (F.bid % 8) * (F.G / 8) + F.bid / 8 : F.bid;
    if (DUAL) { for (int v = vcu; v < 256; v += F.G) { const int bh = v >> 3, s = v & 7; attn_unit<true>(F, p, l, bh >> 2, bh & 3, s); attn_unit<true>(F, p, l, bh >> 2, bh & 3, 15 - s); } }
    else { for (int v = vcu; v < 256; v += F.G) { const int bh = v >> 2, s = v & 3; attn_unit<false>(F, p, l, bh >> 3, bh & 7, s); attn_unit<false>(F, p, l, bh >> 3, bh & 7, 7 - s); } }
}
}
namespace fk {
__device__ __forceinline__ void sgu_unit(Frame& F, const Params& p, int l, int unit) {
    const int g = unit & 3, bn = unit >> 2; const size_t m0 = (size_t)bn * 128;
    int lane = threadIdx.x & 63; asm volatile("" : "+v"(lane));
    const int wid = F.wave, r32 = lane & 31, hi = lane >> 5; const int tid_ = wid * 64 + lane;
    LAS unsigned char* lds = F.lds; LAS unsigned char* Wt = lds; LAS unsigned char* Vt = lds + 32768;
    const bf16* Y1 = (const bf16*)(F.ws + WS_Y1);
    const float* vg = p.sgu_v_g + l * 512 + 8 * lane;
    u32x4 w16[16];
#pragma unroll
    for (int jj = 0; jj < 16; ++jj) w16[jj] = *(const GAS u32x4*)(Y1 + (m0 + wid * 16 + jj) * 3072 + 2048 + 8 * lane);
    const float* Wg = p.sgu_w + ((size_t)l * 4 + g) * 128 * 128;
    f32x4 wa[4], wb[4];
#pragma unroll
    for (int k = 0; k < 4; ++k) { const int item = tid_ + 512 * k, i = item & 127, cidx = item >> 7, ks = cidx >> 1, h2 = cidx & 1;
        wa[k] = *(const GAS f32x4*)(Wg + (size_t)i * 128 + 16 * ks + 4 * h2); wb[k] = *(const GAS f32x4*)(Wg + (size_t)i * 128 + 16 * ks + 8 + 4 * h2); }
    float vgv[8];
#pragma unroll
    for (int t = 0; t < 8; ++t) vgv[t] = vg[t];
#pragma unroll
    for (int jj = 0; jj < 16; ++jj) {
        const int j = wid * 16 + jj; float v[8]; unpack8(w16[jj], v);
        float s = 0.f;
#pragma unroll
        for (int t = 0; t < 8; ++t) { v[t] = gelu_tanh(v[t]); s += v[t] * v[t]; }
        const float rstd = rsqrtf(wave_sum(s) * (1.f / 512.f) + 1e-6f);
        if ((lane >> 4) == g) {
#pragma unroll
            for (int t = 0; t < 8; ++t) v[t] = v[t] * rstd * vgv[t];
            const int db = (lane & 15) >> 2;
            *(LAS u32x4*)(Vt + (db * 8 + (j >> 4)) * 1024 + (j & 15) * 64 + (lane & 3) * 16) = pack8(v);
        }
    }
#pragma unroll
    for (int k = 0; k < 4; ++k) {
        const int item = tid_ + 512 * k, i = item & 127, cidx = item >> 7, ks = cidx >> 1;
        const bool ok = (ks >> 2) <= (i >> 6);
        u32x4 w; w.x = ok ? cvtpk(wa[k].x, wa[k].y) : 0u; w.y = ok ? cvtpk(wa[k].z, wa[k].w) : 0u; w.z = ok ? cvtpk(wb[k].x, wb[k].y) : 0u; w.w = ok ? cvtpk(wb[k].z, wb[k].w) : 0u;
        *(LAS u32x4*)(Wt + cidx * 2048 + i * 16) = w;
    }
    const int ib = wid & 3, ch = wid >> 2;
    bf16 uraw[2][16];
#pragma unroll
    for (int dd = 0; dd < 2; ++dd)
#pragma unroll
        for (int r = 0; r < 16; ++r) uraw[dd][r] = Y1[(m0 + 32 * ib + crow(r, hi)) * 3072 + 1536 + 128 * g + 32 * (2 * ch + dd) + r32];
    __syncthreads();
    f32x16 acc[2];
    acc[0] = (f32x16){0.f, 0.f, 0.f, 0.f, 0.f, 0.f, 0.f, 0.f, 0.f, 0.f, 0.f, 0.f, 0.f, 0.f, 0.f, 0.f}; acc[1] = acc[0];
    const int vlane = ((lane >> 4) & 1) * 32 + (lane & 3) * 8 + (4 * hi + ((lane & 15) >> 2)) * 64;
#pragma unroll
    for (int ks = 0; ks < 8; ++ks) {
        const bf16x8 a = *(const LAS bf16x8*)(Wt + (2 * ks + hi) * 2048 + (32 * ib + r32) * 16);
#pragma unroll
        for (int dd = 0; dd < 2; ++dd) { const lds_cptr vb = (lds_cptr)(Vt + (2 * ch + dd) * 8192 + ks * 1024 + vlane);
            const s16x4 lo = vtr(vb), hh = vtr(vb + 512);
            acc[dd] = __builtin_amdgcn_mfma_f32_32x32x16_bf16(a, (bf16x8){lo[0], lo[1], lo[2], lo[3], hh[0], hh[1], hh[2], hh[3]}, acc[dd], 0, 0, 0); }
    }
    const float* bs = p.sgu_b + l * 512 + g * 128; bf16* OB = (bf16*)(F.ws + WS_OB);
#pragma unroll
    for (int dd = 0; dd < 2; ++dd)
#pragma unroll
        for (int r = 0; r < 16; ++r) { const int i = 32 * ib + crow(r, hi), c = 128 * g + 32 * (2 * ch + dd) + r32;
            const float u = gelu_tanh(bf2f(uraw[dd][r]));
            OB[(m0 + i) * 512 + c] = (bf16)(cvtpk(u * (acc[dd][r] + bs[i]), 0.f) & 0xffffu); }
    __syncthreads();
}

struct SchedG3 {
    static constexpr bool GATHER = false; static constexpr bool HALFM = false;
    __device__ __forceinline__ void a_ready(const GUnit&) const {}
    __device__ __forceinline__ void done(const GUnit&) const {}
    const char* OA; const char* WBR; int G, c;
    __device__ __forceinline__ bool next(int i, GUnit& u) const {
        const int tile = (i / 3) * G + c, n = i % 3; if (tile >= 256) return false;
        const int vt = (tile % 8) * 32 + tile / 8;
        const int pm = vt >> 2, pn = vt & 3;
        u.A = OA + (size_t)n * 16 * MiB + (size_t)pm * 256 * 1024; u.B = WBR + (size_t)n * MiB + (size_t)pn * 256 * 1024; u.nt = 8; u.i0 = pm; u.i1 = pn; u.i2 = n; return true;
    }
    __device__ __forceinline__ void offs(const GUnit&, int R0, int R1, int C0, int C1, unsigned (&oA)[2][2]) const {
        oA[0][0] = (unsigned)R0 * 1024u + C0 * 2u; oA[0][1] = (unsigned)R1 * 1024u + C1 * 2u; oA[1][0] = (unsigned)(R0 + 128) * 1024u + C0 * 2u; oA[1][1] = (unsigned)(R1 + 128) * 1024u + C1 * 2u; }
    __device__ __forceinline__ unsigned ldb_bytes() const { return 1024u; }
};
struct EpiG3 {
    const bf16* XG; bf16* MG;
    __device__ __forceinline__ void operator()(const f32x4 (&acc)[2][2][4][2], const GUnit& u, int wr, int wc, int fr, int fq) const {
        const int n = u.i2; const int row0 = u.i0 * 256 + wr * 64 + fr, col0 = u.i1 * 256 + wc * 32 + 8 * fq;
#pragma unroll
        for (int ai = 0; ai < 2; ++ai)
#pragma unroll
            for (int m = 0; m < 4; ++m) { const size_t row = row0 + ai * 128 + m * 16;
#pragma unroll
                for (int bj = 0; bj < 2; ++bj) { const int col = col0 + bj * 128;
                    float gv[8], pv[8], o[8]; unpack8(*(const GAS u32x4*)(XG + row * 3072 + n * 1024 + col), gv);
                    if (n > 0) unpack8(*(const GAS u32x4*)(MG + row * 1024 + col), pv);
                    const f32x4 v0 = acc[ai][bj][m][0], v1 = acc[ai][bj][m][1];
#pragma unroll
                    for (int t = 0; t < 8; ++t) { const float a = t < 4 ? v0[t & 3] : v1[t & 3]; o[t] = fast_sigmoid(gv[t]) * a + (n > 0 ? pv[t] : 0.f); }
                    *(GAS u32x4*)(MG + row * 1024 + col) = pack8(o); } }
    }
};
template <bool F32IN>
struct EpiG4 {
    bf16* X; const float* gate; const float* Xin;
    __device__ __forceinline__ void operator()(const f32x4 (&acc)[2][2][4][2], const GUnit& u, int wr, int wc, int fr, int fq) const {
        const int row0 = u.i0 * 256 + wr * 64 + fr, col0 = u.i1 * 256 + wc * 32 + 8 * fq; const int b = (u.i0 * 256) / S;
#pragma unroll
        for (int bj = 0; bj < 2; ++bj) { const int col = col0 + bj * 128;
            const f32x4 g0 = *(const GAS f32x4*)(gate + (size_t)b * 6 * D + col), g1 = *(const GAS f32x4*)(gate + (size_t)b * 6 * D + col + 4);
#pragma unroll
            for (int ai = 0; ai < 2; ++ai)
#pragma unroll
                for (int m = 0; m < 4; ++m) { const size_t off = (size_t)(row0 + ai * 128 + m * 16) * D + col;
                    f32x4 x0, x1;
                    if (F32IN) { x0 = *(const GAS f32x4*)(Xin + off); x1 = *(const GAS f32x4*)(Xin + off + 4); }
                    else { float xv[8]; unpack8(*(const GAS u32x4*)(X + off), xv); x0 = (f32x4){xv[0], xv[1], xv[2], xv[3]}; x1 = (f32x4){xv[4], xv[5], xv[6], xv[7]}; }
                    x0 += g0 * acc[ai][bj][m][0]; x1 += g1 * acc[ai][bj][m][1];
                    u32x4 w; w.x = cvtpk(x0[0], x0[1]); w.y = cvtpk(x0[2], x0[3]); w.z = cvtpk(x1[0], x1[1]); w.w = cvtpk(x1[2], x1[3]);
                    *(GAS u32x4*)(X + off) = w; } }
    }
};
struct SchedG2 {
    static constexpr bool GATHER = false; static constexpr bool HALFM = false;
    __device__ __forceinline__ void a_ready(const GUnit&) const {}
    __device__ __forceinline__ void done(const GUnit&) const {}
    const char* Y1; const char* WUQ; const char* WUKV; int G, c;
    __device__ __forceinline__ bool next(int i, GUnit& u) const {
        const int L = i * G + c; if (L >= 448) return false;
        const bool kv = L >= 192; const int q = kv ? L - 192 : L; const int pm = kv ? (q >> 2) : q / 3, pn = kv ? (q & 3) : q % 3;
        u.A = Y1 + (size_t)pm * 256 * 6144 + (kv ? 2816 * 2 : 2560 * 2); u.B = (kv ? WUKV : WUQ) + (size_t)pn * 256 * 512; u.nt = 4; u.i0 = pm; u.i1 = pn; u.i2 = kv ? 1 : 0; return true;
    }
    __device__ __forceinline__ void offs(const GUnit&, int R0, int R1, int C0, int C1, unsigned (&oA)[2][2]) const {
        oA[0][0] = (unsigned)R0 * 6144u + C0 * 2u; oA[0][1] = (unsigned)R1 * 6144u + C1 * 2u; oA[1][0] = (unsigned)(R0 + 128) * 6144u + C0 * 2u; oA[1][1] = (unsigned)(R1 + 128) * 6144u + C1 * 2u; }
    __device__ __forceinline__ unsigned ldb_bytes() const { return 512u; }
};
}
namespace fk {
constexpr int HT_PITCH = 2064;
constexpr int RT_SMALL = 64 * HT_PITCH;
__device__ __forceinline__ void row_router(Frame& F, const Params& p, int l, const float* mod) {
    unsigned char* ws = F.ws; LAS unsigned char* HT = F.lds;
    const bf16* X = (const bf16*)(ws + WS_X); bf16* H = (bf16*)(ws + WS_H);
    const float* g = p.norm_g + (size_t)l * 2 * D + D; const float* shift = mod + 3 * D; const float* scale = mod + 4 * D;
    const float* bg = p.router_g_b + l * 4; const float* be = p.router_e_b + l * 32;
    unsigned* CNT = (unsigned*)(ws + WS_CTL) + CW_CNT + l * 32;
    int* LIST = (int*)(ws + WS_LIST); float* ROWW = (float*)(ws + WS_ROWW); int* TOKSLOT = (int*)(ws + WS_TOKSLOT);
    LAS int* rid = (LAS int*)(F.lds + RT_SMALL); LAS int* rrank = rid + 128; LAS float* rw = (LAS float*)(rrank + 128);
    LAS unsigned* cntl = (LAS unsigned*)(rw + 128); LAS unsigned* cbase = cntl + 32;
    if (F.tid < 32) cntl[F.tid] = 0u;
    constexpr int R = 2;
    const int mb = (F.bid & 7) * 2048 + (F.bid >> 3) * 64;
    for (int kk = 0; kk < 8; kk += R) { const int m0 = mb + kk * 8 + F.wave;
        f32x4 v[R][4];
#pragma unroll
        for (int r = 0; r < R; ++r)
#pragma unroll
            for (int j = 0; j < 4; ++j) { const u32x2 xb = *(const GAS u32x2*)(X + (size_t)(m0 + 8 * r) * D + 4 * F.lane + 256 * j); v[r][j] = (f32x4){bf_lo(xb.x), bf_hi(xb.x), bf_lo(xb.y), bf_hi(xb.y)}; }
#pragma unroll
        for (int r = 0; r < R; ++r) { const int m = m0 + 8 * r, b = m / S; float s = 0.f;
#pragma unroll
            for (int j = 0; j < 4; ++j) s += (v[r][j].x * v[r][j].x + v[r][j].y * v[r][j].y) + (v[r][j].z * v[r][j].z + v[r][j].w * v[r][j].w);
            const float rstd = rsqrtf(wave_sum(s) * (1.f / D) + 1e-6f);
            LAS unsigned char* hrow = HT + ((kk + r) * 8 + F.wave) * HT_PITCH;
#pragma unroll
            for (int j = 0; j < 4; ++j) { const int d = 4 * F.lane + 256 * j;
                const f32x4 gg = *(const GAS f32x4*)(g + d), sc = *(const GAS f32x4*)(scale + (size_t)b * 6 * D + d), sh = *(const GAS f32x4*)(shift + (size_t)b * 6 * D + d);
                const float o0 = v[r][j].x * rstd * gg.x * (1.f + sc.x) + sh.x, o1 = v[r][j].y * rstd * gg.y * (1.f + sc.y) + sh.y, o2 = v[r][j].z * rstd * gg.z * (1.f + sc.z) + sh.z, o3 = v[r][j].w * rstd * gg.w * (1.f + sc.w) + sh.w;
                u32x2 o; o.x = cvtpk(o0, o1); o.y = cvtpk(o2, o3); st8x(H + (size_t)m * D + d, o); *(LAS u32x2*)(hrow + d * 2) = o; }
        }
    }
    __syncthreads();
    const int tt = F.wave & 3, kh = F.wave >> 2, n16 = F.lane & 15, kq = F.lane >> 4;
    const bf16* WRT = (const bf16*)(ws + WS_WRT) + (size_t)l * 48 * 1024;
    f32x4 acc[3];
#pragma unroll
    for (int bl = 0; bl < 3; ++bl) acc[bl] = (f32x4){0.f, 0.f, 0.f, 0.f};
    const LAS unsigned char* hb = HT + (16 * tt + n16) * HT_PITCH + (512 * kh + 8 * kq) * 2;
    const bf16* wb = WRT + (size_t)n16 * 1024 + 512 * kh + 8 * kq;
#pragma unroll 4
    for (int ks = 0; ks < 16; ++ks) {
        const bf16x8 bfr = *(const LAS bf16x8*)(hb + ks * 64);
#pragma unroll
        for (int bl = 0; bl < 3; ++bl) { const bf16x8 afr = *(const GAS bf16x8*)(wb + (size_t)bl * 16 * 1024 + ks * 32);
            acc[bl] = __builtin_amdgcn_mfma_f32_16x16x32_bf16(afr, bfr, acc[bl], 0, 0, 0); }
    }
    __syncthreads();
    LAS float* LGP = (LAS float*)(F.lds);
    LAS float* LG = (LAS float*)(F.lds + 16384);
    if (kh == 1) {
#pragma unroll
        for (int bl = 0; bl < 3; ++bl)
#pragma unroll
            for (int q = 0; q < 4; ++q) LGP[((tt * 3 + bl) * 4 + q) * 64 + F.lane] = acc[bl][q];
    }
    __syncthreads();
    if (kh == 0) {
#pragma unroll
        for (int bl = 0; bl < 3; ++bl)
#pragma unroll
            for (int q = 0; q < 4; ++q) LG[(16 * tt + n16) * 48 + bl * 16 + 4 * kq + q] = acc[bl][q] + LGP[((tt * 3 + bl) * 4 + q) * 64 + F.lane];
    }
    __syncthreads();
    if (F.tid < 64) {
        const int slot = F.tid; const LAS float* lg = LG + slot * 48;
        const float g0 = lg[32] + bg[0], g1 = lg[33] + bg[1], g2 = lg[34] + bg[2], g3 = lg[35] + bg[3];
        int gi = 0; float mx = g0; if (g1 > mx) { mx = g1; gi = 1; } if (g2 > mx) { mx = g2; gi = 2; } if (g3 > mx) { mx = g3; gi = 3; }
        const float gw = 1.f / (__expf(g0 - mx) + __expf(g1 - mx) + __expf(g2 - mx) + __expf(g3 - mx));
        float e[8];
#pragma unroll
        for (int i = 0; i < 8; ++i) e[i] = lg[gi * 8 + i] + be[gi * 8 + i];
        float emx = e[0]; int e0 = 0;
#pragma unroll
        for (int i = 1; i < 8; ++i) if (e[i] > emx) { emx = e[i]; e0 = i; }
        float e2 = -1e30f; int e1 = 0;
#pragma unroll
        for (int i = 0; i < 8; ++i) if (i != e0 && e[i] > e2) { e2 = e[i]; e1 = i; }
        const float p1 = __expf(e2 - emx), w0 = 1.f / (1.f + p1), w1 = p1 / (1.f + p1);
        const int id0 = gi * 8 + e0, id1 = gi * 8 + e1;
        rid[2 * slot] = id0; rid[2 * slot + 1] = id1; rw[2 * slot] = gw * w0; rw[2 * slot + 1] = gw * w1;
        rrank[2 * slot] = (int)__hip_atomic_fetch_add(&cntl[id0], 1u, __ATOMIC_RELAXED, __HIP_MEMORY_SCOPE_WORKGROUP);
        rrank[2 * slot + 1] = (int)__hip_atomic_fetch_add(&cntl[id1], 1u, __ATOMIC_RELAXED, __HIP_MEMORY_SCOPE_WORKGROUP);
    }
    __syncthreads();
    if (F.tid < 32) { const unsigned c = cntl[F.tid]; cbase[F.tid] = c ? atomicAdd(&CNT[F.tid], c) : 0u; }
    __syncthreads();
    if (F.tid < 128) { const int slot = F.tid >> 1, id = rid[F.tid], pos = (int)cbase[id] + rrank[F.tid]; const int m = mb + slot;
        LIST[id * 16384 + pos] = m; ROWW[id * 16384 + pos] = rw[F.tid]; TOKSLOT[id * 16384 + pos] = 2 * m + (F.tid & 1); }
}
__device__ __forceinline__ void moe_table(Frame& F, int l) {
    LAS int* T = (LAS int*)(F.lds + TAB_OFF + 6144);
    int t = threadIdx.x; asm volatile("" : "+v"(t));
    if (t < 32) { const unsigned* CNT = (const unsigned*)(F.ws + WS_CTL) + CW_CNT + l * 32;
        T[t] = (int)__hip_atomic_load(CNT + t, __ATOMIC_RELAXED, __HIP_MEMORY_SCOPE_AGENT); }
    __syncthreads();
    if (t < 33) { int a = 0; for (int e = 0; e < t; ++e) a += (T[e] + 255) >> 8; T[32 + t] = a; }
    __syncthreads();
    if (t < 64) {
        const int e = t & 31, pass = t >> 5; const int c = T[e], nt_ = (c + 255) >> 8; int nhalf_before = 0, nfull_before = 0, nfull_total = 0;
        for (int k = 0; k < 32; ++k) { const int ck = T[k], ntk = (ck + 255) >> 8; const int lastrows = ck - 256 * (ntk - 1); const int hk = (ntk > 0 && lastrows <= 128) ? 1 : 0;
            nfull_total += ntk - hk; if (k < e) { nfull_before += ntk - hk; nhalf_before += hk; } }
        const int lastrows = c - 256 * (nt_ - 1); const int he = (nt_ > 0 && lastrows <= 128) ? 1 : 0;
        if (pass == 0) { for (int m = 0; m < nt_ - he; ++m) T[72 + nfull_before + m] = (e << 16) | (m << 1); }
        else if (he) T[72 + nfull_total + nhalf_before] = (e << 16) | ((nt_ - 1) << 1) | 1;
    }
    __syncthreads();
}
struct SchedG5 {
    static constexpr bool GATHER = true; static constexpr bool HALFM = true;
    const char* H; const char* WGU; const int* LIST; LAS const int* T; int G, c; unsigned* RDY;
    __device__ __forceinline__ void a_ready(const GUnit&) const {}
    __device__ __forceinline__ void done(const GUnit& u) const { asm volatile("s_waitcnt vmcnt(0)" ::: "memory"); if ((threadIdx.x & 63) == 0) __hip_atomic_fetch_add(RDY + u.i3, 1u, __ATOMIC_RELAXED, __HIP_MEMORY_SCOPE_AGENT); }
    __device__ __forceinline__ bool next(int i, GUnit& u) const {
        const int L = i * G + c; const int tot = __builtin_amdgcn_readfirstlane(T[64]); if (L >= 2 * tot) return false;
        const int ent = __builtin_amdgcn_readfirstlane(T[72 + (L >> 1)]), ntile = L & 1; const int e = ent >> 16, mt = (ent >> 1) & 0x7fff;
        const int tpe = __builtin_amdgcn_readfirstlane(T[32 + e]);
        u.A = H; u.B = WGU + ((size_t)e * 512 + ntile * 256) * 2048; u.nt = 16; u.i0 = e; u.i1 = mt; u.i2 = ntile; u.i3 = tpe + mt; u.hm = ent & 1; return true;
    }
    __device__ __forceinline__ void offs(const GUnit& u, int R0, int R1, int C0, int C1, unsigned (&oA)[2][2]) const {
        const int cnt = __builtin_amdgcn_readfirstlane(T[u.i0]); const int* li = LIST + u.i0 * 16384; const int base = u.i1 * 256;
        const int a0 = base + R0, a1 = base + R1, a2 = base + R0 + 128, a3 = base + R1 + 128;
        const int t0 = a0 < cnt ? li[a0] : 0, t1 = a1 < cnt ? li[a1] : 0, t2 = a2 < cnt ? li[a2] : 0, t3 = a3 < cnt ? li[a3] : 0;
        oA[0][0] = (unsigned)t0 * 2048u + C0 * 2u; oA[0][1] = (unsigned)t1 * 2048u + C1 * 2u; oA[1][0] = (unsigned)t2 * 2048u + C0 * 2u; oA[1][1] = (unsigned)t3 * 2048u + C1 * 2u; }
    __device__ __forceinline__ unsigned ldb_bytes() const { return 2048u; }
};
struct EpiG5 {
    bf16* ACT; const float* ROWW; LAS const int* T;
    __device__ __forceinline__ void operator()(const f32x4 (&acc)[2][2][4][2], const GUnit& u, int wr, int wc, int fr, int fq) const {
        const int e = u.i0, cnt = __builtin_amdgcn_readfirstlane(T[e]), rbase = u.i1 * 256, arow0 = (__builtin_amdgcn_readfirstlane(T[32 + e]) + u.i1) * 256; const int f0 = u.i2 * 128 + wc * 32 + 8 * fq;
#pragma unroll
        for (int ai = 0; ai < 2; ++ai)
#pragma unroll
            for (int m = 0; m < 4; ++m) { const int rt = ai * 128 + wr * 64 + m * 16 + fr;
                if (rbase + rt < cnt) { const float w = ROWW[e * 16384 + rbase + rt]; float o[8];
#pragma unroll
                    for (int t = 0; t < 8; ++t) { const float gt = t < 4 ? acc[ai][0][m][0][t & 3] : acc[ai][0][m][1][t & 3], up = t < 4 ? acc[ai][1][m][0][t & 3] : acc[ai][1][m][1][t & 3];
                        o[t] = gt * fast_sigmoid(gt) * up * w; }
                    st16_wt(ACT + (size_t)(arow0 + rt) * 256 + f0, pack8(o)); } }
    }
};
struct SchedG6 {
    static constexpr bool GATHER = false; static constexpr bool HALFM = true;
    const char* ACT; const char* WDN; LAS const int* T; int G, c; const unsigned* RDY; unsigned* tmo;
    __device__ __forceinline__ bool next(int i, GUnit& u) const {
        const int tot = __builtin_amdgcn_readfirstlane(T[64]); const int u5 = 2 * tot; const int nx = (u5 > G && u5 < 2 * G) ? u5 - G : 0;
        if (c < nx) return false;
        const int L = i * (G - nx) + (c - nx); if (L >= 4 * tot) return false;
        const int ent = __builtin_amdgcn_readfirstlane(T[72 + (L >> 2)]), ntile = L & 3; const int e = ent >> 16, mt = (ent >> 1) & 0x7fff;
        const int mtg = __builtin_amdgcn_readfirstlane(T[32 + e]) + mt;
        u.A = ACT + (size_t)mtg * 256 * 512; u.B = WDN + ((size_t)e * 1024 + ntile * 256) * 512; u.nt = 4; u.i0 = e; u.i1 = mt; u.i2 = ntile; u.i3 = mtg; u.hm = ent & 1; return true;
    }
    __device__ __forceinline__ void offs(const GUnit&, int R0, int R1, int C0, int C1, unsigned (&oA)[2][2]) const {
        oA[0][0] = (unsigned)R0 * 512u + C0 * 2u; oA[0][1] = (unsigned)R1 * 512u + C1 * 2u; oA[1][0] = (unsigned)(R0 + 128) * 512u + C0 * 2u; oA[1][1] = (unsigned)(R1 + 128) * 512u + C1 * 2u; }
    __device__ __forceinline__ unsigned ldb_bytes() const { return 512u; }
    __device__ __forceinline__ void a_ready(const GUnit& u) const {
        if (__builtin_amdgcn_readfirstlane(threadIdx.x >> 6) == 0) {
            unsigned polls = 0;
            while ((unsigned)__builtin_amdgcn_readfirstlane(__hip_atomic_load(RDY + u.i3, __ATOMIC_RELAXED, __HIP_MEMORY_SCOPE_AGENT)) < 16u) {
                if ((++polls & 255u) == 0u && __builtin_amdgcn_readfirstlane(__hip_atomic_load(tmo, __ATOMIC_RELAXED, __HIP_MEMORY_SCOPE_AGENT)) != 0u) break;
                if (polls > (1u << 17)) { __hip_atomic_store(tmo, 1u, __ATOMIC_RELAXED, __HIP_MEMORY_SCOPE_AGENT); break; }
                __builtin_amdgcn_s_sleep(8); }
            __builtin_amdgcn_fence(__ATOMIC_ACQUIRE, "agent");
            asm volatile("s_waitcnt vmcnt(0)" ::: "memory");
        }
        asm volatile("" ::: "memory"); __builtin_amdgcn_s_barrier(); asm volatile("" ::: "memory");
    }
    __device__ __forceinline__ void done(const GUnit&) const {}
};
struct EpiG6 {
    bf16* Z; const int* TOKSLOT; LAS const int* T;
    __device__ __forceinline__ void operator()(const f32x4 (&acc)[2][2][4][2], const GUnit& u, int wr, int wc, int fr, int fq) const {
        const int e = u.i0, cnt = __builtin_amdgcn_readfirstlane(T[e]), rbase = u.i1 * 256; const int c0 = u.i2 * 256 + wc * 32 + 8 * fq;
#pragma unroll
        for (int ai = 0; ai < 2; ++ai)
#pragma unroll
            for (int m = 0; m < 4; ++m) { const int rt = ai * 128 + wr * 64 + m * 16 + fr;
                if (rbase + rt < cnt) { const int ts = TOKSLOT[e * 16384 + rbase + rt]; bf16* zp = Z + zrow(ts) + c0;
#pragma unroll
                    for (int bj = 0; bj < 2; ++bj) { const f32x4 v0 = acc[ai][bj][m][0], v1 = acc[ai][bj][m][1];
                        u32x4 w; w.x = cvtpk(v0[0], v0[1]); w.y = cvtpk(v0[2], v0[3]); w.z = cvtpk(v1[0], v1[1]); w.w = cvtpk(v1[2], v1[3]);
                        st16x(zp + bj * 128, w); } } }
    }
};
}
#ifndef PH4MASK
#define PH4MASK 7
#endif
#ifndef PHMASK
#define PHMASK 0xFFFF
#endif
namespace fk {
__device__ __forceinline__ void relaunder(Frame& F) { int t = threadIdx.x; asm volatile("" : "+v"(t)); F.tid = t; F.lane = t & 63; }
__global__ void __launch_bounds__(NTHR, 2) fwd(Params p) {
    extern __shared__ __attribute__((aligned(16))) unsigned char lds_[];
    Frame F; F.lds = (LAS unsigned char*)lds_; F.ws = p.ws; F.tid = threadIdx.x; F.lane = F.tid & 63; F.wave = __builtin_amdgcn_readfirstlane(F.tid >> 6);
    F.G = gridDim.x; F.bid = blockIdx.x; F.gw = F.bid * NWAVES + F.wave; F.NGW = F.G * NWAVES;
    volatile LAS unsigned* MISC = (volatile LAS unsigned*)(F.lds + MISC_OFF);
    if (F.tid < 64) MISC[F.tid] = 0u;
    __syncthreads();
    unsigned* ctl = (unsigned*)(p.ws + WS_CTL);
    XcdBarrier bar = xcd_barrier_post(ctl + CW_BAR, MISC + 8);
    bool first = true; bool gmode = false; bool mode_known = false;
    const int lo = p.ph_lo, hi = p.ph_hi;
#ifdef TIMEPH
    unsigned long long tacc = 0, tprev = 0; int prevph = -1;
#define TSTAMP(k) do { const unsigned long long now_ = __builtin_amdgcn_s_memrealtime(); if (prevph == (TIMEPH) || ((TIMEPH) == -2 && prevph >= 100)) tacc += now_ - tprev; tprev = now_; prevph = (k); } while (0)
#else
#define TSTAMP(k) do {} while (0)
#endif
#ifdef TIMEPH
#define TBAR() do { const unsigned long long now_ = __builtin_amdgcn_s_memrealtime(); if (prevph == (TIMEPH)) tacc += now_ - tprev; tprev = now_; prevph += 100; } while (0)
#else
#define TBAR() do {} while (0)
#endif
#define PHASE(k) PHASE_(k, true)
#define PHASEG(k) PHASE_(k, false)
#define PHASE_(k, glob) if (lo <= (k) && (k) < hi) if ((first ? (void)0 : (({ TBAR(); }), ((glob) || !gmode) ? xcd_barrier(bar) : xcc_barrier(bar, ctl + CW_GBAR, 32u))), first = false, relaunder(F), true) if (({ TSTAMP(k); true; }))
    unsigned char* ws = p.ws;
    if (p.l_lo == 0) PHASE(0) if constexpr (((PHMASK) >> 0) & 1) { p0_prologue(F, p); }
    for (int l = p.l_lo; l < p.l_hi; ++l) {
        const float* mod = (const float*)(ws + WS_MOD) + (size_t)l * NB * 6 * D;
        PHASE(1) if constexpr (((PHMASK) >> 1) & 1) {
            if (!mode_known) {
                mode_known = true;
                if (F.tid == 0) { bool ok = (lo == 0) && (F.G == 256); for (int j = 0; j < 16; ++j) ok = ok && (xb_ld(ctl + CW_BAR + XB_XCNT(j)) == (j < 8 ? 32u : 0u)); MISC[11] = ok ? 1u : 0u; }
                __syncthreads();
                gmode = MISC[11] != 0u;
                if (gmode) F.bid = (int)MISC[10] * 8 + (int)bar.x;
                F.gw = F.bid * NWAVES + F.wave;
            }
            if (l == 0) row_normmod<0>(F, p.x, (bf16*)(ws + WS_X), nullptr, nullptr, p.norm_g + (size_t)l * 2 * D, mod, mod + D, (bf16*)(ws + WS_H), nullptr);
            else row_normmod<2>(F, nullptr, (bf16*)(ws + WS_X), (const bf16*)(ws + WS_Z), mod - (size_t)NB * 6 * D + 5 * D, p.norm_g + (size_t)l * 2 * D, mod, mod + D, (bf16*)(ws + WS_H), nullptr);
        }
        PHASEG(2) if constexpr (((PHMASK) >> 2) & 1) {
            SchedDense S{(const char*)(ws + WS_H), (const char*)(ws + WS_WIN + (size_t)l * 6144 * 2048), 2048u, 2048u, 64, 24, 16, F.G, F.bid};
            EpiG1 E{(bf16*)(ws + WS_Y1), (bf16*)(ws + WS_XG), (bf16*)(ws + WS_KR), (float*)(ws + WS_STAT), p.diff_qk_g + l * 128, p.mla_qk_g + l * 192 + 96, (const float*)(ws + WS_CS), (const float*)(ws + WS_SN)};
            gemm_phase(F.lds, S, E);
        }
        PHASEG(4) if constexpr (((PHMASK) >> 4) & 1) {
            if constexpr ((PH4MASK) & 1) {
              { SchedDense S{(const char*)(ws + WS_Y1) + 2560 * 2, (const char*)(ws + WS_WUQ + (size_t)l * 768 * 512), 6144u, 512u, 64, 3, 4, F.G, F.bid};
                EpiG2<0> E{(bf16*)(ws + WS_QC), (const float*)(ws + WS_STAT), p.mla_qk_g + l * 192, (const float*)(ws + WS_CS), (const float*)(ws + WS_SN)}; gemm_phase(F.lds, S, E); }
              { SchedDense S{(const char*)(ws + WS_Y1) + 2816 * 2, (const char*)(ws + WS_WUKV + (size_t)l * 1024 * 512), 6144u, 512u, 64, 4, 4, F.G, F.bid};
                EpiG2<1> E{(bf16*)(ws + WS_KVC), (const float*)(ws + WS_STAT), p.mla_qk_g + l * 192 + 96, (const float*)(ws + WS_CS), (const float*)(ws + WS_SN)}; gemm_phase(F.lds, S, E); } }
            TSTAMP(41);
            if constexpr ((PH4MASK) & 2) attn_phase<true>(F, p, l);
            TSTAMP(42);
            if constexpr ((PH4MASK) & 4) for (int j = 0; j < 2; ++j) sgu_unit(F, p, l, (F.bid & 7) * 64 + (F.bid >> 3) + 32 * j);
        }
        PHASEG(6) if constexpr (((PHMASK) >> 6) & 1) { attn_phase<false>(F, p, l); }
        PHASEG(7) if constexpr (((PHMASK) >> 7) & 1) {
            SchedG3 S{(const char*)(ws + WS_OA), (const char*)(ws + WS_WBR + (size_t)l * 3 * MiB), F.G, F.bid};
            EpiG3 E{(const bf16*)(ws + WS_XG), (bf16*)(ws + WS_MERGED)};
            gemm_phase(F.lds, S, E);
        }
        PHASEG(8) if constexpr (((PHMASK) >> 8) & 1) {
            SchedDense S{(const char*)(ws + WS_MERGED), (const char*)(ws + WS_WOUT + (size_t)l * 2 * MiB), 2048u, 2048u, 64, 4, 16, F.G, F.bid};
            if (l == 0) { EpiG4<true> E{(bf16*)(ws + WS_X), mod + 2 * D, p.x}; gemm_phase(F.lds, S, E); }
            else { EpiG4<false> E{(bf16*)(ws + WS_X), mod + 2 * D, nullptr}; gemm_phase(F.lds, S, E); }
        }
        PHASEG(9) if constexpr (((PHMASK) >> 9) & 1) { row_router(F, p, l, mod); }
        PHASE(10) if constexpr (((PHMASK) >> 10) & 1) {
            moe_table(F, l);
            unsigned* RDY = (unsigned*)(ws + WS_CTL) + CW_RDY + l * 256;
            { SchedG5 S{(const char*)(ws + WS_H), (const char*)(ws + WS_WGU + (size_t)l * 32 * MiB), (const int*)(ws + WS_LIST), (LAS const int*)(F.lds + TAB_OFF + 6144), F.G, F.bid, RDY};
              EpiG5 E{(bf16*)(ws + WS_ACT), (const float*)(ws + WS_ROWW), (LAS const int*)(F.lds + TAB_OFF + 6144)};
              gemm_phase(F.lds, S, E); }
            TSTAMP(43);
            { SchedG6 S{(const char*)(ws + WS_ACT), (const char*)(ws + WS_WDN + (size_t)l * 16 * MiB), (LAS const int*)(F.lds + TAB_OFF + 6144), F.G, F.bid, RDY, (unsigned*)(ws + WS_CTL) + CW_TMO2};
              EpiG6 E{(bf16*)(ws + WS_Z), (const int*)(ws + WS_TOKSLOT), (LAS const int*)(F.lds + TAB_OFF + 6144)};
              gemm_phase(F.lds, S, E); }
        }
    }
    if (p.l_hi == p.nlayers) PHASE(12) if constexpr (((PHMASK) >> 12) & 1) {
        const float* modl = (const float*)(ws + WS_MOD) + (size_t)(p.nlayers - 1) * NB * 6 * D;
        row_normmod<3>(F, nullptr, (bf16*)(ws + WS_X), (const bf16*)(ws + WS_Z), modl + 5 * D, nullptr, nullptr, nullptr, nullptr, p.out);
    }
#undef PHASE
#ifdef CENSUS_TEST
    if (blockIdx.x == 0 && threadIdx.x == 0) { bool ok = true; for (int j = 0; j < 8; ++j) ok = ok && (xb_ld(ctl + CW_BAR + XB_XCNT(j)) == 32u);
        if (!ok) { const unsigned long long t0 = __builtin_amdgcn_s_memrealtime(); while (__builtin_amdgcn_s_memrealtime() - t0 < 100000ull) __builtin_amdgcn_s_sleep(32); } }
#endif
#ifdef TIMEPH
    TSTAMP(99);
    if (blockIdx.x == 0 && threadIdx.x == 0) { const unsigned long long t0 = __builtin_amdgcn_s_memrealtime(), wait = tacc * (TMULT);
        while (__builtin_amdgcn_s_memrealtime() - t0 < wait) __builtin_amdgcn_s_sleep(32); }
#endif
}
}
static void fill_params(fk::Params& p, void* const* d_in, void* d_out, void* d_ws) {
    p.x = (const float*)d_in[0]; p.c = (const float*)d_in[1]; p.positions = (const int*)d_in[2];
    p.w_ada = (const float*)d_in[3]; p.b_ada = (const float*)d_in[4]; p.norm_g = (const float*)d_in[5]; p.w_in = (const float*)d_in[6];
    p.diff_qk_g = (const float*)d_in[7]; p.diff_lambda = (const float*)d_in[8]; p.diff_out_g = (const float*)d_in[9]; p.rel_bias = (const float*)d_in[10];
    p.sgu_v_g = (const float*)d_in[11]; p.sgu_w = (const float*)d_in[12]; p.sgu_b = (const float*)d_in[13];
    p.mla_lat_g = (const float*)d_in[14]; p.mla_w_uq = (const float*)d_in[15]; p.mla_w_ukv = (const float*)d_in[16]; p.mla_qk_g = (const float*)d_in[17];
    p.w_branch = (const float*)d_in[18]; p.w_out = (const float*)d_in[19]; p.router_g_w = (const float*)d_in[20]; p.router_g_b = (const float*)d_in[21];
    p.router_e_w = (const float*)d_in[22]; p.router_e_b = (const float*)d_in[23]; p.w_e_gate = (const float*)d_in[24]; p.w_e_up = (const float*)d_in[25]; p.w_e_down = (const float*)d_in[26];
    p.out = (float*)d_out; p.ws = (unsigned char*)d_ws;
}
static void launch_fast(hipStream_t st, fk::Params p, int l_lo, int l_hi, int ph_lo, int ph_hi) {
    static bool attr = false;
    if (!attr) { (void)hipFuncSetAttribute((const void*)fk::fwd, hipFuncAttributeMaxDynamicSharedMemorySize, fk::LDS_BYTES); attr = true; }
#if NLAUNCH != 1
    (void)hipMemsetAsync((char*)p.ws + fk::WS_CTL + fk::CW_BAR * 4, 0, XCD_BAR_WORDS * 4, st);
#endif
    p.l_lo = l_lo; p.l_hi = l_hi; p.ph_lo = ph_lo; p.ph_hi = ph_hi;
    hipLaunchKernelGGL(fk::fwd, dim3(256), dim3(fk::NTHR), fk::LDS_BYTES, st, p);
}
extern "C" void kernel_launch(void* const* d_in, const int* in_sizes, int n_in, void* d_out, int out_size, void* d_ws, size_t ws_size, hipStream_t stream) {
    if (fk::WS_END > ws_size) { fprintf(stderr, "ws too small: need %zu have %zu\n", (size_t)fk::WS_END, ws_size); return; }
    (void)hipMemsetAsync((char*)d_ws + fk::WS_CTL, 0, fk::CTL_ZERO_BYTES, stream);
    fk::Params p{}; fill_params(p, d_in, d_out, d_ws); p.nlayers = 4; p.pad_ = 0;
#if NLAUNCH == 1
    launch_fast(stream, p, 0, 4, 0, 13);
#else
    launch_fast(stream, p, 0, 1, 0, 1);
    for (int l = 0; l < 4; ++l) for (int ph = 1; ph <= 11; ++ph) launch_fast(stream, p, l, l + 1, ph, ph + 1);
    launch_fast(stream, p, 3, 4, 12, 13);
#endif
}
```

```cpp
#include <hip/hip_runtime.h>
#include <cstdio>
#include <cstdint>
#define NLAUNCH 1
#define WT_STORES 1
namespace fk {
#define LAS __attribute__((address_space(3)))
#define GAS __attribute__((address_space(1)))
typedef unsigned short bf16;
typedef short bf16x8 __attribute__((ext_vector_type(8)));
typedef short s16x4 __attribute__((ext_vector_type(4)));
typedef float f32x2 __attribute__((ext_vector_type(2)));
typedef float f32x4 __attribute__((ext_vector_type(4)));
typedef float f32x16 __attribute__((ext_vector_type(16)));
typedef unsigned u32x2 __attribute__((ext_vector_type(2)));
typedef unsigned u32x4 __attribute__((ext_vector_type(4)));
typedef __bf16 bf16x2_t __attribute__((ext_vector_type(2)));
constexpr int NB = 8, S = 2048, D = 1024, M = NB * S, NL = 4;
constexpr int NWAVES = 8, NTHR = 512;
constexpr float LOG2E = 1.4426950408889634f;

__device__ __forceinline__ unsigned cvtpk(float lo, float hi) { f32x2 v = {lo, hi}; bf16x2_t b = __builtin_convertvector(v, bf16x2_t); return __builtin_bit_cast(unsigned, b); }
__device__ __forceinline__ float bf_lo(unsigned u) { return __builtin_bit_cast(float, u << 16); }
__device__ __forceinline__ float bf_hi(unsigned u) { return __builtin_bit_cast(float, u & 0xffff0000u); }
__device__ __forceinline__ float bf2f(bf16 u) { return __builtin_bit_cast(float, (unsigned)u << 16); }
template <int K> __device__ __forceinline__ float sw(float v) { return __builtin_bit_cast(float, __builtin_amdgcn_ds_swizzle(__builtin_bit_cast(int, v), 0x1F | (K << 10))); }
__device__ __forceinline__ int x32_addr() { int z = 0; asm volatile("" : "+v"(z)); const int l = __builtin_amdgcn_mbcnt_hi(-1, __builtin_amdgcn_mbcnt_lo(-1, z)); return (l ^ 32) << 2; }
__device__ __forceinline__ float xget32(float v, bool) { return __builtin_bit_cast(float, __builtin_amdgcn_ds_bpermute(x32_addr(), __builtin_bit_cast(int, v))); }
__device__ __forceinline__ float xsum32(float v) { return v + xget32(v, false); }
__device__ __forceinline__ float xmax32(float v) { return __builtin_fmaxf(v, xget32(v, false)); }
#ifdef OLD_WSUM
__device__ __forceinline__ float wave_sum(float v) { for (int o = 1; o < 64; o <<= 1) v += __shfl_xor(v, o); return v; }
#else
__device__ __forceinline__ float wave_sum(float v) { v += sw<1>(v); v += sw<2>(v); v += sw<4>(v); v += sw<8>(v); v += sw<16>(v); return xsum32(v); }
#endif
__device__ __forceinline__ float fast_sigmoid(float x) { return __builtin_amdgcn_rcpf(1.f + __builtin_amdgcn_exp2f(-x * LOG2E)); }
__device__ __forceinline__ float gelu_tanh(float x) { const float y = 0.7978845608028654f * (x + 0.044715f * x * x * x); return x * fast_sigmoid(2.f * y); }
#define LDS_WAIT() asm volatile("s_waitcnt lgkmcnt(0)" ::: "memory")
__device__ __forceinline__ void st16_wt(void* p, u32x4 v) { asm volatile("global_store_dwordx4 %0, %1, off sc1\n\ts_nop 1" :: "v"(p), "v"(v) : "memory"); }
#ifdef WT_ALL
__device__ __forceinline__ void st16x(void* p, u32x4 v) { asm volatile("global_store_dwordx4 %0, %1, off sc1\n\ts_nop 1" :: "v"(p), "v"(v) : "memory"); }
__device__ __forceinline__ void st16f(void* p, f32x4 v) { asm volatile("global_store_dwordx4 %0, %1, off sc1\n\ts_nop 1" :: "v"(p), "v"(v) : "memory"); }
__device__ __forceinline__ void st8x(void* p, u32x2 v) { asm volatile("global_store_dwordx2 %0, %1, off sc1\n\ts_nop 1" :: "v"(p), "v"(v) : "memory"); }
#else
__device__ __forceinline__ void st16x(void* p, u32x4 v) { *(GAS u32x4*)p = v; }
__device__ __forceinline__ void st16f(void* p, f32x4 v) { *(GAS f32x4*)p = v; }
__device__ __forceinline__ void st8x(void* p, u32x2 v) { *(GAS u32x2*)p = v; }
#endif
#ifdef WT_STORES
__device__ __forceinline__ void st16(void* p, u32x4 v) { asm volatile("global_store_dwordx4 %0, %1, off sc1\n\ts_nop 1" :: "v"(p), "v"(v) : "memory"); }
#else
__device__ __forceinline__ void st16(void* p, u32x4 v) { *(GAS u32x4*)p = v; }
#endif
#define VM_WAIT() asm volatile("s_waitcnt vmcnt(0)" ::: "memory")

#define XB_TMO      128
#define XB_XCNT(j)  (256  + 64 * (j))
#define XB_XSUB(j)  (1280 + 64 * (j))
#define XB_XGEN(j)  (2304 + 64 * (j))
#define XB_TOP      3328
#define XB_TOPGEN   3392
#define XCD_BAR_WORDS 3456
#define XB_SPIN_CAP (1u << 18)
__device__ __forceinline__ unsigned xb_ld(unsigned* p)              { return __hip_atomic_load(p, __ATOMIC_RELAXED, __HIP_MEMORY_SCOPE_AGENT); }
__device__ __forceinline__ unsigned xb_add(unsigned* p, unsigned v) { return __hip_atomic_fetch_add(p, v, __ATOMIC_RELAXED, __HIP_MEMORY_SCOPE_AGENT); }
__device__ __forceinline__ unsigned xb_xcc_id() { return (unsigned)__builtin_amdgcn_s_getreg((3 << 11) | 20) & 0xFu; }
#define XB_SPIN(cond, bar) do { unsigned _sp = 0; while (cond) { __builtin_amdgcn_s_sleep(1); \
    if ((++_sp & 255u) == 0u) { if (xb_ld(&(bar)[XB_TMO])) break; if (_sp > XB_SPIN_CAP) { atomicAdd(&(bar)[XB_TMO], 1u); break; } } } } while (0)
struct XcdBarrier { unsigned* bar; unsigned x; volatile LAS unsigned* st; };
__device__ __forceinline__ XcdBarrier xcd_barrier_post(unsigned* bar, volatile LAS unsigned* st) {
    XcdBarrier b; b.bar = bar; b.x = xb_xcc_id(); b.st = st;
    if (threadIdx.x == 0) st[2] = xb_add(&bar[XB_XCNT(b.x)], 1u);
    return b;
}
__device__ __forceinline__ void xcd_barrier_complete(unsigned* bar, unsigned x, unsigned& nloc, unsigned& nx) {
    const unsigned G = gridDim.x * gridDim.y * gridDim.z;
    unsigned sum, cnt, mine, sp = 0u;
    for (;;) {
        sum = 0u; cnt = 0u; mine = 0u;
#pragma unroll
        for (unsigned j = 0; j < 16; ++j) { const unsigned c = xb_ld(&bar[XB_XCNT(j)]); sum += c; cnt += (c > 0u) ? 1u : 0u; mine = (j == x) ? c : mine; }
        if (sum == G) break;
        __builtin_amdgcn_s_sleep(1);
        if ((++sp & 255u) == 0u) { if (xb_ld(&bar[XB_TMO])) break; if (sp > XB_SPIN_CAP) { atomicAdd(&bar[XB_TMO], 1u); break; } }
    }
    nloc = mine > 0u ? mine : 1u; nx = cnt > 0u ? cnt : 1u;
}
__device__ __forceinline__ void xcd_barrier(const XcdBarrier& b) {
    asm volatile("s_waitcnt vmcnt(0)" ::: "memory");
    __syncthreads();
    if (threadIdx.x == 0) {
        unsigned* bar = b.bar;
        __builtin_amdgcn_s_waitcnt(0);
        unsigned nloc = b.st[0], nx = b.st[1];
        if (nloc == 0u) { xcd_barrier_complete(bar, b.x, nloc, nx); b.st[0] = nloc; b.st[1] = nx; }
        const unsigned old = xb_add(&bar[XB_XSUB(b.x)], 1u);
        const unsigned gen = old / nloc;
        if (old + 1u == (gen + 1u) * nloc) {
            __builtin_amdgcn_fence(__ATOMIC_RELEASE, "agent");
            asm volatile("s_waitcnt vmcnt(0)" ::: "memory");
            const unsigned og = xb_add(&bar[XB_TOP], 1u);
            const unsigned tg = og / nx;
            if (og + 1u == (tg + 1u) * nx) xb_add(&bar[XB_TOPGEN], 1u);
            else XB_SPIN(xb_ld(&bar[XB_TOPGEN]) == tg, bar);
            __builtin_amdgcn_fence(__ATOMIC_ACQUIRE, "agent");
            xb_add(&bar[XB_XGEN(b.x)], 1u);
            asm volatile("s_waitcnt vmcnt(0)" ::: "memory");
        } else {
            XB_SPIN(xb_ld(&bar[XB_XGEN(b.x)]) == gen, bar);
            __builtin_amdgcn_fence(__ATOMIC_ACQUIRE, "agent");
            asm volatile("s_waitcnt vmcnt(0)" ::: "memory");
        }
    }
    __syncthreads();
}

__device__ __forceinline__ void xcc_barrier(const XcdBarrier& b, unsigned* gb, unsigned nloc) {
    asm volatile("s_waitcnt vmcnt(0)" ::: "memory");
    __syncthreads();
    if (threadIdx.x == 0) {
        __builtin_amdgcn_s_waitcnt(0);
        const unsigned old = xb_add(&gb[64 * b.x], 1u); const unsigned gen = old / nloc;
        if (old + 1u == (gen + 1u) * nloc) xb_add(&gb[1024 + 64 * b.x], 1u);
        else XB_SPIN(xb_ld(&gb[1024 + 64 * b.x]) == gen, b.bar);
        __builtin_amdgcn_fence(__ATOMIC_ACQUIRE, "agent");
        asm volatile("s_waitcnt vmcnt(0)" ::: "memory");
    }
    __syncthreads();
}

constexpr int BM = 256, BK = 64, HALF = 128, HTB = HALF * BK * 2;
__device__ __forceinline__ void stage_rc(int b, int& R, int& C) { const int st = b / 1024, sb = b % 1024, swz = sb ^ (((sb >> 9) & 1) << 5); R = (st >> 1) * 16 + swz / 64; C = (st & 1) * 32 + (swz % 64) / 2; }
__device__ __forceinline__ int lds_byte(int r, int c) { const int st = (r >> 4) * 2 + (c >> 5), rr = r & 15, cc = c & 31, ob = rr * 64 + cc * 2; return st * 1024 + (ob ^ (((ob >> 9) & 1) << 5)); }
__device__ __forceinline__ int perm32(int rho) { const int n = rho >> 4, i = rho & 15; return 8 * (i >> 2) + 4 * n + (i & 3); }

struct GUnit { const char* A; const char* B; int nt; int i0, i1, i2, i3; int hm; };
template <class Epi, class Sched>
__device__ __forceinline__ void gemm_phase(LAS unsigned char* lds, const Sched& S, const Epi& E) {
    int tid = threadIdx.x; asm volatile("" : "+v"(tid));
    const int wid = __builtin_amdgcn_readfirstlane(tid >> 6), lane = tid & 63, wr = wid >> 2, wc = wid & 3, fr = lane & 15, fq = lane >> 4;
    int R0, C0, R1, C1; stage_rc(tid * 16, R0, C0); stage_rc(tid * 16 + 8192, R1, C1);
    const unsigned ldb = S.ldb_bytes();
    unsigned voffB[2];
    voffB[0] = (unsigned)((R0 & ~31) + perm32(R0 & 31)) * ldb + (unsigned)C0 * 2u; voffB[1] = (unsigned)((R1 & ~31) + perm32(R1 & 31)) * ldb + (unsigned)C1 * 2u;
    unsigned voffBh[2]; voffBh[0] = voffB[0] + (unsigned)HALF * ldb; voffBh[1] = voffB[1] + (unsigned)HALF * ldb;
    const unsigned ldsw = (unsigned)wid * 1024u;
    const int aoff = lds_byte(wr * 64 + fr, fq * 8), boff = lds_byte(wc * 32 + fr, fq * 8);
#define PG8_SA(b, h) (((b) * 2 + (h)) * HTB)
#define PG8_SB(b, h) ((4 + (b) * 2 + (h)) * HTB)
#define PG8_STAGE(bufoff, gbase, voff, kofs) do { _Pragma("unroll") for (int _i = 0; _i < 2; ++_i) \
        __builtin_amdgcn_global_load_lds((const unsigned*)((const char*)(gbase) + (unsigned)((voff)[_i] + (kofs))), (LAS unsigned*)(lds + (bufoff) + ldsw + _i * 8192), 16, 0, 0); } while (0)
#define PG8_LDA(dst, b, h) do { _Pragma("unroll") for (int m = 0; m < 4; ++m) _Pragma("unroll") for (int k = 0; k < 2; ++k) dst[m][k] = *(const LAS bf16x8*)(lds + PG8_SA(b, h) + aoff + m * 2048 + k * 1024); } while (0)
#define PG8_LDB(dst, b, h) do { _Pragma("unroll") for (int n = 0; n < 2; ++n) _Pragma("unroll") for (int k = 0; k < 2; ++k) dst[n][k] = *(const LAS bf16x8*)(lds + PG8_SB(b, h) + boff + n * 2048 + k * 1024); } while (0)
#define PG8_MMA(ai, bj, At, Bt) do { __builtin_amdgcn_s_setprio(1); _Pragma("unroll") for (int m = 0; m < 4; ++m) _Pragma("unroll") for (int n = 0; n < 2; ++n) _Pragma("unroll") for (int k = 0; k < 2; ++k) \
        acc[ai][bj][m][n] = __builtin_amdgcn_mfma_f32_16x16x32_bf16(Bt[n][k], At[m][k], acc[ai][bj][m][n], 0, 0, 0); __builtin_amdgcn_s_setprio(0); } while (0)
#define PG8_WAIT_V(n) asm volatile("s_waitcnt vmcnt(" #n ")" ::: "memory")
#define PG8_WAIT_L(n) asm volatile("s_waitcnt lgkmcnt(" #n ")" ::: "memory")
#define PG8_BAR __builtin_amdgcn_s_barrier()
#define PG8_SCHED __builtin_amdgcn_sched_barrier(0)
    GUnit cur, nxt; int ui = 0;
    if (!S.next(0, cur)) return;
    f32x4 acc[2][2][4][2];
#pragma unroll
    for (int a = 0; a < 2; ++a)
#pragma unroll
        for (int b = 0; b < 2; ++b)
#pragma unroll
            for (int m = 0; m < 4; ++m)
#pragma unroll
                for (int n = 0; n < 2; ++n) acc[a][b][m][n] = (f32x4){0.f, 0.f, 0.f, 0.f};
    bf16x8 At[4][2], B0[2][2], B1[2][2];
    unsigned oAc[2][2], oAn[2][2];
    S.a_ready(cur);
    S.offs(cur, R0, R1, C0, C1, oAc);
    const char* cA = cur.A; const char* cB = cur.B;
    PG8_STAGE(PG8_SB(0, 0), cB, voffB, 0u); PG8_STAGE(PG8_SB(0, 1), cB, voffBh, 0u); PG8_STAGE(PG8_SA(0, 0), cA, oAc[0], 0u); PG8_STAGE(PG8_SA(0, 1), cA, oAc[1], 0u);
    if (wr == 1) PG8_BAR;
    PG8_WAIT_V(2); PG8_BAR;
    PG8_STAGE(PG8_SB(1, 0), cB, voffB, 128u); PG8_STAGE(PG8_SA(1, 0), cA, oAc[0], 128u); PG8_STAGE(PG8_SB(1, 1), cB, voffBh, 128u);
    PG8_WAIT_V(6); PG8_BAR;
    for (;;) {
        const bool has_next = S.next(ui + 1, nxt);
        const char* nA = has_next ? nxt.A : cA; const char* nB = has_next ? nxt.B : cB;
        if constexpr (Sched::GATHER) { if (has_next) S.offs(nxt, R0, R1, C0, C1, oAn);
            else { oAn[0][0] = oAc[0][0]; oAn[0][1] = oAc[0][1]; oAn[1][0] = oAc[1][0]; oAn[1][1] = oAc[1][1]; } }
        int nt = cur.nt; asm volatile("" : "+s"(nt)); const bool hm = Sched::HALFM && cur.hm != 0;
        for (int t = 0; t < nt; t += 2) {
            const bool last = (t == nt - 2);
            if (last && has_next) S.a_ready(nxt);
            const unsigned k1 = (unsigned)(t + 1) * 128u, k2 = last ? 0u : (unsigned)(t + 2) * 128u, k3 = k2 + 128u;
            const char* a2 = last ? nA : cA; const char* b2 = last ? nB : cB;
            unsigned o2[2][2];
            if constexpr (Sched::GATHER) { o2[0][0] = last ? oAn[0][0] : oAc[0][0]; o2[0][1] = last ? oAn[0][1] : oAc[0][1]; o2[1][0] = last ? oAn[1][0] : oAc[1][0]; o2[1][1] = last ? oAn[1][1] : oAc[1][1]; }
            else { o2[0][0] = oAc[0][0]; o2[0][1] = oAc[0][1]; o2[1][0] = oAc[1][0]; o2[1][1] = oAc[1][1]; }
            PG8_LDB(B0, 0, 0); PG8_LDB(B1, 0, 1); PG8_SCHED; PG8_LDA(At, 0, 0); PG8_STAGE(PG8_SA(1, 1), cA, oAc[1], k1);
            PG8_WAIT_V(8); PG8_WAIT_L(0); PG8_BAR; PG8_MMA(0, 0, At, B0); PG8_MMA(0, 1, At, B1); PG8_BAR; PG8_SCHED;
            if (!hm) PG8_LDA(At, 0, 1); PG8_STAGE(PG8_SB(0, 0), b2, voffB, k2); PG8_STAGE(PG8_SB(0, 1), b2, voffBh, k2); PG8_STAGE(PG8_SA(0, 0), a2, o2[0], k2);
            PG8_WAIT_V(8); PG8_WAIT_L(0); PG8_BAR; if (!hm) { PG8_MMA(1, 0, At, B0); PG8_MMA(1, 1, At, B1); } PG8_BAR; PG8_SCHED;
            PG8_LDB(B0, 1, 0); PG8_LDB(B1, 1, 1); PG8_SCHED; PG8_LDA(At, 1, 0); PG8_STAGE(PG8_SA(0, 1), a2, o2[1], k2);
            PG8_WAIT_V(8); PG8_WAIT_L(0); PG8_BAR; PG8_MMA(0, 0, At, B0); PG8_MMA(0, 1, At, B1); PG8_BAR; PG8_SCHED;
            if (!hm) PG8_LDA(At, 1, 1); PG8_STAGE(PG8_SB(1, 0), b2, voffB, k3); PG8_STAGE(PG8_SB(1, 1), b2, voffBh, k3); PG8_STAGE(PG8_SA(1, 0), a2, o2[0], k3);
            PG8_WAIT_V(8); PG8_WAIT_L(0); PG8_BAR; if (!hm) { PG8_MMA(1, 0, At, B0); PG8_MMA(1, 1, At, B1); } PG8_BAR; PG8_SCHED;
        }
        if (wr == 0) PG8_BAR;
        { int fr2 = fr, fq2 = fq; asm volatile("" : "+v"(fr2), "+v"(fq2)); E(acc, cur, wr, wc, fr2, fq2); S.done(cur); }
        if (!has_next) break;
        bool keep_ = false; if constexpr (Sched::ACCUM) keep_ = S.keep_acc(cur);
        if (!keep_) {
#pragma unroll
        for (int a = 0; a < 2; ++a)
#pragma unroll
            for (int b = 0; b < 2; ++b)
#pragma unroll
                for (int m = 0; m < 4; ++m)
#pragma unroll
                    for (int n = 0; n < 2; ++n) acc[a][b][m][n] = (f32x4){0.f, 0.f, 0.f, 0.f};
        }
        cur = nxt; cA = nA; cB = nB; ++ui;
        if constexpr (Sched::GATHER) { oAc[0][0] = oAn[0][0]; oAc[0][1] = oAn[0][1]; oAc[1][0] = oAn[1][0]; oAc[1][1] = oAn[1][1]; }
        if (wr == 1) PG8_BAR;
    }
    PG8_WAIT_V(0);
    PG8_BAR;
#undef PG8_SA
#undef PG8_SB
#undef PG8_STAGE
#undef PG8_LDA
#undef PG8_LDB
#undef PG8_MMA
#undef PG8_WAIT_V
#undef PG8_WAIT_L
#undef PG8_BAR
#undef PG8_SCHED
}
}
namespace fk {
constexpr size_t MiB = 1u << 20;
constexpr size_t WS_CTL = 0, CTL_ZERO_BYTES = 64 * 1024;
constexpr size_t WS_MOD = 1 * MiB;
constexpr size_t WS_BT = WS_MOD + 832 * 1024;
constexpr size_t WS_LAM = WS_BT + 4096;
constexpr size_t WS_ST = WS_MOD + 896 * 1024;
constexpr size_t WS_CS = 2 * MiB, WS_SN = 3 * MiB;
constexpr size_t WS_LIST = 4 * MiB, WS_ROWW = 6 * MiB, WS_TOKSLOT = 8 * MiB;
constexpr size_t WS_WIN = 10 * MiB;
constexpr size_t WS_WUQ = 58 * MiB;
constexpr size_t WS_WRT = 59 * MiB + 512 * 1024;
constexpr size_t WS_WUKV = 60 * MiB;
constexpr size_t WS_WBR = 62 * MiB;
constexpr size_t WS_WOUT = 74 * MiB;
constexpr size_t WS_WGU = 82 * MiB;
constexpr size_t WS_WDN = 210 * MiB;
constexpr size_t WS_X = 274 * MiB;
constexpr size_t WS_MERGED = 306 * MiB;
constexpr size_t WS_POOL = 338 * MiB;
constexpr size_t WS_Y1 = WS_POOL;
constexpr size_t WS_Z = WS_POOL;
constexpr size_t WS_ACT = WS_POOL + 96 * MiB;
constexpr size_t WS_XG = WS_POOL + 96 * MiB;
constexpr size_t WS_QC = WS_POOL + 192 * MiB;
constexpr size_t WS_KVC = WS_POOL + 216 * MiB;
constexpr size_t WS_KR = WS_POOL + 248 * MiB;
constexpr size_t WS_STAT = WS_KR + 1 * MiB;
constexpr size_t WS_STAT2 = WS_STAT + 512 * 1024;
constexpr size_t WS_OA = WS_POOL + 250 * MiB, WS_OB = WS_POOL + 266 * MiB, WS_OC = WS_POOL + 282 * MiB;
constexpr size_t WS_H = WS_POOL + 298 * MiB;
constexpr size_t WS_END = WS_POOL + 330 * MiB;
constexpr int CW_BAR = 1024;
constexpr int CW_CNT = 8192;
constexpr int CW_GBAR = 4608;
constexpr int CW_RDY = 9216;
constexpr int CW_G2CNT = 8512;
constexpr int CW_TMO2 = 8448;
static_assert((CW_RDY + 4 * 256) * 4 <= (int)CTL_ZERO_BYTES, "ctl map 2");
static_assert((CW_BAR + XCD_BAR_WORDS) <= CW_CNT && (CW_CNT + 4 * 32) * 4 <= (int)CTL_ZERO_BYTES, "ctl map");
constexpr int RING_BYTES = 131072, TAB_OFF = RING_BYTES, MISC_OFF = TAB_OFF + 8192, LDS_BYTES = 147456;

__device__ __forceinline__ size_t zrow(int ts) { return (size_t)(ts >> 12) * 6291456u + (size_t)(ts & 4095) * 1024u; }
struct Params {
    const float *x, *c; const int* positions; const float *w_ada, *b_ada, *norm_g, *w_in, *diff_qk_g, *diff_lambda, *diff_out_g, *rel_bias, *sgu_v_g, *sgu_w, *sgu_b,
        *mla_lat_g, *mla_w_uq, *mla_w_ukv, *mla_qk_g, *w_branch, *w_out, *router_g_w, *router_g_b, *router_e_w, *router_e_b, *w_e_gate, *w_e_up, *w_e_down;
    float* out; unsigned char* ws; int ph_lo, ph_hi; int l_lo, l_hi; int nlayers, pad_;
};

__device__ __forceinline__ void transpose_blk(const float* W, int ldw, int sc0, int k0, bf16* WT, int dr0, int ldt, const float* kscale, LAS float* scr, int lane) {
    float tv[32];
#pragma unroll
    for (int i = 0; i < 32; ++i) { const int kk = 2 * i + (lane >> 5); tv[i] = W[(size_t)(k0 + kk) * ldw + sc0 + (lane & 31)]; }
#pragma unroll
    for (int i = 0; i < 32; ++i) { const int kk = 2 * i + (lane >> 5); float v = tv[i]; if (kscale) v *= kscale[k0 + kk]; scr[kk * 33 + (lane & 31)] = v; }
    LDS_WAIT(); asm volatile("" ::: "memory");
    const int c = lane & 7;
#pragma unroll
    for (int j = 0; j < 4; ++j) { const int n = (lane >> 3) + 8 * j; const LAS float* sp = scr + (8 * c) * 33 + n;
        u32x4 o; o.x = cvtpk(sp[0 * 33], sp[1 * 33]); o.y = cvtpk(sp[2 * 33], sp[3 * 33]); o.z = cvtpk(sp[4 * 33], sp[5 * 33]); o.w = cvtpk(sp[6 * 33], sp[7 * 33]);
        *(GAS u32x4*)(WT + (size_t)(dr0 + n) * ldt + k0 + 8 * c) = o; }
    LDS_WAIT(); asm volatile("" ::: "memory");
}
__device__ __forceinline__ void transpose_item(const float* W, int K, int ldw, int c0, int ncols, bf16* WT, int row_off, LAS float* scr, int item, int lane, int ldt = 0) {
    if (ldt == 0) ldt = K;
    const int nblk = ncols / 32, kb = item / nblk, nb = item % nblk;
    transpose_blk(W, ldw, c0 + 32 * nb, 64 * kb, WT, row_off + 32 * nb, ldt, nullptr, scr, lane);
}
}
namespace fk {
struct Frame { LAS unsigned char* lds; unsigned char* ws; int tid, lane, wave, G, bid, gw, NGW; };

constexpr int IT_IN1 = 16 * 93, IT_IN2 = 16 * 96, IT_UQ = 4 * 24, IT_UKV = 2 * 32, IT_BR = 8 * 32, IT_OUT = 16 * 32, IT_NONEXP = IT_IN1 + IT_IN2 + IT_UQ + IT_UKV + 3 * IT_BR + IT_OUT;
constexpr int IT_EXP = 4 * 64 + 128, IT_LAYER = IT_NONEXP + 32 * IT_EXP, IT_TOTAL = NL * IT_LAYER;
__device__ __forceinline__ void p0_prologue(Frame& F, const Params& p) {
    unsigned char* ws = F.ws;
    LAS float* cact = (LAS float*)(F.lds);
    for (int i = F.tid; i < NB * D; i += NTHR) { const float v = p.c[i]; cact[i] = v / (1.f + __expf(-v)); }
    __syncthreads();
    LAS float* part = (LAS float*)(F.lds + 32768);
    float* MOD = (float*)(ws + WS_MOD);
    for (int it = F.bid; it < NL * 192; it += F.G) {
        const int l = it / 192, cg = it % 192, col = cg * 32 + (F.lane & 31), kpar = F.lane >> 5;
        const int kb = F.wave * 128 + kpar;
        const float* w = p.w_ada + (size_t)l * D * 6 * D + (size_t)kb * 6 * D + col;
        float acc[NB];
#pragma unroll
        for (int b = 0; b < NB; ++b) acc[b] = 0.f;
#pragma unroll 16
        for (int i = 0; i < 64; ++i) { const float wv = w[(size_t)(2 * i) * 6 * D];
#pragma unroll
            for (int b = 0; b < NB; ++b) acc[b] += cact[b * D + kb + 2 * i] * wv; }
#pragma unroll
        for (int b = 0; b < NB; ++b) { const float s2 = xsum32(acc[b]); if (F.lane < 32) part[(F.wave * NB + b) * 32 + F.lane] = s2; }
        __syncthreads();
        if (F.tid < 256) { const int b = F.tid >> 5, c = F.tid & 31; float s = 0.f;
#pragma unroll
          for (int wv = 0; wv < 8; ++wv) s += part[(wv * NB + b) * 32 + c];
          MOD[((size_t)l * NB + b) * 6 * D + cg * 32 + c] = s + p.b_ada[l * 6 * D + cg * 32 + c]; }
        __syncthreads();
    }
    const int gt = F.bid * NTHR + F.tid, NGT = F.G * NTHR;
    if (gt < NL) { const float* dl = p.diff_lambda + gt * 256; float s01 = 0.f, s23 = 0.f;
        for (int i = 0; i < 64; ++i) { s01 += dl[i] * dl[64 + i]; s23 += dl[128 + i] * dl[192 + i]; }
        ((float*)(ws + WS_LAM))[gt] = expf(s01) - expf(s23) + (0.8f - 0.6f * expf(-0.3f * (float)gt)); }
    if (gt >= 1024 && gt < 1024 + 4 * 256) { const int i = gt - 1024, h = i >> 8, rel = (i & 255) - 191; const int n = rel < 0 ? -rel : rel;
        int large = 8 + (int)(logf((float)(n > 1 ? n : 1) / 8.f) / 2.772588722239781f * 8.f); if (large > 15) large = 15;
        const int bucket = (rel > 0 ? 16 : 0) + (n < 8 ? n : large);
        ((float*)(ws + WS_BT))[i] = (p.rel_bias[bucket * 4 + h] - p.rel_bias[15 * 4 + h]) * LOG2E; }
    for (int i = gt; i < M * 16; i += NGT) { const int m = i >> 4, j = i & 15; const float inv_freq = powf(10000.f, -(float)(2 * j) / 32.f);
        const float ang = (float)p.positions[m] * inv_freq; ((float*)(ws + WS_CS))[i] = cosf(ang); ((float*)(ws + WS_SN))[i] = sinf(ang); }
    for (int i = gt; i < NL * 96 * 128; i += NGT) { const int l = i / (96 * 128), r = i % (96 * 128); ((u32x4*)(ws + WS_WIN + (size_t)l * 6144 * 2048 + (size_t)2976 * 2048))[r] = (u32x4){0u, 0u, 0u, 0u}; }
    for (int i = gt; i < NL * 48 * 1024; i += NGT) { const int l = i / (48 * 1024), r = i % (48 * 1024), o = r >> 10, k = r & 1023;
        const float v = o < 32 ? p.router_e_w[((size_t)l * D + k) * 32 + o] : (o < 36 ? p.router_g_w[((size_t)l * D + k) * 4 + (o - 32)] : 0.f);
        ((bf16*)(ws + WS_WRT))[i] = (bf16)(cvtpk(v, 0.f) & 0xffffu); }
    for (int i = gt; i < NL * 1024 * 16; i += NGT) { const int rr = i >> 4, q = i & 15; ((u32x4*)(ws + WS_WUKV + (size_t)rr * 512 + 256))[q] = (u32x4){0u, 0u, 0u, 0u}; }
    LAS float* scr = (LAS float*)(F.lds + 49152 + F.wave * 8448);
    for (int it = F.gw; it < IT_TOTAL; it += F.NGW) {
        const int l = it / IT_LAYER; int r = it % IT_LAYER;
        if (r < IT_IN1) { const int kb = r / 93, nb = r % 93, n0 = 32 * nb;
            const int sc0 = n0 < 1024 ? (n0 & ~255) + 64 * ((n0 >> 5) & 3) + 32 * ((n0 >> 7) & 1) : n0;
            transpose_blk(p.w_in + (size_t)l * D * 6048, 6048, sc0, 64 * kb, (bf16*)(ws + WS_WIN) + (size_t)l * 6144 * 1024, n0, 1024, nullptr, scr, F.lane); continue; } r -= IT_IN1;
        if (r < IT_IN2) { transpose_item(p.w_in + (size_t)l * D * 6048, 1024, 6048, 2976, 3072, (bf16*)(ws + WS_WIN) + (size_t)l * 6144 * 1024, 3072, scr, r, F.lane); continue; } r -= IT_IN2;
        if (r < IT_UQ) { const int kb = r / 24, nb = r % 24, n0 = 32 * nb, tt = n0 >> 8, bj = (n0 >> 7) & 1, wc = (n0 >> 5) & 3;
            const int sc0 = tt < 2 ? (4 * tt + wc) * 96 + 32 * bj : (4 * bj + wc) * 96 + 64;
            transpose_blk(p.mla_w_uq + (size_t)l * 256 * 768, 768, sc0, 64 * kb, (bf16*)(ws + WS_WUQ) + (size_t)l * 768 * 256, n0, 256, p.mla_lat_g + l * 384, scr, F.lane); continue; } r -= IT_UQ;
        if (r < IT_UKV) { const int kb = r / 32, nb = r % 32, n0 = 32 * nb, tt = n0 >> 8, bj = (n0 >> 7) & 1, wc = (n0 >> 5) & 3;
            const int sc0 = tt < 2 ? (4 * tt + wc) * 128 + 32 * bj : (4 * (tt - 2) + wc) * 128 + 64 + 32 * bj;
            transpose_blk(p.mla_w_ukv + (size_t)l * 128 * 1024, 1024, sc0, 64 * kb, (bf16*)(ws + WS_WUKV) + (size_t)l * 1024 * 256, n0, 256, p.mla_lat_g + l * 384 + 256, scr, F.lane); continue; } r -= IT_UKV;
        if (r < 3 * IT_BR) { const int n = r / IT_BR; transpose_item(p.w_branch + ((size_t)l * 3 + n) * 512 * 1024, 512, 1024, 0, 1024, (bf16*)(ws + WS_WBR) + ((size_t)l * 3 + n) * 1024 * 512, 0, scr, r % IT_BR, F.lane); continue; } r -= 3 * IT_BR;
        if (r < IT_OUT) { transpose_item(p.w_out + (size_t)l * D * D, 1024, 1024, 0, 1024, (bf16*)(ws + WS_WOUT) + (size_t)l * D * D, 0, scr, r, F.lane); continue; } r -= IT_OUT;
        const int e = r / IT_EXP, q = r % IT_EXP; const size_t le = (size_t)l * 32 + e;
        if (q < 256) { const int jj = q >> 6; const float* src = ((jj & 1) ? p.w_e_up : p.w_e_gate) + le * 1024 * 256;
            transpose_item(src, 1024, 256, (jj >> 1) * 128, 128, (bf16*)(ws + WS_WGU) + le * 512 * 1024, jj * 128, scr, q & 63, F.lane); }
        else transpose_item(p.w_e_down + le * 256 * 1024, 256, 1024, 0, 1024, (bf16*)(ws + WS_WDN) + le * 1024 * 256, 0, scr, q - 256, F.lane);
    }
}

template <int MODE>
__device__ __forceinline__ void row_normmod(Frame& F, const float* xin, bf16* X, const bf16* Z, const float* gateprev, const float* g, const float* shift, const float* scale, bf16* H, float* out) {
    constexpr int R = 2;
    const int mb = (F.bid & 7) * 2048 + (F.bid >> 3) * 64 + F.wave;
    for (int kq = 0; kq < 8; kq += R) { const int m0 = mb + 8 * kq;
        f32x4 v[R][4]; u32x2 z0[R][4], z1[R][4];
#pragma unroll
        for (int r = 0; r < R; ++r) { const int m = m0 + 8 * r;
#pragma unroll
            for (int j = 0; j < 4; ++j) { const int d = 4 * F.lane + 256 * j;
                if (MODE == 0) v[r][j] = *(const GAS f32x4*)(xin + (size_t)m * D + d);
                else { const u32x2 xb = *(const GAS u32x2*)(X + (size_t)m * D + d); v[r][j] = (f32x4){bf_lo(xb.x), bf_hi(xb.x), bf_lo(xb.y), bf_hi(xb.y)}; }
                if (MODE >= 2) { z0[r][j] = *(const GAS u32x2*)(Z + zrow(2 * m) + d); z1[r][j] = *(const GAS u32x2*)(Z + zrow(2 * m + 1) + d); } } }
#pragma unroll
        for (int r = 0; r < R; ++r) { const int m = m0 + 8 * r; const int b = m / S;
#pragma unroll
            for (int j = 0; j < 4; ++j) { const int d = 4 * F.lane + 256 * j;
                if (MODE >= 2) { const f32x4 gt = *(const GAS f32x4*)(gateprev + (size_t)b * 6 * D + d);
                    v[r][j].x += gt.x * (bf_lo(z0[r][j].x) + bf_lo(z1[r][j].x)); v[r][j].y += gt.y * (bf_hi(z0[r][j].x) + bf_hi(z1[r][j].x));
                    v[r][j].z += gt.z * (bf_lo(z0[r][j].y) + bf_lo(z1[r][j].y)); v[r][j].w += gt.w * (bf_hi(z0[r][j].y) + bf_hi(z1[r][j].y)); }
                if (MODE == 2) { u32x2 xo; xo.x = cvtpk(v[r][j].x, v[r][j].y); xo.y = cvtpk(v[r][j].z, v[r][j].w); *(GAS u32x2*)(X + (size_t)m * D + d) = xo;
                    v[r][j] = (f32x4){bf_lo(xo.x), bf_hi(xo.x), bf_lo(xo.y), bf_hi(xo.y)}; }
                if (MODE == 3) *(GAS f32x4*)(out + (size_t)m * D + d) = v[r][j]; }
            if (MODE == 3) continue;
            float s = 0.f;
#pragma unroll
            for (int j = 0; j < 4; ++j) s += (v[r][j].x * v[r][j].x + v[r][j].y * v[r][j].y) + (v[r][j].z * v[r][j].z + v[r][j].w * v[r][j].w);
            const float rstd = rsqrtf(wave_sum(s) * (1.f / D) + 1e-6f);
#pragma unroll
            for (int j = 0; j < 4; ++j) { const int d = 4 * F.lane + 256 * j;
                const f32x4 gg = *(const GAS f32x4*)(g + d), sc = *(const GAS f32x4*)(scale + (size_t)b * 6 * D + d), sh = *(const GAS f32x4*)(shift + (size_t)b * 6 * D + d);
                const float o0 = v[r][j].x * rstd * gg.x * (1.f + sc.x) + sh.x, o1 = v[r][j].y * rstd * gg.y * (1.f + sc.y) + sh.y, o2 = v[r][j].z * rstd * gg.z * (1.f + sc.z) + sh.z, o3 = v[r][j].w * rstd * gg.w * (1.f + sc.w) + sh.w;
                u32x2 o; o.x = cvtpk(o0, o1); o.y = cvtpk(o2, o3); st8x(H + (size_t)m * D + d, o); }
        }
    }
}

struct SchedDense {
    static constexpr bool GATHER = false; static constexpr bool HALFM = false; static constexpr bool ACCUM = false;
    __device__ __forceinline__ void a_ready(const GUnit&) const {}
    __device__ __forceinline__ void done(const GUnit&) const {}
    const char* A; const char* B; unsigned lda_b, ldb_b; int nM, nN, nt, G, c;
    __device__ __forceinline__ bool next(int i, GUnit& u) const {
        const long L = (long)i * G + c; const int nwg = nM * nN; if (L >= nwg) return false;
        int wgid = (int)L; { const int q = nwg / 8, r = nwg % 8, xcd = wgid % 8, off = wgid / 8; wgid = (xcd < r ? xcd * (q + 1) : r * (q + 1) + (xcd - r) * q) + off; }
        const int nig = 8 * nN, gid = wgid / nig, fm = gid * 8, gsz = (nM - fm) < 8 ? (nM - fm) : 8;
        const int pm = fm + ((wgid % nig) % gsz), pn = (wgid % nig) / gsz;
        u.A = A + (size_t)pm * 256 * lda_b; u.B = B + (size_t)pn * 256 * ldb_b; u.nt = nt; u.i0 = pm; u.i1 = pn; u.i2 = 0; return true;
    }
    __device__ __forceinline__ void offs(const GUnit&, int R0, int R1, int C0, int C1, unsigned (&oA)[2][2]) const {
        oA[0][0] = (unsigned)R0 * lda_b + C0 * 2u; oA[0][1] = (unsigned)R1 * lda_b + C1 * 2u; oA[1][0] = (unsigned)(R0 + 128) * lda_b + C0 * 2u; oA[1][1] = (unsigned)(R1 + 128) * lda_b + C1 * 2u; }
    __device__ __forceinline__ unsigned ldb_bytes() const { return ldb_b; }
};
struct SchedDensePub : SchedDense {
    unsigned* cnt;
    __device__ __forceinline__ void done(const GUnit& u) const { asm volatile("s_waitcnt vmcnt(0)" ::: "memory"); if ((threadIdx.x & 63) == 0) __hip_atomic_fetch_add(cnt + (u.i0 >> 3), 1u, __ATOMIC_RELAXED, __HIP_MEMORY_SCOPE_AGENT); }
};
struct EpiStoreBf16 {
    bf16* O0; bf16* O1; int split, ldc0, ldc1;
    __device__ __forceinline__ void operator()(const f32x4 (&acc)[2][2][4][2], const GUnit& u, int wr, int wc, int fr, int fq) const {
        const int pn = u.i1; bf16* base; int ldc; if (pn < split) { base = O0 + 256 * pn; ldc = ldc0; } else { base = O1 + 256 * (pn - split); ldc = ldc1; }
        const int row0 = u.i0 * 256 + wr * 64 + fr, col0 = wc * 32 + 8 * fq;
#pragma unroll
        for (int ai = 0; ai < 2; ++ai)
#pragma unroll
            for (int m = 0; m < 4; ++m) { bf16* rowp = base + (size_t)(row0 + ai * 128 + m * 16) * ldc + col0;
#pragma unroll
                for (int bj = 0; bj < 2; ++bj) { const f32x4 v0 = acc[ai][bj][m][0], v1 = acc[ai][bj][m][1];
                    u32x4 w; w.x = cvtpk(v0[0], v0[1]); w.y = cvtpk(v0[2], v0[3]); w.z = cvtpk(v1[0], v1[1]); w.w = cvtpk(v1[2], v1[3]);
                    st16(rowp + bj * 128, w); } }
    }
};
struct EpiG1 {
    bf16* Y1; bf16* XG; bf16* KR; float* ST; float* ST2; const float* gq; const float* kg; const float* CS; const float* SN;
    __device__ __forceinline__ void operator()(const f32x4 (&acc)[2][2][4][2], const GUnit& u, int wr, int wc, int fr, int fq) const {
        const int pn = u.i1; const int row0 = u.i0 * 256 + wr * 64 + fr;
        if (pn < 4) {
            const float* g = gq + (pn >> 1) * 64; const float mul = pn < 2 ? 0.125f * LOG2E : 1.f;
            f32x4 gv[2][2];
#pragma unroll
            for (int bj = 0; bj < 2; ++bj)
#pragma unroll
                for (int n = 0; n < 2; ++n) gv[bj][n] = *(const GAS f32x4*)(g + 32 * bj + 8 * fq + 4 * n);
#pragma unroll
            for (int ai = 0; ai < 2; ++ai)
#pragma unroll
                for (int m = 0; m < 4; ++m) {
                    float s = 0.f;
#pragma unroll
                    for (int bj = 0; bj < 2; ++bj)
#pragma unroll
                        for (int n = 0; n < 2; ++n) { const f32x4 v = acc[ai][bj][m][n]; s += (v[0] * v[0] + v[1] * v[1]) + (v[2] * v[2] + v[3] * v[3]); }
                    s += sw<16>(s); s = xsum32(s);
                    const float rstd = rsqrtf(s * (1.f / 64.f) + 1e-6f) * mul;
                    bf16* rowp = Y1 + (size_t)(row0 + ai * 128 + m * 16) * 3072 + 256 * pn + 64 * wc + 8 * fq;
#pragma unroll
                    for (int bj = 0; bj < 2; ++bj) { const f32x4 v0 = acc[ai][bj][m][0] * rstd * gv[bj][0], v1 = acc[ai][bj][m][1] * rstd * gv[bj][1];
                        u32x4 w; w.x = cvtpk(v0[0], v0[1]); w.y = cvtpk(v0[2], v0[3]); w.z = cvtpk(v1[0], v1[1]); w.w = cvtpk(v1[2], v1[3]);
                        st16(rowp + 32 * bj, w); }
                }
            return;
        }
        if (pn >= 12) {
            unsigned char* gb = (unsigned char*)XG + 256 * (pn - 12) + wc * 32 + 8 * fq;
#pragma unroll
            for (int ai = 0; ai < 2; ++ai)
#pragma unroll
                for (int m = 0; m < 4; ++m) { unsigned char* rowp = gb + (size_t)(row0 + ai * 128 + m * 16) * 3072;
#pragma unroll
                    for (int bj = 0; bj < 2; ++bj) { const f32x4 v0 = acc[ai][bj][m][0], v1 = acc[ai][bj][m][1]; unsigned q[8];
#pragma unroll
                        for (int t = 0; t < 8; ++t) { const float x = t < 4 ? v0[t & 3] : v1[t & 3]; q[t] = (unsigned)(fast_sigmoid(x) * 255.f + 0.5f); q[t] = q[t] < 1u ? 1u : q[t]; }
                        u32x2 w; w.x = q[0] | (q[1] << 8) | (q[2] << 16) | (q[3] << 24); w.y = q[4] | (q[5] << 8) | (q[6] << 16) | (q[7] << 24);
                        *(GAS u32x2*)(rowp + bj * 128) = w; } }
            return;
        }
        bf16* base = Y1 + 256 * pn; const int col0 = wc * 32 + 8 * fq;
#pragma unroll
        for (int ai = 0; ai < 2; ++ai)
#pragma unroll
            for (int m = 0; m < 4; ++m) { bf16* rowp = base + (size_t)(row0 + ai * 128 + m * 16) * 3072 + col0;
#pragma unroll
                for (int bj = 0; bj < 2; ++bj) { const f32x4 v0 = acc[ai][bj][m][0], v1 = acc[ai][bj][m][1];
                    u32x4 w; w.x = cvtpk(v0[0], v0[1]); w.y = cvtpk(v0[2], v0[3]); w.z = cvtpk(v1[0], v1[1]); w.w = cvtpk(v1[2], v1[3]);
                    st16(rowp + bj * 128, w); } }
        if (pn == 8 || pn == 9) {
#pragma unroll
            for (int ai = 0; ai < 2; ++ai)
#pragma unroll
                for (int m = 0; m < 4; ++m) { float s = 0.f;
#pragma unroll
                    for (int bj = 0; bj < 2; ++bj)
#pragma unroll
                        for (int n = 0; n < 2; ++n) { const f32x4 v = acc[ai][bj][m][n]; const float a0 = gelu_tanh(v[0]), a1 = gelu_tanh(v[1]), a2 = gelu_tanh(v[2]), a3 = gelu_tanh(v[3]); s += (a0 * a0 + a1 * a1) + (a2 * a2 + a3 * a3); }
                    s += sw<16>(s); s = xsum32(s);
                    if (fq == 0) ST2[(size_t)(row0 + ai * 128 + m * 16) * 8 + (pn - 8) * 4 + wc] = s; }
        }
        if (pn == 10 || pn == 11) {
#pragma unroll
            for (int ai = 0; ai < 2; ++ai)
#pragma unroll
                for (int m = 0; m < 4; ++m) { float s = 0.f;
#pragma unroll
                    for (int bj = 0; bj < 2; ++bj) { if (pn == 11 && bj == 1) continue;
#pragma unroll
                        for (int n = 0; n < 2; ++n) { const f32x4 v = acc[ai][bj][m][n]; s += (v[0] * v[0] + v[1] * v[1]) + (v[2] * v[2] + v[3] * v[3]); } }
                    s += sw<16>(s); s = xsum32(s);
                    if (fq == 0) ST[(size_t)(row0 + ai * 128 + m * 16) * 8 + (pn - 10) * 4 + wc] = s; }
        }
        if (pn == 11 && wc == 0) {
            f32x4 g0 = *(const GAS f32x4*)(kg + 64 + 8 * fq), g1 = *(const GAS f32x4*)(kg + 64 + 8 * fq + 4);
#pragma unroll
            for (int ai = 0; ai < 2; ++ai)
#pragma unroll
                for (int m = 0; m < 4; ++m) { const size_t row = row0 + ai * 128 + m * 16;
                    f32x4 v0 = acc[ai][1][m][0], v1 = acc[ai][1][m][1];
                    float s = (v0[0] * v0[0] + v0[1] * v0[1]) + (v0[2] * v0[2] + v0[3] * v0[3]) + (v1[0] * v1[0] + v1[1] * v1[1]) + (v1[2] * v1[2] + v1[3] * v1[3]);
                    s += sw<16>(s); s = xsum32(s);
                    const float rstd = rsqrtf(s * (1.f / 32.f) + 1e-6f);
                    v0 = v0 * rstd * g0; v1 = v1 * rstd * g1;
                    const f32x4 c0 = *(const GAS f32x4*)(CS + row * 16 + 8 * (fq & 1)), c1 = *(const GAS f32x4*)(CS + row * 16 + 8 * (fq & 1) + 4);
                    const f32x4 s0 = *(const GAS f32x4*)(SN + row * 16 + 8 * (fq & 1)), s1 = *(const GAS f32x4*)(SN + row * 16 + 8 * (fq & 1) + 4);
                    f32x4 o0, o1;
#pragma unroll
                    for (int i = 0; i < 4; ++i) { const float p0 = xget32(v0[i], fq >= 2), p1 = xget32(v1[i], fq >= 2);
                        o0[i] = fq < 2 ? v0[i] * c0[i] - p0 * s0[i] : v0[i] * c0[i] + p0 * s0[i]; o1[i] = fq < 2 ? v1[i] * c1[i] - p1 * s1[i] : v1[i] * c1[i] + p1 * s1[i]; }
                    u32x4 w; w.x = cvtpk(o0[0], o0[1]); w.y = cvtpk(o0[2], o0[3]); w.z = cvtpk(o1[0], o1[1]); w.w = cvtpk(o1[2], o1[3]);
                    *(GAS u32x4*)(KR + row * 32 + 8 * fq) = w; }
        }
    }
};
template <int WHICH>
struct EpiG2 {
    bf16* O; const float* ST; const float* g; const float* CS; const float* SN;
    __device__ __forceinline__ void operator()(const f32x4 (&acc)[2][2][4][2], const GUnit& u, int wr, int wc, int fr, int fq) const {
        const int pn = u.i1; const int row0 = u.i0 * 256 + wr * 64 + fr; const float qs = 0.10206207261596577f * LOG2E;
#pragma unroll
        for (int ai = 0; ai < 2; ++ai)
#pragma unroll
            for (int m = 0; m < 4; ++m) { const size_t row = row0 + ai * 128 + m * 16;
                const f32x4 sp = *(const GAS f32x4*)(ST + row * 8 + WHICH * 4);
                const float r0 = rsqrtf(((sp[0] + sp[1]) + (sp[2] + sp[3])) * (WHICH ? 1.f / 128.f : 1.f / 256.f) + 1e-6f);
                f32x4 v[2][2];
#pragma unroll
                for (int bj = 0; bj < 2; ++bj)
#pragma unroll
                    for (int n = 0; n < 2; ++n) v[bj][n] = acc[ai][bj][m][n] * r0;
                if (pn < 2) {
                    float s = 0.f;
#pragma unroll
                    for (int bj = 0; bj < 2; ++bj)
#pragma unroll
                        for (int n = 0; n < 2; ++n) s += (v[bj][n][0] * v[bj][n][0] + v[bj][n][1] * v[bj][n][1]) + (v[bj][n][2] * v[bj][n][2] + v[bj][n][3] * v[bj][n][3]);
                    s += sw<16>(s); s = xsum32(s);
                    const float rstd = rsqrtf(s * (1.f / 64.f) + 1e-6f) * (WHICH ? 1.f : qs);
                    bf16* op = O + row * (WHICH ? 1024 : 768) + (4 * pn + wc) * (WHICH ? 128 : 96) + 8 * fq;
#pragma unroll
                    for (int bj = 0; bj < 2; ++bj) { const f32x4 g0 = *(const GAS f32x4*)(g + 32 * bj + 8 * fq), g1 = *(const GAS f32x4*)(g + 32 * bj + 8 * fq + 4);
                        const f32x4 a = v[bj][0] * rstd * g0, b = v[bj][1] * rstd * g1;
                        u32x4 w; w.x = cvtpk(a[0], a[1]); w.y = cvtpk(a[2], a[3]); w.z = cvtpk(b[0], b[1]); w.w = cvtpk(b[2], b[3]);
                        st16(op + 32 * bj, w); }
                } else if (WHICH == 1) {
                    bf16* op = O + row * 1024 + (4 * (pn - 2) + wc) * 128 + 64 + 8 * fq;
#pragma unroll
                    for (int bj = 0; bj < 2; ++bj) { u32x4 w; w.x = cvtpk(v[bj][0][0], v[bj][0][1]); w.y = cvtpk(v[bj][0][2], v[bj][0][3]); w.z = cvtpk(v[bj][1][0], v[bj][1][1]); w.w = cvtpk(v[bj][1][2], v[bj][1][3]);
                        st16(op + 32 * bj, w); }
                } else {
                    const f32x4 c0 = *(const GAS f32x4*)(CS + row * 16 + 8 * (fq & 1)), c1 = *(const GAS f32x4*)(CS + row * 16 + 8 * (fq & 1) + 4);
                    const f32x4 s0 = *(const GAS f32x4*)(SN + row * 16 + 8 * (fq & 1)), s1 = *(const GAS f32x4*)(SN + row * 16 + 8 * (fq & 1) + 4);
                    const f32x4 g0 = *(const GAS f32x4*)(g + 64 + 8 * fq), g1 = *(const GAS f32x4*)(g + 64 + 8 * fq + 4);
#pragma unroll
                    for (int bj = 0; bj < 2; ++bj) {
                        float s = (v[bj][0][0] * v[bj][0][0] + v[bj][0][1] * v[bj][0][1]) + (v[bj][0][2] * v[bj][0][2] + v[bj][0][3] * v[bj][0][3]) + (v[bj][1][0] * v[bj][1][0] + v[bj][1][1] * v[bj][1][1]) + (v[bj][1][2] * v[bj][1][2] + v[bj][1][3] * v[bj][1][3]);
                        s += sw<16>(s); s = xsum32(s);
                        const float rstd = rsqrtf(s * (1.f / 32.f) + 1e-6f) * qs;
                        const f32x4 a = v[bj][0] * rstd * g0, b = v[bj][1] * rstd * g1; f32x4 o0, o1;
#pragma unroll
                        for (int i = 0; i < 4; ++i) { const float p0 = xget32(a[i], fq >= 2), p1 = xget32(b[i], fq >= 2);
                            o0[i] = fq < 2 ? a[i] * c0[i] - p0 * s0[i] : a[i] * c0[i] + p0 * s0[i]; o1[i] = fq < 2 ? b[i] * c1[i] - p1 * s1[i] : b[i] * c1[i] + p1 * s1[i]; }
                        u32x4 w; w.x = cvtpk(o0[0], o0[1]); w.y = cvtpk(o0[2], o0[3]); w.z = cvtpk(o1[0], o1[1]); w.w = cvtpk(o1[2], o1[3]);
                        st16(O + row * 768 + (4 * bj + wc) * 96 + 64 + 8 * fq, w); }
                }
            }
    }
};
struct EpiG2Both {
    EpiG2<0> q; EpiG2<1> kv;
    __device__ __forceinline__ void operator()(const f32x4 (&acc)[2][2][4][2], const GUnit& u, int wr, int wc, int fr, int fq) const { if (u.i2) kv(acc, u, wr, wc, fr, fq); else q(acc, u, wr, wc, fr, fq); }
};
}
namespace fk {
typedef short v4i16_t __attribute__((ext_vector_type(4)));
typedef LAS const char* lds_cptr;
__device__ __forceinline__ float grp_sum(float s, int lanes) {
    if (lanes > 1) s += sw<1>(s); if (lanes > 2) s += sw<2>(s); if (lanes > 4) s += sw<4>(s);
    if (lanes > 8) s += sw<8>(s); if (lanes > 16) s += sw<16>(s); if (lanes > 32) s = xsum32(s);
    return s;
}
__device__ __forceinline__ void unpack8(const u32x4 w, float (&v)[8]) { v[0] = bf_lo(w.x); v[1] = bf_hi(w.x); v[2] = bf_lo(w.y); v[3] = bf_hi(w.y); v[4] = bf_lo(w.z); v[5] = bf_hi(w.z); v[6] = bf_lo(w.w); v[7] = bf_hi(w.w); }
__device__ __forceinline__ u32x4 pack8(const float (&v)[8]) { u32x4 w; w.x = cvtpk(v[0], v[1]); w.y = cvtpk(v[2], v[3]); w.z = cvtpk(v[4], v[5]); w.w = cvtpk(v[6], v[7]); return w; }
__device__ __forceinline__ void norm8(float (&v)[8], int lanes, float inv_width, const float* g, float mul) {
    float s = 0.f;
#pragma unroll
    for (int t = 0; t < 8; ++t) s += v[t] * v[t];
    const float rstd = rsqrtf(grp_sum(s, lanes) * inv_width + 1e-6f) * mul;
#pragma unroll
    for (int t = 0; t < 8; ++t) v[t] = v[t] * rstd * g[t];
}
__device__ __forceinline__ void rope8(float (&v)[8], int j, const float* cs, const float* sn) {
    const int i0 = 8 * (j & 1);
#pragma unroll
    for (int t = 0; t < 8; ++t) { const float o = sw<2>(v[t]); const float c = cs[i0 + t], s = sn[i0 + t]; v[t] = (j < 2) ? (v[t] * c - o * s) : (v[t] * c + o * s); }
}
__device__ __forceinline__ void prep1(Frame& F, const Params& p, int l) {
    bf16* Y1 = (bf16*)(F.ws + WS_Y1); bf16* KR = (bf16*)(F.ws + WS_KR); const float* CS = (const float*)(F.ws + WS_CS); const float* SN = (const float*)(F.ws + WS_SN);
    const float* gq = p.diff_qk_g + l * 128; const float* gk = gq + 64; const float* latg = p.mla_lat_g + l * 384; const float* kg = p.mla_qk_g + l * 192 + 96;
    const int ln = F.lane;
    const int seg = ln < 32 ? 0 : (ln < 48 ? 1 : (ln < 52 ? 2 : 3)); const int j3 = seg == 0 ? ln : (seg == 1 ? ln - 32 : ln - 48);
    const int off3 = seg == 0 ? 2560 + 8 * j3 : (seg == 1 ? 2816 + 8 * j3 : 2944 + 8 * (j3 & 3));
    const float* g3 = seg == 0 ? latg + 8 * j3 : (seg == 1 ? latg + 256 + 8 * j3 : kg + 64 + 8 * (j3 & 3));
    constexpr int R = 2;
    for (int m0 = F.gw; m0 < M; m0 += R * F.NGW) {
        u32x4 wq[R], wk[R], w3[R];
#pragma unroll
        for (int r = 0; r < R; ++r) { bf16* y = Y1 + (size_t)(m0 + r * F.NGW) * 3072; wq[r] = *(GAS u32x4*)(y + 8 * ln); wk[r] = *(GAS u32x4*)(y + 512 + 8 * ln); w3[r] = *(GAS u32x4*)(y + off3); }
#pragma unroll
        for (int r = 0; r < R; ++r) { const int m = m0 + r * F.NGW; bf16* y = Y1 + (size_t)m * 3072; float v[8];
            unpack8(wq[r], v); norm8(v, 8, 1.f / 64.f, gq + (8 * ln & 63), 0.125f * LOG2E); *(GAS u32x4*)(y + 8 * ln) = pack8(v);
            unpack8(wk[r], v); norm8(v, 8, 1.f / 64.f, gk + (8 * ln & 63), 1.f); *(GAS u32x4*)(y + 512 + 8 * ln) = pack8(v);
            unpack8(w3[r], v);
            float s = 0.f;
#pragma unroll
            for (int t = 0; t < 8; ++t) s += v[t] * v[t];
            s += sw<1>(s); s += sw<2>(s); const float s4 = s; s += sw<4>(s); s += sw<8>(s); const float s16 = s; s += sw<16>(s); const float s32 = s;
            const float rstd = seg == 0 ? rsqrtf(s32 * (1.f / 256.f) + 1e-6f) : (seg == 1 ? rsqrtf(s16 * (1.f / 128.f) + 1e-6f) : rsqrtf(s4 * (1.f / 32.f) + 1e-6f));
#pragma unroll
            for (int t = 0; t < 8; ++t) v[t] = v[t] * rstd * g3[t];
            if (seg <= 1) *(GAS u32x4*)(y + off3) = pack8(v);
            { float vr[8];
#pragma unroll
              for (int t = 0; t < 8; ++t) vr[t] = v[t];
              rope8(vr, j3 & 3, CS + (size_t)m * 16, SN + (size_t)m * 16);
              if (seg == 2) *(GAS u32x4*)(KR + (size_t)m * 32 + 8 * j3) = pack8(vr); }
        }
    }
}
__device__ __forceinline__ void prep2(Frame& F, const Params& p, int l) {
    bf16* QC = (bf16*)(F.ws + WS_QC); bf16* KVC = (bf16*)(F.ws + WS_KVC); const float* CS = (const float*)(F.ws + WS_CS); const float* SN = (const float*)(F.ws + WS_SN);
    const float* g0 = p.mla_qk_g + l * 192; const float* g1 = g0 + 96; const int ln = F.lane; const float qs = 0.10206207261596577f * LOG2E;
    constexpr int R = 2;
    const int qoff = (ln >> 3) * 96 + (ln & 7) * 8, roff = ((ln & 31) >> 2) * 96 + 64 + (ln & 3) * 8, koff = (ln >> 3) * 128 + (ln & 7) * 8;
    for (int m0 = F.gw; m0 < M; m0 += R * F.NGW) {
        u32x4 wq[R], wr[R], wk[R];
#pragma unroll
        for (int r = 0; r < R; ++r) { const size_t m = m0 + r * F.NGW; wq[r] = *(GAS u32x4*)(QC + m * 768 + qoff); wr[r] = *(GAS u32x4*)(QC + m * 768 + roff); wk[r] = *(GAS u32x4*)(KVC + m * 1024 + koff); }
#pragma unroll
        for (int r = 0; r < R; ++r) { const size_t m = m0 + r * F.NGW; float v[8];
            unpack8(wq[r], v); norm8(v, 8, 1.f / 64.f, g0 + (ln & 7) * 8, qs); *(GAS u32x4*)(QC + m * 768 + qoff) = pack8(v);
            unpack8(wr[r], v); norm8(v, 4, 1.f / 32.f, g0 + 64 + (ln & 3) * 8, qs); rope8(v, ln & 3, CS + m * 16, SN + m * 16); if (ln < 32) *(GAS u32x4*)(QC + m * 768 + roff) = pack8(v);
            unpack8(wk[r], v); norm8(v, 8, 1.f / 64.f, g1 + (ln & 7) * 8, 1.f); *(GAS u32x4*)(KVC + m * 1024 + koff) = pack8(v); }
    }
}

__device__ __forceinline__ int crow(int r, int hi) { return (r & 3) + 8 * (r >> 2) + 4 * hi; }
__device__ __forceinline__ s16x4 vtr(lds_cptr p) { return __builtin_bit_cast(s16x4, __builtin_amdgcn_ds_read_tr16_b64_v4i16((LAS v4i16_t*)p)); }
#define ATT_WAITV(n) asm volatile("s_waitcnt vmcnt(" #n ")" ::: "memory")
__device__ __forceinline__ void glds16(const void* gsrc, unsigned lds_dst) { unsigned keep;
    asm volatile("s_mov_b32 %0, m0\n\ts_mov_b32 m0, %2\n\ts_nop 0\n\tglobal_load_lds_dwordx4 %1, off\n\ts_mov_b32 m0, %0" : "=&s"(keep) : "v"(gsrc), "s"(lds_dst) : "memory"); }
template <bool DUAL>
__device__ __forceinline__ void attn_unit(Frame& F, const Params& p, int l, int b, int h, int qb) {
    constexpr int NQF = DUAL ? 4 : 6, NVB = DUAL ? 4 : 2, KP = DUAL ? 16 : 12, NP = DUAL ? 32 : 24, PP = NP / 8, SLOT = NP * 1024, NSLOT = 4;
    constexpr int QROWS = DUAL ? 128 : 256;
    int lane = F.lane; asm volatile("" : "+v"(lane));
    const int wid = F.wave, r32_ = lane & 31, hi_ = lane >> 5;
    const int wq = DUAL ? (wid & 3) : wid, map = DUAL ? (wid >> 2) : 0;
    const int q0 = qb * QROWS + wq * 32;
    const int cw = q0 >> 6, NT = ((qb * QROWS + QROWS) >> 6);
    const size_t tok0 = (size_t)b * S;
    LAS unsigned char* lds = F.lds; const unsigned lds0 = (unsigned)(uintptr_t)F.lds;
    LAS float* wsf = (LAS float*)(lds + TAB_OFF + 4096 + wid * 256);
    LAS float* tab = (LAS float*)(lds + TAB_OFF);
    const bf16* src[PP];
#pragma unroll
    for (int i = 0; i < PP; ++i) {
        const int x = wid * PP + i;
        if (DUAL) {
            const bf16* Y1 = (const bf16*)(F.ws + WS_Y1);
            if (x < KP) src[i] = Y1 + (tok0 + lane) * 3072 + 512 + h * 128 + (x >> 3) * 64 + (x & 7) * 8;
            else { const int v = x - KP; src[i] = Y1 + (tok0 + 16 * (v & 3) + (lane >> 2)) * 3072 + 1024 + h * 128 + (v >> 2) * 32 + (lane & 3) * 8; }
        } else {
            const bf16* KVC = (const bf16*)(F.ws + WS_KVC); const bf16* KR = (const bf16*)(F.ws + WS_KR);
            const int xx = x < 20 ? x : 0;
            if (xx < 8) src[i] = KVC + (tok0 + lane) * 1024 + h * 128 + xx * 8;
            else if (xx < 12) src[i] = KR + (tok0 + lane) * 32 + (xx - 8) * 8;
            else { const int v = xx - 12; src[i] = KVC + (tok0 + 16 * (v & 3) + (lane >> 2)) * 1024 + h * 128 + 64 + (v >> 2) * 32 + (lane & 3) * 8; }
        }
    }
    constexpr int TSTEP = DUAL ? 64 * 3072 : 0;
#define ATT_DMA(t, slot) do { _Pragma("unroll") for (int i_ = 0; i_ < PP; ++i_) { const int x_ = wid * PP + i_; \
        size_t step_; if (DUAL) step_ = (size_t)(t) * TSTEP; else { const int xx_ = x_ < 20 ? x_ : 0; step_ = (size_t)(t) * 64 * ((xx_ >= 8 && xx_ < 12) ? 32 : 1024); } \
        glds16(src[i_] + step_, (unsigned)__builtin_amdgcn_readfirstlane(lds0 + (unsigned)((slot) * SLOT + x_ * 1024))); } } while (0)
    bf16x8 qf[NQF];
    {
        const bf16* Qw = DUAL ? (const bf16*)(F.ws + WS_Y1) + (tok0 + q0 + r32_) * 3072 + h * 128 + map * 64 : (const bf16*)(F.ws + WS_QC) + (tok0 + q0 + r32_) * 768 + h * 96;
#pragma unroll
        for (int d0 = 0; d0 < NQF; ++d0) qf[d0] = *(const GAS bf16x8*)(Qw + d0 * 16 + hi_ * 8);
    }
    if (DUAL) { if (F.tid < 256) tab[F.tid] = ((const float*)(F.ws + WS_BT))[h * 256 + F.tid]; }
    VM_WAIT();
    ATT_DMA(0, 0); if (NT > 1) ATT_DMA(1, 1); if (NT > 2) ATT_DMA(2, 2);
    f32x16 o[NVB];
#pragma unroll
    for (int d = 0; d < NVB; ++d) o[d] = (f32x16){0.f, 0.f, 0.f, 0.f, 0.f, 0.f, 0.f, 0.f, 0.f, 0.f, 0.f, 0.f, 0.f, 0.f, 0.f, 0.f};
    float mrun = 0.f, lrun = 0.f;
    f32x16 negm = (f32x16){0.f, 0.f, 0.f, 0.f, 0.f, 0.f, 0.f, 0.f, 0.f, 0.f, 0.f, 0.f, 0.f, 0.f, 0.f, 0.f};
    const int vlane = ((lane >> 4) & 1) * 32 + (lane & 3) * 8 + (4 * hi_ + ((lane & 15) >> 2)) * 64;
    const int koff = (DUAL ? map * 8192 : 0) + hi_ * 1024 + r32_ * 16;
#define ATT_QK(P0, P1, slot) do { const lds_cptr kb_ = (lds_cptr)(lds + (slot) * SLOT + koff); \
        _Pragma("unroll") for (int d0 = 0; d0 < NQF; ++d0) { const bf16x8 k0_ = *(const LAS bf16x8*)(kb_ + d0 * 2048), k1_ = *(const LAS bf16x8*)(kb_ + d0 * 2048 + 512); \
            P0 = __builtin_amdgcn_mfma_f32_32x32x16_bf16(k0_, qf[d0], d0 == 0 ? negm : P0, 0, 0, 0); P1 = __builtin_amdgcn_mfma_f32_32x32x16_bf16(k1_, qf[d0], d0 == 0 ? negm : P1, 0, 0, 0); } } while (0)
    f32x16 p0, p1, n0, n1;
    p0 = negm; p1 = negm; n0 = negm; n1 = negm;
    if (NT > 2) { if (PP == 4) ATT_WAITV(8); else ATT_WAITV(6); } else if (NT > 1) { if (PP == 4) ATT_WAITV(4); else ATT_WAITV(3); } else ATT_WAITV(0);
    LDS_WAIT(); __builtin_amdgcn_s_barrier();
    ATT_QK(p0, p1, 0);
    for (int j = 0; j < NT; ++j) {
        const int sl = j & 3;
        if (j + 1 < NT) {
            if (j + 2 < NT) { if (PP == 4) ATT_WAITV(4); else ATT_WAITV(3); } else ATT_WAITV(0);
            LDS_WAIT(); __builtin_amdgcn_s_barrier();
            if (j + 3 < NT) ATT_DMA(j + 3, (j + 3) & 3);
        }
        if (j <= cw) {
            const bool nxt = (j + 1 <= cw);
            if (nxt) ATT_QK(n0, n1, (j + 1) & 3);
            if (DUAL) { if (j >= cw - 2) { const int base = 64 * j - (q0 + r32_) + 191 + 4 * hi_;
#pragma unroll
                for (int r = 0; r < 16; ++r) { const int kk = (r & 3) + 8 * (r >> 2); p0[r] += tab[base + kk]; p1[r] += tab[base + kk + 32]; } } }
            float ma = __builtin_fmaxf(__builtin_fmaxf(p0[0], p0[1]), p1[0]), mb = __builtin_fmaxf(__builtin_fmaxf(p0[2], p0[3]), p1[1]); ma = __builtin_fmaxf(__builtin_fmaxf(ma, p1[2]), p1[3]);
#pragma unroll
            for (int r = 4; r < 16; r += 4) { ma = __builtin_fmaxf(__builtin_fmaxf(ma, p0[r]), p0[r + 1]); mb = __builtin_fmaxf(__builtin_fmaxf(mb, p0[r + 2]), p0[r + 3]);
                ma = __builtin_fmaxf(__builtin_fmaxf(ma, p1[r]), p1[r + 1]); mb = __builtin_fmaxf(__builtin_fmaxf(mb, p1[r + 2]), p1[r + 3]); }
            float mx = __builtin_fmaxf(ma, mb); mx = xmax32(mx);
            if (__builtin_expect(__any(mx > 8.f), 0)) {
                const float dl = __builtin_fmaxf(mx, 0.f), f = __builtin_amdgcn_exp2f(-dl); mrun += dl; lrun *= f;
#pragma unroll
                for (int r = 0; r < 16; ++r) { p0[r] -= dl; p1[r] -= dl; n0[r] -= dl; n1[r] -= dl; negm[r] = -mrun; }
                if (hi_ == 0) wsf[r32_] = f;
                LDS_WAIT();
#pragma unroll
                for (int r = 0; r < 16; ++r) { const float fr_ = wsf[crow(r, hi_)];
#pragma unroll
                    for (int d = 0; d < NVB; ++d) o[d][r] *= fr_; }
            }
            float ls = 0.f;
#pragma unroll
            for (int r = 0; r < 16; ++r) { p0[r] = __builtin_amdgcn_exp2f(p0[r]); p1[r] = __builtin_amdgcn_exp2f(p1[r]); ls += p0[r] + p1[r]; }
            lrun += ls;
            u32x4 pw0, pw1, pw2, pw3;
            pw0 = (u32x4){cvtpk(p0[0], p0[1]), cvtpk(p0[2], p0[3]), cvtpk(p0[4], p0[5]), cvtpk(p0[6], p0[7])};
            pw1 = (u32x4){cvtpk(p0[8], p0[9]), cvtpk(p0[10], p0[11]), cvtpk(p0[12], p0[13]), cvtpk(p0[14], p0[15])};
            pw2 = (u32x4){cvtpk(p1[0], p1[1]), cvtpk(p1[2], p1[3]), cvtpk(p1[4], p1[5]), cvtpk(p1[6], p1[7])};
            pw3 = (u32x4){cvtpk(p1[8], p1[9]), cvtpk(p1[10], p1[11]), cvtpk(p1[12], p1[13]), cvtpk(p1[14], p1[15])};
            const bf16x8 pa0 = __builtin_bit_cast(bf16x8, pw0), pa1 = __builtin_bit_cast(bf16x8, pw1), pa2 = __builtin_bit_cast(bf16x8, pw2), pa3 = __builtin_bit_cast(bf16x8, pw3);
            const lds_cptr vb = (lds_cptr)(lds + sl * SLOT + KP * 1024 + vlane);
            s16x4 vf[2][8];
#pragma unroll
            for (int ks = 0; ks < 4; ++ks) { vf[0][2 * ks] = vtr(vb + ks * 1024); vf[0][2 * ks + 1] = vtr(vb + ks * 1024 + 512); }
#pragma unroll
            for (int d = 0; d < NVB; ++d) {
                if (d + 1 < NVB) {
#pragma unroll
                    for (int ks = 0; ks < 4; ++ks) { vf[(d + 1) & 1][2 * ks] = vtr(vb + (d + 1) * 4096 + ks * 1024); vf[(d + 1) & 1][2 * ks + 1] = vtr(vb + (d + 1) * 4096 + ks * 1024 + 512); }
                }
#define ATT_PK(k) (bf16x8){vf[d & 1][2 * (k)][0], vf[d & 1][2 * (k)][1], vf[d & 1][2 * (k)][2], vf[d & 1][2 * (k)][3], vf[d & 1][2 * (k) + 1][0], vf[d & 1][2 * (k) + 1][1], vf[d & 1][2 * (k) + 1][2], vf[d & 1][2 * (k) + 1][3]}
                o[d] = __builtin_amdgcn_mfma_f32_32x32x16_bf16(pa0, ATT_PK(0), o[d], 0, 0, 0);
                o[d] = __builtin_amdgcn_mfma_f32_32x32x16_bf16(pa1, ATT_PK(1), o[d], 0, 0, 0);
                o[d] = __builtin_amdgcn_mfma_f32_32x32x16_bf16(pa2, ATT_PK(2), o[d], 0, 0, 0);
                o[d] = __builtin_amdgcn_mfma_f32_32x32x16_bf16(pa3, ATT_PK(3), o[d], 0, 0, 0);
#undef ATT_PK
                __builtin_amdgcn_sched_barrier(0);
            }
            p0 = n0; p1 = n1;
        }
    }
#undef ATT_QK
    int r32 = r32_, hi = hi_; asm volatile("" : "+v"(r32), "+v"(hi));
    lrun = xsum32(lrun);
    if (hi == 0) wsf[32 + r32] = __builtin_amdgcn_rcpf(lrun);
    LDS_WAIT();
    float rli[16];
#pragma unroll
    for (int r = 0; r < 16; ++r) rli[r] = wsf[32 + crow(r, hi)];
    __builtin_amdgcn_s_barrier();
    if (DUAL) {
        LAS float* stg = (LAS float*)(lds) + (size_t)wq * 32 * 132;
        if (map == 1) {
#pragma unroll
            for (int d = 0; d < NVB; ++d)
#pragma unroll
                for (int r = 0; r < 16; ++r) stg[crow(r, hi) * 132 + d * 32 + r32] = o[d][r] * rli[r];
        }
        LDS_WAIT(); __builtin_amdgcn_s_barrier();
        if (map == 0) {
            const float lam = ((const float*)(F.ws + WS_LAM))[l]; const float li = 1.f - (0.8f - 0.6f * __expf(-0.3f * (float)l));
            float ss[16];
#pragma unroll
            for (int r = 0; r < 16; ++r) { float s = 0.f;
#pragma unroll
                for (int d = 0; d < NVB; ++d) { const float v = o[d][r] * rli[r] - lam * stg[crow(r, hi) * 132 + d * 32 + r32]; o[d][r] = v; s += v * v; }
                ss[r] = s; }
#pragma unroll
            for (int r = 0; r < 16; ++r) { float s = ss[r]; s += sw<1>(s); s += sw<2>(s); s += sw<4>(s); s += sw<8>(s); s += sw<16>(s); ss[r] = rsqrtf(s * (1.f / 128.f) + 1e-6f) * li; }
            const float* og = p.diff_out_g + l * 128; bf16* OA = (bf16*)(F.ws + WS_OA) + (tok0 + q0) * 512 + h * 128;
            LAS bf16* st2 = (LAS bf16*)(lds + 69632) + wq * (32 * 136);
#pragma unroll
            for (int d = 0; d < NVB; ++d) { const float gg = og[d * 32 + r32];
#pragma unroll
                for (int r = 0; r < 16; ++r) st2[crow(r, hi) * 136 + d * 32 + r32] = (bf16)(cvtpk(o[d][r] * ss[r] * gg, 0.f) & 0xffffu); }
            LDS_WAIT();
#pragma unroll
            for (int i = 0; i < 8; ++i) { const int row = i * 4 + (lane >> 4), ch = lane & 15; const u32x4 v = *(const LAS u32x4*)(st2 + row * 136 + ch * 8); st16x(OA + (size_t)row * 512 + ch * 8, v); }
        }
    } else {
        LAS bf16* stg = (LAS bf16*)(lds) + wid * 2048;
#pragma unroll
        for (int r = 0; r < 16; ++r) { const int orow = crow(r, hi);
#pragma unroll
            for (int d = 0; d < NVB; ++d) stg[orow * 64 + d * 32 + r32] = (bf16)(cvtpk(o[d][r] * rli[r], 0.f) & 0xffffu); }
        LDS_WAIT();
        bf16* Ow = (bf16*)(F.ws + WS_OC) + (tok0 + q0) * 512 + h * 64;
#pragma unroll
        for (int i = 0; i < 4; ++i) { const int row = i * 8 + (lane >> 3), ch = lane & 7; const u32x4 v = *(const LAS u32x4*)(stg + row * 64 + ch * 8); st16x(Ow + (size_t)row * 512 + ch * 8, v); }
    }
    LDS_WAIT(); VM_WAIT(); __builtin_amdgcn_s_barrier();
#undef ATT_DMA
}
template <bool DUAL>
__device__ __forceinline__ void attn_phase(Frame& F, const Params& p, int l) {
    const int vcu = (F.G % 8 == 0) ? (F.bid % 8) * (F.G / 8) + F.bid / 8 : F.bid;
    if (DUAL) { for (int v = vcu; v < 256; v += F.G) { const int bh = v >> 3, s = v & 7; attn_unit<true>(F, p, l, bh >> 2, bh & 3, s); attn_unit<true>(F, p, l, bh >> 2, bh & 3, 15 - s); } }
    else { for (int v = vcu; v < 256; v += F.G) { const int bh = v >> 2, s = v & 3; attn_unit<false>(F, p, l, bh >> 3, bh & 7, s); attn_unit<false>(F, p, l, bh >> 3, bh & 7, 7 - s); } }
}
}
namespace fk {
__device__ __forceinline__ void sgu_unit(Frame& F, const Params& p, int l, int unit) {
    const int g = unit & 3, bn = unit >> 2; const size_t m0 = (size_t)bn * 128;
    int lane = threadIdx.x & 63; asm volatile("" : "+v"(lane));
    const int wid = F.wave, r32 = lane & 31, hi = lane >> 5; const int tid_ = wid * 64 + lane;
    LAS unsigned char* lds = F.lds; LAS unsigned char* Wt = lds; LAS unsigned char* Vt = lds + 32768;
    const bf16* Y1 = (const bf16*)(F.ws + WS_Y1);
    const int rsub = lane >> 4, ch16 = lane & 15;
    u32x4 w4[4]; f32x4 sa[4], sb[4];
    const float* ST2 = (const float*)(F.ws + WS_STAT2);
#pragma unroll
    for (int it = 0; it < 4; ++it) { const size_t row = m0 + wid * 16 + it * 4 + rsub;
        w4[it] = *(const GAS u32x4*)(Y1 + row * 3072 + 2048 + g * 128 + ch16 * 8); sa[it] = *(const GAS f32x4*)(ST2 + row * 8); sb[it] = *(const GAS f32x4*)(ST2 + row * 8 + 4); }
    const float* Wg = p.sgu_w + ((size_t)l * 4 + g) * 128 * 128;
    f32x4 wa[4], wb[4];
#pragma unroll
    for (int k = 0; k < 4; ++k) { const int item = tid_ + 512 * k, i = item & 127, cidx = item >> 7, ks = cidx >> 1, h2 = cidx & 1;
        wa[k] = *(const GAS f32x4*)(Wg + (size_t)i * 128 + 16 * ks + 4 * h2); wb[k] = *(const GAS f32x4*)(Wg + (size_t)i * 128 + 16 * ks + 8 + 4 * h2); }
    const float* vg = p.sgu_v_g + l * 512 + g * 128 + ch16 * 8;
    float vgv[8];
#pragma unroll
    for (int t = 0; t < 8; ++t) vgv[t] = vg[t];
#pragma unroll
    for (int it = 0; it < 4; ++it) {
        const int j = wid * 16 + it * 4 + rsub; float v[8]; unpack8(w4[it], v);
        const float rstd = rsqrtf((((sa[it][0] + sa[it][1]) + (sa[it][2] + sa[it][3])) + ((sb[it][0] + sb[it][1]) + (sb[it][2] + sb[it][3]))) * (1.f / 512.f) + 1e-6f);
#pragma unroll
        for (int t = 0; t < 8; ++t) v[t] = gelu_tanh(v[t]) * rstd * vgv[t];
        *(LAS u32x4*)(Vt + ((ch16 >> 2) * 8 + (j >> 4)) * 1024 + (j & 15) * 64 + (ch16 & 3) * 16) = pack8(v);
    }
#pragma unroll
    for (int k = 0; k < 4; ++k) {
        const int item = tid_ + 512 * k, i = item & 127, cidx = item >> 7, ks = cidx >> 1;
        const bool ok = (ks >> 2) <= (i >> 6);
        u32x4 w; w.x = ok ? cvtpk(wa[k].x, wa[k].y) : 0u; w.y = ok ? cvtpk(wa[k].z, wa[k].w) : 0u; w.z = ok ? cvtpk(wb[k].x, wb[k].y) : 0u; w.w = ok ? cvtpk(wb[k].z, wb[k].w) : 0u;
        *(LAS u32x4*)(Wt + cidx * 2048 + i * 16) = w;
    }
    const int ib = wid & 3, ch = wid >> 2;
    bf16 uraw[2][16];
#pragma unroll
    for (int dd = 0; dd < 2; ++dd)
#pragma unroll
        for (int r = 0; r < 16; ++r) uraw[dd][r] = Y1[(m0 + 32 * ib + crow(r, hi)) * 3072 + 1536 + 128 * g + 32 * (2 * ch + dd) + r32];
    __syncthreads();
    f32x16 acc[2];
    acc[0] = (f32x16){0.f, 0.f, 0.f, 0.f, 0.f, 0.f, 0.f, 0.f, 0.f, 0.f, 0.f, 0.f, 0.f, 0.f, 0.f, 0.f}; acc[1] = acc[0];
    const int vlane = ((lane >> 4) & 1) * 32 + (lane & 3) * 8 + (4 * hi + ((lane & 15) >> 2)) * 64;
#pragma unroll
    for (int ks = 0; ks < 8; ++ks) {
        const bf16x8 a = *(const LAS bf16x8*)(Wt + (2 * ks + hi) * 2048 + (32 * ib + r32) * 16);
#pragma unroll
        for (int dd = 0; dd < 2; ++dd) { const lds_cptr vb = (lds_cptr)(Vt + (2 * ch + dd) * 8192 + ks * 1024 + vlane);
            const s16x4 lo = vtr(vb), hh = vtr(vb + 512);
            acc[dd] = __builtin_amdgcn_mfma_f32_32x32x16_bf16(a, (bf16x8){lo[0], lo[1], lo[2], lo[3], hh[0], hh[1], hh[2], hh[3]}, acc[dd], 0, 0, 0); }
    }
    const float* bs = p.sgu_b + l * 512 + g * 128; bf16* OB = (bf16*)(F.ws + WS_OB);
#pragma unroll
    for (int dd = 0; dd < 2; ++dd)
#pragma unroll
        for (int r = 0; r < 16; ++r) { const int i = 32 * ib + crow(r, hi), c = 128 * g + 32 * (2 * ch + dd) + r32;
            const float u = gelu_tanh(bf2f(uraw[dd][r]));
            OB[(m0 + i) * 512 + c] = (bf16)(cvtpk(u * (acc[dd][r] + bs[i]), 0.f) & 0xffffu); }
    __syncthreads();
}

struct SchedG3 {
    static constexpr bool GATHER = false; static constexpr bool HALFM = false; static constexpr bool ACCUM = true;
    __device__ __forceinline__ void a_ready(const GUnit&) const {}
    __device__ __forceinline__ void done(const GUnit&) const {}
    __device__ __forceinline__ bool keep_acc(const GUnit& u) const { return u.i2 < 2; }
    const char* OA; const char* WBR; int G, c;
    __device__ __forceinline__ bool next(int i, GUnit& u) const {
        const int tile = (i / 3) * G + c, n = i % 3; if (tile >= 256) return false;
        const int vt = (tile % 8) * 32 + tile / 8;
        const int pm = vt >> 2, pn = vt & 3;
        u.A = OA + (size_t)n * 16 * MiB + (size_t)pm * 256 * 1024; u.B = WBR + (size_t)n * MiB + (size_t)pn * 256 * 1024; u.nt = 8; u.i0 = pm; u.i1 = pn; u.i2 = n; return true;
    }
    __device__ __forceinline__ void offs(const GUnit&, int R0, int R1, int C0, int C1, unsigned (&oA)[2][2]) const {
        oA[0][0] = (unsigned)R0 * 1024u + C0 * 2u; oA[0][1] = (unsigned)R1 * 1024u + C1 * 2u; oA[1][0] = (unsigned)(R0 + 128) * 1024u + C0 * 2u; oA[1][1] = (unsigned)(R1 + 128) * 1024u + C1 * 2u; }
    __device__ __forceinline__ unsigned ldb_bytes() const { return 1024u; }
};
struct EpiG3 {
    const bf16* XG; bf16* MG;
    __device__ __forceinline__ void operator()(f32x4 (&acc)[2][2][4][2], const GUnit& u, int wr, int wc, int fr, int fq) const {
        const int n = u.i2; const int row0 = u.i0 * 256 + wr * 64 + fr, col0 = u.i1 * 256 + wc * 32 + 8 * fq; const unsigned char* G8 = (const unsigned char*)XG;
#pragma unroll
        for (int ai = 0; ai < 2; ++ai)
#pragma unroll
            for (int m = 0; m < 4; ++m) { const size_t row = row0 + ai * 128 + m * 16;
#pragma unroll
                for (int bj = 0; bj < 2; ++bj) { const int col = col0 + bj * 128;
                    const u32x2 ga = *(const GAS u32x2*)(G8 + row * 3072 + n * 1024 + col);
                    if (n < 2) {
                        const u32x2 gb = *(const GAS u32x2*)(G8 + row * 3072 + (n + 1) * 1024 + col);
#pragma unroll
                        for (int t = 0; t < 8; ++t) { const unsigned qa = ((t < 4 ? ga.x : ga.y) >> (8 * (t & 3))) & 255u, qb = ((t < 4 ? gb.x : gb.y) >> (8 * (t & 3))) & 255u;
                            const float r = (float)qa * __builtin_amdgcn_rcpf((float)qb); if (t < 4) acc[ai][bj][m][0][t & 3] *= r; else acc[ai][bj][m][1][t & 3] *= r; }
                    } else {
                        float o[8];
#pragma unroll
                        for (int t = 0; t < 8; ++t) { const unsigned qa = ((t < 4 ? ga.x : ga.y) >> (8 * (t & 3))) & 255u; const float a = t < 4 ? acc[ai][bj][m][0][t & 3] : acc[ai][bj][m][1][t & 3]; o[t] = a * ((float)qa * (1.f / 255.f)); }
                        *(GAS u32x4*)(MG + row * 1024 + col) = pack8(o); } } }
    }
};
template <bool F32IN>
struct EpiG4 {
    bf16* X; const float* gate; const float* Xin;
    __device__ __forceinline__ void operator()(const f32x4 (&acc)[2][2][4][2], const GUnit& u, int wr, int wc, int fr, int fq) const {
        const int row0 = u.i0 * 256 + wr * 64 + fr, col0 = u.i1 * 256 + wc * 32 + 8 * fq; const int b = (u.i0 * 256) / S;
#pragma unroll
        for (int bj = 0; bj < 2; ++bj) { const int col = col0 + bj * 128;
            const f32x4 g0 = *(const GAS f32x4*)(gate + (size_t)b * 6 * D + col), g1 = *(const GAS f32x4*)(gate + (size_t)b * 6 * D + col + 4);
#pragma unroll
            for (int ai = 0; ai < 2; ++ai)
#pragma unroll
                for (int m = 0; m < 4; ++m) { const size_t off = (size_t)(row0 + ai * 128 + m * 16) * D + col;
                    f32x4 x0, x1;
                    if (F32IN) { x0 = *(const GAS f32x4*)(Xin + off); x1 = *(const GAS f32x4*)(Xin + off + 4); }
                    else { float xv[8]; unpack8(*(const GAS u32x4*)(X + off), xv); x0 = (f32x4){xv[0], xv[1], xv[2], xv[3]}; x1 = (f32x4){xv[4], xv[5], xv[6], xv[7]}; }
                    x0 += g0 * acc[ai][bj][m][0]; x1 += g1 * acc[ai][bj][m][1];
                    u32x4 w; w.x = cvtpk(x0[0], x0[1]); w.y = cvtpk(x0[2], x0[3]); w.z = cvtpk(x1[0], x1[1]); w.w = cvtpk(x1[2], x1[3]);
                    *(GAS u32x4*)(X + off) = w; } }
    }
};
struct SchedG2 {
    static constexpr bool GATHER = false; static constexpr bool HALFM = false; static constexpr bool ACCUM = false;
    __device__ __forceinline__ void a_ready(const GUnit&) const {}
    __device__ __forceinline__ void done(const GUnit&) const {}
    const char* Y1; const char* WUQ; const char* WUKV; int G, c;
    __device__ __forceinline__ bool next(int i, GUnit& u) const {
        const int un = (c >> 3) + 32 * i; if (un >= 56) return false;
        const int pm = (c & 7) * 8 + un / 7, ct = un % 7; const bool kv = ct >= 3; const int pn = kv ? ct - 3 : ct;
        u.A = Y1 + (size_t)pm * 256 * 6144 + (kv ? 2816 * 2 : 2560 * 2); u.B = (kv ? WUKV : WUQ) + (size_t)pn * 256 * 512; u.nt = 4; u.i0 = pm; u.i1 = pn; u.i2 = kv ? 1 : 0; return true;
    }
    __device__ __forceinline__ void offs(const GUnit&, int R0, int R1, int C0, int C1, unsigned (&oA)[2][2]) const {
        oA[0][0] = (unsigned)R0 * 6144u + C0 * 2u; oA[0][1] = (unsigned)R1 * 6144u + C1 * 2u; oA[1][0] = (unsigned)(R0 + 128) * 6144u + C0 * 2u; oA[1][1] = (unsigned)(R1 + 128) * 6144u + C1 * 2u; }
    __device__ __forceinline__ unsigned ldb_bytes() const { return 512u; }
};
}
namespace fk {
constexpr int HT_PITCH = 2064;
constexpr int RT_SMALL = 64 * HT_PITCH;
__device__ __forceinline__ void row_router(Frame& F, const Params& p, int l, const float* mod) {
    unsigned char* ws = F.ws; LAS unsigned char* HT = F.lds;
    const bf16* X = (const bf16*)(ws + WS_X); bf16* H = (bf16*)(ws + WS_H);
    const float* g = p.norm_g + (size_t)l * 2 * D + D; const float* shift = mod + 3 * D; const float* scale = mod + 4 * D;
    const float* bg = p.router_g_b + l * 4; const float* be = p.router_e_b + l * 32;
    unsigned* CNT = (unsigned*)(ws + WS_CTL) + CW_CNT + l * 32;
    int* LIST = (int*)(ws + WS_LIST); float* ROWW = (float*)(ws + WS_ROWW); int* TOKSLOT = (int*)(ws + WS_TOKSLOT);
    LAS int* rid = (LAS int*)(F.lds + RT_SMALL); LAS int* rrank = rid + 128; LAS float* rw = (LAS float*)(rrank + 128);
    LAS unsigned* cntl = (LAS unsigned*)(rw + 128); LAS unsigned* cbase = cntl + 32;
    if (F.tid < 32) cntl[F.tid] = 0u;
    constexpr int R = 2;
    const int mb = (F.bid & 7) * 2048 + (F.bid >> 3) * 64;
    for (int kk = 0; kk < 8; kk += R) { const int m0 = mb + kk * 8 + F.wave;
        f32x4 v[R][4];
#pragma unroll
        for (int r = 0; r < R; ++r)
#pragma unroll
            for (int j = 0; j < 4; ++j) { const u32x2 xb = *(const GAS u32x2*)(X + (size_t)(m0 + 8 * r) * D + 4 * F.lane + 256 * j); v[r][j] = (f32x4){bf_lo(xb.x), bf_hi(xb.x), bf_lo(xb.y), bf_hi(xb.y)}; }
#pragma unroll
        for (int r = 0; r < R; ++r) { const int m = m0 + 8 * r, b = m / S; float s = 0.f;
#pragma unroll
            for (int j = 0; j < 4; ++j) s += (v[r][j].x * v[r][j].x + v[r][j].y * v[r][j].y) + (v[r][j].z * v[r][j].z + v[r][j].w * v[r][j].w);
            const float rstd = rsqrtf(wave_sum(s) * (1.f / D) + 1e-6f);
            LAS unsigned char* hrow = HT + ((kk + r) * 8 + F.wave) * HT_PITCH;
#pragma unroll
            for (int j = 0; j < 4; ++j) { const int d = 4 * F.lane + 256 * j;
                const f32x4 gg = *(const GAS f32x4*)(g + d), sc = *(const GAS f32x4*)(scale + (size_t)b * 6 * D + d), sh = *(const GAS f32x4*)(shift + (size_t)b * 6 * D + d);
                const float o0 = v[r][j].x * rstd * gg.x * (1.f + sc.x) + sh.x, o1 = v[r][j].y * rstd * gg.y * (1.f + sc.y) + sh.y, o2 = v[r][j].z * rstd * gg.z * (1.f + sc.z) + sh.z, o3 = v[r][j].w * rstd * gg.w * (1.f + sc.w) + sh.w;
                u32x2 o; o.x = cvtpk(o0, o1); o.y = cvtpk(o2, o3); st8x(H + (size_t)m * D + d, o); *(LAS u32x2*)(hrow + d * 2) = o; }
        }
    }
    __syncthreads();
    const int tt = F.wave & 3, kh = F.wave >> 2, n16 = F.lane & 15, kq = F.lane >> 4;
    const bf16* WRT = (const bf16*)(ws + WS_WRT) + (size_t)l * 48 * 1024;
    f32x4 acc[3];
#pragma unroll
    for (int bl = 0; bl < 3; ++bl) acc[bl] = (f32x4){0.f, 0.f, 0.f, 0.f};
    const LAS unsigned char* hb = HT + (16 * tt + n16) * HT_PITCH + (512 * kh + 8 * kq) * 2;
    const bf16* wb = WRT + (size_t)n16 * 1024 + 512 * kh + 8 * kq;
#pragma unroll 4
    for (int ks = 0; ks < 16; ++ks) {
        const bf16x8 bfr = *(const LAS bf16x8*)(hb + ks * 64);
#pragma unroll
        for (int bl = 0; bl < 3; ++bl) { const bf16x8 afr = *(const GAS bf16x8*)(wb + (size_t)bl * 16 * 1024 + ks * 32);
            acc[bl] = __builtin_amdgcn_mfma_f32_16x16x32_bf16(afr, bfr, acc[bl], 0, 0, 0); }
    }
    __syncthreads();
    LAS float* LGP = (LAS float*)(F.lds);
    LAS float* LG = (LAS float*)(F.lds + 16384);
    if (kh == 1) {
#pragma unroll
        for (int bl = 0; bl < 3; ++bl)
#pragma unroll
            for (int q = 0; q < 4; ++q) LGP[((tt * 3 + bl) * 4 + q) * 64 + F.lane] = acc[bl][q];
    }
    __syncthreads();
    if (kh == 0) {
#pragma unroll
        for (int bl = 0; bl < 3; ++bl)
#pragma unroll
            for (int q = 0; q < 4; ++q) LG[(16 * tt + n16) * 48 + bl * 16 + 4 * kq + q] = acc[bl][q] + LGP[((tt * 3 + bl) * 4 + q) * 64 + F.lane];
    }
    __syncthreads();
    if (F.tid < 64) {
        const int slot = F.tid; const LAS float* lg = LG + slot * 48;
        const float g0 = lg[32] + bg[0], g1 = lg[33] + bg[1], g2 = lg[34] + bg[2], g3 = lg[35] + bg[3];
        int gi = 0; float mx = g0; if (g1 > mx) { mx = g1; gi = 1; } if (g2 > mx) { mx = g2; gi = 2; } if (g3 > mx) { mx = g3; gi = 3; }
        const float gw = 1.f / (__expf(g0 - mx) + __expf(g1 - mx) + __expf(g2 - mx) + __expf(g3 - mx));
        float e[8];
#pragma unroll
        for (int i = 0; i < 8; ++i) e[i] = lg[gi * 8 + i] + be[gi * 8 + i];
        float emx = e[0]; int e0 = 0;
#pragma unroll
        for (int i = 1; i < 8; ++i) if (e[i] > emx) { emx = e[i]; e0 = i; }
        float e2 = -1e30f; int e1 = 0;
#pragma unroll
        for (int i = 0; i < 8; ++i) if (i != e0 && e[i] > e2) { e2 = e[i]; e1 = i; }
        const float p1 = __expf(e2 - emx), w0 = 1.f / (1.f + p1), w1 = p1 / (1.f + p1);
        const int id0 = gi * 8 + e0, id1 = gi * 8 + e1;
        rid[2 * slot] = id0; rid[2 * slot + 1] = id1; rw[2 * slot] = gw * w0; rw[2 * slot + 1] = gw * w1;
        rrank[2 * slot] = (int)__hip_atomic_fetch_add(&cntl[id0], 1u, __ATOMIC_RELAXED, __HIP_MEMORY_SCOPE_WORKGROUP);
        rrank[2 * slot + 1] = (int)__hip_atomic_fetch_add(&cntl[id1], 1u, __ATOMIC_RELAXED, __HIP_MEMORY_SCOPE_WORKGROUP);
    }
    __syncthreads();
    if (F.tid < 32) { const unsigned c = cntl[F.tid]; cbase[F.tid] = c ? atomicAdd(&CNT[F.tid], c) : 0u; }
    __syncthreads();
    if (F.tid < 128) { const int slot = F.tid >> 1, id = rid[F.tid], pos = (int)cbase[id] + rrank[F.tid]; const int m = mb + slot;
        LIST[id * 16384 + pos] = m; ROWW[id * 16384 + pos] = rw[F.tid]; TOKSLOT[id * 16384 + pos] = 2 * m + (F.tid & 1); }
}
__device__ __forceinline__ void moe_table(Frame& F, int l) {
    LAS int* T = (LAS int*)(F.lds + TAB_OFF + 6144);
    int t = threadIdx.x; asm volatile("" : "+v"(t));
    if (t < 32) { const unsigned* CNT = (const unsigned*)(F.ws + WS_CTL) + CW_CNT + l * 32;
        T[t] = (int)__hip_atomic_load(CNT + t, __ATOMIC_RELAXED, __HIP_MEMORY_SCOPE_AGENT); }
    __syncthreads();
    if (t < 33) { int a = 0; for (int e = 0; e < t; ++e) a += (T[e] + 255) >> 8; T[32 + t] = a; }
    __syncthreads();
    if (t < 64) {
        const int e = t & 31, pass = t >> 5; const int c = T[e], nt_ = (c + 255) >> 8; int nhalf_before = 0, nfull_before = 0, nfull_total = 0;
        for (int k = 0; k < 32; ++k) { const int ck = T[k], ntk = (ck + 255) >> 8; const int lastrows = ck - 256 * (ntk - 1); const int hk = (ntk > 0 && lastrows <= 128) ? 1 : 0;
            nfull_total += ntk - hk; if (k < e) { nfull_before += ntk - hk; nhalf_before += hk; } }
        const int lastrows = c - 256 * (nt_ - 1); const int he = (nt_ > 0 && lastrows <= 128) ? 1 : 0;
        if (pass == 0) { for (int m = 0; m < nt_ - he; ++m) T[72 + nfull_before + m] = (e << 16) | (m << 1); }
        else if (he) T[72 + nfull_total + nhalf_before] = (e << 16) | ((nt_ - 1) << 1) | 1;
    }
    __syncthreads();
}
struct SchedG5 {
    static constexpr bool GATHER = true; static constexpr bool HALFM = true; static constexpr bool ACCUM = false;
    const char* H; const char* WGU; const int* LIST; LAS const int* T; int G, c; unsigned* RDY;
    __device__ __forceinline__ void a_ready(const GUnit&) const {}
    __device__ __forceinline__ void done(const GUnit& u) const { asm volatile("s_waitcnt vmcnt(0)" ::: "memory"); if ((threadIdx.x & 63) == 0) __hip_atomic_fetch_add(RDY + u.i3, 1u, __ATOMIC_RELAXED, __HIP_MEMORY_SCOPE_AGENT); }
    __device__ __forceinline__ bool next(int i, GUnit& u) const {
        const int L = i * G + c; const int tot = __builtin_amdgcn_readfirstlane(T[64]); if (L >= 2 * tot) return false;
        const int ent = __builtin_amdgcn_readfirstlane(T[72 + (L >> 1)]), ntile = L & 1; const int e = ent >> 16, mt = (ent >> 1) & 0x7fff;
        const int tpe = __builtin_amdgcn_readfirstlane(T[32 + e]);
        u.A = H; u.B = WGU + ((size_t)e * 512 + ntile * 256) * 2048; u.nt = 16; u.i0 = e; u.i1 = mt; u.i2 = ntile; u.i3 = tpe + mt; u.hm = ent & 1; return true;
    }
    __device__ __forceinline__ void offs(const GUnit& u, int R0, int R1, int C0, int C1, unsigned (&oA)[2][2]) const {
        const int cnt = __builtin_amdgcn_readfirstlane(T[u.i0]); const int* li = LIST + u.i0 * 16384; const int base = u.i1 * 256;
        const int a0 = base + R0, a1 = base + R1, a2 = base + R0 + 128, a3 = base + R1 + 128;
        const int t0 = a0 < cnt ? li[a0] : 0, t1 = a1 < cnt ? li[a1] : 0, t2 = a2 < cnt ? li[a2] : 0, t3 = a3 < cnt ? li[a3] : 0;
        oA[0][0] = (unsigned)t0 * 2048u + C0 * 2u; oA[0][1] = (unsigned)t1 * 2048u + C1 * 2u; oA[1][0] = (unsigned)t2 * 2048u + C0 * 2u; oA[1][1] = (unsigned)t3 * 2048u + C1 * 2u; }
    __device__ __forceinline__ unsigned ldb_bytes() const { return 2048u; }
};
struct EpiG5 {
    bf16* ACT; const float* ROWW; LAS const int* T;
    __device__ __forceinline__ void operator()(const f32x4 (&acc)[2][2][4][2], const GUnit& u, int wr, int wc, int fr, int fq) const {
        const int e = u.i0, cnt = __builtin_amdgcn_readfirstlane(T[e]), rbase = u.i1 * 256, arow0 = (__builtin_amdgcn_readfirstlane(T[32 + e]) + u.i1) * 256; const int f0 = u.i2 * 128 + wc * 32 + 8 * fq;
#pragma unroll
        for (int ai = 0; ai < 2; ++ai)
#pragma unroll
            for (int m = 0; m < 4; ++m) { const int rt = ai * 128 + wr * 64 + m * 16 + fr;
                if (rbase + rt < cnt) { const float w = ROWW[e * 16384 + rbase + rt]; float o[8];
#pragma unroll
                    for (int t = 0; t < 8; ++t) { const float gt = t < 4 ? acc[ai][0][m][0][t & 3] : acc[ai][0][m][1][t & 3], up = t < 4 ? acc[ai][1][m][0][t & 3] : acc[ai][1][m][1][t & 3];
                        o[t] = gt * fast_sigmoid(gt) * up * w; }
                    st16_wt(ACT + (size_t)(arow0 + rt) * 256 + f0, pack8(o)); } }
    }
};
struct SchedG6 {
    static constexpr bool GATHER = false; static constexpr bool HALFM = true; static constexpr bool ACCUM = false;
    const char* ACT; const char* WDN; LAS const int* T; int G, c; const unsigned* RDY; unsigned* tmo;
    __device__ __forceinline__ bool next(int i, GUnit& u) const {
        const int tot = __builtin_amdgcn_readfirstlane(T[64]); const int u5 = 2 * tot; const int nx = (u5 > G && u5 < 2 * G) ? u5 - G : 0;
        if (c < nx) return false;
        const int L = i * (G - nx) + (c - nx); if (L >= 4 * tot) return false;
        const int ent = __builtin_amdgcn_readfirstlane(T[72 + (L >> 2)]), ntile = L & 3; const int e = ent >> 16, mt = (ent >> 1) & 0x7fff;
        const int mtg = __builtin_amdgcn_readfirstlane(T[32 + e]) + mt;
        u.A = ACT + (size_t)mtg * 256 * 512; u.B = WDN + ((size_t)e * 1024 + ntile * 256) * 512; u.nt = 4; u.i0 = e; u.i1 = mt; u.i2 = ntile; u.i3 = mtg; u.hm = ent & 1; return true;
    }
    __device__ __forceinline__ void offs(const GUnit&, int R0, int R1, int C0, int C1, unsigned (&oA)[2][2]) const {
        oA[0][0] = (unsigned)R0 * 512u + C0 * 2u; oA[0][1] = (unsigned)R1 * 512u + C1 * 2u; oA[1][0] = (unsigned)(R0 + 128) * 512u + C0 * 2u; oA[1][1] = (unsigned)(R1 + 128) * 512u + C1 * 2u; }
    __device__ __forceinline__ unsigned ldb_bytes() const { return 512u; }
    __device__ __forceinline__ void a_ready(const GUnit& u) const {
        if (__builtin_amdgcn_readfirstlane(threadIdx.x >> 6) == 0) {
            unsigned polls = 0;
            while ((unsigned)__builtin_amdgcn_readfirstlane(__hip_atomic_load(RDY + u.i3, __ATOMIC_RELAXED, __HIP_MEMORY_SCOPE_AGENT)) < 16u) {
                if ((++polls & 255u) == 0u && __builtin_amdgcn_readfirstlane(__hip_atomic_load(tmo, __ATOMIC_RELAXED, __HIP_MEMORY_SCOPE_AGENT)) != 0u) break;
                if (polls > (1u << 17)) { __hip_atomic_store(tmo, 1u, __ATOMIC_RELAXED, __HIP_MEMORY_SCOPE_AGENT); break; }
                __builtin_amdgcn_s_sleep(8); }
            __builtin_amdgcn_fence(__ATOMIC_ACQUIRE, "agent");
            asm volatile("s_waitcnt vmcnt(0)" ::: "memory");
        }
        asm volatile("" ::: "memory"); __builtin_amdgcn_s_barrier(); asm volatile("" ::: "memory");
    }
    __device__ __forceinline__ void done(const GUnit&) const {}
};
struct EpiG6 {
    bf16* Z; const int* TOKSLOT; LAS const int* T;
    __device__ __forceinline__ void operator()(const f32x4 (&acc)[2][2][4][2], const GUnit& u, int wr, int wc, int fr, int fq) const {
        const int e = u.i0, cnt = __builtin_amdgcn_readfirstlane(T[e]), rbase = u.i1 * 256; const int c0 = u.i2 * 256 + wc * 32 + 8 * fq;
#pragma unroll
        for (int ai = 0; ai < 2; ++ai)
#pragma unroll
            for (int m = 0; m < 4; ++m) { const int rt = ai * 128 + wr * 64 + m * 16 + fr;
                if (rbase + rt < cnt) { const int ts = TOKSLOT[e * 16384 + rbase + rt]; bf16* zp = Z + zrow(ts) + c0;
#pragma unroll
                    for (int bj = 0; bj < 2; ++bj) { const f32x4 v0 = acc[ai][bj][m][0], v1 = acc[ai][bj][m][1];
                        u32x4 w; w.x = cvtpk(v0[0], v0[1]); w.y = cvtpk(v0[2], v0[3]); w.z = cvtpk(v1[0], v1[1]); w.w = cvtpk(v1[2], v1[3]);
                        st16x(zp + bj * 128, w); } } }
    }
};
}
#ifndef PH4MASK
#define PH4MASK 7
#endif
#ifndef PHMASK
#define PHMASK 0xFFFF
#endif
namespace fk {
__device__ __forceinline__ void relaunder(Frame& F) { int t = threadIdx.x; asm volatile("" : "+v"(t)); F.tid = t; F.lane = t & 63; }
__global__ void __launch_bounds__(NTHR, 2) fwd(Params p) {
    extern __shared__ __attribute__((aligned(16))) unsigned char lds_[];
    Frame F; F.lds = (LAS unsigned char*)lds_; F.ws = p.ws; F.tid = threadIdx.x; F.lane = F.tid & 63; F.wave = __builtin_amdgcn_readfirstlane(F.tid >> 6);
    F.G = gridDim.x; F.bid = blockIdx.x; F.gw = F.bid * NWAVES + F.wave; F.NGW = F.G * NWAVES;
    volatile LAS unsigned* MISC = (volatile LAS unsigned*)(F.lds + MISC_OFF);
    if (F.tid < 64) MISC[F.tid] = 0u;
    __syncthreads();
    unsigned* ctl = (unsigned*)(p.ws + WS_CTL);
    XcdBarrier bar = xcd_barrier_post(ctl + CW_BAR, MISC + 8);
    bool first = true; bool gmode = false; bool mode_known = false;
    const int lo = p.ph_lo, hi = p.ph_hi;
#ifdef TIMEPH
    unsigned long long tacc = 0, tprev = 0; int prevph = -1;
#define TSTAMP(k) do { const unsigned long long now_ = __builtin_amdgcn_s_memrealtime(); if (prevph == (TIMEPH) || ((TIMEPH) == -2 && prevph >= 100)) tacc += now_ - tprev; tprev = now_; prevph = (k); } while (0)
#else
#define TSTAMP(k) do {} while (0)
#endif
#ifdef TIMEPH
#define TBAR() do { const unsigned long long now_ = __builtin_amdgcn_s_memrealtime(); if (prevph == (TIMEPH)) tacc += now_ - tprev; tprev = now_; prevph += 100; } while (0)
#else
#define TBAR() do {} while (0)
#endif
#define PHASE(k) PHASE_(k, true)
#define PHASEG(k) PHASE_(k, false)
#define PHASE_(k, glob) if (lo <= (k) && (k) < hi) if ((first ? (void)0 : (({ TBAR(); }), ((glob) || !gmode) ? xcd_barrier(bar) : xcc_barrier(bar, ctl + CW_GBAR, 32u))), first = false, relaunder(F), true) if (({ TSTAMP(k); true; }))
    unsigned char* ws = p.ws;
    if (p.l_lo == 0) PHASE(0) if constexpr (((PHMASK) >> 0) & 1) { p0_prologue(F, p); }
    for (int l = p.l_lo; l < p.l_hi; ++l) {
        const float* mod = (const float*)(ws + WS_MOD) + (size_t)l * NB * 6 * D;
        PHASE(1) if constexpr (((PHMASK) >> 1) & 1) {
            if (!mode_known) {
                mode_known = true;
                if (F.tid == 0) { bool ok = (lo == 0) && (F.G == 256); for (int j = 0; j < 16; ++j) ok = ok && (xb_ld(ctl + CW_BAR + XB_XCNT(j)) == (j < 8 ? 32u : 0u)); MISC[11] = ok ? 1u : 0u; }
                __syncthreads();
                gmode = MISC[11] != 0u;
                if (gmode) F.bid = (int)MISC[10] * 8 + (int)bar.x;
                F.gw = F.bid * NWAVES + F.wave;
            }
            if (l == 0) row_normmod<0>(F, p.x, (bf16*)(ws + WS_X), nullptr, nullptr, p.norm_g + (size_t)l * 2 * D, mod, mod + D, (bf16*)(ws + WS_H), nullptr);
            else row_normmod<2>(F, nullptr, (bf16*)(ws + WS_X), (const bf16*)(ws + WS_Z), mod - (size_t)NB * 6 * D + 5 * D, p.norm_g + (size_t)l * 2 * D, mod, mod + D, (bf16*)(ws + WS_H), nullptr);
        }
        PHASEG(2) if constexpr (((PHMASK) >> 2) & 1) {
            SchedDense S{(const char*)(ws + WS_H), (const char*)(ws + WS_WIN + (size_t)l * 6144 * 2048), 2048u, 2048u, 64, 24, 16, F.G, F.bid};
            EpiG1 E{(bf16*)(ws + WS_Y1), (bf16*)(ws + WS_XG), (bf16*)(ws + WS_KR), (float*)(ws + WS_STAT), (float*)(ws + WS_STAT2), p.diff_qk_g + l * 128, p.mla_qk_g + l * 192 + 96, (const float*)(ws + WS_CS), (const float*)(ws + WS_SN)};
            gemm_phase(F.lds, S, E);
        }
        PHASEG(4) if constexpr (((PHMASK) >> 4) & 1) {
            if constexpr ((PH4MASK) & 1) {
                SchedG2 S{(const char*)(ws + WS_Y1), (const char*)(ws + WS_WUQ + (size_t)l * 768 * 512), (const char*)(ws + WS_WUKV + (size_t)l * 1024 * 512), F.G, F.bid};
                EpiG2Both E{{(bf16*)(ws + WS_QC), (const float*)(ws + WS_STAT), p.mla_qk_g + l * 192, (const float*)(ws + WS_CS), (const float*)(ws + WS_SN)},
                            {(bf16*)(ws + WS_KVC), (const float*)(ws + WS_STAT), p.mla_qk_g + l * 192 + 96, (const float*)(ws + WS_CS), (const float*)(ws + WS_SN)}};
                gemm_phase(F.lds, S, E); }
            TSTAMP(41);
            if constexpr ((PH4MASK) & 2) attn_phase<true>(F, p, l);
            TSTAMP(42);
            if constexpr ((PH4MASK) & 4) for (int j = 0; j < 2; ++j) sgu_unit(F, p, l, (F.bid & 7) * 64 + (F.bid >> 3) + 32 * j);
        }
        PHASEG(6) if constexpr (((PHMASK) >> 6) & 1) { attn_phase<false>(F, p, l); }
        PHASEG(7) if constexpr (((PHMASK) >> 7) & 1) {
            SchedG3 S{(const char*)(ws + WS_OA), (const char*)(ws + WS_WBR + (size_t)l * 3 * MiB), F.G, F.bid};
            EpiG3 E{(const bf16*)(ws + WS_XG), (bf16*)(ws + WS_MERGED)};
            gemm_phase(F.lds, S, E);
        }
        PHASEG(8) if constexpr (((PHMASK) >> 8) & 1) {
            SchedDense S{(const char*)(ws + WS_MERGED), (const char*)(ws + WS_WOUT + (size_t)l * 2 * MiB), 2048u, 2048u, 64, 4, 16, F.G, F.bid};
            if (l == 0) { EpiG4<true> E{(bf16*)(ws + WS_X), mod + 2 * D, p.x}; gemm_phase(F.lds, S, E); }
            else { EpiG4<false> E{(bf16*)(ws + WS_X), mod + 2 * D, nullptr}; gemm_phase(F.lds, S, E); }
        }
        PHASEG(9) if constexpr (((PHMASK) >> 9) & 1) { row_router(F, p, l, mod); }
        PHASE(10) if constexpr (((PHMASK) >> 10) & 1) {
            moe_table(F, l);
            unsigned* RDY = (unsigned*)(ws + WS_CTL) + CW_RDY + l * 256;
            { SchedG5 S{(const char*)(ws + WS_H), (const char*)(ws + WS_WGU + (size_t)l * 32 * MiB), (const int*)(ws + WS_LIST), (LAS const int*)(F.lds + TAB_OFF + 6144), F.G, F.bid, RDY};
              EpiG5 E{(bf16*)(ws + WS_ACT), (const float*)(ws + WS_ROWW), (LAS const int*)(F.lds + TAB_OFF + 6144)};
              gemm_phase(F.lds, S, E); }
            TSTAMP(43);
            { SchedG6 S{(const char*)(ws + WS_ACT), (const char*)(ws + WS_WDN + (size_t)l * 16 * MiB), (LAS const int*)(F.lds + TAB_OFF + 6144), F.G, F.bid, RDY, (unsigned*)(ws + WS_CTL) + CW_TMO2};
              EpiG6 E{(bf16*)(ws + WS_Z), (const int*)(ws + WS_TOKSLOT), (LAS const int*)(F.lds + TAB_OFF + 6144)};
              gemm_phase(F.lds, S, E); }
        }
    }
    if (p.l_hi == p.nlayers) PHASE(12) if constexpr (((PHMASK) >> 12) & 1) {
        const float* modl = (const float*)(ws + WS_MOD) + (size_t)(p.nlayers - 1) * NB * 6 * D;
        row_normmod<3>(F, nullptr, (bf16*)(ws + WS_X), (const bf16*)(ws + WS_Z), modl + 5 * D, nullptr, nullptr, nullptr, nullptr, p.out);
    }
#undef PHASE
#ifdef CENSUS_TEST
    if (blockIdx.x == 0 && threadIdx.x == 0) { bool ok = true; for (int j = 0; j < 8; ++j) ok = ok && (xb_ld(ctl + CW_BAR + XB_XCNT(j)) == 32u);
        if (!ok) { const unsigned long long t0 = __builtin_amdgcn_s_memrealtime(); while (__builtin_amdgcn_s_memrealtime() - t0 < 100000ull) __builtin_amdgcn_s_sleep(32); } }
#endif
#ifdef TIMEPH
    TSTAMP(99);
    if (blockIdx.x == 0 && threadIdx.x == 0) { const unsigned long long t0 = __builtin_amdgcn_s_memrealtime(), wait = tacc * (TMULT);
        while (__builtin_amdgcn_s_memrealtime() - t0 < wait) __builtin_amdgcn_s_sleep(32); }
#endif
}
}
static void fill_params(fk::Params& p, void* const* d_in, void* d_out, void* d_ws) {
    p.x = (const float*)d_in[0]; p.c = (const float*)d_in[1]; p.positions = (const int*)d_in[2];
    p.w_ada = (const float*)d_in[3]; p.b_ada = (const float*)d_in[4]; p.norm_g = (const float*)d_in[5]; p.w_in = (const float*)d_in[6];
    p.diff_qk_g = (const float*)d_in[7]; p.diff_lambda = (const float*)d_in[8]; p.diff_out_g = (const float*)d_in[9]; p.rel_bias = (const float*)d_in[10];
    p.sgu_v_g = (const float*)d_in[11]; p.sgu_w = (const float*)d_in[12]; p.sgu_b = (const float*)d_in[13];
    p.mla_lat_g = (const float*)d_in[14]; p.mla_w_uq = (const float*)d_in[15]; p.mla_w_ukv = (const float*)d_in[16]; p.mla_qk_g = (const float*)d_in[17];
    p.w_branch = (const float*)d_in[18]; p.w_out = (const float*)d_in[19]; p.router_g_w = (const float*)d_in[20]; p.router_g_b = (const float*)d_in[21];
    p.router_e_w = (const float*)d_in[22]; p.router_e_b = (const float*)d_in[23]; p.w_e_gate = (const float*)d_in[24]; p.w_e_up = (const float*)d_in[25]; p.w_e_down = (const float*)d_in[26];
    p.out = (float*)d_out; p.ws = (unsigned char*)d_ws;
}
static void launch_fast(hipStream_t st, fk::Params p, int l_lo, int l_hi, int ph_lo, int ph_hi) {
    static bool attr = false;
    if (!attr) { (void)hipFuncSetAttribute((const void*)fk::fwd, hipFuncAttributeMaxDynamicSharedMemorySize, fk::LDS_BYTES); attr = true; }
#if NLAUNCH != 1
    (void)hipMemsetAsync((char*)p.ws + fk::WS_CTL + fk::CW_BAR * 4, 0, XCD_BAR_WORDS * 4, st);
#endif
    p.l_lo = l_lo; p.l_hi = l_hi; p.ph_lo = ph_lo; p.ph_hi = ph_hi;
    hipLaunchKernelGGL(fk::fwd, dim3(256), dim3(fk::NTHR), fk::LDS_BYTES, st, p);
}
extern "C" void kernel_launch(void* const* d_in, const int* in_sizes, int n_in, void* d_out, int out_size, void* d_ws, size_t ws_size, hipStream_t stream) {
    if (fk::WS_END > ws_size) { fprintf(stderr, "ws too small: need %zu have %zu\n", (size_t)fk::WS_END, ws_size); return; }
    (void)hipMemsetAsync((char*)d_ws + fk::WS_CTL, 0, fk::CTL_ZERO_BYTES, stream);
    fk::Params p{}; fill_params(p, d_in, d_out, d_ws); p.nlayers = 4; p.pad_ = 0;
#if NLAUNCH == 1
    launch_fast(stream, p, 0, 4, 0, 13);
#else
    launch_fast(stream, p, 0, 1, 0, 1);
    for (int l = 0; l < 4; ++l) for (int ph = 1; ph <= 11; ++ph) launch_fast(stream, p, l, l + 1, ph, ph + 1);
    launch_fast(stream, p, 3, 4, 12, 13);
#endif
}
```

```cpp
#include <hip/hip_runtime.h>
#include <cstdio>
#include <cstdint>
#define NLAUNCH 1
#define WT_STORES 1
namespace fk {
#define LAS __attribute__((address_space(3)))
#define GAS __attribute__((address_space(1)))
typedef unsigned short bf16;
typedef short bf16x8 __attribute__((ext_vector_type(8)));
typedef short s16x4 __attribute__((ext_vector_type(4)));
typedef float f32x2 __attribute__((ext_vector_type(2)));
typedef float f32x4 __attribute__((ext_vector_type(4)));
typedef float f32x16 __attribute__((ext_vector_type(16)));
typedef unsigned u32x2 __attribute__((ext_vector_type(2)));
typedef unsigned u32x4 __attribute__((ext_vector_type(4)));
typedef __bf16 bf16x2_t __attribute__((ext_vector_type(2)));
constexpr int NB = 8, S = 2048, D = 1024, M = NB * S, NL = 4;
constexpr int NWAVES = 8, NTHR = 512;
constexpr float LOG2E = 1.4426950408889634f;

__device__ __forceinline__ unsigned cvtpk(float lo, float hi) { f32x2 v = {lo, hi}; bf16x2_t b = __builtin_convertvector(v, bf16x2_t); return __builtin_bit_cast(unsigned, b); }
__device__ __forceinline__ float bf_lo(unsigned u) { return __builtin_bit_cast(float, u << 16); }
__device__ __forceinline__ float bf_hi(unsigned u) { return __builtin_bit_cast(float, u & 0xffff0000u); }
__device__ __forceinline__ float bf2f(bf16 u) { return __builtin_bit_cast(float, (unsigned)u << 16); }
template <int K> __device__ __forceinline__ float sw(float v) { return __builtin_bit_cast(float, __builtin_amdgcn_ds_swizzle(__builtin_bit_cast(int, v), 0x1F | (K << 10))); }
__device__ __forceinline__ int x32_addr() { int z = 0; asm volatile("" : "+v"(z)); const int l = __builtin_amdgcn_mbcnt_hi(-1, __builtin_amdgcn_mbcnt_lo(-1, z)); return (l ^ 32) << 2; }
__device__ __forceinline__ float xget32(float v, bool) { return __builtin_bit_cast(float, __builtin_amdgcn_ds_bpermute(x32_addr(), __builtin_bit_cast(int, v))); }
__device__ __forceinline__ float xsum32(float v) { return v + xget32(v, false); }
__device__ __forceinline__ float xmax32(float v) { return __builtin_fmaxf(v, xget32(v, false)); }
#ifdef OLD_WSUM
__device__ __forceinline__ float wave_sum(float v) { for (int o = 1; o < 64; o <<= 1) v += __shfl_xor(v, o); return v; }
#else
__device__ __forceinline__ float wave_sum(float v) { v += sw<1>(v); v += sw<2>(v); v += sw<4>(v); v += sw<8>(v); v += sw<16>(v); return xsum32(v); }
#endif
__device__ __forceinline__ float fast_sigmoid(float x) { return __builtin_amdgcn_rcpf(1.f + __builtin_amdgcn_exp2f(-x * LOG2E)); }
__device__ __forceinline__ float gelu_tanh(float x) { const float y = 0.7978845608028654f * (x + 0.044715f * x * x * x); return x * fast_sigmoid(2.f * y); }
#define LDS_WAIT() asm volatile("s_waitcnt lgkmcnt(0)" ::: "memory")
__device__ __forceinline__ void st16_wt(void* p, u32x4 v) { asm volatile("global_store_dwordx4 %0, %1, off sc1\n\ts_nop 1" :: "v"(p), "v"(v) : "memory"); }
#ifdef WT_ALL
__device__ __forceinline__ void st16x(void* p, u32x4 v) { asm volatile("global_store_dwordx4 %0, %1, off sc1\n\ts_nop 1" :: "v"(p), "v"(v) : "memory"); }
__device__ __forceinline__ void st16f(void* p, f32x4 v) { asm volatile("global_store_dwordx4 %0, %1, off sc1\n\ts_nop 1" :: "v"(p), "v"(v) : "memory"); }
__device__ __forceinline__ void st8x(void* p, u32x2 v) { asm volatile("global_store_dwordx2 %0, %1, off sc1\n\ts_nop 1" :: "v"(p), "v"(v) : "memory"); }
#else
__device__ __forceinline__ void st16x(void* p, u32x4 v) { *(GAS u32x4*)p = v; }
__device__ __forceinline__ void st16f(void* p, f32x4 v) { *(GAS f32x4*)p = v; }
__device__ __forceinline__ void st8x(void* p, u32x2 v) { *(GAS u32x2*)p = v; }
#endif
#ifdef WT_STORES
__device__ __forceinline__ void st16(void* p, u32x4 v) { asm volatile("global_store_dwordx4 %0, %1, off sc1\n\ts_nop 1" :: "v"(p), "v"(v) : "memory"); }
#else
__device__ __forceinline__ void st16(void* p, u32x4 v) { *(GAS u32x4*)p = v; }
#endif
#define VM_WAIT() asm volatile("s_waitcnt vmcnt(0)" ::: "memory")

#define XB_TMO      128
#define XB_XCNT(j)  (256  + 64 * (j))
#define XB_XSUB(j)  (1280 + 64 * (j))
#define XB_XGEN(j)  (2304 + 64 * (j))
#define XB_TOP      3328
#define XB_TOPGEN   3392
#define XCD_BAR_WORDS 3456
#define XB_SPIN_CAP (1u << 18)
__device__ __forceinline__ unsigned xb_ld(unsigned* p)              { return __hip_atomic_load(p, __ATOMIC_RELAXED, __HIP_MEMORY_SCOPE_AGENT); }
__device__ __forceinline__ unsigned xb_add(unsigned* p, unsigned v) { return __hip_atomic_fetch_add(p, v, __ATOMIC_RELAXED, __HIP_MEMORY_SCOPE_AGENT); }
__device__ __forceinline__ unsigned xb_xcc_id() { return (unsigned)__builtin_amdgcn_s_getreg((3 << 11) | 20) & 0xFu; }
#define XB_SPIN(cond, bar) do { unsigned _sp = 0; while (cond) { __builtin_amdgcn_s_sleep(1); \
    if ((++_sp & 255u) == 0u) { if (xb_ld(&(bar)[XB_TMO])) break; if (_sp > XB_SPIN_CAP) { atomicAdd(&(bar)[XB_TMO], 1u); break; } } } } while (0)
struct XcdBarrier { unsigned* bar; unsigned x; volatile LAS unsigned* st; };
__device__ __forceinline__ XcdBarrier xcd_barrier_post(unsigned* bar, volatile LAS unsigned* st) {
    XcdBarrier b; b.bar = bar; b.x = xb_xcc_id(); b.st = st;
    if (threadIdx.x == 0) st[2] = xb_add(&bar[XB_XCNT(b.x)], 1u);
    return b;
}
__device__ __forceinline__ void xcd_barrier_complete(unsigned* bar, unsigned x, unsigned& nloc, unsigned& nx) {
    const unsigned G = gridDim.x * gridDim.y * gridDim.z;
    unsigned sum, cnt, mine, sp = 0u;
    for (;;) {
        sum = 0u; cnt = 0u; mine = 0u;
#pragma unroll
        for (unsigned j = 0; j < 16; ++j) { const unsigned c = xb_ld(&bar[XB_XCNT(j)]); sum += c; cnt += (c > 0u) ? 1u : 0u; mine = (j == x) ? c : mine; }
        if (sum == G) break;
        __builtin_amdgcn_s_sleep(1);
        if ((++sp & 255u) == 0u) { if (xb_ld(&bar[XB_TMO])) break; if (sp > XB_SPIN_CAP) { atomicAdd(&bar[XB_TMO], 1u); break; } }
    }
    nloc = mine > 0u ? mine : 1u; nx = cnt > 0u ? cnt : 1u;
}
__device__ __forceinline__ void xcd_barrier(const XcdBarrier& b) {
    asm volatile("s_waitcnt vmcnt(0)" ::: "memory");
    __syncthreads();
    if (threadIdx.x == 0) {
        unsigned* bar = b.bar;
        __builtin_amdgcn_s_waitcnt(0);
        unsigned nloc = b.st[0], nx = b.st[1];
        if (nloc == 0u) { xcd_barrier_complete(bar, b.x, nloc, nx); b.st[0] = nloc; b.st[1] = nx; }
        const unsigned old = xb_add(&bar[XB_XSUB(b.x)], 1u);
        const unsigned gen = old / nloc;
        if (old + 1u == (gen + 1u) * nloc) {
            __builtin_amdgcn_fence(__ATOMIC_RELEASE, "agent");
            asm volatile("s_waitcnt vmcnt(0)" ::: "memory");
            const unsigned og = xb_add(&bar[XB_TOP], 1u);
            const unsigned tg = og / nx;
            if (og + 1u == (tg + 1u) * nx) xb_add(&bar[XB_TOPGEN], 1u);
            else XB_SPIN(xb_ld(&bar[XB_TOPGEN]) == tg, bar);
            __builtin_amdgcn_fence(__ATOMIC_ACQUIRE, "agent");
            xb_add(&bar[XB_XGEN(b.x)], 1u);
            asm volatile("s_waitcnt vmcnt(0)" ::: "memory");
        } else {
            XB_SPIN(xb_ld(&bar[XB_XGEN(b.x)]) == gen, bar);
            __builtin_amdgcn_fence(__ATOMIC_ACQUIRE, "agent");
            asm volatile("s_waitcnt vmcnt(0)" ::: "memory");
        }
    }
    __syncthreads();
}

__device__ __forceinline__ void xcc_barrier(const XcdBarrier& b, unsigned* gb, unsigned nloc) {
    asm volatile("s_waitcnt vmcnt(0)" ::: "memory");
    __syncthreads();
    if (threadIdx.x == 0) {
        __builtin_amdgcn_s_waitcnt(0);
        const unsigned old = xb_add(&gb[64 * b.x], 1u); const unsigned gen = old / nloc;
        if (old + 1u == (gen + 1u) * nloc) xb_add(&gb[1024 + 64 * b.x], 1u);
        else XB_SPIN(xb_ld(&gb[1024 + 64 * b.x]) == gen, b.bar);
        __builtin_amdgcn_fence(__ATOMIC_ACQUIRE, "agent");
        asm volatile("s_waitcnt vmcnt(0)" ::: "memory");
    }
    __syncthreads();
}

constexpr int BM = 256, BK = 64, HALF = 128, HTB = HALF * BK * 2;
__device__ __forceinline__ void stage_rc(int b, int& R, int& C) { const int st = b / 1024, sb = b % 1024, swz = sb ^ (((sb >> 9) & 1) << 5); R = (st >> 1) * 16 + swz / 64; C = (st & 1) * 32 + (swz % 64) / 2; }
__device__ __forceinline__ int lds_byte(int r, int c) { const int st = (r >> 4) * 2 + (c >> 5), rr = r & 15, cc = c & 31, ob = rr * 64 + cc * 2; return st * 1024 + (ob ^ (((ob >> 9) & 1) << 5)); }
__device__ __forceinline__ int perm32(int rho) { const int n = rho >> 4, i = rho & 15; return 8 * (i >> 2) + 4 * n + (i & 3); }

struct GUnit { const char* A; const char* B; int nt; int i0, i1, i2, i3; int hm; };
template <class Epi, class Sched>
__device__ __forceinline__ void gemm_phase(LAS unsigned char* lds, const Sched& S, const Epi& E) {
    int tid = threadIdx.x; asm volatile("" : "+v"(tid));
    const int wid = __builtin_amdgcn_readfirstlane(tid >> 6), lane = tid & 63, wr = wid >> 2, wc = wid & 3, fr = lane & 15, fq = lane >> 4;
    int R0, C0, R1, C1; stage_rc(tid * 16, R0, C0); stage_rc(tid * 16 + 8192, R1, C1);
    const unsigned ldb = S.ldb_bytes();
    unsigned voffB[2];
    voffB[0] = (unsigned)((R0 & ~31) + perm32(R0 & 31)) * ldb + (unsigned)C0 * 2u; voffB[1] = (unsigned)((R1 & ~31) + perm32(R1 & 31)) * ldb + (unsigned)C1 * 2u;
    unsigned voffBh[2]; voffBh[0] = voffB[0] + (unsigned)HALF * ldb; voffBh[1] = voffB[1] + (unsigned)HALF * ldb;
    const unsigned ldsw = (unsigned)wid * 1024u;
    const int aoff = lds_byte(wr * 64 + fr, fq * 8), boff = lds_byte(wc * 32 + fr, fq * 8);
#define PG8_SA(b, h) (((b) * 2 + (h)) * HTB)
#define PG8_SB(b, h) ((4 + (b) * 2 + (h)) * HTB)
#define PG8_STAGE(bufoff, gbase, voff, kofs) do { _Pragma("unroll") for (int _i = 0; _i < 2; ++_i) \
        __builtin_amdgcn_global_load_lds((const unsigned*)((const char*)(gbase) + (unsigned)((voff)[_i] + (kofs))), (LAS unsigned*)(lds + (bufoff) + ldsw + _i * 8192), 16, 0, 0); } while (0)
#define PG8_LDA(dst, b, h) do { _Pragma("unroll") for (int m = 0; m < 4; ++m) _Pragma("unroll") for (int k = 0; k < 2; ++k) dst[m][k] = *(const LAS bf16x8*)(lds + PG8_SA(b, h) + aoff + m * 2048 + k * 1024); } while (0)
#define PG8_LDB(dst, b, h) do { _Pragma("unroll") for (int n = 0; n < 2; ++n) _Pragma("unroll") for (int k = 0; k < 2; ++k) dst[n][k] = *(const LAS bf16x8*)(lds + PG8_SB(b, h) + boff + n * 2048 + k * 1024); } while (0)
#define PG8_MMA(ai, bj, At, Bt) do { __builtin_amdgcn_s_setprio(1); _Pragma("unroll") for (int m = 0; m < 4; ++m) _Pragma("unroll") for (int n = 0; n < 2; ++n) _Pragma("unroll") for (int k = 0; k < 2; ++k) \
        acc[ai][bj][m][n] = __builtin_amdgcn_mfma_f32_16x16x32_bf16(Bt[n][k], At[m][k], acc[ai][bj][m][n], 0, 0, 0); __builtin_amdgcn_s_setprio(0); } while (0)
#define PG8_WAIT_V(n) asm volatile("s_waitcnt vmcnt(" #n ")" ::: "memory")
#define PG8_WAIT_L(n) asm volatile("s_waitcnt lgkmcnt(" #n ")" ::: "memory")
#define PG8_BAR __builtin_amdgcn_s_barrier()
#define PG8_SCHED __builtin_amdgcn_sched_barrier(0)
    GUnit cur, nxt; int ui = 0;
    if (!S.next(0, cur)) return;
    f32x4 acc[2][2][4][2];
#pragma unroll
    for (int a = 0; a < 2; ++a)
#pragma unroll
        for (int b = 0; b < 2; ++b)
#pragma unroll
            for (int m = 0; m < 4; ++m)
#pragma unroll
                for (int n = 0; n < 2; ++n) acc[a][b][m][n] = (f32x4){0.f, 0.f, 0.f, 0.f};
    bf16x8 At[4][2], B0[2][2], B1[2][2];
    unsigned oAc[2][2], oAn[2][2];
    S.a_ready(cur);
    S.offs(cur, R0, R1, C0, C1, oAc);
    const char* cA = cur.A; const char* cB = cur.B;
    PG8_STAGE(PG8_SB(0, 0), cB, voffB, 0u); PG8_STAGE(PG8_SB(0, 1), cB, voffBh, 0u); PG8_STAGE(PG8_SA(0, 0), cA, oAc[0], 0u); PG8_STAGE(PG8_SA(0, 1), cA, oAc[1], 0u);
    if (wr == 1) PG8_BAR;
    PG8_WAIT_V(2); PG8_BAR;
    PG8_STAGE(PG8_SB(1, 0), cB, voffB, 128u); PG8_STAGE(PG8_SA(1, 0), cA, oAc[0], 128u); PG8_STAGE(PG8_SB(1, 1), cB, voffBh, 128u);
    PG8_WAIT_V(6); PG8_BAR;
    for (;;) {
        const bool has_next = S.next(ui + 1, nxt);
        const char* nA = has_next ? nxt.A : cA; const char* nB = has_next ? nxt.B : cB;
        if constexpr (Sched::GATHER) { if (has_next) S.offs(nxt, R0, R1, C0, C1, oAn);
            else { oAn[0][0] = oAc[0][0]; oAn[0][1] = oAc[0][1]; oAn[1][0] = oAc[1][0]; oAn[1][1] = oAc[1][1]; } }
        int nt = cur.nt; asm volatile("" : "+s"(nt)); const bool hm = Sched::HALFM && cur.hm != 0;
        for (int t = 0; t < nt; t += 2) {
            const bool last = (t == nt - 2);
            if (last && has_next) S.a_ready(nxt);
            const unsigned k1 = (unsigned)(t + 1) * 128u, k2 = last ? 0u : (unsigned)(t + 2) * 128u, k3 = k2 + 128u;
            const char* a2 = last ? nA : cA; const char* b2 = last ? nB : cB;
            unsigned o2[2][2];
            if constexpr (Sched::GATHER) { o2[0][0] = last ? oAn[0][0] : oAc[0][0]; o2[0][1] = last ? oAn[0][1] : oAc[0][1]; o2[1][0] = last ? oAn[1][0] : oAc[1][0]; o2[1][1] = last ? oAn[1][1] : oAc[1][1]; }
            else { o2[0][0] = oAc[0][0]; o2[0][1] = oAc[0][1]; o2[1][0] = oAc[1][0]; o2[1][1] = oAc[1][1]; }
            PG8_LDB(B0, 0, 0); PG8_LDB(B1, 0, 1); PG8_SCHED; PG8_LDA(At, 0, 0); PG8_STAGE(PG8_SA(1, 1), cA, oAc[1], k1);
            PG8_WAIT_V(8); PG8_WAIT_L(0); PG8_BAR; PG8_MMA(0, 0, At, B0); PG8_MMA(0, 1, At, B1); PG8_BAR; PG8_SCHED;
            if (!hm) PG8_LDA(At, 0, 1); PG8_STAGE(PG8_SB(0, 0), b2, voffB, k2); PG8_STAGE(PG8_SB(0, 1), b2, voffBh, k2); PG8_STAGE(PG8_SA(0, 0), a2, o2[0], k2);
            PG8_WAIT_V(8); PG8_WAIT_L(0); PG8_BAR; if (!hm) { PG8_MMA(1, 0, At, B0); PG8_MMA(1, 1, At, B1); } PG8_BAR; PG8_SCHED;
            PG8_LDB(B0, 1, 0); PG8_LDB(B1, 1, 1); PG8_SCHED; PG8_LDA(At, 1, 0); PG8_STAGE(PG8_SA(0, 1), a2, o2[1], k2);
            PG8_WAIT_V(8); PG8_WAIT_L(0); PG8_BAR; PG8_MMA(0, 0, At, B0); PG8_MMA(0, 1, At, B1); PG8_BAR; PG8_SCHED;
            if (!hm) PG8_LDA(At, 1, 1); PG8_STAGE(PG8_SB(1, 0), b2, voffB, k3); PG8_STAGE(PG8_SB(1, 1), b2, voffBh, k3); PG8_STAGE(PG8_SA(1, 0), a2, o2[0], k3);
            PG8_WAIT_V(8); PG8_WAIT_L(0); PG8_BAR; if (!hm) { PG8_MMA(1, 0, At, B0); PG8_MMA(1, 1, At, B1); } PG8_BAR; PG8_SCHED;
        }
        if (wr == 0) PG8_BAR;
        { int fr2 = fr, fq2 = fq; asm volatile("" : "+v"(fr2), "+v"(fq2)); E(acc, cur, wr, wc, fr2, fq2); S.done(cur); }
        if (!has_next) break;
        bool keep_ = false; if constexpr (Sched::ACCUM) keep_ = S.keep_acc(cur);
        if (!keep_) {
#pragma unroll
        for (int a = 0; a < 2; ++a)
#pragma unroll
            for (int b = 0; b < 2; ++b)
#pragma unroll
                for (int m = 0; m < 4; ++m)
#pragma unroll
                    for (int n = 0; n < 2; ++n) acc[a][b][m][n] = (f32x4){0.f, 0.f, 0.f, 0.f};
        }
        cur = nxt; cA = nA; cB = nB; ++ui;
        if constexpr (Sched::GATHER) { oAc[0][0] = oAn[0][0]; oAc[0][1] = oAn[0][1]; oAc[1][0] = oAn[1][0]; oAc[1][1] = oAn[1][1]; }
        if (wr == 1) PG8_BAR;
    }
    PG8_WAIT_V(0);
    PG8_BAR;
#undef PG8_SA
#undef PG8_SB
#undef PG8_STAGE
#undef PG8_LDA
#undef PG8_LDB
#undef PG8_MMA
#undef PG8_WAIT_V
#undef PG8_WAIT_L
#undef PG8_BAR
#undef PG8_SCHED
}
}
namespace fk {
constexpr size_t MiB = 1u << 20;
constexpr size_t WS_CTL = 0, CTL_ZERO_BYTES = 64 * 1024;
constexpr size_t WS_MOD = 1 * MiB;
constexpr size_t WS_BT = WS_MOD + 832 * 1024;
constexpr size_t WS_LAM = WS_BT + 4096;
constexpr size_t WS_ST = WS_MOD + 896 * 1024;
constexpr size_t WS_CS = 2 * MiB, WS_SN = 3 * MiB;
constexpr size_t WS_LIST = 4 * MiB, WS_ROWW = 6 * MiB, WS_TOKSLOT = 8 * MiB;
constexpr size_t WS_WIN = 10 * MiB;
constexpr size_t WS_WUQ = 58 * MiB;
constexpr size_t WS_WRT = 59 * MiB + 512 * 1024;
constexpr size_t WS_WUKV = 60 * MiB;
constexpr size_t WS_WBR = 62 * MiB;
constexpr size_t WS_WOUT = 74 * MiB;
constexpr size_t WS_WGU = 82 * MiB;
constexpr size_t WS_WDN = 210 * MiB;
constexpr size_t WS_X = 274 * MiB;
constexpr size_t WS_MERGED = 306 * MiB;
constexpr size_t WS_POOL = 338 * MiB;
constexpr size_t WS_Y1 = WS_POOL;
constexpr size_t WS_Z = WS_POOL;
constexpr size_t WS_ACT = WS_POOL + 96 * MiB;
constexpr size_t WS_XG = WS_POOL + 96 * MiB;
constexpr size_t WS_QC = WS_POOL + 192 * MiB;
constexpr size_t WS_KVC = WS_POOL + 216 * MiB;
constexpr size_t WS_KR = WS_POOL + 248 * MiB;
constexpr size_t WS_STAT = WS_KR + 1 * MiB;
constexpr size_t WS_STAT2 = WS_STAT + 512 * 1024;
constexpr size_t WS_OA = WS_POOL + 250 * MiB, WS_OB = WS_POOL + 266 * MiB, WS_OC = WS_POOL + 282 * MiB;
constexpr size_t WS_H = WS_POOL + 298 * MiB;
constexpr size_t WS_END = WS_POOL + 330 * MiB;
constexpr int CW_BAR = 1024;
constexpr int CW_CNT = 8192;
constexpr int CW_GBAR = 4608;
constexpr int CW_RDY = 9216;
constexpr int CW_G2CNT = 8512;
constexpr int CW_TMO2 = 8448;
static_assert((CW_RDY + 4 * 256) * 4 <= (int)CTL_ZERO_BYTES, "ctl map 2");
static_assert((CW_BAR + XCD_BAR_WORDS) <= CW_CNT && (CW_CNT + 4 * 32) * 4 <= (int)CTL_ZERO_BYTES, "ctl map");
constexpr int RING_BYTES = 131072, TAB_OFF = RING_BYTES, MISC_OFF = TAB_OFF + 8192, LDS_BYTES = 147456;

__device__ __forceinline__ size_t zrow(int ts) { return (size_t)(ts >> 12) * 6291456u + (size_t)(ts & 4095) * 1024u; }
struct Params {
    const float *x, *c; const int* positions; const float *w_ada, *b_ada, *norm_g, *w_in, *diff_qk_g, *diff_lambda, *diff_out_g, *rel_bias, *sgu_v_g, *sgu_w, *sgu_b,
        *mla_lat_g, *mla_w_uq, *mla_w_ukv, *mla_qk_g, *w_branch, *w_out, *router_g_w, *router_g_b, *router_e_w, *router_e_b, *w_e_gate, *w_e_up, *w_e_down;
    float* out; unsigned char* ws; int ph_lo, ph_hi; int l_lo, l_hi; int nlayers, pad_;
};

__device__ __forceinline__ void transpose_blk(const float* W, int ldw, int sc0, int k0, bf16* WT, int dr0, int ldt, const float* kscale, LAS float* scr, int lane) {
    float tv[32];
#pragma unroll
    for (int i = 0; i < 32; ++i) { const int kk = 2 * i + (lane >> 5); tv[i] = W[(size_t)(k0 + kk) * ldw + sc0 + (lane & 31)]; }
#pragma unroll
    for (int i = 0; i < 32; ++i) { const int kk = 2 * i + (lane >> 5); float v = tv[i]; if (kscale) v *= kscale[k0 + kk]; scr[kk * 33 + (lane & 31)] = v; }
    LDS_WAIT(); asm volatile("" ::: "memory");
    const int c = lane & 7;
#pragma unroll
    for (int j = 0; j < 4; ++j) { const int n = (lane >> 3) + 8 * j; const LAS float* sp = scr + (8 * c) * 33 + n;
        u32x4 o; o.x = cvtpk(sp[0 * 33], sp[1 * 33]); o.y = cvtpk(sp[2 * 33], sp[3 * 33]); o.z = cvtpk(sp[4 * 33], sp[5 * 33]); o.w = cvtpk(sp[6 * 33], sp[7 * 33]);
        *(GAS u32x4*)(WT + (size_t)(dr0 + n) * ldt + k0 + 8 * c) = o; }
    LDS_WAIT(); asm volatile("" ::: "memory");
}
__device__ __forceinline__ void transpose_item(const float* W, int K, int ldw, int c0, int ncols, bf16* WT, int row_off, LAS float* scr, int item, int lane, int ldt = 0) {
    if (ldt == 0) ldt = K;
    const int nblk = ncols / 32, kb = item / nblk, nb = item % nblk;
    transpose_blk(W, ldw, c0 + 32 * nb, 64 * kb, WT, row_off + 32 * nb, ldt, nullptr, scr, lane);
}
}
namespace fk {
struct Frame { LAS unsigned char* lds; unsigned char* ws; int tid, lane, wave, G, bid, gw, NGW; };

constexpr int IT_IN1 = 16 * 93, IT_IN2 = 16 * 96, IT_UQ = 4 * 24, IT_UKV = 2 * 32, IT_BR = 8 * 32, IT_OUT = 16 * 32, IT_NONEXP = IT_IN1 + IT_IN2 + IT_UQ + IT_UKV + 3 * IT_BR + IT_OUT;
constexpr int IT_EXP = 4 * 64 + 128, IT_LAYER = IT_NONEXP + 32 * IT_EXP, IT_TOTAL = NL * IT_LAYER;
__device__ __forceinline__ void p0_prologue(Frame& F, const Params& p) {
    unsigned char* ws = F.ws;
    LAS float* cact = (LAS float*)(F.lds);
    for (int i = F.tid; i < NB * D; i += NTHR) { const float v = p.c[i]; cact[i] = v / (1.f + __expf(-v)); }
    __syncthreads();
    LAS float* part = (LAS float*)(F.lds + 32768);
    float* MOD = (float*)(ws + WS_MOD);
    for (int it = F.bid; it < NL * 192; it += F.G) {
        const int l = it / 192, cg = it % 192, col = cg * 32 + (F.lane & 31), kpar = F.lane >> 5;
        const int kb = F.wave * 128 + kpar;
        const float* w = p.w_ada + (size_t)l * D * 6 * D + (size_t)kb * 6 * D + col;
        float acc[NB];
#pragma unroll
        for (int b = 0; b < NB; ++b) acc[b] = 0.f;
#pragma unroll 16
        for (int i = 0; i < 64; ++i) { const float wv = w[(size_t)(2 * i) * 6 * D];
#pragma unroll
            for (int b = 0; b < NB; ++b) acc[b] += cact[b * D + kb + 2 * i] * wv; }
#pragma unroll
        for (int b = 0; b < NB; ++b) { const float s2 = xsum32(acc[b]); if (F.lane < 32) part[(F.wave * NB + b) * 32 + F.lane] = s2; }
        __syncthreads();
        if (F.tid < 256) { const int b = F.tid >> 5, c = F.tid & 31; float s = 0.f;
#pragma unroll
          for (int wv = 0; wv < 8; ++wv) s += part[(wv * NB + b) * 32 + c];
          MOD[((size_t)l * NB + b) * 6 * D + cg * 32 + c] = s + p.b_ada[l * 6 * D + cg * 32 + c]; }
        __syncthreads();
    }
    const int gt = F.bid * NTHR + F.tid, NGT = F.G * NTHR;
    if (gt < NL) { const float* dl = p.diff_lambda + gt * 256; float s01 = 0.f, s23 = 0.f;
        for (int i = 0; i < 64; ++i) { s01 += dl[i] * dl[64 + i]; s23 += dl[128 + i] * dl[192 + i]; }
        ((float*)(ws + WS_LAM))[gt] = expf(s01) - expf(s23) + (0.8f - 0.6f * expf(-0.3f * (float)gt)); }
    if (gt >= 1024 && gt < 1024 + 4 * 256) { const int i = gt - 1024, h = i >> 8, rel = (i & 255) - 191; const int n = rel < 0 ? -rel : rel;
        int large = 8 + (int)(logf((float)(n > 1 ? n : 1) / 8.f) / 2.772588722239781f * 8.f); if (large > 15) large = 15;
        const int bucket = (rel > 0 ? 16 : 0) + (n < 8 ? n : large);
        ((float*)(ws + WS_BT))[i] = (p.rel_bias[bucket * 4 + h] - p.rel_bias[15 * 4 + h]) * LOG2E; }
    for (int i = gt; i < M * 16; i += NGT) { const int m = i >> 4, j = i & 15; const float inv_freq = powf(10000.f, -(float)(2 * j) / 32.f);
        const float ang = (float)p.positions[m] * inv_freq; ((float*)(ws + WS_CS))[i] = cosf(ang); ((float*)(ws + WS_SN))[i] = sinf(ang); }
    for (int i = gt; i < NL * 96 * 128; i += NGT) { const int l = i / (96 * 128), r = i % (96 * 128); ((u32x4*)(ws + WS_WIN + (size_t)l * 6144 * 2048 + (size_t)2976 * 2048))[r] = (u32x4){0u, 0u, 0u, 0u}; }
    for (int i = gt; i < NL * 48 * 1024; i += NGT) { const int l = i / (48 * 1024), r = i % (48 * 1024), o = r >> 10, k = r & 1023;
        const float v = o < 32 ? p.router_e_w[((size_t)l * D + k) * 32 + o] : (o < 36 ? p.router_g_w[((size_t)l * D + k) * 4 + (o - 32)] : 0.f);
        ((bf16*)(ws + WS_WRT))[i] = (bf16)(cvtpk(v, 0.f) & 0xffffu); }
    for (int i = gt; i < NL * 1024 * 16; i += NGT) { const int rr = i >> 4, q = i & 15; ((u32x4*)(ws + WS_WUKV + (size_t)rr * 512 + 256))[q] = (u32x4){0u, 0u, 0u, 0u}; }
    LAS float* scr = (LAS float*)(F.lds + 49152 + F.wave * 8448);
    for (int it = F.gw; it < IT_TOTAL; it += F.NGW) {
        const int l = it / IT_LAYER; int r = it % IT_LAYER;
        if (r < IT_IN1) { const int kb = r / 93, nb = r % 93, n0 = 32 * nb;
            const int sc0 = n0 < 1024 ? (n0 & ~255) + 64 * ((n0 >> 5) & 3) + 32 * ((n0 >> 7) & 1) : n0;
            transpose_blk(p.w_in + (size_t)l * D * 6048, 6048, sc0, 64 * kb, (bf16*)(ws + WS_WIN) + (size_t)l * 6144 * 1024, n0, 1024, nullptr, scr, F.lane); continue; } r -= IT_IN1;
        if (r < IT_IN2) { transpose_item(p.w_in + (size_t)l * D * 6048, 1024, 6048, 2976, 3072, (bf16*)(ws + WS_WIN) + (size_t)l * 6144 * 1024, 3072, scr, r, F.lane); continue; } r -= IT_IN2;
        if (r < IT_UQ) { const int kb = r / 24, nb = r % 24, n0 = 32 * nb, tt = n0 >> 8, bj = (n0 >> 7) & 1, wc = (n0 >> 5) & 3;
            const int sc0 = tt < 2 ? (4 * tt + wc) * 96 + 32 * bj : (4 * bj + wc) * 96 + 64;
            transpose_blk(p.mla_w_uq + (size_t)l * 256 * 768, 768, sc0, 64 * kb, (bf16*)(ws + WS_WUQ) + (size_t)l * 768 * 256, n0, 256, p.mla_lat_g + l * 384, scr, F.lane); continue; } r -= IT_UQ;
        if (r < IT_UKV) { const int kb = r / 32, nb = r % 32, n0 = 32 * nb, tt = n0 >> 8, bj = (n0 >> 7) & 1, wc = (n0 >> 5) & 3;
            const int sc0 = tt < 2 ? (4 * tt + wc) * 128 + 32 * bj : (4 * (tt - 2) + wc) * 128 + 64 + 32 * bj;
            transpose_blk(p.mla_w_ukv + (size_t)l * 128 * 1024, 1024, sc0, 64 * kb, (bf16*)(ws + WS_WUKV) + (size_t)l * 1024 * 256, n0, 256, p.mla_lat_g + l * 384 + 256, scr, F.lane); continue; } r -= IT_UKV;
        if (r < 3 * IT_BR) { const int n = r / IT_BR; transpose_item(p.w_branch + ((size_t)l * 3 + n) * 512 * 1024, 512, 1024, 0, 1024, (bf16*)(ws + WS_WBR) + ((size_t)l * 3 + n) * 1024 * 512, 0, scr, r % IT_BR, F.lane); continue; } r -= 3 * IT_BR;
        if (r < IT_OUT) { transpose_item(p.w_out + (size_t)l * D * D, 1024, 1024, 0, 1024, (bf16*)(ws + WS_WOUT) + (size_t)l * D * D, 0, scr, r, F.lane); continue; } r -= IT_OUT;
        const int e = r / IT_EXP, q = r % IT_EXP; const size_t le = (size_t)l * 32 + e;
        if (q < 256) { const int jj = q >> 6; const float* src = ((jj & 1) ? p.w_e_up : p.w_e_gate) + le * 1024 * 256;
            transpose_item(src, 1024, 256, (jj >> 1) * 128, 128, (bf16*)(ws + WS_WGU) + le * 512 * 1024, jj * 128, scr, q & 63, F.lane); }
        else transpose_item(p.w_e_down + le * 256 * 1024, 256, 1024, 0, 1024, (bf16*)(ws + WS_WDN) + le * 1024 * 256, 0, scr, q - 256, F.lane);
    }
}

template <int MODE>
__device__ __forceinline__ void row_normmod(Frame& F, const float* xin, bf16* X, const bf16* Z, const float* gateprev, const float* g, const float* shift, const float* scale, bf16* H, float* out) {
    constexpr int R = 2;
    const int mb = (F.bid & 7) * 2048 + (F.bid >> 3) * 64 + F.wave;
    for (int kq = 0; kq < 8; kq += R) { const int m0 = mb + 8 * kq;
        f32x4 v[R][4]; u32x2 z0[R][4], z1[R][4];
#pragma unroll
        for (int r = 0; r < R; ++r) { const int m = m0 + 8 * r;
#pragma unroll
            for (int j = 0; j < 4; ++j) { const int d = 4 * F.lane + 256 * j;
                if (MODE == 0) v[r][j] = *(const GAS f32x4*)(xin + (size_t)m * D + d);
                else { const u32x2 xb = *(const GAS u32x2*)(X + (size_t)m * D + d); v[r][j] = (f32x4){bf_lo(xb.x), bf_hi(xb.x), bf_lo(xb.y), bf_hi(xb.y)}; }
                if (MODE >= 2) { z0[r][j] = *(const GAS u32x2*)(Z + zrow(2 * m) + d); z1[r][j] = *(const GAS u32x2*)(Z + zrow(2 * m + 1) + d); } } }
#pragma unroll
        for (int r = 0; r < R; ++r) { const int m = m0 + 8 * r; const int b = m / S;
#pragma unroll
            for (int j = 0; j < 4; ++j) { const int d = 4 * F.lane + 256 * j;
                if (MODE >= 2) { const f32x4 gt = *(const GAS f32x4*)(gateprev + (size_t)b * 6 * D + d);
                    v[r][j].x += gt.x * (bf_lo(z0[r][j].x) + bf_lo(z1[r][j].x)); v[r][j].y += gt.y * (bf_hi(z0[r][j].x) + bf_hi(z1[r][j].x));
                    v[r][j].z += gt.z * (bf_lo(z0[r][j].y) + bf_lo(z1[r][j].y)); v[r][j].w += gt.w * (bf_hi(z0[r][j].y) + bf_hi(z1[r][j].y)); }
                if (MODE == 2) { u32x2 xo; xo.x = cvtpk(v[r][j].x, v[r][j].y); xo.y = cvtpk(v[r][j].z, v[r][j].w); *(GAS u32x2*)(X + (size_t)m * D + d) = xo;
                    v[r][j] = (f32x4){bf_lo(xo.x), bf_hi(xo.x), bf_lo(xo.y), bf_hi(xo.y)}; }
                if (MODE == 3) *(GAS f32x4*)(out + (size_t)m * D + d) = v[r][j]; }
            if (MODE == 3) continue;
            float s = 0.f;
#pragma unroll
            for (int j = 0; j < 4; ++j) s += (v[r][j].x * v[r][j].x + v[r][j].y * v[r][j].y) + (v[r][j].z * v[r][j].z + v[r][j].w * v[r][j].w);
            const float rstd = rsqrtf(wave_sum(s) * (1.f / D) + 1e-6f);
#pragma unroll
            for (int j = 0; j < 4; ++j) { const int d = 4 * F.lane + 256 * j;
                const f32x4 gg = *(const GAS f32x4*)(g + d), sc = *(const GAS f32x4*)(scale + (size_t)b * 6 * D + d), sh = *(const GAS f32x4*)(shift + (size_t)b * 6 * D + d);
                const float o0 = v[r][j].x * rstd * gg.x * (1.f + sc.x) + sh.x, o1 = v[r][j].y * rstd * gg.y * (1.f + sc.y) + sh.y, o2 = v[r][j].z * rstd * gg.z * (1.f + sc.z) + sh.z, o3 = v[r][j].w * rstd * gg.w * (1.f + sc.w) + sh.w;
                u32x2 o; o.x = cvtpk(o0, o1); o.y = cvtpk(o2, o3); st8x(H + (size_t)m * D + d, o); }
        }
    }
}

struct SchedDense {
    static constexpr bool GATHER = false; static constexpr bool HALFM = false; static constexpr bool ACCUM = false;
    __device__ __forceinline__ void a_ready(const GUnit&) const {}
    __device__ __forceinline__ void done(const GUnit&) const {}
    const char* A; const char* B; unsigned lda_b, ldb_b; int nM, nN, nt, G, c;
    __device__ __forceinline__ bool next(int i, GUnit& u) const {
        const long L = (long)i * G + c; const int nwg = nM * nN; if (L >= nwg) return false;
        int wgid = (int)L; { const int q = nwg / 8, r = nwg % 8, xcd = wgid % 8, off = wgid / 8; wgid = (xcd < r ? xcd * (q + 1) : r * (q + 1) + (xcd - r) * q) + off; }
        const int nig = 8 * nN, gid = wgid / nig, fm = gid * 8, gsz = (nM - fm) < 8 ? (nM - fm) : 8;
        const int pm = fm + ((wgid % nig) % gsz), pn = (wgid % nig) / gsz;
        u.A = A + (size_t)pm * 256 * lda_b; u.B = B + (size_t)pn * 256 * ldb_b; u.nt = nt; u.i0 = pm; u.i1 = pn; u.i2 = 0; return true;
    }
    __device__ __forceinline__ void offs(const GUnit&, int R0, int R1, int C0, int C1, unsigned (&oA)[2][2]) const {
        oA[0][0] = (unsigned)R0 * lda_b + C0 * 2u; oA[0][1] = (unsigned)R1 * lda_b + C1 * 2u; oA[1][0] = (unsigned)(R0 + 128) * lda_b + C0 * 2u; oA[1][1] = (unsigned)(R1 + 128) * lda_b + C1 * 2u; }
    __device__ __forceinline__ unsigned ldb_bytes() const { return ldb_b; }
};
struct SchedDensePub : SchedDense {
    unsigned* cnt;
    __device__ __forceinline__ void done(const GUnit& u) const { asm volatile("s_waitcnt vmcnt(0)" ::: "memory"); if ((threadIdx.x & 63) == 0) __hip_atomic_fetch_add(cnt + (u.i0 >> 3), 1u, __ATOMIC_RELAXED, __HIP_MEMORY_SCOPE_AGENT); }
};
struct EpiStoreBf16 {
    bf16* O0; bf16* O1; int split, ldc0, ldc1;
    __device__ __forceinline__ void operator()(const f32x4 (&acc)[2][2][4][2], const GUnit& u, int wr, int wc, int fr, int fq) const {
        const int pn = u.i1; bf16* base; int ldc; if (pn < split) { base = O0 + 256 * pn; ldc = ldc0; } else { base = O1 + 256 * (pn - split); ldc = ldc1; }
        const int row0 = u.i0 * 256 + wr * 64 + fr, col0 = wc * 32 + 8 * fq;
#pragma unroll
        for (int ai = 0; ai < 2; ++ai)
#pragma unroll
            for (int m = 0; m < 4; ++m) { bf16* rowp = base + (size_t)(row0 + ai * 128 + m * 16) * ldc + col0;
#pragma unroll
                for (int bj = 0; bj < 2; ++bj) { const f32x4 v0 = acc[ai][bj][m][0], v1 = acc[ai][bj][m][1];
                    u32x4 w; w.x = cvtpk(v0[0], v0[1]); w.y = cvtpk(v0[2], v0[3]); w.z = cvtpk(v1[0], v1[1]); w.w = cvtpk(v1[2], v1[3]);
                    st16(rowp + bj * 128, w); } }
    }
};
struct EpiG1 {
    bf16* Y1; bf16* XG; bf16* KR; float* ST; float* ST2; const float* gq; const float* kg; const float* CS; const float* SN;
    __device__ __forceinline__ void operator()(const f32x4 (&acc)[2][2][4][2], const GUnit& u, int wr, int wc, int fr, int fq) const {
        const int pn = u.i1; const int row0 = u.i0 * 256 + wr * 64 + fr;
        if (pn < 4) {
            const float* g = gq + (pn >> 1) * 64; const float mul = pn < 2 ? 0.125f * LOG2E : 1.f;
            f32x4 gv[2][2];
#pragma unroll
            for (int bj = 0; bj < 2; ++bj)
#pragma unroll
                for (int n = 0; n < 2; ++n) gv[bj][n] = *(const GAS f32x4*)(g + 32 * bj + 8 * fq + 4 * n);
#pragma unroll
            for (int ai = 0; ai < 2; ++ai)
#pragma unroll
                for (int m = 0; m < 4; ++m) {
                    float s = 0.f;
#pragma unroll
                    for (int bj = 0; bj < 2; ++bj)
#pragma unroll
                        for (int n = 0; n < 2; ++n) { const f32x4 v = acc[ai][bj][m][n]; s += (v[0] * v[0] + v[1] * v[1]) + (v[2] * v[2] + v[3] * v[3]); }
                    s += sw<16>(s); s = xsum32(s);
                    const float rstd = rsqrtf(s * (1.f / 64.f) + 1e-6f) * mul;
                    bf16* rowp = Y1 + (size_t)(row0 + ai * 128 + m * 16) * 3072 + 256 * pn + 64 * wc + 8 * fq;
#pragma unroll
                    for (int bj = 0; bj < 2; ++bj) { const f32x4 v0 = acc[ai][bj][m][0] * rstd * gv[bj][0], v1 = acc[ai][bj][m][1] * rstd * gv[bj][1];
                        u32x4 w; w.x = cvtpk(v0[0], v0[1]); w.y = cvtpk(v0[2], v0[3]); w.z = cvtpk(v1[0], v1[1]); w.w = cvtpk(v1[2], v1[3]);
                        st16(rowp + 32 * bj, w); }
                }
            return;
        }
        if (pn >= 12) {
            unsigned char* gb = (unsigned char*)XG + 256 * (pn - 12) + wc * 32 + 8 * fq;
#pragma unroll
            for (int ai = 0; ai < 2; ++ai)
#pragma unroll
                for (int m = 0; m < 4; ++m) { unsigned char* rowp = gb + (size_t)(row0 + ai * 128 + m * 16) * 3072;
#pragma unroll
                    for (int bj = 0; bj < 2; ++bj) { const f32x4 v0 = acc[ai][bj][m][0], v1 = acc[ai][bj][m][1]; unsigned q[8];
#pragma unroll
                        for (int t = 0; t < 8; ++t) { const float x = t < 4 ? v0[t & 3] : v1[t & 3]; q[t] = (unsigned)(fast_sigmoid(x) * 255.f + 0.5f); q[t] = q[t] < 1u ? 1u : q[t]; }
                        u32x2 w; w.x = q[0] | (q[1] << 8) | (q[2] << 16) | (q[3] << 24); w.y = q[4] | (q[5] << 8) | (q[6] << 16) | (q[7] << 24);
                        *(GAS u32x2*)(rowp + bj * 128) = w; } }
            return;
        }
        bf16* base = Y1 + 256 * pn; const int col0 = wc * 32 + 8 * fq;
#pragma unroll
        for (int ai = 0; ai < 2; ++ai)
#pragma unroll
            for (int m = 0; m < 4; ++m) { bf16* rowp = base + (size_t)(row0 + ai * 128 + m * 16) * 3072 + col0;
#pragma unroll
                for (int bj = 0; bj < 2; ++bj) { const f32x4 v0 = acc[ai][bj][m][0], v1 = acc[ai][bj][m][1];
                    u32x4 w; w.x = cvtpk(v0[0], v0[1]); w.y = cvtpk(v0[2], v0[3]); w.z = cvtpk(v1[0], v1[1]); w.w = cvtpk(v1[2], v1[3]);
                    st16(rowp + bj * 128, w); } }
        if (pn == 8 || pn == 9) {
#pragma unroll
            for (int ai = 0; ai < 2; ++ai)
#pragma unroll
                for (int m = 0; m < 4; ++m) { float s = 0.f;
#pragma unroll
                    for (int bj = 0; bj < 2; ++bj)
#pragma unroll
                        for (int n = 0; n < 2; ++n) { const f32x4 v = acc[ai][bj][m][n]; const float a0 = gelu_tanh(v[0]), a1 = gelu_tanh(v[1]), a2 = gelu_tanh(v[2]), a3 = gelu_tanh(v[3]); s += (a0 * a0 + a1 * a1) + (a2 * a2 + a3 * a3); }
                    s += sw<16>(s); s = xsum32(s);
                    if (fq == 0) ST2[(size_t)(row0 + ai * 128 + m * 16) * 8 + (pn - 8) * 4 + wc] = s; }
        }
        if (pn == 10 || pn == 11) {
#pragma unroll
            for (int ai = 0; ai < 2; ++ai)
#pragma unroll
                for (int m = 0; m < 4; ++m) { float s = 0.f;
#pragma unroll
                    for (int bj = 0; bj < 2; ++bj) { if (pn == 11 && bj == 1) continue;
#pragma unroll
                        for (int n = 0; n < 2; ++n) { const f32x4 v = acc[ai][bj][m][n]; s += (v[0] * v[0] + v[1] * v[1]) + (v[2] * v[2] + v[3] * v[3]); } }
                    s += sw<16>(s); s = xsum32(s);
                    if (fq == 0) ST[(size_t)(row0 + ai * 128 + m * 16) * 8 + (pn - 10) * 4 + wc] = s; }
        }
        if (pn == 11 && wc == 0) {
            f32x4 g0 = *(const GAS f32x4*)(kg + 64 + 8 * fq), g1 = *(const GAS f32x4*)(kg + 64 + 8 * fq + 4);
#pragma unroll
            for (int ai = 0; ai < 2; ++ai)
#pragma unroll
                for (int m = 0; m < 4; ++m) { const size_t row = row0 + ai * 128 + m * 16;
                    f32x4 v0 = acc[ai][1][m][0], v1 = acc[ai][1][m][1];
                    float s = (v0[0] * v0[0] + v0[1] * v0[1]) + (v0[2] * v0[2] + v0[3] * v0[3]) + (v1[0] * v1[0] + v1[1] * v1[1]) + (v1[2] * v1[2] + v1[3] * v1[3]);
                    s += sw<16>(s); s = xsum32(s);
                    const float rstd = rsqrtf(s * (1.f / 32.f) + 1e-6f);
                    v0 = v0 * rstd * g0; v1 = v1 * rstd * g1;
                    const f32x4 c0 = *(const GAS f32x4*)(CS + row * 16 + 8 * (fq & 1)), c1 = *(const GAS f32x4*)(CS + row * 16 + 8 * (fq & 1) + 4);
                    const f32x4 s0 = *(const GAS f32x4*)(SN + row * 16 + 8 * (fq & 1)), s1 = *(const GAS f32x4*)(SN + row * 16 + 8 * (fq & 1) + 4);
                    f32x4 o0, o1;
#pragma unroll
                    for (int i = 0; i < 4; ++i) { const float p0 = xget32(v0[i], fq >= 2), p1 = xget32(v1[i], fq >= 2);
                        o0[i] = fq < 2 ? v0[i] * c0[i] - p0 * s0[i] : v0[i] * c0[i] + p0 * s0[i]; o1[i] = fq < 2 ? v1[i] * c1[i] - p1 * s1[i] : v1[i] * c1[i] + p1 * s1[i]; }
                    u32x4 w; w.x = cvtpk(o0[0], o0[1]); w.y = cvtpk(o0[2], o0[3]); w.z = cvtpk(o1[0], o1[1]); w.w = cvtpk(o1[2], o1[3]);
                    *(GAS u32x4*)(KR + row * 32 + 8 * fq) = w; }
        }
    }
};
template <int WHICH>
struct EpiG2 {
    bf16* O; const float* ST; const float* g; const float* CS; const float* SN;
    __device__ __forceinline__ void operator()(const f32x4 (&acc)[2][2][4][2], const GUnit& u, int wr, int wc, int fr, int fq) const {
        const int pn = u.i1; const int row0 = u.i0 * 256 + wr * 64 + fr; const float qs = 0.10206207261596577f * LOG2E;
#pragma unroll
        for (int ai = 0; ai < 2; ++ai)
#pragma unroll
            for (int m = 0; m < 4; ++m) { const size_t row = row0 + ai * 128 + m * 16;
                const f32x4 sp = *(const GAS f32x4*)(ST + row * 8 + WHICH * 4);
                const float r0 = rsqrtf(((sp[0] + sp[1]) + (sp[2] + sp[3])) * (WHICH ? 1.f / 128.f : 1.f / 256.f) + 1e-6f);
                f32x4 v[2][2];
#pragma unroll
                for (int bj = 0; bj < 2; ++bj)
#pragma unroll
                    for (int n = 0; n < 2; ++n) v[bj][n] = acc[ai][bj][m][n] * r0;
                if (pn < 2) {
                    float s = 0.f;
#pragma unroll
                    for (int bj = 0; bj < 2; ++bj)
#pragma unroll
                        for (int n = 0; n < 2; ++n) s += (v[bj][n][0] * v[bj][n][0] + v[bj][n][1] * v[bj][n][1]) + (v[bj][n][2] * v[bj][n][2] + v[bj][n][3] * v[bj][n][3]);
                    s += sw<16>(s); s = xsum32(s);
                    const float rstd = rsqrtf(s * (1.f / 64.f) + 1e-6f) * (WHICH ? 1.f : qs);
                    bf16* op = O + row * (WHICH ? 1024 : 768) + (4 * pn + wc) * (WHICH ? 128 : 96) + 8 * fq;
#pragma unroll
                    for (int bj = 0; bj < 2; ++bj) { const f32x4 g0 = *(const GAS f32x4*)(g + 32 * bj + 8 * fq), g1 = *(const GAS f32x4*)(g + 32 * bj + 8 * fq + 4);
                        const f32x4 a = v[bj][0] * rstd * g0, b = v[bj][1] * rstd * g1;
                        u32x4 w; w.x = cvtpk(a[0], a[1]); w.y = cvtpk(a[2], a[3]); w.z = cvtpk(b[0], b[1]); w.w = cvtpk(b[2], b[3]);
                        st16(op + 32 * bj, w); }
                } else if (WHICH == 1) {
                    bf16* op = O + row * 1024 + (4 * (pn - 2) + wc) * 128 + 64 + 8 * fq;
#pragma unroll
                    for (int bj = 0; bj < 2; ++bj) { u32x4 w; w.x = cvtpk(v[bj][0][0], v[bj][0][1]); w.y = cvtpk(v[bj][0][2], v[bj][0][3]); w.z = cvtpk(v[bj][1][0], v[bj][1][1]); w.w = cvtpk(v[bj][1][2], v[bj][1][3]);
                        st16(op + 32 * bj, w); }
                } else {
                    const f32x4 c0 = *(const GAS f32x4*)(CS + row * 16 + 8 * (fq & 1)), c1 = *(const GAS f32x4*)(CS + row * 16 + 8 * (fq & 1) + 4);
                    const f32x4 s0 = *(const GAS f32x4*)(SN + row * 16 + 8 * (fq & 1)), s1 = *(const GAS f32x4*)(SN + row * 16 + 8 * (fq & 1) + 4);
                    const f32x4 g0 = *(const GAS f32x4*)(g + 64 + 8 * fq), g1 = *(const GAS f32x4*)(g + 64 + 8 * fq + 4);
#pragma unroll
                    for (int bj = 0; bj < 2; ++bj) {
                        float s = (v[bj][0][0] * v[bj][0][0] + v[bj][0][1] * v[bj][0][1]) + (v[bj][0][2] * v[bj][0][2] + v[bj][0][3] * v[bj][0][3]) + (v[bj][1][0] * v[bj][1][0] + v[bj][1][1] * v[bj][1][1]) + (v[bj][1][2] * v[bj][1][2] + v[bj][1][3] * v[bj][1][3]);
                        s += sw<16>(s); s = xsum32(s);
                        const float rstd = rsqrtf(s * (1.f / 32.f) + 1e-6f) * qs;
                        const f32x4 a = v[bj][0] * rstd * g0, b = v[bj][1] * rstd * g1; f32x4 o0, o1;
#pragma unroll
                        for (int i = 0; i < 4; ++i) { const float p0 = xget32(a[i], fq >= 2), p1 = xget32(b[i], fq >= 2);
                            o0[i] = fq < 2 ? a[i] * c0[i] - p0 * s0[i] : a[i] * c0[i] + p0 * s0[i]; o1[i] = fq < 2 ? b[i] * c1[i] - p1 * s1[i] : b[i] * c1[i] + p1 * s1[i]; }
                        u32x4 w; w.x = cvtpk(o0[0], o0[1]); w.y = cvtpk(o0[2], o0[3]); w.z = cvtpk(o1[0], o1[1]); w.w = cvtpk(o1[2], o1[3]);
                        st16(O + row * 768 + (4 * bj + wc) * 96 + 64 + 8 * fq, w); }
                }
            }
    }
};
struct EpiG2Both {
    EpiG2<0> q; EpiG2<1> kv;
    __device__ __forceinline__ void operator()(const f32x4 (&acc)[2][2][4][2], const GUnit& u, int wr, int wc, int fr, int fq) const { if (u.i2) kv(acc, u, wr, wc, fr, fq); else q(acc, u, wr, wc, fr, fq); }
};
}
namespace fk {
typedef short v4i16_t __attribute__((ext_vector_type(4)));
typedef LAS const char* lds_cptr;
__device__ __forceinline__ float grp_sum(float s, int lanes) {
    if (lanes > 1) s += sw<1>(s); if (lanes > 2) s += sw<2>(s); if (lanes > 4) s += sw<4>(s);
    if (lanes > 8) s += sw<8>(s); if (lanes > 16) s += sw<16>(s); if (lanes > 32) s = xsum32(s);
    return s;
}
__device__ __forceinline__ void unpack8(const u32x4 w, float (&v)[8]) { v[0] = bf_lo(w.x); v[1] = bf_hi(w.x); v[2] = bf_lo(w.y); v[3] = bf_hi(w.y); v[4] = bf_lo(w.z); v[5] = bf_hi(w.z); v[6] = bf_lo(w.w); v[7] = bf_hi(w.w); }
__device__ __forceinline__ u32x4 pack8(const float (&v)[8]) { u32x4 w; w.x = cvtpk(v[0], v[1]); w.y = cvtpk(v[2], v[3]); w.z = cvtpk(v[4], v[5]); w.w = cvtpk(v[6], v[7]); return w; }
__device__ __forceinline__ void norm8(float (&v)[8], int lanes, float inv_width, const float* g, float mul) {
    float s = 0.f;
#pragma unroll
    for (int t = 0; t < 8; ++t) s += v[t] * v[t];
    const float rstd = rsqrtf(grp_sum(s, lanes) * inv_width + 1e-6f) * mul;
#pragma unroll
    for (int t = 0; t < 8; ++t) v[t] = v[t] * rstd * g[t];
}
__device__ __forceinline__ void rope8(float (&v)[8], int j, const float* cs, const float* sn) {
    const int i0 = 8 * (j & 1);
#pragma unroll
    for (int t = 0; t < 8; ++t) { const float o = sw<2>(v[t]); const float c = cs[i0 + t], s = sn[i0 + t]; v[t] = (j < 2) ? (v[t] * c - o * s) : (v[t] * c + o * s); }
}
__device__ __forceinline__ void prep1(Frame& F, const Params& p, int l) {
    bf16* Y1 = (bf16*)(F.ws + WS_Y1); bf16* KR = (bf16*)(F.ws + WS_KR); const float* CS = (const float*)(F.ws + WS_CS); const float* SN = (const float*)(F.ws + WS_SN);
    const float* gq = p.diff_qk_g + l * 128; const float* gk = gq + 64; const float* latg = p.mla_lat_g + l * 384; const float* kg = p.mla_qk_g + l * 192 + 96;
    const int ln = F.lane;
    const int seg = ln < 32 ? 0 : (ln < 48 ? 1 : (ln < 52 ? 2 : 3)); const int j3 = seg == 0 ? ln : (seg == 1 ? ln - 32 : ln - 48);
    const int off3 = seg == 0 ? 2560 + 8 * j3 : (seg == 1 ? 2816 + 8 * j3 : 2944 + 8 * (j3 & 3));
    const float* g3 = seg == 0 ? latg + 8 * j3 : (seg == 1 ? latg + 256 + 8 * j3 : kg + 64 + 8 * (j3 & 3));
    constexpr int R = 2;
    for (int m0 = F.gw; m0 < M; m0 += R * F.NGW) {
        u32x4 wq[R], wk[R], w3[R];
#pragma unroll
        for (int r = 0; r < R; ++r) { bf16* y = Y1 + (size_t)(m0 + r * F.NGW) * 3072; wq[r] = *(GAS u32x4*)(y + 8 * ln); wk[r] = *(GAS u32x4*)(y + 512 + 8 * ln); w3[r] = *(GAS u32x4*)(y + off3); }
#pragma unroll
        for (int r = 0; r < R; ++r) { const int m = m0 + r * F.NGW; bf16* y = Y1 + (size_t)m * 3072; float v[8];
            unpack8(wq[r], v); norm8(v, 8, 1.f / 64.f, gq + (8 * ln & 63), 0.125f * LOG2E); *(GAS u32x4*)(y + 8 * ln) = pack8(v);
            unpack8(wk[r], v); norm8(v, 8, 1.f / 64.f, gk + (8 * ln & 63), 1.f); *(GAS u32x4*)(y + 512 + 8 * ln) = pack8(v);
            unpack8(w3[r], v);
            float s = 0.f;
#pragma unroll
            for (int t = 0; t < 8; ++t) s += v[t] * v[t];
            s += sw<1>(s); s += sw<2>(s); const float s4 = s; s += sw<4>(s); s += sw<8>(s); const float s16 = s; s += sw<16>(s); const float s32 = s;
            const float rstd = seg == 0 ? rsqrtf(s32 * (1.f / 256.f) + 1e-6f) : (seg == 1 ? rsqrtf(s16 * (1.f / 128.f) + 1e-6f) : rsqrtf(s4 * (1.f / 32.f) + 1e-6f));
#pragma unroll
            for (int t = 0; t < 8; ++t) v[t] = v[t] * rstd * g3[t];
            if (seg <= 1) *(GAS u32x4*)(y + off3) = pack8(v);
            { float vr[8];
#pragma unroll
              for (int t = 0; t < 8; ++t) vr[t] = v[t];
              rope8(vr, j3 & 3, CS + (size_t)m * 16, SN + (size_t)m * 16);
              if (seg == 2) *(GAS u32x4*)(KR + (size_t)m * 32 + 8 * j3) = pack8(vr); }
        }
    }
}
__device__ __forceinline__ void prep2(Frame& F, const Params& p, int l) {
    bf16* QC = (bf16*)(F.ws + WS_QC); bf16* KVC = (bf16*)(F.ws + WS_KVC); const float* CS = (const float*)(F.ws + WS_CS); const float* SN = (const float*)(F.ws + WS_SN);
    const float* g0 = p.mla_qk_g + l * 192; const float* g1 = g0 + 96; const int ln = F.lane; const float qs = 0.10206207261596577f * LOG2E;
    constexpr int R = 2;
    const int qoff = (ln >> 3) * 96 + (ln & 7) * 8, roff = ((ln & 31) >> 2) * 96 + 64 + (ln & 3) * 8, koff = (ln >> 3) * 128 + (ln & 7) * 8;
    for (int m0 = F.gw; m0 < M; m0 += R * F.NGW) {
        u32x4 wq[R], wr[R], wk[R];
#pragma unroll
        for (int r = 0; r < R; ++r) { const size_t m = m0 + r * F.NGW; wq[r] = *(GAS u32x4*)(QC + m * 768 + qoff); wr[r] = *(GAS u32x4*)(QC + m * 768 + roff); wk[r] = *(GAS u32x4*)(KVC + m * 1024 + koff); }
#pragma unroll
        for (int r = 0; r < R; ++r) { const size_t m = m0 + r * F.NGW; float v[8];
            unpack8(wq[r], v); norm8(v, 8, 1.f / 64.f, g0 + (ln & 7) * 8, qs); *(GAS u32x4*)(QC + m * 768 + qoff) = pack8(v);
            unpack8(wr[r], v); norm8(v, 4, 1.f / 32.f, g0 + 64 + (ln & 3) * 8, qs); rope8(v, ln & 3, CS + m * 16, SN + m * 16); if (ln < 32) *(GAS u32x4*)(QC + m * 768 + roff) = pack8(v);
            unpack8(wk[r], v); norm8(v, 8, 1.f / 64.f, g1 + (ln & 7) * 8, 1.f); *(GAS u32x4*)(KVC + m * 1024 + koff) = pack8(v); }
    }
}

__device__ __forceinline__ int crow(int r, int hi) { return (r & 3) + 8 * (r >> 2) + 4 * hi; }
__device__ __forceinline__ s16x4 vtr(lds_cptr p) { return __builtin_bit_cast(s16x4, __builtin_amdgcn_ds_read_tr16_b64_v4i16((LAS v4i16_t*)p)); }
#define ATT_WAITV(n) asm volatile("s_waitcnt vmcnt(" #n ")" ::: "memory")
__device__ __forceinline__ void glds16(const void* gsrc, unsigned lds_dst) { unsigned keep;
    asm volatile("s_mov_b32 %0, m0\n\ts_mov_b32 m0, %2\n\ts_nop 0\n\tglobal_load_lds_dwordx4 %1, off\n\ts_mov_b32 m0, %0" : "=&s"(keep) : "v"(gsrc), "s"(lds_dst) : "memory"); }
template <bool DUAL>
__device__ __forceinline__ void attn_unit(Frame& F, const Params& p, int l, int b, int h, int qb) {
    constexpr int NQF = DUAL ? 4 : 6, NQK = 2 * NQF, NVB = DUAL ? 4 : 2, NPV = 4 * NVB, KP = DUAL ? 16 : 12, NP = DUAL ? 32 : 24, PP = NP / 8;
    constexpr int KB = KP * 1024, VB = (DUAL ? 16 : 8) * 1024, VOFF = 3 * KB, DUMMY = VOFF + 3 * VB;
    constexpr int QROWS = DUAL ? 128 : 256;
    int lane = F.lane; asm volatile("" : "+v"(lane));
    const int wid = F.wave, r32_ = lane & 31, hi_ = lane >> 5;
    const int wq = DUAL ? (wid & 3) : wid, map = DUAL ? (wid >> 2) : 0;
    const int q0 = qb * QROWS + wq * 32;
    const int cw = q0 >> 6, NT = ((qb * QROWS + QROWS) >> 6);
    const size_t tok0 = (size_t)b * S;
    LAS unsigned char* lds = F.lds; const unsigned lds0 = (unsigned)(uintptr_t)F.lds;
    LAS float* wsf = (LAS float*)(lds + TAB_OFF + 4096 + wid * 256);
    LAS float* tab = (LAS float*)(lds + TAB_OFF);
    const bf16* src[PP]; int pst[PP], pc[PP]; bool pk[PP];
#pragma unroll
    for (int i = 0; i < PP; ++i) {
        const int x = wid * PP + i;
        if (DUAL) {
            const bf16* Y1 = (const bf16*)(F.ws + WS_Y1);
            if (x < KP) src[i] = Y1 + (tok0 + lane) * 3072 + 512 + h * 128 + (x >> 3) * 64 + (x & 7) * 8;
            else { const int v = x - KP; src[i] = Y1 + (tok0 + 16 * (v & 3) + (lane >> 2)) * 3072 + 1024 + h * 128 + (v >> 2) * 32 + (lane & 3) * 8; }
            pk[i] = x < KP; pst[i] = 64 * 3072; pc[i] = (x < KP ? x : x - KP) * 1024;
        } else {
            const bf16* KVC = (const bf16*)(F.ws + WS_KVC); const bf16* KR = (const bf16*)(F.ws + WS_KR);
            const int xx = x < 20 ? x : 0;
            if (xx < 8) src[i] = KVC + (tok0 + lane) * 1024 + h * 128 + xx * 8;
            else if (xx < 12) src[i] = KR + (tok0 + lane) * 32 + (xx - 8) * 8;
            else { const int v = xx - 12; src[i] = KVC + (tok0 + 16 * (v & 3) + (lane >> 2)) * 1024 + h * 128 + 64 + (v >> 2) * 32 + (lane & 3) * 8; }
            pk[i] = x < 12; pst[i] = x < 8 ? 64 * 1024 : (x < 12 ? 64 * 32 : (x < 20 ? 64 * 1024 : 0)); pc[i] = x < 12 ? x * 1024 : (x < 20 ? (x - 12) * 1024 : 3 * VB + (x - 20) * 1024);
        }
        pst[i] = __builtin_amdgcn_readfirstlane(pst[i]); pc[i] = __builtin_amdgcn_readfirstlane(pc[i]);
    }
#define ATT_BATCH(s, kd, vd) do { const int tk_ = ((s) + 3 < NT) ? (s) + 3 : NT - 1; const int tv0_ = ((s) + 1 < NT) ? (s) + 1 : NT - 1; const int tv_ = tv0_ < 0 ? 0 : tv0_; \
        _Pragma("unroll") for (int i_ = 0; i_ < PP; ++i_) { const int tile_ = pk[i_] ? tk_ : tv_; const unsigned dst_ = (unsigned)((pk[i_] ? (kd) : VOFF + (vd)) + pc[i_]); \
            glds16(src[i_] + (unsigned)(tile_ * pst[i_]), (unsigned)__builtin_amdgcn_readfirstlane(lds0 + dst_)); } } while (0)
    bf16x8 qf[NQF];
    {
        const bf16* Qw = DUAL ? (const bf16*)(F.ws + WS_Y1) + (tok0 + q0 + r32_) * 3072 + h * 128 + map * 64 : (const bf16*)(F.ws + WS_QC) + (tok0 + q0 + r32_) * 768 + h * 96;
#pragma unroll
        for (int d0 = 0; d0 < NQF; ++d0) qf[d0] = *(const GAS bf16x8*)(Qw + d0 * 16 + hi_ * 8);
    }
    if (DUAL) { if (F.tid < 256) tab[F.tid] = ((const float*)(F.ws + WS_BT))[h * 256 + F.tid]; }
    ATT_BATCH(-3, 0, VB); ATT_BATCH(-2, KB, 2 * VB); ATT_BATCH(-1, 2 * KB, 0);
    f32x16 o[NVB];
#pragma unroll
    for (int d = 0; d < NVB; ++d) o[d] = (f32x16){0.f, 0.f, 0.f, 0.f, 0.f, 0.f, 0.f, 0.f, 0.f, 0.f, 0.f, 0.f, 0.f, 0.f, 0.f, 0.f};
    float mrun = 0.f, lrun = 0.f;
    f32x16 negm = (f32x16){0.f, 0.f, 0.f, 0.f, 0.f, 0.f, 0.f, 0.f, 0.f, 0.f, 0.f, 0.f, 0.f, 0.f, 0.f, 0.f};
    const int vlane = ((lane >> 4) & 1) * 32 + (lane & 3) * 8 + (4 * hi_ + ((lane & 15) >> 2)) * 64;
    const int koff = (DUAL ? map * 8192 : 0) + hi_ * 1024 + r32_ * 16;
    f32x16 pA0, pA1, pB0, pB1; pA0 = negm; pA1 = negm; pB0 = negm; pB1 = negm;
    bf16x8 kfr[3]; s16x4 vfr[3][2]; unsigned pw[16]; bool resc = false;
#pragma unroll
    for (int i = 0; i < 16; ++i) pw[i] = 0u;
#define ATT_SB() __builtin_amdgcn_sched_barrier(0)
#define ATT_PIN(x) asm volatile("" : "+v"(x))
#define ATT_PEL(P0, P1, i) ((i) < 16 ? P0[(i) & 15] : P1[(i) & 15])
#define ATT_KRD(g, ks_) (*(const LAS bf16x8*)((lds_cptr)(lds + (ks_) + koff) + ((g) >> 1) * 2048 + ((g) & 1) * 512))
#define ATT_KPRE(ks_) do { kfr[0] = ATT_KRD(0, ks_); kfr[1] = ATT_KRD(1, ks_); } while (0)
#define ATT_VRD(g, vs_, w) do { const lds_cptr vb_ = (lds_cptr)(lds + VOFF + (vs_) + vlane) + ((g) % NVB) * 4096 + ((g) / NVB) * 1024; vfr[w][0] = vtr(vb_); vfr[w][1] = vtr(vb_ + 512); } while (0)
#define ATT_VPRE(vs_) do { ATT_VRD(0, vs_, 0); ATT_VRD(1, vs_, 1); } while (0)
#define ATT_PHA(C0, C1, P0, P1, MF, FILL, ks_) do { float sacc_ = 0.f; \
        _Pragma("unroll") for (int g = 0; g < NQK; ++g) { \
            if (MF) { if (g + 2 < NQK) kfr[(g + 2) % 3] = ATT_KRD(g + 2, ks_); \
                if ((g & 1) == 0) C0 = __builtin_amdgcn_mfma_f32_32x32x16_bf16(kfr[g % 3], qf[g >> 1], g < 2 ? negm : C0, 0, 0, 0); \
                else C1 = __builtin_amdgcn_mfma_f32_32x32x16_bf16(kfr[g % 3], qf[g >> 1], g < 2 ? negm : C1, 0, 0, 0); } \
            if (FILL) { \
                _Pragma("unroll") for (int e = (g * 32) / NQK; e < ((g + 1) * 32) / NQK; ++e) sacc_ += ATT_PEL(P0, P1, e); \
                ATT_PIN(sacc_); \
                _Pragma("unroll") for (int w = (g * 16) / NQK; w < ((g + 1) * 16) / NQK; ++w) { pw[w] = cvtpk(ATT_PEL(P0, P1, 2 * w), ATT_PEL(P0, P1, 2 * w + 1)); ATT_PIN(pw[w]); } } \
            ATT_SB(); } \
        if (FILL) lrun += sacc_; } while (0)
#define ATT_PAF(k) __builtin_bit_cast(bf16x8, ((u32x4){pw[4 * (k)], pw[4 * (k) + 1], pw[4 * (k) + 2], pw[4 * (k) + 3]}))
#define ATT_VFR(w) (bf16x8){vfr[w][0][0], vfr[w][0][1], vfr[w][0][2], vfr[w][0][3], vfr[w][1][0], vfr[w][1][1], vfr[w][1][2], vfr[w][1][3]}
#define ATT_PHB(C0, C1, PV, EXPS, vs_) do { \
        _Pragma("unroll") for (int g = 0; g < NPV; ++g) { \
            if (PV) { if (g + 2 < NPV) ATT_VRD(g + 2, vs_, (g + 2) % 3); \
                o[g % NVB] = __builtin_amdgcn_mfma_f32_32x32x16_bf16(ATT_PAF(g / NVB), ATT_VFR(g % 3), o[g % NVB], 0, 0, 0); } \
            if (EXPS) { \
                _Pragma("unroll") for (int e = (g * 32) / NPV; e < ((g + 1) * 32) / NPV; ++e) { if (e < 16) C0[e & 15] = __builtin_amdgcn_exp2f(C0[e & 15]); else C1[e & 15] = __builtin_amdgcn_exp2f(C1[e & 15]); } \
                if (((g * 32) / NPV) < 16) ATT_PIN(C0); else ATT_PIN(C1); } \
            ATT_SB(); } } while (0)
#define ATT_M(t, kd, vd) do { if ((t) <= NT - 1) { if (PP == 4) ATT_WAITV(4); else ATT_WAITV(3); } else ATT_WAITV(0); \
        LDS_WAIT(); __builtin_amdgcn_s_barrier(); if ((t) <= NT - 2) ATT_BATCH(t, kd, vd); } while (0)
#define ATT_DECIDE(C0, C1, t) do { \
        if (DUAL) { if ((t) >= cw - 2) { const int base = 64 * (t) - (q0 + r32_) + 191 + 4 * hi_; \
            _Pragma("unroll") for (int r = 0; r < 16; ++r) { const int kk = (r & 3) + 8 * (r >> 2); C0[r] += tab[base + kk]; C1[r] += tab[base + kk + 32]; } } } \
        float ma = __builtin_fmaxf(__builtin_fmaxf(C0[0], C0[1]), C1[0]), mb = __builtin_fmaxf(__builtin_fmaxf(C0[2], C0[3]), C1[1]); ma = __builtin_fmaxf(__builtin_fmaxf(ma, C1[2]), C1[3]); \
        _Pragma("unroll") for (int r = 4; r < 16; r += 4) { ma = __builtin_fmaxf(__builtin_fmaxf(ma, C0[r]), C0[r + 1]); mb = __builtin_fmaxf(__builtin_fmaxf(mb, C0[r + 2]), C0[r + 3]); \
            ma = __builtin_fmaxf(__builtin_fmaxf(ma, C1[r]), C1[r + 1]); mb = __builtin_fmaxf(__builtin_fmaxf(mb, C1[r + 2]), C1[r + 3]); } \
        float mx = __builtin_fmaxf(ma, mb); { const auto rr_ = __builtin_amdgcn_permlane32_swap(__builtin_bit_cast(unsigned, mx), __builtin_bit_cast(unsigned, mx), false, false); mx = __builtin_fmaxf(__builtin_bit_cast(float, rr_[0]), __builtin_bit_cast(float, rr_[1])); } resc = false; \
        if (__builtin_expect(__any(mx > 8.f), 0)) {                       \
            const float dl = __builtin_fmaxf(mx, 0.f), f = __builtin_amdgcn_exp2f(-dl); mrun += dl; lrun *= f; \
            _Pragma("unroll") for (int r = 0; r < 16; ++r) { C0[r] -= dl; C1[r] -= dl; negm[r] = -mrun; } \
            if (hi_ == 0) wsf[r32_] = f; resc = true; } } while (0)
#define ATT_RESC() do { if (resc) { LDS_WAIT(); \
        _Pragma("unroll") for (int r = 0; r < 16; ++r) { const float fr_ = wsf[crow(r, hi_)]; _Pragma("unroll") for (int d = 0; d < NVB; ++d) o[d][r] *= fr_; } } } while (0)
#define ATT_ROT() do { const int s_ = s0; s0 = s1; s1 = s2; s2 = s_; } while (0)
#define ATT_STEP(C0, C1, P0, P1, t) do { \
        ATT_PHA(C0, C1, P0, P1, true, true, s0 * KB); \
        ATT_M(t, s0 * KB, s1 * VB); \
        ATT_VPRE(s2 * VB); \
        ATT_DECIDE(C0, C1, t); ATT_SB(); ATT_PHB(C0, C1, true, true, s2 * VB); ATT_RESC(); if ((t) + 1 <= cw) ATT_KPRE(s1 * KB); \
        ATT_ROT(); } while (0)
    int s0 = 0, s1 = 1, s2 = 2;
    if (PP == 4) ATT_WAITV(8); else ATT_WAITV(6);
    LDS_WAIT(); __builtin_amdgcn_s_barrier();
    ATT_KPRE(0);
    ATT_PHA(pA0, pA1, pB0, pB1, true, false, 0);
    ATT_M(0, 0, VB);
    ATT_DECIDE(pA0, pA1, 0); ATT_SB();
    ATT_PHB(pA0, pA1, false, true, 0);
    if (1 <= cw) ATT_KPRE(KB);
    ATT_ROT();
    int t = 1;
    for (; t + 1 <= cw; t += 2) {
        ATT_STEP(pB0, pB1, pA0, pA1, t);
        ATT_STEP(pA0, pA1, pB0, pB1, t + 1);
    }
    if (t <= cw) { ATT_STEP(pB0, pB1, pA0, pA1, t); pA0 = pB0; pA1 = pB1; ++t; }
    ATT_PHA(pB0, pB1, pA0, pA1, false, true, 0);
    ATT_M(t, s0 * KB, s1 * VB);
    ATT_VPRE(s2 * VB);
    ATT_PHB(pB0, pB1, true, false, s2 * VB);
    ATT_ROT(); ++t;
    for (; t <= NT; ++t) { ATT_M(t, s0 * KB, s1 * VB); ATT_ROT(); }
#undef ATT_ROT
#undef ATT_STEP
#undef ATT_RESC
#undef ATT_DECIDE
#undef ATT_M
#undef ATT_PHB
#undef ATT_VFR
#undef ATT_PAF
#undef ATT_PHA
#undef ATT_VPRE
#undef ATT_VRD
#undef ATT_KPRE
#undef ATT_KRD
#undef ATT_PEL
#undef ATT_PIN
#undef ATT_SB
#undef ATT_BATCH
    int r32 = r32_, hi = hi_; asm volatile("" : "+v"(r32), "+v"(hi));
    lrun = xsum32(lrun);
    if (hi == 0) wsf[32 + r32] = __builtin_amdgcn_rcpf(lrun);
    LDS_WAIT();
    float rli[16];
#pragma unroll
    for (int r = 0; r < 16; ++r) rli[r] = wsf[32 + crow(r, hi)];
    __builtin_amdgcn_s_barrier();
    if (DUAL) {
        LAS float* stg = (LAS float*)(lds) + (size_t)wq * 32 * 132;
        if (map == 1) {
#pragma unroll
            for (int d = 0; d < NVB; ++d)
#pragma unroll
                for (int r = 0; r < 16; ++r) stg[crow(r, hi) * 132 + d * 32 + r32] = o[d][r] * rli[r];
        }
        LDS_WAIT(); __builtin_amdgcn_s_barrier();
        if (map == 0) {
            const float lam = ((const float*)(F.ws + WS_LAM))[l]; const float li = 1.f - (0.8f - 0.6f * __expf(-0.3f * (float)l));
            float ss[16];
#pragma unroll
            for (int r = 0; r < 16; ++r) { float s = 0.f;
#pragma unroll
                for (int d = 0; d < NVB; ++d) { const float v = o[d][r] * rli[r] - lam * stg[crow(r, hi) * 132 + d * 32 + r32]; o[d][r] = v; s += v * v; }
                ss[r] = s; }
#pragma unroll
            for (int r = 0; r < 16; ++r) { float s = ss[r]; s += sw<1>(s); s += sw<2>(s); s += sw<4>(s); s += sw<8>(s); s += sw<16>(s); ss[r] = rsqrtf(s * (1.f / 128.f) + 1e-6f) * li; }
            const float* og = p.diff_out_g + l * 128; bf16* OA = (bf16*)(F.ws + WS_OA) + (tok0 + q0) * 512 + h * 128;
            LAS bf16* st2 = (LAS bf16*)(lds + 69632) + wq * (32 * 136);
#pragma unroll
            for (int d = 0; d < NVB; ++d) { const float gg = og[d * 32 + r32];
#pragma unroll
                for (int r = 0; r < 16; ++r) st2[crow(r, hi) * 136 + d * 32 + r32] = (bf16)(cvtpk(o[d][r] * ss[r] * gg, 0.f) & 0xffffu); }
            LDS_WAIT();
#pragma unroll
            for (int i = 0; i < 8; ++i) { const int row = i * 4 + (lane >> 4), ch = lane & 15; const u32x4 v = *(const LAS u32x4*)(st2 + row * 136 + ch * 8); st16x(OA + (size_t)row * 512 + ch * 8, v); }
        }
    } else {
        LAS bf16* stg = (LAS bf16*)(lds) + wid * 2048;
#pragma unroll
        for (int r = 0; r < 16; ++r) { const int orow = crow(r, hi);
#pragma unroll
            for (int d = 0; d < NVB; ++d) stg[orow * 64 + d * 32 + r32] = (bf16)(cvtpk(o[d][r] * rli[r], 0.f) & 0xffffu); }
        LDS_WAIT();
        bf16* Ow = (bf16*)(F.ws + WS_OC) + (tok0 + q0) * 512 + h * 64;
#pragma unroll
        for (int i = 0; i < 4; ++i) { const int row = i * 8 + (lane >> 3), ch = lane & 7; const u32x4 v = *(const LAS u32x4*)(stg + row * 64 + ch * 8); st16x(Ow + (size_t)row * 512 + ch * 8, v); }
    }
    LDS_WAIT(); __builtin_amdgcn_s_barrier();
}
template <bool DUAL>
__device__ __forceinline__ void attn_phase(Frame& F, const Params& p, int l) {
    const int vcu = (F.G % 8 == 0) ? (F.bid % 8) * (F.G / 8) + F.bid / 8 : F.bid;
    if (DUAL) { for (int v = vcu; v < 256; v += F.G) { const int bh = v >> 3, s = v & 7; attn_unit<true>(F, p, l, bh >> 2, bh & 3, s); attn_unit<true>(F, p, l, bh >> 2, bh & 3, 15 - s); } }
    else { for (int v = vcu; v < 256; v += F.G) { const int bh = v >> 2, s = v & 3; attn_unit<false>(F, p, l, bh >> 3, bh & 7, s); attn_unit<false>(F, p, l, bh >> 3, bh & 7, 7 - s); } }
}
}
namespace fk {
__device__ __forceinline__ void sgu_unit(Frame& F, const Params& p, int l, int unit) {
    const int g = unit & 3, bn = unit >> 2; const size_t m0 = (size_t)bn * 128;
    int lane = threadIdx.x & 63; asm volatile("" : "+v"(lane));
    const int wid = F.wave, r32 = lane & 31, hi = lane >> 5; const int tid_ = wid * 64 + lane;
    LAS unsigned char* lds = F.lds; LAS unsigned char* Wt = lds; LAS unsigned char* Vt = lds + 32768;
    const bf16* Y1 = (const bf16*)(F.ws + WS_Y1);
    const int rsub = lane >> 4, ch16 = lane & 15;
    u32x4 w4[4]; f32x4 sa[4], sb[4];
    const float* ST2 = (const float*)(F.ws + WS_STAT2);
#pragma unroll
    for (int it = 0; it < 4; ++it) { const size_t row = m0 + wid * 16 + it * 4 + rsub;
        w4[it] = *(const GAS u32x4*)(Y1 + row * 3072 + 2048 + g * 128 + ch16 * 8); sa[it] = *(const GAS f32x4*)(ST2 + row * 8); sb[it] = *(const GAS f32x4*)(ST2 + row * 8 + 4); }
    const float* Wg = p.sgu_w + ((size_t)l * 4 + g) * 128 * 128;
    f32x4 wa[4], wb[4];
#pragma unroll
    for (int k = 0; k < 4; ++k) { const int item = tid_ + 512 * k, i = item & 127, cidx = item >> 7, ks = cidx >> 1, h2 = cidx & 1;
        wa[k] = *(const GAS f32x4*)(Wg + (size_t)i * 128 + 16 * ks + 4 * h2); wb[k] = *(const GAS f32x4*)(Wg + (size_t)i * 128 + 16 * ks + 8 + 4 * h2); }
    const float* vg = p.sgu_v_g + l * 512 + g * 128 + ch16 * 8;
    float vgv[8];
#pragma unroll
    for (int t = 0; t < 8; ++t) vgv[t] = vg[t];
#pragma unroll
    for (int it = 0; it < 4; ++it) {
        const int j = wid * 16 + it * 4 + rsub; float v[8]; unpack8(w4[it], v);
        const float rstd = rsqrtf((((sa[it][0] + sa[it][1]) + (sa[it][2] + sa[it][3])) + ((sb[it][0] + sb[it][1]) + (sb[it][2] + sb[it][3]))) * (1.f / 512.f) + 1e-6f);
#pragma unroll
        for (int t = 0; t < 8; ++t) v[t] = gelu_tanh(v[t]) * rstd * vgv[t];
        *(LAS u32x4*)(Vt + ((ch16 >> 2) * 8 + (j >> 4)) * 1024 + (j & 15) * 64 + (ch16 & 3) * 16) = pack8(v);
    }
#pragma unroll
    for (int k = 0; k < 4; ++k) {
        const int item = tid_ + 512 * k, i = item & 127, cidx = item >> 7, ks = cidx >> 1;
        const bool ok = (ks >> 2) <= (i >> 6);
        u32x4 w; w.x = ok ? cvtpk(wa[k].x, wa[k].y) : 0u; w.y = ok ? cvtpk(wa[k].z, wa[k].w) : 0u; w.z = ok ? cvtpk(wb[k].x, wb[k].y) : 0u; w.w = ok ? cvtpk(wb[k].z, wb[k].w) : 0u;
        *(LAS u32x4*)(Wt + cidx * 2048 + i * 16) = w;
    }
    const int ib = wid & 3, ch = wid >> 2;
    bf16 uraw[2][16];
#pragma unroll
    for (int dd = 0; dd < 2; ++dd)
#pragma unroll
        for (int r = 0; r < 16; ++r) uraw[dd][r] = Y1[(m0 + 32 * ib + crow(r, hi)) * 3072 + 1536 + 128 * g + 32 * (2 * ch + dd) + r32];
    __syncthreads();
    f32x16 acc[2];
    acc[0] = (f32x16){0.f, 0.f, 0.f, 0.f, 0.f, 0.f, 0.f, 0.f, 0.f, 0.f, 0.f, 0.f, 0.f, 0.f, 0.f, 0.f}; acc[1] = acc[0];
    const int vlane = ((lane >> 4) & 1) * 32 + (lane & 3) * 8 + (4 * hi + ((lane & 15) >> 2)) * 64;
#pragma unroll
    for (int ks = 0; ks < 8; ++ks) {
        const bf16x8 a = *(const LAS bf16x8*)(Wt + (2 * ks + hi) * 2048 + (32 * ib + r32) * 16);
#pragma unroll
        for (int dd = 0; dd < 2; ++dd) { const lds_cptr vb = (lds_cptr)(Vt + (2 * ch + dd) * 8192 + ks * 1024 + vlane);
            const s16x4 lo = vtr(vb), hh = vtr(vb + 512);
            acc[dd] = __builtin_amdgcn_mfma_f32_32x32x16_bf16(a, (bf16x8){lo[0], lo[1], lo[2], lo[3], hh[0], hh[1], hh[2], hh[3]}, acc[dd], 0, 0, 0); }
    }
    const float* bs = p.sgu_b + l * 512 + g * 128; bf16* OB = (bf16*)(F.ws + WS_OB);
#pragma unroll
    for (int dd = 0; dd < 2; ++dd)
#pragma unroll
        for (int r = 0; r < 16; ++r) { const int i = 32 * ib + crow(r, hi), c = 128 * g + 32 * (2 * ch + dd) + r32;
            const float u = gelu_tanh(bf2f(uraw[dd][r]));
            OB[(m0 + i) * 512 + c] = (bf16)(cvtpk(u * (acc[dd][r] + bs[i]), 0.f) & 0xffffu); }
    __syncthreads();
}

struct SchedG3 {
    static constexpr bool GATHER = false; static constexpr bool HALFM = false; static constexpr bool ACCUM = true;
    __device__ __forceinline__ void a_ready(const GUnit&) const {}
    __device__ __forceinline__ void done(const GUnit&) const {}
    __device__ __forceinline__ bool keep_acc(const GUnit& u) const { return u.i2 < 2; }
    const char* OA; const char* WBR; int G, c;
    __device__ __forceinline__ bool next(int i, GUnit& u) const {
        const int tile = (i / 3) * G + c, n = i % 3; if (tile >= 256) return false;
        const int vt = (tile % 8) * 32 + tile / 8;
        const int pm = vt >> 2, pn = vt & 3;
        u.A = OA + (size_t)n * 16 * MiB + (size_t)pm * 256 * 1024; u.B = WBR + (size_t)n * MiB + (size_t)pn * 256 * 1024; u.nt = 8; u.i0 = pm; u.i1 = pn; u.i2 = n; return true;
    }
    __device__ __forceinline__ void offs(const GUnit&, int R0, int R1, int C0, int C1, unsigned (&oA)[2][2]) const {
        oA[0][0] = (unsigned)R0 * 1024u + C0 * 2u; oA[0][1] = (unsigned)R1 * 1024u + C1 * 2u; oA[1][0] = (unsigned)(R0 + 128) * 1024u + C0 * 2u; oA[1][1] = (unsigned)(R1 + 128) * 1024u + C1 * 2u; }
    __device__ __forceinline__ unsigned ldb_bytes() const { return 1024u; }
};
struct EpiG3 {
    const bf16* XG; bf16* MG;
    __device__ __forceinline__ void operator()(f32x4 (&acc)[2][2][4][2], const GUnit& u, int wr, int wc, int fr, int fq) const {
        const int n = u.i2; const int row0 = u.i0 * 256 + wr * 64 + fr, col0 = u.i1 * 256 + wc * 32 + 8 * fq; const unsigned char* G8 = (const unsigned char*)XG;
#pragma unroll
        for (int ai = 0; ai < 2; ++ai)
#pragma unroll
            for (int m = 0; m < 4; ++m) { const size_t row = row0 + ai * 128 + m * 16;
#pragma unroll
                for (int bj = 0; bj < 2; ++bj) { const int col = col0 + bj * 128;
                    const u32x2 ga = *(const GAS u32x2*)(G8 + row * 3072 + n * 1024 + col);
                    if (n < 2) {
                        const u32x2 gb = *(const GAS u32x2*)(G8 + row * 3072 + (n + 1) * 1024 + col);
#pragma unroll
                        for (int t = 0; t < 8; ++t) { const unsigned qa = ((t < 4 ? ga.x : ga.y) >> (8 * (t & 3))) & 255u, qb = ((t < 4 ? gb.x : gb.y) >> (8 * (t & 3))) & 255u;
                            const float r = (float)qa * __builtin_amdgcn_rcpf((float)qb); if (t < 4) acc[ai][bj][m][0][t & 3] *= r; else acc[ai][bj][m][1][t & 3] *= r; }
                    } else {
                        float o[8];
#pragma unroll
                        for (int t = 0; t < 8; ++t) { const unsigned qa = ((t < 4 ? ga.x : ga.y) >> (8 * (t & 3))) & 255u; const float a = t < 4 ? acc[ai][bj][m][0][t & 3] : acc[ai][bj][m][1][t & 3]; o[t] = a * ((float)qa * (1.f / 255.f)); }
                        *(GAS u32x4*)(MG + row * 1024 + col) = pack8(o); } } }
    }
};
template <bool F32IN>
struct EpiG4 {
    bf16* X; const float* gate; const float* Xin;
    __device__ __forceinline__ void operator()(const f32x4 (&acc)[2][2][4][2], const GUnit& u, int wr, int wc, int fr, int fq) const {
        const int row0 = u.i0 * 256 + wr * 64 + fr, col0 = u.i1 * 256 + wc * 32 + 8 * fq; const int b = (u.i0 * 256) / S;
#pragma unroll
        for (int bj = 0; bj < 2; ++bj) { const int col = col0 + bj * 128;
            const f32x4 g0 = *(const GAS f32x4*)(gate + (size_t)b * 6 * D + col), g1 = *(const GAS f32x4*)(gate + (size_t)b * 6 * D + col + 4);
#pragma unroll
            for (int ai = 0; ai < 2; ++ai)
#pragma unroll
                for (int m = 0; m < 4; ++m) { const size_t off = (size_t)(row0 + ai * 128 + m * 16) * D + col;
                    f32x4 x0, x1;
                    if (F32IN) { x0 = *(const GAS f32x4*)(Xin + off); x1 = *(const GAS f32x4*)(Xin + off + 4); }
                    else { float xv[8]; unpack8(*(const GAS u32x4*)(X + off), xv); x0 = (f32x4){xv[0], xv[1], xv[2], xv[3]}; x1 = (f32x4){xv[4], xv[5], xv[6], xv[7]}; }
                    x0 += g0 * acc[ai][bj][m][0]; x1 += g1 * acc[ai][bj][m][1];
                    u32x4 w; w.x = cvtpk(x0[0], x0[1]); w.y = cvtpk(x0[2], x0[3]); w.z = cvtpk(x1[0], x1[1]); w.w = cvtpk(x1[2], x1[3]);
                    *(GAS u32x4*)(X + off) = w; } }
    }
};
struct SchedG2 {
    static constexpr bool GATHER = false; static constexpr bool HALFM = false; static constexpr bool ACCUM = false;
    __device__ __forceinline__ void a_ready(const GUnit&) const {}
    __device__ __forceinline__ void done(const GUnit&) const {}
    const char* Y1; const char* WUQ; const char* WUKV; int G, c;
    __device__ __forceinline__ bool next(int i, GUnit& u) const {
        const int un = (c >> 3) + 32 * i; if (un >= 56) return false;
        const int pm = (c & 7) * 8 + un / 7, ct = un % 7; const bool kv = ct >= 3; const int pn = kv ? ct - 3 : ct;
        u.A = Y1 + (size_t)pm * 256 * 6144 + (kv ? 2816 * 2 : 2560 * 2); u.B = (kv ? WUKV : WUQ) + (size_t)pn * 256 * 512; u.nt = 4; u.i0 = pm; u.i1 = pn; u.i2 = kv ? 1 : 0; return true;
    }
    __device__ __forceinline__ void offs(const GUnit&, int R0, int R1, int C0, int C1, unsigned (&oA)[2][2]) const {
        oA[0][0] = (unsigned)R0 * 6144u + C0 * 2u; oA[0][1] = (unsigned)R1 * 6144u + C1 * 2u; oA[1][0] = (unsigned)(R0 + 128) * 6144u + C0 * 2u; oA[1][1] = (unsigned)(R1 + 128) * 6144u + C1 * 2u; }
    __device__ __forceinline__ unsigned ldb_bytes() const { return 512u; }
};
}
namespace fk {
constexpr int HT_PITCH = 2064;
constexpr int RT_SMALL = 64 * HT_PITCH;
__device__ __forceinline__ void row_router(Frame& F, const Params& p, int l, const float* mod) {
    unsigned char* ws = F.ws; LAS unsigned char* HT = F.lds;
    const bf16* X = (const bf16*)(ws + WS_X); bf16* H = (bf16*)(ws + WS_H);
    const float* g = p.norm_g + (size_t)l * 2 * D + D; const float* shift = mod + 3 * D; const float* scale = mod + 4 * D;
    const float* bg = p.router_g_b + l * 4; const float* be = p.router_e_b + l * 32;
    unsigned* CNT = (unsigned*)(ws + WS_CTL) + CW_CNT + l * 32;
    int* LIST = (int*)(ws + WS_LIST); float* ROWW = (float*)(ws + WS_ROWW); int* TOKSLOT = (int*)(ws + WS_TOKSLOT);
    LAS int* rid = (LAS int*)(F.lds + RT_SMALL); LAS int* rrank = rid + 128; LAS float* rw = (LAS float*)(rrank + 128);
    LAS unsigned* cntl = (LAS unsigned*)(rw + 128); LAS unsigned* cbase = cntl + 32;
    if (F.tid < 32) cntl[F.tid] = 0u;
    constexpr int R = 2;
    const int mb = (F.bid & 7) * 2048 + (F.bid >> 3) * 64;
    for (int kk = 0; kk < 8; kk += R) { const int m0 = mb + kk * 8 + F.wave;
        f32x4 v[R][4];
#pragma unroll
        for (int r = 0; r < R; ++r)
#pragma unroll
            for (int j = 0; j < 4; ++j) { const u32x2 xb = *(const GAS u32x2*)(X + (size_t)(m0 + 8 * r) * D + 4 * F.lane + 256 * j); v[r][j] = (f32x4){bf_lo(xb.x), bf_hi(xb.x), bf_lo(xb.y), bf_hi(xb.y)}; }
#pragma unroll
        for (int r = 0; r < R; ++r) { const int m = m0 + 8 * r, b = m / S; float s = 0.f;
#pragma unroll
            for (int j = 0; j < 4; ++j) s += (v[r][j].x * v[r][j].x + v[r][j].y * v[r][j].y) + (v[r][j].z * v[r][j].z + v[r][j].w * v[r][j].w);
            const float rstd = rsqrtf(wave_sum(s) * (1.f / D) + 1e-6f);
            LAS unsigned char* hrow = HT + ((kk + r) * 8 + F.wave) * HT_PITCH;
#pragma unroll
            for (int j = 0; j < 4; ++j) { const int d = 4 * F.lane + 256 * j;
                const f32x4 gg = *(const GAS f32x4*)(g + d), sc = *(const GAS f32x4*)(scale + (size_t)b * 6 * D + d), sh = *(const GAS f32x4*)(shift + (size_t)b * 6 * D + d);
                const float o0 = v[r][j].x * rstd * gg.x * (1.f + sc.x) + sh.x, o1 = v[r][j].y * rstd * gg.y * (1.f + sc.y) + sh.y, o2 = v[r][j].z * rstd * gg.z * (1.f + sc.z) + sh.z, o3 = v[r][j].w * rstd * gg.w * (1.f + sc.w) + sh.w;
                u32x2 o; o.x = cvtpk(o0, o1); o.y = cvtpk(o2, o3); st8x(H + (size_t)m * D + d, o); *(LAS u32x2*)(hrow + d * 2) = o; }
        }
    }
    __syncthreads();
    const int tt = F.wave & 3, kh = F.wave >> 2, n16 = F.lane & 15, kq = F.lane >> 4;
    const bf16* WRT = (const bf16*)(ws + WS_WRT) + (size_t)l * 48 * 1024;
    f32x4 acc[3];
#pragma unroll
    for (int bl = 0; bl < 3; ++bl) acc[bl] = (f32x4){0.f, 0.f, 0.f, 0.f};
    const LAS unsigned char* hb = HT + (16 * tt + n16) * HT_PITCH + (512 * kh + 8 * kq) * 2;
    const bf16* wb = WRT + (size_t)n16 * 1024 + 512 * kh + 8 * kq;
#pragma unroll 4
    for (int ks = 0; ks < 16; ++ks) {
        const bf16x8 bfr = *(const LAS bf16x8*)(hb + ks * 64);
#pragma unroll
        for (int bl = 0; bl < 3; ++bl) { const bf16x8 afr = *(const GAS bf16x8*)(wb + (size_t)bl * 16 * 1024 + ks * 32);
            acc[bl] = __builtin_amdgcn_mfma_f32_16x16x32_bf16(afr, bfr, acc[bl], 0, 0, 0); }
    }
    __syncthreads();
    LAS float* LGP = (LAS float*)(F.lds);
    LAS float* LG = (LAS float*)(F.lds + 16384);
    if (kh == 1) {
#pragma unroll
        for (int bl = 0; bl < 3; ++bl)
#pragma unroll
            for (int q = 0; q < 4; ++q) LGP[((tt * 3 + bl) * 4 + q) * 64 + F.lane] = acc[bl][q];
    }
    __syncthreads();
    if (kh == 0) {
#pragma unroll
        for (int bl = 0; bl < 3; ++bl)
#pragma unroll
            for (int q = 0; q < 4; ++q) LG[(16 * tt + n16) * 48 + bl * 16 + 4 * kq + q] = acc[bl][q] + LGP[((tt * 3 + bl) * 4 + q) * 64 + F.lane];
    }
    __syncthreads();
    if (F.tid < 64) {
        const int slot = F.tid; const LAS float* lg = LG + slot * 48;
        const float g0 = lg[32] + bg[0], g1 = lg[33] + bg[1], g2 = lg[34] + bg[2], g3 = lg[35] + bg[3];
        int gi = 0; float mx = g0; if (g1 > mx) { mx = g1; gi = 1; } if (g2 > mx) { mx = g2; gi = 2; } if (g3 > mx) { mx = g3; gi = 3; }
        const float gw = 1.f / (__expf(g0 - mx) + __expf(g1 - mx) + __expf(g2 - mx) + __expf(g3 - mx));
        float e[8];
#pragma unroll
        for (int i = 0; i < 8; ++i) e[i] = lg[gi * 8 + i] + be[gi * 8 + i];
        float emx = e[0]; int e0 = 0;
#pragma unroll
        for (int i = 1; i < 8; ++i) if (e[i] > emx) { emx = e[i]; e0 = i; }
        float e2 = -1e30f; int e1 = 0;
#pragma unroll
        for (int i = 0; i < 8; ++i) if (i != e0 && e[i] > e2) { e2 = e[i]; e1 = i; }
        const float p1 = __expf(e2 - emx), w0 = 1.f / (1.f + p1), w1 = p1 / (1.f + p1);
        const int id0 = gi * 8 + e0, id1 = gi * 8 + e1;
        rid[2 * slot] = id0; rid[2 * slot + 1] = id1; rw[2 * slot] = gw * w0; rw[2 * slot + 1] = gw * w1;
        rrank[2 * slot] = (int)__hip_atomic_fetch_add(&cntl[id0], 1u, __ATOMIC_RELAXED, __HIP_MEMORY_SCOPE_WORKGROUP);
        rrank[2 * slot + 1] = (int)__hip_atomic_fetch_add(&cntl[id1], 1u, __ATOMIC_RELAXED, __HIP_MEMORY_SCOPE_WORKGROUP);
    }
    __syncthreads();
    if (F.tid < 32) { const unsigned c = cntl[F.tid]; cbase[F.tid] = c ? atomicAdd(&CNT[F.tid], c) : 0u; }
    __syncthreads();
    if (F.tid < 128) { const int slot = F.tid >> 1, id = rid[F.tid], pos = (int)cbase[id] + rrank[F.tid]; const int m = mb + slot;
        LIST[id * 16384 + pos] = m; ROWW[id * 16384 + pos] = rw[F.tid]; TOKSLOT[id * 16384 + pos] = 2 * m + (F.tid & 1); }
}
__device__ __forceinline__ void moe_table(Frame& F, int l) {
    LAS int* T = (LAS int*)(F.lds + TAB_OFF + 6144);
    int t = threadIdx.x; asm volatile("" : "+v"(t));
    if (t < 32) { const unsigned* CNT = (const unsigned*)(F.ws + WS_CTL) + CW_CNT + l * 32;
        T[t] = (int)__hip_atomic_load(CNT + t, __ATOMIC_RELAXED, __HIP_MEMORY_SCOPE_AGENT); }
    __syncthreads();
    if (t < 33) { int a = 0; for (int e = 0; e < t; ++e) a += (T[e] + 255) >> 8; T[32 + t] = a; }
    __syncthreads();
    if (t < 64) {
        const int e = t & 31, pass = t >> 5; const int c = T[e], nt_ = (c + 255) >> 8; int nhalf_before = 0, nfull_before = 0, nfull_total = 0;
        for (int k = 0; k < 32; ++k) { const int ck = T[k], ntk = (ck + 255) >> 8; const int lastrows = ck - 256 * (ntk - 1); const int hk = (ntk > 0 && lastrows <= 128) ? 1 : 0;
            nfull_total += ntk - hk; if (k < e) { nfull_before += ntk - hk; nhalf_before += hk; } }
        const int lastrows = c - 256 * (nt_ - 1); const int he = (nt_ > 0 && lastrows <= 128) ? 1 : 0;
        if (pass == 0) { for (int m = 0; m < nt_ - he; ++m) T[72 + nfull_before + m] = (e << 16) | (m << 1); }
        else if (he) T[72 + nfull_total + nhalf_before] = (e << 16) | ((nt_ - 1) << 1) | 1;
    }
    __syncthreads();
}
struct SchedG5 {
    static constexpr bool GATHER = true; static constexpr bool HALFM = true; static constexpr bool ACCUM = false;
    const char* H; const char* WGU; const int* LIST; LAS const int* T; int G, c; unsigned* RDY;
    __device__ __forceinline__ void a_ready(const GUnit&) const {}
    __device__ __forceinline__ void done(const GUnit& u) const { asm volatile("s_waitcnt vmcnt(0)" ::: "memory"); if ((threadIdx.x & 63) == 0) __hip_atomic_fetch_add(RDY + u.i3, 1u, __ATOMIC_RELAXED, __HIP_MEMORY_SCOPE_AGENT); }
    __device__ __forceinline__ bool next(int i, GUnit& u) const {
        const int L = i * G + c; const int tot = __builtin_amdgcn_readfirstlane(T[64]); if (L >= 2 * tot) return false;
        const int ent = __builtin_amdgcn_readfirstlane(T[72 + (L >> 1)]), ntile = L & 1; const int e = ent >> 16, mt = (ent >> 1) & 0x7fff;
        const int tpe = __builtin_amdgcn_readfirstlane(T[32 + e]);
        u.A = H; u.B = WGU + ((size_t)e * 512 + ntile * 256) * 2048; u.nt = 16; u.i0 = e; u.i1 = mt; u.i2 = ntile; u.i3 = tpe + mt; u.hm = ent & 1; return true;
    }
    __device__ __forceinline__ void offs(const GUnit& u, int R0, int R1, int C0, int C1, unsigned (&oA)[2][2]) const {
        const int cnt = __builtin_amdgcn_readfirstlane(T[u.i0]); const int* li = LIST + u.i0 * 16384; const int base = u.i1 * 256;
        const int a0 = base + R0, a1 = base + R1, a2 = base + R0 + 128, a3 = base + R1 + 128;
        const int t0 = a0 < cnt ? li[a0] : 0, t1 = a1 < cnt ? li[a1] : 0, t2 = a2 < cnt ? li[a2] : 0, t3 = a3 < cnt ? li[a3] : 0;
        oA[0][0] = (unsigned)t0 * 2048u + C0 * 2u; oA[0][1] = (unsigned)t1 * 2048u + C1 * 2u; oA[1][0] = (unsigned)t2 * 2048u + C0 * 2u; oA[1][1] = (unsigned)t3 * 2048u + C1 * 2u; }
    __device__ __forceinline__ unsigned ldb_bytes() const { return 2048u; }
};
struct EpiG5 {
    bf16* ACT; const float* ROWW; LAS const int* T;
    __device__ __forceinline__ void operator()(const f32x4 (&acc)[2][2][4][2], const GUnit& u, int wr, int wc, int fr, int fq) const {
        const int e = u.i0, cnt = __builtin_amdgcn_readfirstlane(T[e]), rbase = u.i1 * 256, arow0 = (__builtin_amdgcn_readfirstlane(T[32 + e]) + u.i1) * 256; const int f0 = u.i2 * 128 + wc * 32 + 8 * fq;
#pragma unroll
        for (int ai = 0; ai < 2; ++ai)
#pragma unroll
            for (int m = 0; m < 4; ++m) { const int rt = ai * 128 + wr * 64 + m * 16 + fr;
                if (rbase + rt < cnt) { const float w = ROWW[e * 16384 + rbase + rt]; float o[8];
#pragma unroll
                    for (int t = 0; t < 8; ++t) { const float gt = t < 4 ? acc[ai][0][m][0][t & 3] : acc[ai][0][m][1][t & 3], up = t < 4 ? acc[ai][1][m][0][t & 3] : acc[ai][1][m][1][t & 3];
                        o[t] = gt * fast_sigmoid(gt) * up * w; }
                    st16_wt(ACT + (size_t)(arow0 + rt) * 256 + f0, pack8(o)); } }
    }
};
struct SchedG6 {
    static constexpr bool GATHER = false; static constexpr bool HALFM = true; static constexpr bool ACCUM = false;
    const char* ACT; const char* WDN; LAS const int* T; int G, c; const unsigned* RDY; unsigned* tmo;
    __device__ __forceinline__ bool next(int i, GUnit& u) const {
        const int tot = __builtin_amdgcn_readfirstlane(T[64]); const int u5 = 2 * tot; const int nx = (u5 > G && u5 < 2 * G) ? u5 - G : 0;
        if (c < nx) return false;
        const int L = i * (G - nx) + (c - nx); if (L >= 4 * tot) return false;
        const int ent = __builtin_amdgcn_readfirstlane(T[72 + (L >> 2)]), ntile = L & 3; const int e = ent >> 16, mt = (ent >> 1) & 0x7fff;
        const int mtg = __builtin_amdgcn_readfirstlane(T[32 + e]) + mt;
        u.A = ACT + (size_t)mtg * 256 * 512; u.B = WDN + ((size_t)e * 1024 + ntile * 256) * 512; u.nt = 4; u.i0 = e; u.i1 = mt; u.i2 = ntile; u.i3 = mtg; u.hm = ent & 1; return true;
    }
    __device__ __forceinline__ void offs(const GUnit&, int R0, int R1, int C0, int C1, unsigned (&oA)[2][2]) const {
        oA[0][0] = (unsigned)R0 * 512u + C0 * 2u; oA[0][1] = (unsigned)R1 * 512u + C1 * 2u; oA[1][0] = (unsigned)(R0 + 128) * 512u + C0 * 2u; oA[1][1] = (unsigned)(R1 + 128) * 512u + C1 * 2u; }
    __device__ __forceinline__ unsigned ldb_bytes() const { return 512u; }
    __device__ __forceinline__ void a_ready(const GUnit& u) const {
        if (__builtin_amdgcn_readfirstlane(threadIdx.x >> 6) == 0) {
            unsigned polls = 0;
            while ((unsigned)__builtin_amdgcn_readfirstlane(__hip_atomic_load(RDY + u.i3, __ATOMIC_RELAXED, __HIP_MEMORY_SCOPE_AGENT)) < 16u) {
                if ((++polls & 255u) == 0u && __builtin_amdgcn_readfirstlane(__hip_atomic_load(tmo, __ATOMIC_RELAXED, __HIP_MEMORY_SCOPE_AGENT)) != 0u) break;
                if (polls > (1u << 17)) { __hip_atomic_store(tmo, 1u, __ATOMIC_RELAXED, __HIP_MEMORY_SCOPE_AGENT); break; }
                __builtin_amdgcn_s_sleep(8); }
            __builtin_amdgcn_fence(__ATOMIC_ACQUIRE, "agent");
            asm volatile("s_waitcnt vmcnt(0)" ::: "memory");
        }
        asm volatile("" ::: "memory"); __builtin_amdgcn_s_barrier(); asm volatile("" ::: "memory");
    }
    __device__ __forceinline__ void done(const GUnit&) const {}
};
struct EpiG6 {
    bf16* Z; const int* TOKSLOT; LAS const int* T;
    __device__ __forceinline__ void operator()(const f32x4 (&acc)[2][2][4][2], const GUnit& u, int wr, int wc, int fr, int fq) const {
        const int e = u.i0, cnt = __builtin_amdgcn_readfirstlane(T[e]), rbase = u.i1 * 256; const int c0 = u.i2 * 256 + wc * 32 + 8 * fq;
#pragma unroll
        for (int ai = 0; ai < 2; ++ai)
#pragma unroll
            for (int m = 0; m < 4; ++m) { const int rt = ai * 128 + wr * 64 + m * 16 + fr;
                if (rbase + rt < cnt) { const int ts = TOKSLOT[e * 16384 + rbase + rt]; bf16* zp = Z + zrow(ts) + c0;
#pragma unroll
                    for (int bj = 0; bj < 2; ++bj) { const f32x4 v0 = acc[ai][bj][m][0], v1 = acc[ai][bj][m][1];
                        u32x4 w; w.x = cvtpk(v0[0], v0[1]); w.y = cvtpk(v0[2], v0[3]); w.z = cvtpk(v1[0], v1[1]); w.w = cvtpk(v1[2], v1[3]);
                        st16x(zp + bj * 128, w); } } }
    }
};
}
#ifndef PH4MASK
#define PH4MASK 7
#endif
#ifndef PHMASK
#define PHMASK 0xFFFF
#endif
namespace fk {
__device__ __forceinline__ void relaunder(Frame& F) { int t = threadIdx.x; asm volatile("" : "+v"(t)); F.tid = t; F.lane = t & 63; }
__global__ void __launch_bounds__(NTHR, 2) fwd(Params p) {
    extern __shared__ __attribute__((aligned(16))) unsigned char lds_[];
    Frame F; F.lds = (LAS unsigned char*)lds_; F.ws = p.ws; F.tid = threadIdx.x; F.lane = F.tid & 63; F.wave = __builtin_amdgcn_readfirstlane(F.tid >> 6);
    F.G = gridDim.x; F.bid = blockIdx.x; F.gw = F.bid * NWAVES + F.wave; F.NGW = F.G * NWAVES;
    volatile LAS unsigned* MISC = (volatile LAS unsigned*)(F.lds + MISC_OFF);
    if (F.tid < 64) MISC[F.tid] = 0u;
    __syncthreads();
    unsigned* ctl = (unsigned*)(p.ws + WS_CTL);
    XcdBarrier bar = xcd_barrier_post(ctl + CW_BAR, MISC + 8);
    bool first = true; bool gmode = false; bool mode_known = false;
    const int lo = p.ph_lo, hi = p.ph_hi;
#ifdef TIMEPH
    unsigned long long tacc = 0, tprev = 0; int prevph = -1;
#define TSTAMP(k) do { const unsigned long long now_ = __builtin_amdgcn_s_memrealtime(); if (prevph == (TIMEPH) || ((TIMEPH) == -2 && prevph >= 100)) tacc += now_ - tprev; tprev = now_; prevph = (k); } while (0)
#else
#define TSTAMP(k) do {} while (0)
#endif
#ifdef TIMEPH
#define TBAR() do { const unsigned long long now_ = __builtin_amdgcn_s_memrealtime(); if (prevph == (TIMEPH)) tacc += now_ - tprev; tprev = now_; prevph += 100; } while (0)
#else
#define TBAR() do {} while (0)
#endif
#define PHASE(k) PHASE_(k, true)
#define PHASEG(k) PHASE_(k, false)
#define PHASE_(k, glob) if (lo <= (k) && (k) < hi) if ((first ? (void)0 : (({ TBAR(); }), ((glob) || !gmode) ? xcd_barrier(bar) : xcc_barrier(bar, ctl + CW_GBAR, 32u))), first = false, relaunder(F), true) if (({ TSTAMP(k); true; }))
    unsigned char* ws = p.ws;
    if (p.l_lo == 0) PHASE(0) if constexpr (((PHMASK) >> 0) & 1) { p0_prologue(F, p); }
    for (int l = p.l_lo; l < p.l_hi; ++l) {
        const float* mod = (const float*)(ws + WS_MOD) + (size_t)l * NB * 6 * D;
        PHASE(1) if constexpr (((PHMASK) >> 1) & 1) {
            if (!mode_known) {
                mode_known = true;
                if (F.tid == 0) { bool ok = (lo == 0) && (F.G == 256); for (int j = 0; j < 16; ++j) ok = ok && (xb_ld(ctl + CW_BAR + XB_XCNT(j)) == (j < 8 ? 32u : 0u)); MISC[11] = ok ? 1u : 0u; }
                __syncthreads();
                gmode = MISC[11] != 0u;
                if (gmode) F.bid = (int)MISC[10] * 8 + (int)bar.x;
                F.gw = F.bid * NWAVES + F.wave;
            }
            if (l == 0) row_normmod<0>(F, p.x, (bf16*)(ws + WS_X), nullptr, nullptr, p.norm_g + (size_t)l * 2 * D, mod, mod + D, (bf16*)(ws + WS_H), nullptr);
            else row_normmod<2>(F, nullptr, (bf16*)(ws + WS_X), (const bf16*)(ws + WS_Z), mod - (size_t)NB * 6 * D + 5 * D, p.norm_g + (size_t)l * 2 * D, mod, mod + D, (bf16*)(ws + WS_H), nullptr);
        }
        PHASEG(2) if constexpr (((PHMASK) >> 2) & 1) {
            SchedDense S{(const char*)(ws + WS_H), (const char*)(ws + WS_WIN + (size_t)l * 6144 * 2048), 2048u, 2048u, 64, 24, 16, F.G, F.bid};
            EpiG1 E{(bf16*)(ws + WS_Y1), (bf16*)(ws + WS_XG), (bf16*)(ws + WS_KR), (float*)(ws + WS_STAT), (float*)(ws + WS_STAT2), p.diff_qk_g + l * 128, p.mla_qk_g + l * 192 + 96, (const float*)(ws + WS_CS), (const float*)(ws + WS_SN)};
            gemm_phase(F.lds, S, E);
        }
        PHASEG(4) if constexpr (((PHMASK) >> 4) & 1) {
            if constexpr ((PH4MASK) & 1) {
                SchedG2 S{(const char*)(ws + WS_Y1), (const char*)(ws + WS_WUQ + (size_t)l * 768 * 512), (const char*)(ws + WS_WUKV + (size_t)l * 1024 * 512), F.G, F.bid};
                EpiG2Both E{{(bf16*)(ws + WS_QC), (const float*)(ws + WS_STAT), p.mla_qk_g + l * 192, (const float*)(ws + WS_CS), (const float*)(ws + WS_SN)},
                            {(bf16*)(ws + WS_KVC), (const float*)(ws + WS_STAT), p.mla_qk_g + l * 192 + 96, (const float*)(ws + WS_CS), (const float*)(ws + WS_SN)}};
                gemm_phase(F.lds, S, E); }
            TSTAMP(41);
            if constexpr ((PH4MASK) & 2) attn_phase<true>(F, p, l);
            TSTAMP(42);
            if constexpr ((PH4MASK) & 4) for (int j = 0; j < 2; ++j) sgu_unit(F, p, l, (F.bid & 7) * 64 + (F.bid >> 3) + 32 * j);
        }
        PHASEG(6) if constexpr (((PHMASK) >> 6) & 1) { attn_phase<false>(F, p, l); }
        PHASEG(7) if constexpr (((PHMASK) >> 7) & 1) {
            SchedG3 S{(const char*)(ws + WS_OA), (const char*)(ws + WS_WBR + (size_t)l * 3 * MiB), F.G, F.bid};
            EpiG3 E{(const bf16*)(ws + WS_XG), (bf16*)(ws + WS_MERGED)};
            gemm_phase(F.lds, S, E);
        }
        PHASEG(8) if constexpr (((PHMASK) >> 8) & 1) {
            SchedDense S{(const char*)(ws + WS_MERGED), (const char*)(ws + WS_WOUT + (size_t)l * 2 * MiB), 2048u, 2048u, 64, 4, 16, F.G, F.bid};
            if (l == 0) { EpiG4<true> E{(bf16*)(ws + WS_X), mod + 2 * D, p.x}; gemm_phase(F.lds, S, E); }
            else { EpiG4<false> E{(bf16*)(ws + WS_X), mod + 2 * D, nullptr}; gemm_phase(F.lds, S, E); }
        }
        PHASEG(9) if constexpr (((PHMASK) >> 9) & 1) { row_router(F, p, l, mod); }
        PHASE(10) if constexpr (((PHMASK) >> 10) & 1) {
            moe_table(F, l);
            unsigned* RDY = (unsigned*)(ws + WS_CTL) + CW_RDY + l * 256;
            { SchedG5 S{(const char*)(ws + WS_H), (const char*)(ws + WS_WGU + (size_t)l * 32 * MiB), (const int*)(ws + WS_LIST), (LAS const int*)(F.lds + TAB_OFF + 6144), F.G, F.bid, RDY};
              EpiG5 E{(bf16*)(ws + WS_ACT), (const float*)(ws + WS_ROWW), (LAS const int*)(F.lds + TAB_OFF + 6144)};
              gemm_phase(F.lds, S, E); }
            TSTAMP(43);
            { SchedG6 S{(const char*)(ws + WS_ACT), (const char*)(ws + WS_WDN + (size_t)l * 16 * MiB), (LAS const int*)(F.lds + TAB_OFF + 6144), F.G, F.bid, RDY, (unsigned*)(ws + WS_CTL) + CW_TMO2};
              EpiG6 E{(bf16*)(ws + WS_Z), (const int*)(ws + WS_TOKSLOT), (LAS const int*)(F.lds + TAB_OFF + 6144)};
              gemm_phase(F.lds, S, E); }
        }
    }
    if (p.l_hi == p.nlayers) PHASE(12) if constexpr (((PHMASK) >> 12) & 1) {
        const float* modl = (const float*)(ws + WS_MOD) + (size_t)(p.nlayers - 1) * NB * 6 * D;
        row_normmod<3>(F, nullptr, (bf16*)(ws + WS_X), (const bf16*)(ws + WS_Z), modl + 5 * D, nullptr, nullptr, nullptr, nullptr, p.out);
    }
#undef PHASE
#ifdef CENSUS_TEST
    if (blockIdx.x == 0 && threadIdx.x == 0) { bool ok = true; for (int j = 0; j < 8; ++j) ok = ok && (xb_ld(ctl + CW_BAR + XB_XCNT(j)) == 32u);
        if (!ok) { const unsigned long long t0 = __builtin_amdgcn_s_memrealtime(); while (__builtin_amdgcn_s_memrealtime() - t0 < 100000ull) __builtin_amdgcn_s_sleep(32); } }
#endif
#ifdef TIMEPH
    TSTAMP(99);
    if (blockIdx.x == 0 && threadIdx.x == 0) { const unsigned long long t0 = __builtin_amdgcn_s_memrealtime(), wait = tacc * (TMULT);
        while (__builtin_amdgcn_s_memrealtime() - t0 < wait) __builtin_amdgcn_s_sleep(32); }
#endif
}
}
static void fill_params(fk::Params& p, void* const* d_in, void* d_out, void* d_ws) {
    p.x = (const float*)d_in[0]; p.c = (const float*)d_in[1]; p.positions = (const int*)d_in[2];
    p.w_ada = (const float*)d_in[3]; p.b_ada = (const float*)d_in[4]; p.norm_g = (const float*)d_in[5]; p.w_in = (const float*)d_in[6];
    p.diff_qk_g = (const float*)d_in[7]; p.diff_lambda = (const float*)d_in[8]; p.diff_out_g = (const float*)d_in[9]; p.rel_bias = (const float*)d_in[10];
    p.sgu_v_g = (const float*)d_in[11]; p.sgu_w = (const float*)d_in[12]; p.sgu_b = (const float*)d_in[13];
    p.mla_lat_g = (const float*)d_in[14]; p.mla_w_uq = (const float*)d_in[15]; p.mla_w_ukv = (const float*)d_in[16]; p.mla_qk_g = (const float*)d_in[17];
    p.w_branch = (const float*)d_in[18]; p.w_out = (const float*)d_in[19]; p.router_g_w = (const float*)d_in[20]; p.router_g_b = (const float*)d_in[21];
    p.router_e_w = (const float*)d_in[22]; p.router_e_b = (const float*)d_in[23]; p.w_e_gate = (const float*)d_in[24]; p.w_e_up = (const float*)d_in[25]; p.w_e_down = (const float*)d_in[26];
    p.out = (float*)d_out; p.ws = (unsigned char*)d_ws;
}
static void launch_fast(hipStream_t st, fk::Params p, int l_lo, int l_hi, int ph_lo, int ph_hi) {
    static bool attr = false;
    if (!attr) { (void)hipFuncSetAttribute((const void*)fk::fwd, hipFuncAttributeMaxDynamicSharedMemorySize, fk::LDS_BYTES); attr = true; }
#if NLAUNCH != 1
    (void)hipMemsetAsync((char*)p.ws + fk::WS_CTL + fk::CW_BAR * 4, 0, XCD_BAR_WORDS * 4, st);
#endif
    p.l_lo = l_lo; p.l_hi = l_hi; p.ph_lo = ph_lo; p.ph_hi = ph_hi;
    hipLaunchKernelGGL(fk::fwd, dim3(256), dim3(fk::NTHR), fk::LDS_BYTES, st, p);
}
extern "C" void kernel_launch(void* const* d_in, const int* in_sizes, int n_in, void* d_out, int out_size, void* d_ws, size_t ws_size, hipStream_t stream) {
    if (fk::WS_END > ws_size) { fprintf(stderr, "ws too small: need %zu have %zu\n", (size_t)fk::WS_END, ws_size); return; }
    (void)hipMemsetAsync((char*)d_ws + fk::WS_CTL, 0, fk::CTL_ZERO_BYTES, stream);
    fk::Params p{}; fill_params(p, d_in, d_out, d_ws); p.nlayers = 4; p.pad_ = 0;
#if NLAUNCH == 1
    launch_fast(stream, p, 0, 4, 0, 13);
#else
    launch_fast(stream, p, 0, 1, 0, 1);
    for (int l = 0; l < 4; ++l) for (int ph = 1; ph <= 11; ++ph) launch_fast(stream, p, l, l + 1, ph, ph + 1);
    launch_fast(stream, p, 3, 4, 12, 13);
#endif
}
```

```cpp
#include <hip/hip_runtime.h>
#include <cstdio>
#include <cstdint>
#define NLAUNCH 1
#define WT_STORES 1
#define PADN 40
namespace fk {
#define LAS __attribute__((address_space(3)))
#define GAS __attribute__((address_space(1)))
typedef unsigned short bf16;
typedef short bf16x8 __attribute__((ext_vector_type(8)));
typedef short s16x4 __attribute__((ext_vector_type(4)));
typedef float f32x2 __attribute__((ext_vector_type(2)));
typedef float f32x4 __attribute__((ext_vector_type(4)));
typedef float f32x16 __attribute__((ext_vector_type(16)));
typedef unsigned u32x2 __attribute__((ext_vector_type(2)));
typedef unsigned u32x4 __attribute__((ext_vector_type(4)));
typedef __bf16 bf16x2_t __attribute__((ext_vector_type(2)));
constexpr int NB = 8, S = 2048, D = 1024, M = NB * S, NL = 4;
constexpr int NWAVES = 8, NTHR = 512;
constexpr float LOG2E = 1.4426950408889634f;

__device__ __forceinline__ unsigned cvtpk(float lo, float hi) { f32x2 v = {lo, hi}; bf16x2_t b = __builtin_convertvector(v, bf16x2_t); return __builtin_bit_cast(unsigned, b); }
__device__ __forceinline__ float bf_lo(unsigned u) { return __builtin_bit_cast(float, u << 16); }
__device__ __forceinline__ float bf_hi(unsigned u) { return __builtin_bit_cast(float, u & 0xffff0000u); }
__device__ __forceinline__ float bf2f(bf16 u) { return __builtin_bit_cast(float, (unsigned)u << 16); }
template <int K> __device__ __forceinline__ float sw(float v) { return __builtin_bit_cast(float, __builtin_amdgcn_ds_swizzle(__builtin_bit_cast(int, v), 0x1F | (K << 10))); }
__device__ __forceinline__ int x32_addr() { int z = 0; asm volatile("" : "+v"(z)); const int l = __builtin_amdgcn_mbcnt_hi(-1, __builtin_amdgcn_mbcnt_lo(-1, z)); return (l ^ 32) << 2; }
__device__ __forceinline__ float xget32(float v, bool) { return __builtin_bit_cast(float, __builtin_amdgcn_ds_bpermute(x32_addr(), __builtin_bit_cast(int, v))); }
__device__ __forceinline__ float xsum32(float v) { return v + xget32(v, false); }
__device__ __forceinline__ float xmax32(float v) { return __builtin_fmaxf(v, xget32(v, false)); }
#ifdef OLD_WSUM
__device__ __forceinline__ float wave_sum(float v) { for (int o = 1; o < 64; o <<= 1) v += __shfl_xor(v, o); return v; }
#else
__device__ __forceinline__ float wave_sum(float v) { v += sw<1>(v); v += sw<2>(v); v += sw<4>(v); v += sw<8>(v); v += sw<16>(v); return xsum32(v); }
#endif
__device__ __forceinline__ float fast_sigmoid(float x) { return __builtin_amdgcn_rcpf(1.f + __builtin_amdgcn_exp2f(-x * LOG2E)); }
__device__ __forceinline__ float gelu_tanh(float x) { const float y = 0.7978845608028654f * (x + 0.044715f * x * x * x); return x * fast_sigmoid(2.f * y); }
#define LDS_WAIT() asm volatile("s_waitcnt lgkmcnt(0)" ::: "memory")
__device__ __forceinline__ void st16_wt(void* p, u32x4 v) { asm volatile("global_store_dwordx4 %0, %1, off sc1\n\ts_nop 1" :: "v"(p), "v"(v) : "memory"); }
#ifdef WT_ALL
__device__ __forceinline__ void st16x(void* p, u32x4 v) { asm volatile("global_store_dwordx4 %0, %1, off sc1\n\ts_nop 1" :: "v"(p), "v"(v) : "memory"); }
__device__ __forceinline__ void st16f(void* p, f32x4 v) { asm volatile("global_store_dwordx4 %0, %1, off sc1\n\ts_nop 1" :: "v"(p), "v"(v) : "memory"); }
__device__ __forceinline__ void st8x(void* p, u32x2 v) { asm volatile("global_store_dwordx2 %0, %1, off sc1\n\ts_nop 1" :: "v"(p), "v"(v) : "memory"); }
#else
__device__ __forceinline__ void st16x(void* p, u32x4 v) { *(GAS u32x4*)p = v; }
__device__ __forceinline__ void st16f(void* p, f32x4 v) { *(GAS f32x4*)p = v; }
__device__ __forceinline__ void st8x(void* p, u32x2 v) { *(GAS u32x2*)p = v; }
#endif
#ifdef WT_STORES
__device__ __forceinline__ void st16(void* p, u32x4 v) { asm volatile("global_store_dwordx4 %0, %1, off sc1\n\ts_nop 1" :: "v"(p), "v"(v) : "memory"); }
#else
__device__ __forceinline__ void st16(void* p, u32x4 v) { *(GAS u32x4*)p = v; }
#endif
#define VM_WAIT() asm volatile("s_waitcnt vmcnt(0)" ::: "memory")

#define XB_TMO      128
#define XB_XCNT(j)  (256  + 64 * (j))
#define XB_XSUB(j)  (1280 + 64 * (j))
#define XB_XGEN(j)  (2304 + 64 * (j))
#define XB_TOP      3328
#define XB_TOPGEN   3392
#define XCD_BAR_WORDS 3456
#define XB_SPIN_CAP (1u << 18)
__device__ __forceinline__ unsigned xb_ld(unsigned* p)              { return __hip_atomic_load(p, __ATOMIC_RELAXED, __HIP_MEMORY_SCOPE_AGENT); }
__device__ __forceinline__ unsigned xb_add(unsigned* p, unsigned v) { return __hip_atomic_fetch_add(p, v, __ATOMIC_RELAXED, __HIP_MEMORY_SCOPE_AGENT); }
__device__ __forceinline__ unsigned xb_xcc_id() { return (unsigned)__builtin_amdgcn_s_getreg((3 << 11) | 20) & 0xFu; }
#define XB_SPIN(cond, bar) do { unsigned _sp = 0; while (cond) { __builtin_amdgcn_s_sleep(1); \
    if ((++_sp & 255u) == 0u) { if (xb_ld(&(bar)[XB_TMO])) break; if (_sp > XB_SPIN_CAP) { atomicAdd(&(bar)[XB_TMO], 1u); break; } } } } while (0)
struct XcdBarrier { unsigned* bar; unsigned x; volatile LAS unsigned* st; };
__device__ __forceinline__ XcdBarrier xcd_barrier_post(unsigned* bar, volatile LAS unsigned* st) {
    XcdBarrier b; b.bar = bar; b.x = xb_xcc_id(); b.st = st;
    if (threadIdx.x == 0) st[2] = xb_add(&bar[XB_XCNT(b.x)], 1u);
    return b;
}
__device__ __forceinline__ void xcd_barrier_complete(unsigned* bar, unsigned x, unsigned& nloc, unsigned& nx) {
    const unsigned G = gridDim.x * gridDim.y * gridDim.z;
    unsigned sum, cnt, mine, sp = 0u;
    for (;;) {
        sum = 0u; cnt = 0u; mine = 0u;
#pragma unroll
        for (unsigned j = 0; j < 16; ++j) { const unsigned c = xb_ld(&bar[XB_XCNT(j)]); sum += c; cnt += (c > 0u) ? 1u : 0u; mine = (j == x) ? c : mine; }
        if (sum == G) break;
        __builtin_amdgcn_s_sleep(1);
        if ((++sp & 255u) == 0u) { if (xb_ld(&bar[XB_TMO])) break; if (sp > XB_SPIN_CAP) { atomicAdd(&bar[XB_TMO], 1u); break; } }
    }
    nloc = mine > 0u ? mine : 1u; nx = cnt > 0u ? cnt : 1u;
}
__device__ __forceinline__ void xcd_barrier(const XcdBarrier& b) {
    asm volatile("s_waitcnt vmcnt(0)" ::: "memory");
    __syncthreads();
    if (threadIdx.x == 0) {
        unsigned* bar = b.bar;
        __builtin_amdgcn_s_waitcnt(0);
        unsigned nloc = b.st[0], nx = b.st[1];
        if (nloc == 0u) { xcd_barrier_complete(bar, b.x, nloc, nx); b.st[0] = nloc; b.st[1] = nx; }
        const unsigned old = xb_add(&bar[XB_XSUB(b.x)], 1u);
        const unsigned gen = old / nloc;
        if (old + 1u == (gen + 1u) * nloc) {
            __builtin_amdgcn_fence(__ATOMIC_RELEASE, "agent");
            asm volatile("s_waitcnt vmcnt(0)" ::: "memory");
            const unsigned og = xb_add(&bar[XB_TOP], 1u);
            const unsigned tg = og / nx;
            if (og + 1u == (tg + 1u) * nx) xb_add(&bar[XB_TOPGEN], 1u);
            else XB_SPIN(xb_ld(&bar[XB_TOPGEN]) == tg, bar);
            __builtin_amdgcn_fence(__ATOMIC_ACQUIRE, "agent");
            xb_add(&bar[XB_XGEN(b.x)], 1u);
            asm volatile("s_waitcnt vmcnt(0)" ::: "memory");
        } else {
            XB_SPIN(xb_ld(&bar[XB_XGEN(b.x)]) == gen, bar);
            __builtin_amdgcn_fence(__ATOMIC_ACQUIRE, "agent");
            asm volatile("s_waitcnt vmcnt(0)" ::: "memory");
        }
    }
    __syncthreads();
}

__device__ __forceinline__ void xcc_barrier(const XcdBarrier& b, unsigned* gb, unsigned nloc) {
    asm volatile("s_waitcnt vmcnt(0)" ::: "memory");
    __syncthreads();
    if (threadIdx.x == 0) {
        __builtin_amdgcn_s_waitcnt(0);
        const unsigned old = xb_add(&gb[64 * b.x], 1u); const unsigned gen = old / nloc;
        if (old + 1u == (gen + 1u) * nloc) xb_add(&gb[1024 + 64 * b.x], 1u);
        else XB_SPIN(xb_ld(&gb[1024 + 64 * b.x]) == gen, b.bar);
        __builtin_amdgcn_fence(__ATOMIC_ACQUIRE, "agent");
        asm volatile("s_waitcnt vmcnt(0)" ::: "memory");
    }
    __syncthreads();
}

constexpr int BM = 256, BK = 64, HALF = 128, HTB = HALF * BK * 2;
__device__ __forceinline__ void stage_rc(int b, int& R, int& C) { const int st = b / 1024, sb = b % 1024, swz = sb ^ (((sb >> 9) & 1) << 5); R = (st >> 1) * 16 + swz / 64; C = (st & 1) * 32 + (swz % 64) / 2; }
__device__ __forceinline__ int lds_byte(int r, int c) { const int st = (r >> 4) * 2 + (c >> 5), rr = r & 15, cc = c & 31, ob = rr * 64 + cc * 2; return st * 1024 + (ob ^ (((ob >> 9) & 1) << 5)); }
__device__ __forceinline__ int perm32(int rho) { const int n = rho >> 4, i = rho & 15; return 8 * (i >> 2) + 4 * n + (i & 3); }

struct GUnit { const char* A; const char* B; int nt; int i0, i1, i2, i3; int hm; };
template <class Epi, class Sched>
__device__ __forceinline__ void gemm_phase(LAS unsigned char* lds, const Sched& S, const Epi& E) {
    int tid = threadIdx.x; asm volatile("" : "+v"(tid));
    const int wid = __builtin_amdgcn_readfirstlane(tid >> 6), lane = tid & 63, wr = wid >> 2, wc = wid & 3, fr = lane & 15, fq = lane >> 4;
    int R0, C0, R1, C1; stage_rc(tid * 16, R0, C0); stage_rc(tid * 16 + 8192, R1, C1);
    const unsigned ldb = S.ldb_bytes();
    unsigned voffB[2];
    voffB[0] = (unsigned)((R0 & ~31) + perm32(R0 & 31)) * ldb + (unsigned)C0 * 2u; voffB[1] = (unsigned)((R1 & ~31) + perm32(R1 & 31)) * ldb + (unsigned)C1 * 2u;
    unsigned voffBh[2]; voffBh[0] = voffB[0] + (unsigned)HALF * ldb; voffBh[1] = voffB[1] + (unsigned)HALF * ldb;
    const unsigned ldsw = (unsigned)wid * 1024u;
    const int aoff = lds_byte(wr * 64 + fr, fq * 8), boff = lds_byte(wc * 32 + fr, fq * 8);
#define PG8_SA(b, h) (((b) * 2 + (h)) * HTB)
#define PG8_SB(b, h) ((4 + (b) * 2 + (h)) * HTB)
#define PG8_STAGE(bufoff, gbase, voff, kofs) do { _Pragma("unroll") for (int _i = 0; _i < 2; ++_i) \
        __builtin_amdgcn_global_load_lds((const unsigned*)((const char*)(gbase) + (unsigned)((voff)[_i] + (kofs))), (LAS unsigned*)(lds + (bufoff) + ldsw + _i * 8192), 16, 0, 0); } while (0)
#define PG8_LDA(dst, b, h) do { _Pragma("unroll") for (int m = 0; m < 4; ++m) _Pragma("unroll") for (int k = 0; k < 2; ++k) dst[m][k] = *(const LAS bf16x8*)(lds + PG8_SA(b, h) + aoff + m * 2048 + k * 1024); } while (0)
#define PG8_LDB(dst, b, h) do { _Pragma("unroll") for (int n = 0; n < 2; ++n) _Pragma("unroll") for (int k = 0; k < 2; ++k) dst[n][k] = *(const LAS bf16x8*)(lds + PG8_SB(b, h) + boff + n * 2048 + k * 1024); } while (0)
#define PG8_MMA(ai, bj, At, Bt) do { __builtin_amdgcn_s_setprio(1); _Pragma("unroll") for (int m = 0; m < 4; ++m) _Pragma("unroll") for (int n = 0; n < 2; ++n) _Pragma("unroll") for (int k = 0; k < 2; ++k) \
        acc[ai][bj][m][n] = __builtin_amdgcn_mfma_f32_16x16x32_bf16(Bt[n][k], At[m][k], acc[ai][bj][m][n], 0, 0, 0); __builtin_amdgcn_s_setprio(0); } while (0)
#define PG8_WAIT_V(n) asm volatile("s_waitcnt vmcnt(" #n ")" ::: "memory")
#define PG8_WAIT_L(n) asm volatile("s_waitcnt lgkmcnt(" #n ")" ::: "memory")
#define PG8_BAR __builtin_amdgcn_s_barrier()
#define PG8_SCHED __builtin_amdgcn_sched_barrier(0)
    GUnit cur, nxt; int ui = 0;
    if (!S.next(0, cur)) return;
    f32x4 acc[2][2][4][2];
#pragma unroll
    for (int a = 0; a < 2; ++a)
#pragma unroll
        for (int b = 0; b < 2; ++b)
#pragma unroll
            for (int m = 0; m < 4; ++m)
#pragma unroll
                for (int n = 0; n < 2; ++n) acc[a][b][m][n] = (f32x4){0.f, 0.f, 0.f, 0.f};
    bf16x8 At[4][2], B0[2][2], B1[2][2];
    unsigned oAc[2][2], oAn[2][2];
    S.a_ready(cur);
    S.offs(cur, R0, R1, C0, C1, oAc);
    const char* cA = cur.A; const char* cB = cur.B;
    PG8_STAGE(PG8_SB(0, 0), cB, voffB, 0u); PG8_STAGE(PG8_SB(0, 1), cB, voffBh, 0u); PG8_STAGE(PG8_SA(0, 0), cA, oAc[0], 0u); PG8_STAGE(PG8_SA(0, 1), cA, oAc[1], 0u);
    if (wr == 1) PG8_BAR;
    PG8_WAIT_V(2); PG8_BAR;
    PG8_STAGE(PG8_SB(1, 0), cB, voffB, 128u); PG8_STAGE(PG8_SA(1, 0), cA, oAc[0], 128u); PG8_STAGE(PG8_SB(1, 1), cB, voffBh, 128u);
    PG8_WAIT_V(6); PG8_BAR;
    for (;;) {
        const bool has_next = S.next(ui + 1, nxt);
        const char* nA = has_next ? nxt.A : cA; const char* nB = has_next ? nxt.B : cB;
        if constexpr (Sched::GATHER) { if (has_next) S.offs(nxt, R0, R1, C0, C1, oAn);
            else { oAn[0][0] = oAc[0][0]; oAn[0][1] = oAc[0][1]; oAn[1][0] = oAc[1][0]; oAn[1][1] = oAc[1][1]; } }
        int nt = cur.nt; asm volatile("" : "+s"(nt)); const bool hm = Sched::HALFM && cur.hm != 0;
        for (int t = 0; t < nt; t += 2) {
            const bool last = (t == nt - 2);
            if (last && has_next) S.a_ready(nxt);
            const unsigned k1 = (unsigned)(t + 1) * 128u, k2 = last ? 0u : (unsigned)(t + 2) * 128u, k3 = k2 + 128u;
            const char* a2 = last ? nA : cA; const char* b2 = last ? nB : cB;
            unsigned o2[2][2];
            if constexpr (Sched::GATHER) { o2[0][0] = last ? oAn[0][0] : oAc[0][0]; o2[0][1] = last ? oAn[0][1] : oAc[0][1]; o2[1][0] = last ? oAn[1][0] : oAc[1][0]; o2[1][1] = last ? oAn[1][1] : oAc[1][1]; }
            else { o2[0][0] = oAc[0][0]; o2[0][1] = oAc[0][1]; o2[1][0] = oAc[1][0]; o2[1][1] = oAc[1][1]; }
            PG8_LDB(B0, 0, 0); PG8_LDB(B1, 0, 1); PG8_SCHED; PG8_LDA(At, 0, 0); PG8_STAGE(PG8_SA(1, 1), cA, oAc[1], k1);
            PG8_WAIT_V(8); PG8_WAIT_L(0); PG8_BAR; PG8_MMA(0, 0, At, B0); PG8_MMA(0, 1, At, B1); PG8_BAR; PG8_SCHED;
            if (!hm) PG8_LDA(At, 0, 1); PG8_STAGE(PG8_SB(0, 0), b2, voffB, k2); PG8_STAGE(PG8_SB(0, 1), b2, voffBh, k2); PG8_STAGE(PG8_SA(0, 0), a2, o2[0], k2);
            PG8_WAIT_V(8); PG8_WAIT_L(0); PG8_BAR; if (!hm) { PG8_MMA(1, 0, At, B0); PG8_MMA(1, 1, At, B1); } PG8_BAR; PG8_SCHED;
            PG8_LDB(B0, 1, 0); PG8_LDB(B1, 1, 1); PG8_SCHED; PG8_LDA(At, 1, 0); PG8_STAGE(PG8_SA(0, 1), a2, o2[1], k2);
            PG8_WAIT_V(8); PG8_WAIT_L(0); PG8_BAR; PG8_MMA(0, 0, At, B0); PG8_MMA(0, 1, At, B1); PG8_BAR; PG8_SCHED;
            if (!hm) PG8_LDA(At, 1, 1); PG8_STAGE(PG8_SB(1, 0), b2, voffB, k3); PG8_STAGE(PG8_SB(1, 1), b2, voffBh, k3); PG8_STAGE(PG8_SA(1, 0), a2, o2[0], k3);
            PG8_WAIT_V(8); PG8_WAIT_L(0); PG8_BAR; if (!hm) { PG8_MMA(1, 0, At, B0); PG8_MMA(1, 1, At, B1); } PG8_BAR; PG8_SCHED;
        }
        if (wr == 0) PG8_BAR;
#ifdef SUBPH
        unsigned long long ep_t0_ = __builtin_amdgcn_s_memrealtime();
#endif
        { int fr2 = fr, fq2 = fq; asm volatile("" : "+v"(fr2), "+v"(fq2)); E(acc, cur, wr, wc, fr2, fq2); S.done(cur); }
#ifdef SUBPH
        { volatile LAS unsigned* MISC_ = (volatile LAS unsigned*)(lds + 131072 + 8192); if (threadIdx.x == 0 && MISC_[21] == (unsigned)(SUBPH)) MISC_[20] += (unsigned)(__builtin_amdgcn_s_memrealtime() - ep_t0_); }
#endif
        if (!has_next) break;
        bool keep_ = false; if constexpr (Sched::ACCUM) keep_ = S.keep_acc(cur);
        if (!keep_) {
#pragma unroll
        for (int a = 0; a < 2; ++a)
#pragma unroll
            for (int b = 0; b < 2; ++b)
#pragma unroll
                for (int m = 0; m < 4; ++m)
#pragma unroll
                    for (int n = 0; n < 2; ++n) acc[a][b][m][n] = (f32x4){0.f, 0.f, 0.f, 0.f};
        }
        cur = nxt; cA = nA; cB = nB; ++ui;
        if constexpr (Sched::GATHER) { oAc[0][0] = oAn[0][0]; oAc[0][1] = oAn[0][1]; oAc[1][0] = oAn[1][0]; oAc[1][1] = oAn[1][1]; }
        if (wr == 1) PG8_BAR;
    }
    PG8_WAIT_V(0);
    PG8_BAR;
#undef PG8_SA
#undef PG8_SB
#undef PG8_STAGE
#undef PG8_LDA
#undef PG8_LDB
#undef PG8_MMA
#undef PG8_WAIT_V
#undef PG8_WAIT_L
#undef PG8_BAR
#undef PG8_SCHED
}
}
namespace fk {
constexpr size_t MiB = 1u << 20;
constexpr size_t WS_CTL = 0, CTL_ZERO_BYTES = 64 * 1024;
constexpr size_t WS_MOD = 1 * MiB;
constexpr size_t WS_BT = WS_MOD + 832 * 1024;
constexpr size_t WS_LAM = WS_BT + 4096;
constexpr size_t WS_ST = WS_MOD + 896 * 1024;
constexpr size_t WS_CS = 2 * MiB, WS_SN = 3 * MiB;
constexpr size_t WS_LIST = 4 * MiB, WS_ROWW = 6 * MiB, WS_TOKSLOT = 8 * MiB;
constexpr size_t WS_WIN = 10 * MiB;
constexpr size_t WS_WUQ = 58 * MiB;
constexpr size_t WS_WRT = 59 * MiB + 512 * 1024;
constexpr size_t WS_WUKV = 60 * MiB;
constexpr size_t WS_WBR = 62 * MiB;
constexpr size_t WS_WOUT = 74 * MiB;
constexpr size_t WS_WGU = 82 * MiB;
constexpr size_t WS_WDN = 210 * MiB;
constexpr size_t WS_X = 274 * MiB;
constexpr size_t WS_MERGED = 306 * MiB;
constexpr size_t WS_POOL = 338 * MiB;
constexpr size_t WS_Y1 = WS_POOL;
constexpr size_t WS_Z = WS_POOL;
constexpr size_t WS_ACT = WS_POOL + 96 * MiB;
constexpr size_t WS_XG = WS_POOL + 96 * MiB;
constexpr size_t WS_QC = WS_POOL + 192 * MiB;
constexpr size_t WS_KVC = WS_POOL + 216 * MiB;
constexpr size_t WS_KR = WS_POOL + 248 * MiB;
constexpr size_t WS_STAT = WS_KR + 1 * MiB;
constexpr size_t WS_STAT2 = WS_STAT + 512 * 1024;
constexpr size_t WS_OA = WS_POOL + 250 * MiB, WS_OB = WS_POOL + 266 * MiB, WS_OC = WS_POOL + 282 * MiB;
constexpr size_t WS_H = WS_POOL + 298 * MiB;
constexpr size_t WS_END = WS_POOL + 330 * MiB;
constexpr int CW_BAR = 1024;
constexpr int CW_CNT = 8192;
constexpr int CW_GBAR = 4608;
constexpr int CW_RDY = 9216;
constexpr int CW_G2CNT = 8512;
constexpr int CW_TMO2 = 8448;
static_assert((CW_RDY + 4 * 256) * 4 <= (int)CTL_ZERO_BYTES, "ctl map 2");
static_assert((CW_BAR + XCD_BAR_WORDS) <= CW_CNT && (CW_CNT + 4 * 32) * 4 <= (int)CTL_ZERO_BYTES, "ctl map");
constexpr int RING_BYTES = 131072, TAB_OFF = RING_BYTES, MISC_OFF = TAB_OFF + 8192, LDS_BYTES = 147456;

__device__ __forceinline__ size_t zrow(int ts) { return (size_t)(ts >> 12) * 6291456u + (size_t)(ts & 4095) * 1024u; }
struct Params {
    const float *x, *c; const int* positions; const float *w_ada, *b_ada, *norm_g, *w_in, *diff_qk_g, *diff_lambda, *diff_out_g, *rel_bias, *sgu_v_g, *sgu_w, *sgu_b,
        *mla_lat_g, *mla_w_uq, *mla_w_ukv, *mla_qk_g, *w_branch, *w_out, *router_g_w, *router_g_b, *router_e_w, *router_e_b, *w_e_gate, *w_e_up, *w_e_down;
    float* out; unsigned char* ws; int ph_lo, ph_hi; int l_lo, l_hi; int nlayers, pad_;
};

__device__ __forceinline__ void transpose_blk(const float* W, int ldw, int sc0, int k0, bf16* WT, int dr0, int ldt, const float* kscale, LAS float* scr, int lane) {
    f32x4 tv[8];
#pragma unroll
    for (int i = 0; i < 8; ++i) { const int kk = 8 * i + (lane >> 3); tv[i] = *(const GAS f32x4*)(W + (size_t)(k0 + kk) * ldw + sc0 + (lane & 7) * 4); }
#pragma unroll
    for (int i = 0; i < 8; ++i) { const int kk = 8 * i + (lane >> 3); f32x4 v = tv[i]; if (kscale) v *= kscale[k0 + kk];
        LAS float* d = scr + kk * 33 + (lane & 7) * 4; d[0] = v.x; d[1] = v.y; d[2] = v.z; d[3] = v.w; }
    LDS_WAIT(); asm volatile("" ::: "memory");
    const int c = lane & 7;
#pragma unroll
    for (int j = 0; j < 4; ++j) { const int n = (lane >> 3) + 8 * j; const LAS float* sp = scr + (8 * c) * 33 + n;
        u32x4 o; o.x = cvtpk(sp[0 * 33], sp[1 * 33]); o.y = cvtpk(sp[2 * 33], sp[3 * 33]); o.z = cvtpk(sp[4 * 33], sp[5 * 33]); o.w = cvtpk(sp[6 * 33], sp[7 * 33]);
        *(GAS u32x4*)(WT + (size_t)(dr0 + n) * ldt + k0 + 8 * c) = o; }
    LDS_WAIT(); asm volatile("" ::: "memory");
}
__device__ __forceinline__ void transpose_item(const float* W, int K, int ldw, int c0, int ncols, bf16* WT, int row_off, LAS float* scr, int item, int lane, int ldt = 0) {
    if (ldt == 0) ldt = K;
    const int nblk = ncols / 32, kb = item / nblk, nb = item % nblk;
    transpose_blk(W, ldw, c0 + 32 * nb, 64 * kb, WT, row_off + 32 * nb, ldt, nullptr, scr, lane);
}
}
namespace fk {
struct Frame { LAS unsigned char* lds; unsigned char* ws; int tid, lane, wave, G, bid, gw, NGW;
#ifdef SUBT
    unsigned long long tsub;
#endif
};
#ifdef SUBT
#define SUB_T0(id) unsigned long long subt0_##id = ((SUBT) == (id)) ? __builtin_amdgcn_s_memrealtime() : 0ull
#define SUB_T1(F, id) do { if ((SUBT) == (id)) F.tsub += __builtin_amdgcn_s_memrealtime() - subt0_##id; } while (0)
#else
#define SUB_T0(id) do {} while (0)
#define SUB_T1(F, id) do {} while (0)
#endif

constexpr int IT_IN1 = 16 * 93, IT_IN2 = 16 * 96, IT_UQ = 4 * 24, IT_UKV = 2 * 32, IT_BR = 8 * 32, IT_OUT = 16 * 32, IT_NONEXP = IT_IN1 + IT_IN2 + IT_UQ + IT_UKV + 3 * IT_BR + IT_OUT;
constexpr int IT_EXP = 4 * 64 + 128, IT_LAYER = IT_NONEXP + 32 * IT_EXP, IT_TOTAL = NL * IT_LAYER;
__device__ __forceinline__ void p0_prologue(Frame& F, const Params& p) {
    unsigned char* ws = F.ws;
    LAS float* cact = (LAS float*)(F.lds);
    SUB_T0(21);
    for (int i = F.tid; i < NB * D; i += NTHR) { const float v = p.c[i]; cact[i] = v / (1.f + __expf(-v)); }
    __syncthreads();
    LAS float* part = (LAS float*)(F.lds + 32768);
    float* MOD = (float*)(ws + WS_MOD);
    for (int it = F.bid; it < NL * 64; it += F.G) {
        const int l = it >> 6, cg = it & 63;
        const int sl = F.lane < 48 ? F.lane : F.lane - 48;
        const int c4 = (sl % 24) * 4, krow = sl / 24;
        const int kb = F.wave * 128 + krow;
        const float* w = p.w_ada + (size_t)l * D * 6 * D + (size_t)kb * 6 * D + cg * 96 + c4;
        f32x4 acc[NB];
#pragma unroll
        for (int b = 0; b < NB; ++b) acc[b] = (f32x4){0.f, 0.f, 0.f, 0.f};
#pragma unroll 1
        for (int i0 = 0; i0 < 64; i0 += 16) {
            f32x4 wv[16];
#pragma unroll
            for (int i = 0; i < 16; ++i) wv[i] = *(const GAS f32x4*)(w + (size_t)(2 * (i0 + i)) * 6 * D);
#pragma unroll
            for (int i = 0; i < 16; ++i) {
#pragma unroll
                for (int b = 0; b < NB; ++b) acc[b] += wv[i] * cact[b * D + kb + 2 * (i0 + i)]; }
        }
        if (F.lane < 48) {
#pragma unroll
            for (int b = 0; b < NB; ++b) *(LAS f32x4*)(part + ((F.wave * 2 + krow) * NB + b) * 96 + c4) = acc[b]; }
        __syncthreads();
        for (int o = F.tid; o < NB * 96; o += NTHR) { const int b = o / 96, c = o % 96; float s = 0.f;
#pragma unroll
            for (int j = 0; j < 16; ++j) s += part[(j * NB + b) * 96 + c];
            MOD[((size_t)l * NB + b) * 6 * D + cg * 96 + c] = s + p.b_ada[l * 6 * D + cg * 96 + c]; }
        __syncthreads();
    }
    SUB_T1(F, 21); SUB_T0(22);
    const int gt = F.bid * NTHR + F.tid, NGT = F.G * NTHR;
    if (gt < NL) { const float* dl = p.diff_lambda + gt * 256; float s01 = 0.f, s23 = 0.f;
        for (int i = 0; i < 64; ++i) { s01 += dl[i] * dl[64 + i]; s23 += dl[128 + i] * dl[192 + i]; }
        ((float*)(ws + WS_LAM))[gt] = expf(s01) - expf(s23) + (0.8f - 0.6f * expf(-0.3f * (float)gt)); }
    if (gt >= 1024 && gt < 1024 + 4 * 256) { const int i = gt - 1024, h = i >> 8, rel = (i & 255) - 191; const int n = rel < 0 ? -rel : rel;
        int large = 8 + (int)(logf((float)(n > 1 ? n : 1) / 8.f) / 2.772588722239781f * 8.f); if (large > 15) large = 15;
        const int bucket = (rel > 0 ? 16 : 0) + (n < 8 ? n : large);
        ((float*)(ws + WS_BT))[i] = (p.rel_bias[bucket * 4 + h] - p.rel_bias[15 * 4 + h]) * LOG2E; }
    for (int i = gt; i < M * 16; i += NGT) { const int m = i >> 4, j = i & 15; const float inv_freq = powf(10000.f, -(float)(2 * j) / 32.f);
        const float ang = (float)p.positions[m] * inv_freq; ((float*)(ws + WS_CS))[i] = cosf(ang); ((float*)(ws + WS_SN))[i] = sinf(ang); }
    for (int i = gt; i < NL * 96 * 128; i += NGT) { const int l = i / (96 * 128), r = i % (96 * 128); ((u32x4*)(ws + WS_WIN + (size_t)l * 6144 * 2048 + (size_t)2976 * 2048))[r] = (u32x4){0u, 0u, 0u, 0u}; }
    for (int i = gt; i < NL * 48 * 1024; i += NGT) { const int l = i / (48 * 1024), r = i % (48 * 1024), o = r >> 10, k = r & 1023;
        const float v = o < 32 ? p.router_e_w[((size_t)l * D + k) * 32 + o] : (o < 36 ? p.router_g_w[((size_t)l * D + k) * 4 + (o - 32)] : 0.f);
        ((bf16*)(ws + WS_WRT))[i] = (bf16)(cvtpk(v, 0.f) & 0xffffu); }
    for (int i = gt; i < NL * 1024 * 16; i += NGT) { const int rr = i >> 4, q = i & 15; ((u32x4*)(ws + WS_WUKV + (size_t)rr * 512 + 256))[q] = (u32x4){0u, 0u, 0u, 0u}; }
    SUB_T1(F, 22);
    LAS float* scr = (LAS float*)(F.lds + 49152 + F.wave * 8448);
    auto do_item = [&](int it) {
        const int l = it / IT_LAYER; int r = it % IT_LAYER;
        if (r < IT_IN1) { const int kb = r / 93, nb = r % 93, n0 = 32 * nb;
            const int sc0 = n0 < 1024 ? (n0 & ~255) + 64 * ((n0 >> 5) & 3) + 32 * ((n0 >> 7) & 1) : n0;
            transpose_blk(p.w_in + (size_t)l * D * 6048, 6048, sc0, 64 * kb, (bf16*)(ws + WS_WIN) + (size_t)l * 6144 * 1024, n0, 1024, nullptr, scr, F.lane); return; } r -= IT_IN1;
        if (r < IT_IN2) { transpose_item(p.w_in + (size_t)l * D * 6048, 1024, 6048, 2976, 3072, (bf16*)(ws + WS_WIN) + (size_t)l * 6144 * 1024, 3072, scr, r, F.lane); return; } r -= IT_IN2;
        if (r < IT_UQ) { const int kb = r / 24, nb = r % 24, n0 = 32 * nb, tt = n0 >> 8, bj = (n0 >> 7) & 1, wc = (n0 >> 5) & 3;
            const int sc0 = tt < 2 ? (4 * tt + wc) * 96 + 32 * bj : (4 * bj + wc) * 96 + 64;
            transpose_blk(p.mla_w_uq + (size_t)l * 256 * 768, 768, sc0, 64 * kb, (bf16*)(ws + WS_WUQ) + (size_t)l * 768 * 256, n0, 256, p.mla_lat_g + l * 384, scr, F.lane); return; } r -= IT_UQ;
        if (r < IT_UKV) { const int kb = r / 32, nb = r % 32, n0 = 32 * nb, tt = n0 >> 8, bj = (n0 >> 7) & 1, wc = (n0 >> 5) & 3;
            const int sc0 = tt < 2 ? (4 * tt + wc) * 128 + 32 * bj : (4 * (tt - 2) + wc) * 128 + 64 + 32 * bj;
            transpose_blk(p.mla_w_ukv + (size_t)l * 128 * 1024, 1024, sc0, 64 * kb, (bf16*)(ws + WS_WUKV) + (size_t)l * 1024 * 256, n0, 256, p.mla_lat_g + l * 384 + 256, scr, F.lane); return; } r -= IT_UKV;
        if (r < 3 * IT_BR) { const int n = r / IT_BR; transpose_item(p.w_branch + ((size_t)l * 3 + n) * 512 * 1024, 512, 1024, 0, 1024, (bf16*)(ws + WS_WBR) + ((size_t)l * 3 + n) * 1024 * 512, 0, scr, r % IT_BR, F.lane); return; } r -= 3 * IT_BR;
        if (r < IT_OUT) { transpose_item(p.w_out + (size_t)l * D * D, 1024, 1024, 0, 1024, (bf16*)(ws + WS_WOUT) + (size_t)l * D * D, 0, scr, r, F.lane); return; } r -= IT_OUT;
        const int e = r / IT_EXP, q = r % IT_EXP; const size_t le = (size_t)l * 32 + e;
        if (q < 256) { const int jj = q >> 6; const float* src = ((jj & 1) ? p.w_e_up : p.w_e_gate) + le * 1024 * 256;
            transpose_item(src, 1024, 256, (jj >> 1) * 128, 128, (bf16*)(ws + WS_WGU) + le * 512 * 1024, jj * 128, scr, q & 63, F.lane); }
        else transpose_item(p.w_e_down + le * 256 * 1024, 256, 1024, 0, 1024, (bf16*)(ws + WS_WDN) + le * 1024 * 256, 0, scr, q - 256, F.lane);
    };
    for (int it = F.gw; it < IT_TOTAL; it += F.NGW) do_item(it);
}

template <int MODE>
__device__ __forceinline__ void row_normmod(Frame& F, const float* xin, bf16* X, const bf16* Z, const float* gateprev, const float* g, const float* shift, const float* scale, bf16* H, float* out) {
    constexpr int R = 2;
    const int mb = (F.bid & 7) * 2048 + (F.bid >> 3) * 64 + F.wave;
    const int bb = F.bid & 7;
    f32x4 ga[4], shv[4], gtv[4];
#pragma unroll
    for (int j = 0; j < 4; ++j) { const int d = 4 * F.lane + 256 * j;
        if (MODE != 3) { const f32x4 gg = *(const GAS f32x4*)(g + d), sc = *(const GAS f32x4*)(scale + (size_t)bb * 6 * D + d); shv[j] = *(const GAS f32x4*)(shift + (size_t)bb * 6 * D + d);
            ga[j] = (f32x4){gg.x * (1.f + sc.x), gg.y * (1.f + sc.y), gg.z * (1.f + sc.z), gg.w * (1.f + sc.w)}; }
        if (MODE >= 2) gtv[j] = *(const GAS f32x4*)(gateprev + (size_t)bb * 6 * D + d); }
    for (int kq = 0; kq < 8; kq += R) { const int m0 = mb + 8 * kq;
        f32x4 v[R][4]; u32x2 z0[R][4], z1[R][4];
#pragma unroll
        for (int r = 0; r < R; ++r) { const int m = m0 + 8 * r;
#pragma unroll
            for (int j = 0; j < 4; ++j) { const int d = 4 * F.lane + 256 * j;
                if (MODE == 0) v[r][j] = *(const GAS f32x4*)(xin + (size_t)m * D + d);
                else { const u32x2 xb = *(const GAS u32x2*)(X + (size_t)m * D + d); v[r][j] = (f32x4){bf_lo(xb.x), bf_hi(xb.x), bf_lo(xb.y), bf_hi(xb.y)}; }
                if (MODE >= 2) { z0[r][j] = *(const GAS u32x2*)(Z + zrow(2 * m) + d); z1[r][j] = *(const GAS u32x2*)(Z + zrow(2 * m + 1) + d); } } }
#pragma unroll
        for (int r = 0; r < R; ++r) { const int m = m0 + 8 * r; const int b = m / S;
#pragma unroll
            for (int j = 0; j < 4; ++j) { const int d = 4 * F.lane + 256 * j;
                if (MODE >= 2) { const f32x4 gt = gtv[j];
                    v[r][j].x += gt.x * (bf_lo(z0[r][j].x) + bf_lo(z1[r][j].x)); v[r][j].y += gt.y * (bf_hi(z0[r][j].x) + bf_hi(z1[r][j].x));
                    v[r][j].z += gt.z * (bf_lo(z0[r][j].y) + bf_lo(z1[r][j].y)); v[r][j].w += gt.w * (bf_hi(z0[r][j].y) + bf_hi(z1[r][j].y)); }
                if (MODE == 2) { u32x2 xo; xo.x = cvtpk(v[r][j].x, v[r][j].y); xo.y = cvtpk(v[r][j].z, v[r][j].w); *(GAS u32x2*)(X + (size_t)m * D + d) = xo;
                    v[r][j] = (f32x4){bf_lo(xo.x), bf_hi(xo.x), bf_lo(xo.y), bf_hi(xo.y)}; }
                if (MODE == 3) *(GAS f32x4*)(out + (size_t)m * D + d) = v[r][j]; }
            if (MODE == 3) continue;
            float s = 0.f;
#pragma unroll
            for (int j = 0; j < 4; ++j) s += (v[r][j].x * v[r][j].x + v[r][j].y * v[r][j].y) + (v[r][j].z * v[r][j].z + v[r][j].w * v[r][j].w);
            const float rstd = rsqrtf(wave_sum(s) * (1.f / D) + 1e-6f);
#pragma unroll
            for (int j = 0; j < 4; ++j) { const int d = 4 * F.lane + 256 * j;
                const float o0 = v[r][j].x * rstd * ga[j].x + shv[j].x, o1 = v[r][j].y * rstd * ga[j].y + shv[j].y, o2 = v[r][j].z * rstd * ga[j].z + shv[j].z, o3 = v[r][j].w * rstd * ga[j].w + shv[j].w;
                u32x2 o; o.x = cvtpk(o0, o1); o.y = cvtpk(o2, o3); st8x(H + (size_t)m * D + d, o); }
        }
    }
}

struct SchedDense {
    static constexpr bool GATHER = false; static constexpr bool HALFM = false; static constexpr bool ACCUM = false;
    __device__ __forceinline__ void a_ready(const GUnit&) const {}
    __device__ __forceinline__ void done(const GUnit&) const {}
    const char* A; const char* B; unsigned lda_b, ldb_b; int nM, nN, nt, G, c;
    __device__ __forceinline__ bool next(int i, GUnit& u) const {
        const long L = (long)i * G + c; const int nwg = nM * nN; if (L >= nwg) return false;
        int wgid = (int)L; { const int q = nwg / 8, r = nwg % 8, xcd = wgid % 8, off = wgid / 8; wgid = (xcd < r ? xcd * (q + 1) : r * (q + 1) + (xcd - r) * q) + off; }
        const int nig = 8 * nN, gid = wgid / nig, fm = gid * 8, gsz = (nM - fm) < 8 ? (nM - fm) : 8;
        const int pm = fm + ((wgid % nig) % gsz), pn = (wgid % nig) / gsz;
        u.A = A + (size_t)pm * 256 * lda_b; u.B = B + (size_t)pn * 256 * ldb_b; u.nt = nt; u.i0 = pm; u.i1 = pn; u.i2 = 0; return true;
    }
    __device__ __forceinline__ void offs(const GUnit&, int R0, int R1, int C0, int C1, unsigned (&oA)[2][2]) const {
        oA[0][0] = (unsigned)R0 * lda_b + C0 * 2u; oA[0][1] = (unsigned)R1 * lda_b + C1 * 2u; oA[1][0] = (unsigned)(R0 + 128) * lda_b + C0 * 2u; oA[1][1] = (unsigned)(R1 + 128) * lda_b + C1 * 2u; }
    __device__ __forceinline__ unsigned ldb_bytes() const { return ldb_b; }
};
struct SchedDensePub : SchedDense {
    unsigned* cnt;
    __device__ __forceinline__ void done(const GUnit& u) const { asm volatile("s_waitcnt vmcnt(0)" ::: "memory"); if ((threadIdx.x & 63) == 0) __hip_atomic_fetch_add(cnt + (u.i0 >> 3), 1u, __ATOMIC_RELAXED, __HIP_MEMORY_SCOPE_AGENT); }
};
struct EpiStoreBf16 {
    bf16* O0; bf16* O1; int split, ldc0, ldc1;
    __device__ __forceinline__ void operator()(const f32x4 (&acc)[2][2][4][2], const GUnit& u, int wr, int wc, int fr, int fq) const {
        const int pn = u.i1; bf16* base; int ldc; if (pn < split) { base = O0 + 256 * pn; ldc = ldc0; } else { base = O1 + 256 * (pn - split); ldc = ldc1; }
        const int row0 = u.i0 * 256 + wr * 64 + fr, col0 = wc * 32 + 8 * fq;
#pragma unroll
        for (int ai = 0; ai < 2; ++ai)
#pragma unroll
            for (int m = 0; m < 4; ++m) { bf16* rowp = base + (size_t)(row0 + ai * 128 + m * 16) * ldc + col0;
#pragma unroll
                for (int bj = 0; bj < 2; ++bj) { const f32x4 v0 = acc[ai][bj][m][0], v1 = acc[ai][bj][m][1];
                    u32x4 w; w.x = cvtpk(v0[0], v0[1]); w.y = cvtpk(v0[2], v0[3]); w.z = cvtpk(v1[0], v1[1]); w.w = cvtpk(v1[2], v1[3]);
                    st16(rowp + bj * 128, w); } }
    }
};
struct EpiG1 {
    bf16* Y1; bf16* XG; bf16* KR; float* ST; float* ST2; const float* gq; const float* kg; const float* CS; const float* SN;
    __device__ __forceinline__ void operator()(const f32x4 (&acc)[2][2][4][2], const GUnit& u, int wr, int wc, int fr, int fq) const {
        const int pn = u.i1; const int row0 = u.i0 * 256 + wr * 64 + fr;
        if (pn < 4) {
            const float* g = gq + (pn >> 1) * 64; const float mul = pn < 2 ? 0.125f * LOG2E : 1.f;
            f32x4 gv[2][2];
#pragma unroll
            for (int bj = 0; bj < 2; ++bj)
#pragma unroll
                for (int n = 0; n < 2; ++n) gv[bj][n] = *(const GAS f32x4*)(g + 32 * bj + 8 * fq + 4 * n);
            float sj[8];
#pragma unroll
            for (int j = 0; j < 8; ++j) { const int ai = j >> 2, m = j & 3; float s = 0.f;
#pragma unroll
                for (int bj = 0; bj < 2; ++bj)
#pragma unroll
                    for (int n = 0; n < 2; ++n) { const f32x4 v = acc[ai][bj][m][n]; s += (v[0] * v[0] + v[1] * v[1]) + (v[2] * v[2] + v[3] * v[3]); }
                sj[j] = s; }
#pragma unroll
            for (int j = 0; j < 8; ++j) sj[j] += sw<16>(sj[j]);
#pragma unroll
            for (int j = 0; j < 8; ++j) sj[j] = xsum32(sj[j]);
#pragma unroll
            for (int ai = 0; ai < 2; ++ai)
#pragma unroll
                for (int m = 0; m < 4; ++m) {
                    const float rstd = rsqrtf(sj[ai * 4 + m] * (1.f / 64.f) + 1e-6f) * mul;
                    bf16* rowp = Y1 + (size_t)(row0 + ai * 128 + m * 16) * 3072 + 256 * pn + 64 * wc + 8 * fq;
#pragma unroll
                    for (int bj = 0; bj < 2; ++bj) { const f32x4 v0 = acc[ai][bj][m][0] * rstd * gv[bj][0], v1 = acc[ai][bj][m][1] * rstd * gv[bj][1];
                        u32x4 w; w.x = cvtpk(v0[0], v0[1]); w.y = cvtpk(v0[2], v0[3]); w.z = cvtpk(v1[0], v1[1]); w.w = cvtpk(v1[2], v1[3]);
                        st16(rowp + 32 * bj, w); }
                }
            return;
        }
        if (pn >= 12) {
            const int gn = (pn - 12) >> 2, gp = (pn - 12) & 3;
            unsigned char* gb = (unsigned char*)XG + ((((size_t)(u.i0 * 4 + gp) * 3 + gn) * 8 + (wr * 4 + wc)) * 8) * 1024 + (fq * 16 + fr) * 16;
#pragma unroll
            for (int ai = 0; ai < 2; ++ai)
#pragma unroll
                for (int m = 0; m < 4; ++m) { u32x4 w;
#pragma unroll
                    for (int bj = 0; bj < 2; ++bj) { const f32x4 v0 = acc[ai][bj][m][0], v1 = acc[ai][bj][m][1]; unsigned q[8];
#pragma unroll
                        for (int t = 0; t < 8; ++t) { const float x = t < 4 ? v0[t & 3] : v1[t & 3]; q[t] = (unsigned)(fast_sigmoid(x) * 255.f + 0.5f); q[t] = q[t] < 1u ? 1u : q[t]; }
                        const unsigned lo = q[0] | (q[1] << 8) | (q[2] << 16) | (q[3] << 24), hi2 = q[4] | (q[5] << 8) | (q[6] << 16) | (q[7] << 24);
                        if (bj == 0) { w.x = lo; w.y = hi2; } else { w.z = lo; w.w = hi2; } }
                    *(GAS u32x4*)(gb + (ai * 4 + m) * 1024) = w; }
            return;
        }
        bf16* base = Y1 + 256 * pn; const int col0 = wc * 32 + 8 * fq;
#pragma unroll
        for (int ai = 0; ai < 2; ++ai)
#pragma unroll
            for (int m = 0; m < 4; ++m) { bf16* rowp = base + (size_t)(row0 + ai * 128 + m * 16) * 3072 + col0;
#pragma unroll
                for (int bj = 0; bj < 2; ++bj) { const f32x4 v0 = acc[ai][bj][m][0], v1 = acc[ai][bj][m][1];
                    u32x4 w; w.x = cvtpk(v0[0], v0[1]); w.y = cvtpk(v0[2], v0[3]); w.z = cvtpk(v1[0], v1[1]); w.w = cvtpk(v1[2], v1[3]);
                    st16(rowp + bj * 128, w); } }
        if (pn == 8 || pn == 9) {
#pragma unroll
            for (int ai = 0; ai < 2; ++ai) { float sj[4];
#pragma unroll
                for (int m = 0; m < 4; ++m) { float s = 0.f;
#pragma unroll
                    for (int bj = 0; bj < 2; ++bj)
#pragma unroll
                        for (int n = 0; n < 2; ++n) { const f32x4 v = acc[ai][bj][m][n]; const float a0 = gelu_tanh(v[0]), a1 = gelu_tanh(v[1]), a2 = gelu_tanh(v[2]), a3 = gelu_tanh(v[3]); s += (a0 * a0 + a1 * a1) + (a2 * a2 + a3 * a3); }
                    sj[m] = s; }
#pragma unroll
                for (int m = 0; m < 4; ++m) sj[m] += sw<16>(sj[m]);
#pragma unroll
                for (int m = 0; m < 4; ++m) sj[m] = xsum32(sj[m]);
#pragma unroll
                for (int m = 0; m < 4; ++m) if (fq == 0) ST2[(size_t)(row0 + ai * 128 + m * 16) * 8 + (pn - 8) * 4 + wc] = sj[m]; }
        }
        if (pn == 10 || pn == 11) {
            float sj[8];
#pragma unroll
            for (int j = 0; j < 8; ++j) { const int ai = j >> 2, m = j & 3; float s = 0.f;
#pragma unroll
                for (int bj = 0; bj < 2; ++bj) { if (pn == 11 && bj == 1) continue;
#pragma unroll
                    for (int n = 0; n < 2; ++n) { const f32x4 v = acc[ai][bj][m][n]; s += (v[0] * v[0] + v[1] * v[1]) + (v[2] * v[2] + v[3] * v[3]); } }
                sj[j] = s; }
#pragma unroll
            for (int j = 0; j < 8; ++j) sj[j] += sw<16>(sj[j]);
#pragma unroll
            for (int j = 0; j < 8; ++j) sj[j] = xsum32(sj[j]);
#pragma unroll
            for (int j = 0; j < 8; ++j) if (fq == 0) ST[(size_t)(row0 + (j >> 2) * 128 + (j & 3) * 16) * 8 + (pn - 10) * 4 + wc] = sj[j];
        }
        if (pn == 11 && wc == 0) {
            f32x4 g0 = *(const GAS f32x4*)(kg + 64 + 8 * fq), g1 = *(const GAS f32x4*)(kg + 64 + 8 * fq + 4);
#pragma unroll
            for (int ai = 0; ai < 2; ++ai)
#pragma unroll
                for (int m = 0; m < 4; ++m) { const size_t row = row0 + ai * 128 + m * 16;
                    f32x4 v0 = acc[ai][1][m][0], v1 = acc[ai][1][m][1];
                    float s = (v0[0] * v0[0] + v0[1] * v0[1]) + (v0[2] * v0[2] + v0[3] * v0[3]) + (v1[0] * v1[0] + v1[1] * v1[1]) + (v1[2] * v1[2] + v1[3] * v1[3]);
                    s += sw<16>(s); s = xsum32(s);
                    const float rstd = rsqrtf(s * (1.f / 32.f) + 1e-6f);
                    v0 = v0 * rstd * g0; v1 = v1 * rstd * g1;
                    const f32x4 c0 = *(const GAS f32x4*)(CS + row * 16 + 8 * (fq & 1)), c1 = *(const GAS f32x4*)(CS + row * 16 + 8 * (fq & 1) + 4);
                    const f32x4 s0 = *(const GAS f32x4*)(SN + row * 16 + 8 * (fq & 1)), s1 = *(const GAS f32x4*)(SN + row * 16 + 8 * (fq & 1) + 4);
                    f32x4 o0, o1;
#pragma unroll
                    for (int i = 0; i < 4; ++i) { const float p0 = xget32(v0[i], fq >= 2), p1 = xget32(v1[i], fq >= 2);
                        o0[i] = fq < 2 ? v0[i] * c0[i] - p0 * s0[i] : v0[i] * c0[i] + p0 * s0[i]; o1[i] = fq < 2 ? v1[i] * c1[i] - p1 * s1[i] : v1[i] * c1[i] + p1 * s1[i]; }
                    u32x4 w; w.x = cvtpk(o0[0], o0[1]); w.y = cvtpk(o0[2], o0[3]); w.z = cvtpk(o1[0], o1[1]); w.w = cvtpk(o1[2], o1[3]);
                    *(GAS u32x4*)(KR + row * 32 + 8 * fq) = w; }
        }
    }
};
template <int WHICH>
struct EpiG2 {
    bf16* O; const float* ST; const float* g; const float* CS; const float* SN;
    __device__ __forceinline__ void operator()(const f32x4 (&acc)[2][2][4][2], const GUnit& u, int wr, int wc, int fr, int fq) const {
        const int pn = u.i1; const int row0 = u.i0 * 256 + wr * 64 + fr; const float qs = 0.10206207261596577f * LOG2E;
        float r0[8];
#pragma unroll
        for (int h2 = 0; h2 < 2; ++h2) { f32x4 sp[4];
#pragma unroll
            for (int j = 0; j < 4; ++j) sp[j] = *(const GAS f32x4*)(ST + (size_t)(row0 + h2 * 128 + j * 16) * 8 + WHICH * 4);
#pragma unroll
            for (int j = 0; j < 4; ++j) r0[4 * h2 + j] = rsqrtf(((sp[j][0] + sp[j][1]) + (sp[j][2] + sp[j][3])) * (WHICH ? 1.f / 128.f : 1.f / 256.f) + 1e-6f);
            asm volatile("" ::: "memory"); }
        if (pn < 2) {
            float s[8];
#pragma unroll
            for (int j = 0; j < 8; ++j) { const int ai = j >> 2, m = j & 3; float t = 0.f;
#pragma unroll
                for (int bj = 0; bj < 2; ++bj)
#pragma unroll
                    for (int n = 0; n < 2; ++n) { const f32x4 a = acc[ai][bj][m][n]; t += (a[0] * a[0] + a[1] * a[1]) + (a[2] * a[2] + a[3] * a[3]); }
                s[j] = t * r0[j] * r0[j]; }
#pragma unroll
            for (int j = 0; j < 8; ++j) s[j] += sw<16>(s[j]);
#pragma unroll
            for (int j = 0; j < 8; ++j) s[j] = xsum32(s[j]);
            f32x4 g0[2], g1[2];
#pragma unroll
            for (int bj = 0; bj < 2; ++bj) { g0[bj] = *(const GAS f32x4*)(g + 32 * bj + 8 * fq); g1[bj] = *(const GAS f32x4*)(g + 32 * bj + 8 * fq + 4); }
#pragma unroll
            for (int j = 0; j < 8; ++j) { const int ai = j >> 2, m = j & 3; const size_t row = row0 + ai * 128 + m * 16;
                const float rstd = rsqrtf(s[j] * (1.f / 64.f) + 1e-6f) * (WHICH ? 1.f : qs) * r0[j];
                bf16* op = O + row * (WHICH ? 1024 : 768) + (4 * pn + wc) * (WHICH ? 128 : 96) + 8 * fq;
#pragma unroll
                for (int bj = 0; bj < 2; ++bj) { const f32x4 a = acc[ai][bj][m][0] * rstd * g0[bj], b = acc[ai][bj][m][1] * rstd * g1[bj];
                    u32x4 w; w.x = cvtpk(a[0], a[1]); w.y = cvtpk(a[2], a[3]); w.z = cvtpk(b[0], b[1]); w.w = cvtpk(b[2], b[3]);
                    st16(op + 32 * bj, w); }
                asm volatile("" ::: "memory"); }
        } else if (WHICH == 1) {
#pragma unroll
            for (int j = 0; j < 8; ++j) { const int ai = j >> 2, m = j & 3; const size_t row = row0 + ai * 128 + m * 16;
                bf16* op = O + row * 1024 + (4 * (pn - 2) + wc) * 128 + 64 + 8 * fq;
#pragma unroll
                for (int bj = 0; bj < 2; ++bj) { const f32x4 a = acc[ai][bj][m][0] * r0[j], b = acc[ai][bj][m][1] * r0[j];
                    u32x4 w; w.x = cvtpk(a[0], a[1]); w.y = cvtpk(a[2], a[3]); w.z = cvtpk(b[0], b[1]); w.w = cvtpk(b[2], b[3]);
                    st16(op + 32 * bj, w); } }
        } else {
            const f32x4 g0 = *(const GAS f32x4*)(g + 64 + 8 * fq), g1 = *(const GAS f32x4*)(g + 64 + 8 * fq + 4);
#pragma unroll
            for (int hq = 0; hq < 4; ++hq) { const int ai = hq >> 1, mb = (hq & 1) * 2;
                float s[4];
#pragma unroll
                for (int mm = 0; mm < 2; ++mm)
#pragma unroll
                    for (int bj = 0; bj < 2; ++bj) { const int m = mb + mm; const f32x4 a = acc[ai][bj][m][0], b = acc[ai][bj][m][1];
                        s[2 * mm + bj] = ((a[0] * a[0] + a[1] * a[1]) + (a[2] * a[2] + a[3] * a[3]) + (b[0] * b[0] + b[1] * b[1]) + (b[2] * b[2] + b[3] * b[3])) * r0[4 * ai + m] * r0[4 * ai + m]; }
#pragma unroll
                for (int k = 0; k < 4; ++k) s[k] += sw<16>(s[k]);
#pragma unroll
                for (int k = 0; k < 4; ++k) s[k] = xsum32(s[k]);
#pragma unroll
                for (int mm = 0; mm < 2; ++mm) { const int m = mb + mm; const size_t row = row0 + ai * 128 + m * 16;
                    const f32x4 c0 = *(const GAS f32x4*)(CS + row * 16 + 8 * (fq & 1)), c1 = *(const GAS f32x4*)(CS + row * 16 + 8 * (fq & 1) + 4);
                    const f32x4 s0 = *(const GAS f32x4*)(SN + row * 16 + 8 * (fq & 1)), s1 = *(const GAS f32x4*)(SN + row * 16 + 8 * (fq & 1) + 4);
#pragma unroll
                    for (int bj = 0; bj < 2; ++bj) {
                        const float rstd = rsqrtf(s[2 * mm + bj] * (1.f / 32.f) + 1e-6f) * qs * r0[4 * ai + m];
                        const f32x4 a = acc[ai][bj][m][0] * rstd * g0, b = acc[ai][bj][m][1] * rstd * g1; f32x4 o0, o1;
#pragma unroll
                        for (int i = 0; i < 4; ++i) { const float p0 = xget32(a[i], fq >= 2), p1 = xget32(b[i], fq >= 2);
                            o0[i] = fq < 2 ? a[i] * c0[i] - p0 * s0[i] : a[i] * c0[i] + p0 * s0[i]; o1[i] = fq < 2 ? b[i] * c1[i] - p1 * s1[i] : b[i] * c1[i] + p1 * s1[i]; }
                        u32x4 w; w.x = cvtpk(o0[0], o0[1]); w.y = cvtpk(o0[2], o0[3]); w.z = cvtpk(o1[0], o1[1]); w.w = cvtpk(o1[2], o1[3]);
                        st16(O + row * 768 + (4 * bj + wc) * 96 + 64 + 8 * fq, w); } }
                asm volatile("" ::: "memory");
            }
        }
    }
};
struct EpiG2Both {
    EpiG2<0> q; EpiG2<1> kv;
    __device__ __forceinline__ void operator()(const f32x4 (&acc)[2][2][4][2], const GUnit& u, int wr, int wc, int fr, int fq) const { if (u.i2) kv(acc, u, wr, wc, fr, fq); else q(acc, u, wr, wc, fr, fq); }
};
}
namespace fk {
typedef short v4i16_t __attribute__((ext_vector_type(4)));
typedef LAS const char* lds_cptr;
__device__ __forceinline__ float grp_sum(float s, int lanes) {
    if (lanes > 1) s += sw<1>(s); if (lanes > 2) s += sw<2>(s); if (lanes > 4) s += sw<4>(s);
    if (lanes > 8) s += sw<8>(s); if (lanes > 16) s += sw<16>(s); if (lanes > 32) s = xsum32(s);
    return s;
}
__device__ __forceinline__ void unpack8(const u32x4 w, float (&v)[8]) { v[0] = bf_lo(w.x); v[1] = bf_hi(w.x); v[2] = bf_lo(w.y); v[3] = bf_hi(w.y); v[4] = bf_lo(w.z); v[5] = bf_hi(w.z); v[6] = bf_lo(w.w); v[7] = bf_hi(w.w); }
__device__ __forceinline__ u32x4 pack8(const float (&v)[8]) { u32x4 w; w.x = cvtpk(v[0], v[1]); w.y = cvtpk(v[2], v[3]); w.z = cvtpk(v[4], v[5]); w.w = cvtpk(v[6], v[7]); return w; }
__device__ __forceinline__ void norm8(float (&v)[8], int lanes, float inv_width, const float* g, float mul) {
    float s = 0.f;
#pragma unroll
    for (int t = 0; t < 8; ++t) s += v[t] * v[t];
    const float rstd = rsqrtf(grp_sum(s, lanes) * inv_width + 1e-6f) * mul;
#pragma unroll
    for (int t = 0; t < 8; ++t) v[t] = v[t] * rstd * g[t];
}
__device__ __forceinline__ void rope8(float (&v)[8], int j, const float* cs, const float* sn) {
    const int i0 = 8 * (j & 1);
#pragma unroll
    for (int t = 0; t < 8; ++t) { const float o = sw<2>(v[t]); const float c = cs[i0 + t], s = sn[i0 + t]; v[t] = (j < 2) ? (v[t] * c - o * s) : (v[t] * c + o * s); }
}
__device__ __forceinline__ void prep1(Frame& F, const Params& p, int l) {
    bf16* Y1 = (bf16*)(F.ws + WS_Y1); bf16* KR = (bf16*)(F.ws + WS_KR); const float* CS = (const float*)(F.ws + WS_CS); const float* SN = (const float*)(F.ws + WS_SN);
    const float* gq = p.diff_qk_g + l * 128; const float* gk = gq + 64; const float* latg = p.mla_lat_g + l * 384; const float* kg = p.mla_qk_g + l * 192 + 96;
    const int ln = F.lane;
    const int seg = ln < 32 ? 0 : (ln < 48 ? 1 : (ln < 52 ? 2 : 3)); const int j3 = seg == 0 ? ln : (seg == 1 ? ln - 32 : ln - 48);
    const int off3 = seg == 0 ? 2560 + 8 * j3 : (seg == 1 ? 2816 + 8 * j3 : 2944 + 8 * (j3 & 3));
    const float* g3 = seg == 0 ? latg + 8 * j3 : (seg == 1 ? latg + 256 + 8 * j3 : kg + 64 + 8 * (j3 & 3));
    constexpr int R = 2;
    for (int m0 = F.gw; m0 < M; m0 += R * F.NGW) {
        u32x4 wq[R], wk[R], w3[R];
#pragma unroll
        for (int r = 0; r < R; ++r) { bf16* y = Y1 + (size_t)(m0 + r * F.NGW) * 3072; wq[r] = *(GAS u32x4*)(y + 8 * ln); wk[r] = *(GAS u32x4*)(y + 512 + 8 * ln); w3[r] = *(GAS u32x4*)(y + off3); }
#pragma unroll
        for (int r = 0; r < R; ++r) { const int m = m0 + r * F.NGW; bf16* y = Y1 + (size_t)m * 3072; float v[8];
            unpack8(wq[r], v); norm8(v, 8, 1.f / 64.f, gq + (8 * ln & 63), 0.125f * LOG2E); *(GAS u32x4*)(y + 8 * ln) = pack8(v);
            unpack8(wk[r], v); norm8(v, 8, 1.f / 64.f, gk + (8 * ln & 63), 1.f); *(GAS u32x4*)(y + 512 + 8 * ln) = pack8(v);
            unpack8(w3[r], v);
            float s = 0.f;
#pragma unroll
            for (int t = 0; t < 8; ++t) s += v[t] * v[t];
            s += sw<1>(s); s += sw<2>(s); const float s4 = s; s += sw<4>(s); s += sw<8>(s); const float s16 = s; s += sw<16>(s); const float s32 = s;
            const float rstd = seg == 0 ? rsqrtf(s32 * (1.f / 256.f) + 1e-6f) : (seg == 1 ? rsqrtf(s16 * (1.f / 128.f) + 1e-6f) : rsqrtf(s4 * (1.f / 32.f) + 1e-6f));
#pragma unroll
            for (int t = 0; t < 8; ++t) v[t] = v[t] * rstd * g3[t];
            if (seg <= 1) *(GAS u32x4*)(y + off3) = pack8(v);
            { float vr[8];
#pragma unroll
              for (int t = 0; t < 8; ++t) vr[t] = v[t];
              rope8(vr, j3 & 3, CS + (size_t)m * 16, SN + (size_t)m * 16);
              if (seg == 2) *(GAS u32x4*)(KR + (size_t)m * 32 + 8 * j3) = pack8(vr); }
        }
    }
}
__device__ __forceinline__ void prep2(Frame& F, const Params& p, int l) {
    bf16* QC = (bf16*)(F.ws + WS_QC); bf16* KVC = (bf16*)(F.ws + WS_KVC); const float* CS = (const float*)(F.ws + WS_CS); const float* SN = (const float*)(F.ws + WS_SN);
    const float* g0 = p.mla_qk_g + l * 192; const float* g1 = g0 + 96; const int ln = F.lane; const float qs = 0.10206207261596577f * LOG2E;
    constexpr int R = 2;
    const int qoff = (ln >> 3) * 96 + (ln & 7) * 8, roff = ((ln & 31) >> 2) * 96 + 64 + (ln & 3) * 8, koff = (ln >> 3) * 128 + (ln & 7) * 8;
    for (int m0 = F.gw; m0 < M; m0 += R * F.NGW) {
        u32x4 wq[R], wr[R], wk[R];
#pragma unroll
        for (int r = 0; r < R; ++r) { const size_t m = m0 + r * F.NGW; wq[r] = *(GAS u32x4*)(QC + m * 768 + qoff); wr[r] = *(GAS u32x4*)(QC + m * 768 + roff); wk[r] = *(GAS u32x4*)(KVC + m * 1024 + koff); }
#pragma unroll
        for (int r = 0; r < R; ++r) { const size_t m = m0 + r * F.NGW; float v[8];
            unpack8(wq[r], v); norm8(v, 8, 1.f / 64.f, g0 + (ln & 7) * 8, qs); *(GAS u32x4*)(QC + m * 768 + qoff) = pack8(v);
            unpack8(wr[r], v); norm8(v, 4, 1.f / 32.f, g0 + 64 + (ln & 3) * 8, qs); rope8(v, ln & 3, CS + m * 16, SN + m * 16); if (ln < 32) *(GAS u32x4*)(QC + m * 768 + roff) = pack8(v);
            unpack8(wk[r], v); norm8(v, 8, 1.f / 64.f, g1 + (ln & 7) * 8, 1.f); *(GAS u32x4*)(KVC + m * 1024 + koff) = pack8(v); }
    }
}

#ifndef ATT_THR
#define ATT_THR 8.f
#endif
__device__ __forceinline__ int crow(int r, int hi) { return (r & 3) + 8 * (r >> 2) + 4 * hi; }
__device__ __forceinline__ s16x4 vtr(lds_cptr p) { return __builtin_bit_cast(s16x4, __builtin_amdgcn_ds_read_tr16_b64_v4i16((LAS v4i16_t*)p)); }
#define ATT_WAITV(n) asm volatile("s_waitcnt vmcnt(" #n ")" ::: "memory")
__device__ __forceinline__ void glds16(const void* gsrc, unsigned lds_dst) { unsigned keep;
    asm volatile("s_mov_b32 %0, m0\n\ts_mov_b32 m0, %2\n\ts_nop 0\n\tglobal_load_lds_dwordx4 %1, off\n\ts_mov_b32 m0, %0" : "=&s"(keep) : "v"(gsrc), "s"(lds_dst) : "memory"); }
template <bool DUAL>
__device__ __forceinline__ void attn_unit(Frame& F, const Params& p, int l, int b, int h, int qb) {
    constexpr int NQF = DUAL ? 4 : 6, NQK = 2 * NQF, NVB = DUAL ? 4 : 2, NPV = 4 * NVB, KP = DUAL ? 16 : 12, NP = DUAL ? 32 : 24, PP = NP / 8;
    constexpr int KB = KP * 1024, VB = (DUAL ? 16 : 8) * 1024, VOFF = 3 * KB, DUMMY = VOFF + 3 * VB;
    constexpr int QROWS = DUAL ? 128 : 256;
    int lane = F.lane; asm volatile("" : "+v"(lane));
    const int wid = F.wave, r32_ = lane & 31, hi_ = lane >> 5;
    const int wq = DUAL ? (wid & 3) : wid, map = DUAL ? (wid >> 2) : 0;
    const int q0 = qb * QROWS + wq * 32;
    const int cw = q0 >> 6, NT = ((qb * QROWS + QROWS) >> 6);
    const size_t tok0 = (size_t)b * S;
    LAS unsigned char* lds = F.lds; const unsigned lds0 = (unsigned)(uintptr_t)F.lds;
    LAS float* wsf = (LAS float*)(lds + TAB_OFF + 4096 + wid * 256);
    LAS float* tab = (LAS float*)(lds + TAB_OFF);
    const bf16* src[PP]; int pst[PP], pc[PP]; bool pk[PP];
#pragma unroll
    for (int i = 0; i < PP; ++i) {
        const int x = wid * PP + i;
        if (DUAL) {
            const bf16* Y1 = (const bf16*)(F.ws + WS_Y1);
            if (x < KP) src[i] = Y1 + (tok0 + lane) * 3072 + 512 + h * 128 + (x >> 3) * 64 + (x & 7) * 8;
            else { const int v = x - KP; src[i] = Y1 + (tok0 + 16 * (v & 3) + (lane >> 2)) * 3072 + 1024 + h * 128 + (v >> 2) * 32 + (lane & 3) * 8; }
            pk[i] = x < KP; pst[i] = 64 * 3072; pc[i] = (x < KP ? x : x - KP) * 1024;
        } else {
            const bf16* KVC = (const bf16*)(F.ws + WS_KVC); const bf16* KR = (const bf16*)(F.ws + WS_KR);
            const int xx = x < 20 ? x : 0;
            if (xx < 8) src[i] = KVC + (tok0 + lane) * 1024 + h * 128 + xx * 8;
            else if (xx < 12) src[i] = KR + (tok0 + lane) * 32 + (xx - 8) * 8;
            else { const int v = xx - 12; src[i] = KVC + (tok0 + 16 * (v & 3) + (lane >> 2)) * 1024 + h * 128 + 64 + (v >> 2) * 32 + (lane & 3) * 8; }
            pk[i] = x < 12; pst[i] = x < 8 ? 64 * 1024 : (x < 12 ? 64 * 32 : (x < 20 ? 64 * 1024 : 0)); pc[i] = x < 12 ? x * 1024 : (x < 20 ? (x - 12) * 1024 : 3 * VB + (x - 20) * 1024);
        }
        pst[i] = __builtin_amdgcn_readfirstlane(pst[i]); pc[i] = __builtin_amdgcn_readfirstlane(pc[i]);
    }
#define ATT_BATCH(s, kd, vd) do { const int tk_ = ((s) + 3 < NT) ? (s) + 3 : NT - 1; const int tv0_ = ((s) + 1 < NT) ? (s) + 1 : NT - 1; const int tv_ = tv0_ < 0 ? 0 : tv0_; \
        _Pragma("unroll") for (int i_ = 0; i_ < PP; ++i_) { const int tile_ = pk[i_] ? tk_ : tv_; const unsigned dst_ = (unsigned)((pk[i_] ? (kd) : VOFF + (vd)) + pc[i_]); \
            glds16(src[i_] + (unsigned)(tile_ * pst[i_]), (unsigned)__builtin_amdgcn_readfirstlane(lds0 + dst_)); } } while (0)
    bf16x8 qf[NQF];
    {
        const bf16* Qw = DUAL ? (const bf16*)(F.ws + WS_Y1) + (tok0 + q0 + r32_) * 3072 + h * 128 + map * 64 : (const bf16*)(F.ws + WS_QC) + (tok0 + q0 + r32_) * 768 + h * 96;
#pragma unroll
        for (int d0 = 0; d0 < NQF; ++d0) qf[d0] = *(const GAS bf16x8*)(Qw + d0 * 16 + hi_ * 8);
    }
    if (DUAL) { if (F.tid < 256) tab[F.tid] = ((const float*)(F.ws + WS_BT))[h * 256 + F.tid]; }
    ATT_BATCH(-3, 0, VB); ATT_BATCH(-2, KB, 2 * VB); ATT_BATCH(-1, 2 * KB, 0);
    f32x16 o[NVB];
#pragma unroll
    for (int d = 0; d < NVB; ++d) o[d] = (f32x16){0.f, 0.f, 0.f, 0.f, 0.f, 0.f, 0.f, 0.f, 0.f, 0.f, 0.f, 0.f, 0.f, 0.f, 0.f, 0.f};
    float mrun = 0.f, lrun = 0.f;
    f32x16 negm = (f32x16){0.f, 0.f, 0.f, 0.f, 0.f, 0.f, 0.f, 0.f, 0.f, 0.f, 0.f, 0.f, 0.f, 0.f, 0.f, 0.f};
    const int vlane = ((lane >> 4) & 1) * 32 + (lane & 3) * 8 + (4 * hi_ + ((lane & 15) >> 2)) * 64;
    const int koff = (DUAL ? map * 8192 : 0) + hi_ * 1024 + r32_ * 16;
    f32x16 pA0, pA1, pB0, pB1; pA0 = negm; pA1 = negm; pB0 = negm; pB1 = negm;
    bf16x8 kfr[3]; s16x4 vfr[3][2]; unsigned pw[16]; bool resc = false;
#pragma unroll
    for (int i = 0; i < 16; ++i) pw[i] = 0u;
#define ATT_SB() __builtin_amdgcn_sched_barrier(0)
#define ATT_PIN(x) asm volatile("" : "+v"(x))
#define ATT_PEL(P0, P1, i) ((i) < 16 ? P0[(i) & 15] : P1[(i) & 15])
#define ATT_KRD(g, ks_) (*(const LAS bf16x8*)((lds_cptr)(lds + (ks_) + koff) + ((g) >> 1) * 2048 + ((g) & 1) * 512))
#define ATT_KPRE(ks_) do { kfr[0] = ATT_KRD(0, ks_); kfr[1] = ATT_KRD(1, ks_); } while (0)
#define ATT_VRD(g, vs_, w) do { const lds_cptr vb_ = (lds_cptr)(lds + VOFF + (vs_) + vlane) + ((g) % NVB) * 4096 + ((g) / NVB) * 1024; vfr[w][0] = vtr(vb_); vfr[w][1] = vtr(vb_ + 512); } while (0)
#define ATT_VPRE(vs_) do { ATT_VRD(0, vs_, 0); ATT_VRD(1, vs_, 1); } while (0)
#define ATT_PHA(C0, C1, P0, P1, MF, FILL, ks_) do { float sacc_ = 0.f; \
        _Pragma("unroll") for (int g = 0; g < NQK; ++g) { \
            if (MF) { if (g + 2 < NQK) kfr[(g + 2) % 3] = ATT_KRD(g + 2, ks_); \
                if ((g & 1) == 0) C0 = __builtin_amdgcn_mfma_f32_32x32x16_bf16(kfr[g % 3], qf[g >> 1], g < 2 ? negm : C0, 0, 0, 0); \
                else C1 = __builtin_amdgcn_mfma_f32_32x32x16_bf16(kfr[g % 3], qf[g >> 1], g < 2 ? negm : C1, 0, 0, 0); } \
            if (FILL) { \
                _Pragma("unroll") for (int e = (g * 32) / NQK; e < ((g + 1) * 32) / NQK; ++e) sacc_ += ATT_PEL(P0, P1, e); \
                ATT_PIN(sacc_); \
                _Pragma("unroll") for (int w = (g * 16) / NQK; w < ((g + 1) * 16) / NQK; ++w) { pw[w] = cvtpk(ATT_PEL(P0, P1, 2 * w), ATT_PEL(P0, P1, 2 * w + 1)); ATT_PIN(pw[w]); } } \
            ATT_SB(); } \
        if (FILL) lrun += sacc_; } while (0)
#define ATT_PAF(k) __builtin_bit_cast(bf16x8, ((u32x4){pw[4 * (k)], pw[4 * (k) + 1], pw[4 * (k) + 2], pw[4 * (k) + 3]}))
#define ATT_VFR(w) (bf16x8){vfr[w][0][0], vfr[w][0][1], vfr[w][0][2], vfr[w][0][3], vfr[w][1][0], vfr[w][1][1], vfr[w][1][2], vfr[w][1][3]}
#define ATT_PHB(C0, C1, PV, EXPS, vs_) do { \
        _Pragma("unroll") for (int g = 0; g < NPV; ++g) { \
            if (PV) { if (g + 2 < NPV) ATT_VRD(g + 2, vs_, (g + 2) % 3); \
                o[g % NVB] = __builtin_amdgcn_mfma_f32_32x32x16_bf16(ATT_PAF(g / NVB), ATT_VFR(g % 3), o[g % NVB], 0, 0, 0); } \
            if (EXPS) { \
                _Pragma("unroll") for (int e = (g * 32) / NPV; e < ((g + 1) * 32) / NPV; ++e) { if (e < 16) C0[e & 15] = __builtin_amdgcn_exp2f(C0[e & 15]); else C1[e & 15] = __builtin_amdgcn_exp2f(C1[e & 15]); } \
                if (((g * 32) / NPV) < 16) ATT_PIN(C0); else ATT_PIN(C1); } \
            ATT_SB(); } } while (0)
#define ATT_M(t, kd, vd) do { if ((t) <= NT - 1) { if (PP == 4) ATT_WAITV(4); else ATT_WAITV(3); } else ATT_WAITV(0); \
        LDS_WAIT(); __builtin_amdgcn_s_barrier(); if ((t) <= NT - 2) ATT_BATCH(t, kd, vd); } while (0)
#define ATT_DECIDE(C0, C1, t) do { \
        if (DUAL) { if ((t) >= cw - 2) { const int base = 64 * (t) - (q0 + r32_) + 191 + 4 * hi_; \
            _Pragma("unroll") for (int r = 0; r < 16; ++r) { const int kk = (r & 3) + 8 * (r >> 2); C0[r] += tab[base + kk]; C1[r] += tab[base + kk + 32]; } } } \
        float ma = __builtin_fmaxf(__builtin_fmaxf(C0[0], C0[1]), C1[0]), mb = __builtin_fmaxf(__builtin_fmaxf(C0[2], C0[3]), C1[1]); ma = __builtin_fmaxf(__builtin_fmaxf(ma, C1[2]), C1[3]); \
        _Pragma("unroll") for (int r = 4; r < 16; r += 4) { ma = __builtin_fmaxf(__builtin_fmaxf(ma, C0[r]), C0[r + 1]); mb = __builtin_fmaxf(__builtin_fmaxf(mb, C0[r + 2]), C0[r + 3]); \
            ma = __builtin_fmaxf(__builtin_fmaxf(ma, C1[r]), C1[r + 1]); mb = __builtin_fmaxf(__builtin_fmaxf(mb, C1[r + 2]), C1[r + 3]); } \
        float mx = __builtin_fmaxf(ma, mb); { const auto rr_ = __builtin_amdgcn_permlane32_swap(__builtin_bit_cast(unsigned, mx), __builtin_bit_cast(unsigned, mx), false, false); mx = __builtin_fmaxf(__builtin_bit_cast(float, rr_[0]), __builtin_bit_cast(float, rr_[1])); } resc = false; \
        if (__builtin_expect(__any(mx > ATT_THR), 0)) {                       \
            const float dl = __builtin_fmaxf(mx, 0.f), f = __builtin_amdgcn_exp2f(-dl); mrun += dl; lrun *= f; \
            _Pragma("unroll") for (int r = 0; r < 16; ++r) { C0[r] -= dl; C1[r] -= dl; negm[r] = -mrun; } \
            if (hi_ == 0) wsf[r32_] = f; resc = true; } } while (0)
#define ATT_RESC() do { if (resc) { LDS_WAIT(); \
        _Pragma("unroll") for (int r = 0; r < 16; ++r) { const float fr_ = wsf[crow(r, hi_)]; _Pragma("unroll") for (int d = 0; d < NVB; ++d) o[d][r] *= fr_; } } } while (0)
#define ATT_ROT() do { const int s_ = s0; s0 = s1; s1 = s2; s2 = s_; } while (0)
#define ATT_STEP(C0, C1, P0, P1, t) do { \
        ATT_PHA(C0, C1, P0, P1, true, true, s0 * KB); \
        ATT_M(t, s0 * KB, s1 * VB); \
        ATT_VPRE(s2 * VB); \
        ATT_DECIDE(C0, C1, t); ATT_SB(); ATT_PHB(C0, C1, true, true, s2 * VB); ATT_RESC(); if ((t) + 1 <= cw) ATT_KPRE(s1 * KB); \
        ATT_ROT(); } while (0)
    int s0 = 0, s1 = 1, s2 = 2;
    if (PP == 4) ATT_WAITV(8); else ATT_WAITV(6);
    LDS_WAIT(); __builtin_amdgcn_s_barrier();
    ATT_KPRE(0);
    ATT_PHA(pA0, pA1, pB0, pB1, true, false, 0);
    ATT_M(0, 0, VB);
    ATT_DECIDE(pA0, pA1, 0); ATT_SB();
    ATT_PHB(pA0, pA1, false, true, 0);
    if (1 <= cw) ATT_KPRE(KB);
    ATT_ROT();
    int t = 1;
    for (; t + 1 <= cw; t += 2) {
        ATT_STEP(pB0, pB1, pA0, pA1, t);
        ATT_STEP(pA0, pA1, pB0, pB1, t + 1);
    }
    if (t <= cw) { ATT_STEP(pB0, pB1, pA0, pA1, t); pA0 = pB0; pA1 = pB1; ++t; }
    ATT_PHA(pB0, pB1, pA0, pA1, false, true, 0);
    ATT_M(t, s0 * KB, s1 * VB);
    ATT_VPRE(s2 * VB);
    ATT_PHB(pB0, pB1, true, false, s2 * VB);
    ATT_ROT(); ++t;
    for (; t <= NT; ++t) { ATT_M(t, s0 * KB, s1 * VB); ATT_ROT(); }
#undef ATT_ROT
#undef ATT_STEP
#undef ATT_RESC
#undef ATT_DECIDE
#undef ATT_M
#undef ATT_PHB
#undef ATT_VFR
#undef ATT_PAF
#undef ATT_PHA
#undef ATT_VPRE
#undef ATT_VRD
#undef ATT_KPRE
#undef ATT_KRD
#undef ATT_PEL
#undef ATT_PIN
#undef ATT_SB
#undef ATT_BATCH
    int r32 = r32_, hi = hi_; asm volatile("" : "+v"(r32), "+v"(hi));
    lrun = xsum32(lrun);
    if (hi == 0) wsf[32 + r32] = __builtin_amdgcn_rcpf(lrun);
    LDS_WAIT();
    float rli[16];
#pragma unroll
    for (int r = 0; r < 16; ++r) rli[r] = wsf[32 + crow(r, hi)];
    __builtin_amdgcn_s_barrier();
    if (DUAL) {
        LAS float* stg = (LAS float*)(lds) + (size_t)wq * 32 * 132;
        if (map == 1) {
#pragma unroll
            for (int d = 0; d < NVB; ++d)
#pragma unroll
                for (int r = 0; r < 16; ++r) stg[crow(r, hi) * 132 + d * 32 + r32] = o[d][r] * rli[r];
        }
        LDS_WAIT(); __builtin_amdgcn_s_barrier();
        if (map == 0) {
            const float lam = ((const float*)(F.ws + WS_LAM))[l]; const float li = 1.f - (0.8f - 0.6f * __expf(-0.3f * (float)l));
            float ss[16];
#pragma unroll
            for (int r = 0; r < 16; ++r) { float s = 0.f;
#pragma unroll
                for (int d = 0; d < NVB; ++d) { const float v = o[d][r] * rli[r] - lam * stg[crow(r, hi) * 132 + d * 32 + r32]; o[d][r] = v; s += v * v; }
                ss[r] = s; }
#pragma unroll
            for (int r = 0; r < 16; ++r) { float s = ss[r]; s += sw<1>(s); s += sw<2>(s); s += sw<4>(s); s += sw<8>(s); s += sw<16>(s); ss[r] = rsqrtf(s * (1.f / 128.f) + 1e-6f) * li; }
            const float* og = p.diff_out_g + l * 128; bf16* OA = (bf16*)(F.ws + WS_OA) + (tok0 + q0) * 512 + h * 128;
            LAS bf16* st2 = (LAS bf16*)(lds + 69632) + wq * (32 * 136);
#pragma unroll
            for (int d = 0; d < NVB; ++d) { const float gg = og[d * 32 + r32];
#pragma unroll
                for (int r = 0; r < 16; ++r) st2[crow(r, hi) * 136 + d * 32 + r32] = (bf16)(cvtpk(o[d][r] * ss[r] * gg, 0.f) & 0xffffu); }
            LDS_WAIT();
#pragma unroll
            for (int i = 0; i < 8; ++i) { const int row = i * 4 + (lane >> 4), ch = lane & 15; const u32x4 v = *(const LAS u32x4*)(st2 + row * 136 + ch * 8); st16x(OA + (size_t)row * 512 + ch * 8, v); }
        }
    } else {
        LAS bf16* stg = (LAS bf16*)(lds) + wid * 2048;
#pragma unroll
        for (int r = 0; r < 16; ++r) { const int orow = crow(r, hi);
#pragma unroll
            for (int d = 0; d < NVB; ++d) stg[orow * 64 + d * 32 + r32] = (bf16)(cvtpk(o[d][r] * rli[r], 0.f) & 0xffffu); }
        LDS_WAIT();
        bf16* Ow = (bf16*)(F.ws + WS_OC) + (tok0 + q0) * 512 + h * 64;
#pragma unroll
        for (int i = 0; i < 4; ++i) { const int row = i * 8 + (lane >> 3), ch = lane & 7; const u32x4 v = *(const LAS u32x4*)(stg + row * 64 + ch * 8); st16x(Ow + (size_t)row * 512 + ch * 8, v); }
    }
    LDS_WAIT(); __builtin_amdgcn_s_barrier();
}
template <bool DUAL>
__device__ __forceinline__ void attn_phase(Frame& F, const Params& p, int l) {
    const int vcu = (F.G % 8 == 0) ? (F.bid % 8) * (F.G / 8) + F.bid / 8 : F.bid;
    if (DUAL) { for (int v = vcu; v < 256; v += F.G) { const int bh = v >> 3, s = v & 7; attn_unit<true>(F, p, l, bh >> 2, bh & 3, s); attn_unit<true>(F, p, l, bh >> 2, bh & 3, 15 - s); } }
    else { for (int v = vcu; v < 256; v += F.G) { const int bh = v >> 2, s = v & 3; attn_unit<false>(F, p, l, bh >> 3, bh & 7, s); attn_unit<false>(F, p, l, bh >> 3, bh & 7, 7 - s); } }
}
}
namespace fk {
__device__ __forceinline__ void sgu_unit(Frame& F, const Params& p, int l, int unit) {
    const int g = unit & 3, bn = unit >> 2; const size_t m0 = (size_t)bn * 128;
    int lane = threadIdx.x & 63; asm volatile("" : "+v"(lane));
    const int wid = F.wave, r32 = lane & 31, hi = lane >> 5; const int tid_ = wid * 64 + lane;
    LAS unsigned char* lds = F.lds; LAS unsigned char* Wt = lds; LAS unsigned char* Vt = lds + 32768;
    const bf16* Y1 = (const bf16*)(F.ws + WS_Y1);
    const int rsub = lane >> 4, ch16 = lane & 15;
    u32x4 w4[4]; f32x4 sa[4], sb[4];
    const float* ST2 = (const float*)(F.ws + WS_STAT2);
#pragma unroll
    for (int it = 0; it < 4; ++it) { const size_t row = m0 + wid * 16 + it * 4 + rsub;
        w4[it] = *(const GAS u32x4*)(Y1 + row * 3072 + 2048 + g * 128 + ch16 * 8); sa[it] = *(const GAS f32x4*)(ST2 + row * 8); sb[it] = *(const GAS f32x4*)(ST2 + row * 8 + 4); }
    const float* Wg = p.sgu_w + ((size_t)l * 4 + g) * 128 * 128;
    f32x4 wa[4], wb[4];
#pragma unroll
    for (int k = 0; k < 4; ++k) { const int item = tid_ + 512 * k, i = item & 127, cidx = item >> 7, ks = cidx >> 1, h2 = cidx & 1;
        wa[k] = *(const GAS f32x4*)(Wg + (size_t)i * 128 + 16 * ks + 4 * h2); wb[k] = *(const GAS f32x4*)(Wg + (size_t)i * 128 + 16 * ks + 8 + 4 * h2); }
    const float* vg = p.sgu_v_g + l * 512 + g * 128 + ch16 * 8;
    float vgv[8];
#pragma unroll
    for (int t = 0; t < 8; ++t) vgv[t] = vg[t];
#pragma unroll
    for (int it = 0; it < 4; ++it) {
        const int j = wid * 16 + it * 4 + rsub; float v[8]; unpack8(w4[it], v);
        const float rstd = rsqrtf((((sa[it][0] + sa[it][1]) + (sa[it][2] + sa[it][3])) + ((sb[it][0] + sb[it][1]) + (sb[it][2] + sb[it][3]))) * (1.f / 512.f) + 1e-6f);
#pragma unroll
        for (int t = 0; t < 8; ++t) v[t] = gelu_tanh(v[t]) * rstd * vgv[t];
        *(LAS u32x4*)(Vt + ((ch16 >> 2) * 8 + (j >> 4)) * 1024 + (j & 15) * 64 + (ch16 & 3) * 16) = pack8(v);
    }
#pragma unroll
    for (int k = 0; k < 4; ++k) {
        const int item = tid_ + 512 * k, i = item & 127, cidx = item >> 7, ks = cidx >> 1;
        const bool ok = (ks >> 2) <= (i >> 6);
        u32x4 w; w.x = ok ? cvtpk(wa[k].x, wa[k].y) : 0u; w.y = ok ? cvtpk(wa[k].z, wa[k].w) : 0u; w.z = ok ? cvtpk(wb[k].x, wb[k].y) : 0u; w.w = ok ? cvtpk(wb[k].z, wb[k].w) : 0u;
        *(LAS u32x4*)(Wt + cidx * 2048 + i * 16) = w;
    }
    const int ib = wid & 3, ch = wid >> 2;
    bf16 uraw[2][16];
#pragma unroll
    for (int dd = 0; dd < 2; ++dd)
#pragma unroll
        for (int r = 0; r < 16; ++r) uraw[dd][r] = Y1[(m0 + 32 * ib + crow(r, hi)) * 3072 + 1536 + 128 * g + 32 * (2 * ch + dd) + r32];
    __syncthreads();
    f32x16 acc[2];
    acc[0] = (f32x16){0.f, 0.f, 0.f, 0.f, 0.f, 0.f, 0.f, 0.f, 0.f, 0.f, 0.f, 0.f, 0.f, 0.f, 0.f, 0.f}; acc[1] = acc[0];
    const int vlane = ((lane >> 4) & 1) * 32 + (lane & 3) * 8 + (4 * hi + ((lane & 15) >> 2)) * 64;
#pragma unroll
    for (int ks = 0; ks < 8; ++ks) {
        const bf16x8 a = *(const LAS bf16x8*)(Wt + (2 * ks + hi) * 2048 + (32 * ib + r32) * 16);
#pragma unroll
        for (int dd = 0; dd < 2; ++dd) { const lds_cptr vb = (lds_cptr)(Vt + (2 * ch + dd) * 8192 + ks * 1024 + vlane);
            const s16x4 lo = vtr(vb), hh = vtr(vb + 512);
            acc[dd] = __builtin_amdgcn_mfma_f32_32x32x16_bf16(a, (bf16x8){lo[0], lo[1], lo[2], lo[3], hh[0], hh[1], hh[2], hh[3]}, acc[dd], 0, 0, 0); }
    }
    const float* bs = p.sgu_b + l * 512 + g * 128; bf16* OB = (bf16*)(F.ws + WS_OB);
#pragma unroll
    for (int dd = 0; dd < 2; ++dd)
#pragma unroll
        for (int r = 0; r < 16; ++r) { const int i = 32 * ib + crow(r, hi), c = 128 * g + 32 * (2 * ch + dd) + r32;
            const float u = gelu_tanh(bf2f(uraw[dd][r]));
            OB[(m0 + i) * 512 + c] = (bf16)(cvtpk(u * (acc[dd][r] + bs[i]), 0.f) & 0xffffu); }
    __syncthreads();
}

__device__ __forceinline__ void sgu_pair(Frame& F, const Params& p, int l, int unit0) {
    const int g = unit0 & 3, bn0 = unit0 >> 2;
    int lane = threadIdx.x & 63; asm volatile("" : "+v"(lane));
    const int wid = F.wave, r32 = lane & 31, hi = lane >> 5; const int tid_ = wid * 64 + lane;
    LAS unsigned char* lds = F.lds; LAS unsigned char* Wt = lds; LAS unsigned char* Vt = lds + 32768; LAS unsigned char* Ut = lds + 65536; LAS unsigned char* Ot = lds + 98304;
    const bf16* Y1 = (const bf16*)(F.ws + WS_Y1); const float* ST2 = (const float*)(F.ws + WS_STAT2); bf16* OB = (bf16*)(F.ws + WS_OB);
    const int rsub = lane >> 4, ch16 = lane & 15;
    u32x4 w4[4], u4[4]; f32x4 sa[4], sb[4];
#define SGU_LOAD(m0_) do { _Pragma("unroll") for (int it = 0; it < 4; ++it) { const size_t row = (m0_) + wid * 16 + it * 4 + rsub; \
        w4[it] = *(const GAS u32x4*)(Y1 + row * 3072 + 2048 + g * 128 + ch16 * 8); u4[it] = *(const GAS u32x4*)(Y1 + row * 3072 + 1536 + g * 128 + ch16 * 8); \
        sa[it] = *(const GAS f32x4*)(ST2 + row * 8); sb[it] = *(const GAS f32x4*)(ST2 + row * 8 + 4); } } while (0)
    const size_t mA = (size_t)bn0 * 128, mB = (size_t)(bn0 + 8) * 128;
    SUB_T0(1);
    SGU_LOAD(mA);
    const float* Wg = p.sgu_w + ((size_t)l * 4 + g) * 128 * 128;
    f32x4 wa[4], wb[4];
#pragma unroll
    for (int k = 0; k < 4; ++k) { const int item = tid_ + 512 * k, i = item & 127, cidx = item >> 7, ks = cidx >> 1, h2 = cidx & 1;
        wa[k] = *(const GAS f32x4*)(Wg + (size_t)i * 128 + 16 * ks + 4 * h2); wb[k] = *(const GAS f32x4*)(Wg + (size_t)i * 128 + 16 * ks + 8 + 4 * h2); }
    const float* vg = p.sgu_v_g + l * 512 + g * 128 + ch16 * 8;
    float vgv[8];
#pragma unroll
    for (int t = 0; t < 8; ++t) vgv[t] = vg[t];
#define SGU_CONVERT() do { _Pragma("unroll") for (int it = 0; it < 4; ++it) { \
        const int j = wid * 16 + it * 4 + rsub; float v[8]; unpack8(w4[it], v); \
        const float rstd = rsqrtf((((sa[it][0] + sa[it][1]) + (sa[it][2] + sa[it][3])) + ((sb[it][0] + sb[it][1]) + (sb[it][2] + sb[it][3]))) * (1.f / 512.f) + 1e-6f); \
        _Pragma("unroll") for (int t = 0; t < 8; ++t) v[t] = gelu_tanh(v[t]) * rstd * vgv[t]; \
        *(LAS u32x4*)(Vt + ((ch16 >> 2) * 8 + (j >> 4)) * 1024 + (j & 15) * 64 + (ch16 & 3) * 16) = pack8(v); \
        *(LAS u32x4*)(Ut + j * 256 + ch16 * 16) = u4[it]; } } while (0)
    SGU_CONVERT();
#pragma unroll
    for (int k = 0; k < 4; ++k) {
        const int item = tid_ + 512 * k, i = item & 127, cidx = item >> 7, ks = cidx >> 1;
        const bool ok = (ks >> 2) <= (i >> 6);
        u32x4 w; w.x = ok ? cvtpk(wa[k].x, wa[k].y) : 0u; w.y = ok ? cvtpk(wa[k].z, wa[k].w) : 0u; w.z = ok ? cvtpk(wb[k].x, wb[k].y) : 0u; w.w = ok ? cvtpk(wb[k].z, wb[k].w) : 0u;
        *(LAS u32x4*)(Wt + cidx * 2048 + i * 16) = w;
    }
    LDS_WAIT(); SUB_T1(F, 1); SUB_T0(2);
    SGU_LOAD(mB);
    const int ib = wid & 3, ch = wid >> 2;
    const int vlane = ((lane >> 4) & 1) * 32 + (lane & 3) * 8 + (4 * hi + ((lane & 15) >> 2)) * 64;
    const float* bs = p.sgu_b + l * 512 + g * 128;
#define SGU_COMPUTE() do { f32x16 acc[2]; \
        acc[0] = (f32x16){0.f, 0.f, 0.f, 0.f, 0.f, 0.f, 0.f, 0.f, 0.f, 0.f, 0.f, 0.f, 0.f, 0.f, 0.f, 0.f}; acc[1] = acc[0]; \
        _Pragma("unroll") for (int ks = 0; ks < 8; ++ks) { \
            const bf16x8 a = *(const LAS bf16x8*)(Wt + (2 * ks + hi) * 2048 + (32 * ib + r32) * 16); \
            _Pragma("unroll") for (int dd = 0; dd < 2; ++dd) { const lds_cptr vb = (lds_cptr)(Vt + (2 * ch + dd) * 8192 + ks * 1024 + vlane); \
                const s16x4 lo = vtr(vb), hh = vtr(vb + 512); \
                acc[dd] = __builtin_amdgcn_mfma_f32_32x32x16_bf16(a, (bf16x8){lo[0], lo[1], lo[2], lo[3], hh[0], hh[1], hh[2], hh[3]}, acc[dd], 0, 0, 0); } } \
        _Pragma("unroll") for (int dd = 0; dd < 2; ++dd) \
            _Pragma("unroll") for (int r = 0; r < 16; ++r) { const int i = 32 * ib + crow(r, hi), c = 32 * (2 * ch + dd) + r32; \
                const float uu = gelu_tanh(bf2f(*(const LAS bf16*)(Ut + i * 256 + c * 2))); \
                *(LAS bf16*)(Ot + i * 256 + c * 2) = (bf16)(cvtpk(uu * (acc[dd][r] + bs[i]), 0.f) & 0xffffu); } } while (0)
#define SGU_STORE(m0_) do { _Pragma("unroll") for (int k = 0; k < 4; ++k) { const int id = tid_ + 512 * k, row = id >> 4, chk = id & 15; \
        const u32x4 v = *(const LAS u32x4*)(Ot + row * 256 + chk * 16); st16x(OB + ((m0_) + row) * 512 + 128 * g + chk * 8, v); } } while (0)
    __syncthreads();
    SGU_COMPUTE();
    __syncthreads();
    SUB_T1(F, 2); SUB_T0(3);
    SGU_STORE(mA);
    SGU_CONVERT();
    __syncthreads();
    SGU_COMPUTE();
    __syncthreads();
    SGU_STORE(mB);
    __syncthreads();
    SUB_T1(F, 3);
#undef SGU_LOAD
#undef SGU_CONVERT
#undef SGU_COMPUTE
#undef SGU_STORE
}

struct SchedG3 {
    static constexpr bool GATHER = false; static constexpr bool HALFM = false; static constexpr bool ACCUM = true;
    __device__ __forceinline__ void a_ready(const GUnit&) const {}
    __device__ __forceinline__ void done(const GUnit&) const {}
    __device__ __forceinline__ bool keep_acc(const GUnit& u) const { return u.i2 < 2; }
    const char* OA; const char* WBR; int G, c;
    __device__ __forceinline__ bool next(int i, GUnit& u) const {
        const int tile = (i / 3) * G + c, n = i % 3; if (tile >= 256) return false;
        const int vt = (tile % 8) * 32 + tile / 8;
        const int pm = vt >> 2, pn = vt & 3;
        u.A = OA + (size_t)n * 16 * MiB + (size_t)pm * 256 * 1024; u.B = WBR + (size_t)n * MiB + (size_t)pn * 256 * 1024; u.nt = 8; u.i0 = pm; u.i1 = pn; u.i2 = n; return true;
    }
    __device__ __forceinline__ void offs(const GUnit&, int R0, int R1, int C0, int C1, unsigned (&oA)[2][2]) const {
        oA[0][0] = (unsigned)R0 * 1024u + C0 * 2u; oA[0][1] = (unsigned)R1 * 1024u + C1 * 2u; oA[1][0] = (unsigned)(R0 + 128) * 1024u + C0 * 2u; oA[1][1] = (unsigned)(R1 + 128) * 1024u + C1 * 2u; }
    __device__ __forceinline__ unsigned ldb_bytes() const { return 1024u; }
};
struct EpiG3 {
    const bf16* XG; bf16* MG;
#ifdef SUBT
    Frame* Fp;
#endif
    __device__ __forceinline__ void operator()(f32x4 (&acc)[2][2][4][2], const GUnit& u, int wr, int wc, int fr, int fq) const {
        const int n = u.i2; const int row0 = u.i0 * 256 + wr * 64 + fr, col0 = u.i1 * 256 + wc * 32 + 8 * fq;
        SUB_T0(5);
        const unsigned char* pa = (const unsigned char*)XG + ((((size_t)(u.i0 * 4 + u.i1) * 3 + n) * 8 + (wr * 4 + wc)) * 8) * 1024 + (fq * 16 + fr) * 16;
        if (n < 2) {
            u32x4 ca[2], cb[2], na[2], nb[2];
#pragma unroll
            for (int q = 0; q < 2; ++q) { ca[q] = *(const GAS u32x4*)(pa + q * 1024); cb[q] = *(const GAS u32x4*)(pa + 65536 + q * 1024); }
#pragma unroll
            for (int grp = 0; grp < 4; ++grp) {
                if (grp < 3) {
#pragma unroll
                    for (int q = 0; q < 2; ++q) { na[q] = *(const GAS u32x4*)(pa + (2 * grp + 2 + q) * 1024); nb[q] = *(const GAS u32x4*)(pa + 65536 + (2 * grp + 2 + q) * 1024); }
                }
                asm volatile("" ::: "memory");
#pragma unroll
                for (int q = 0; q < 2; ++q) { const int j = 2 * grp + q, ai = j >> 2, m = j & 3;
#pragma unroll
                    for (int bj = 0; bj < 2; ++bj)
#pragma unroll
                        for (int t = 0; t < 8; ++t) { const unsigned wa_ = ca[q][2 * bj + (t >> 2)], wb_ = cb[q][2 * bj + (t >> 2)];
                            const unsigned qa = (wa_ >> (8 * (t & 3))) & 255u, qb = (wb_ >> (8 * (t & 3))) & 255u;
                            const float r = (float)qa * __builtin_amdgcn_rcpf((float)qb); if (t < 4) acc[ai][bj][m][0][t & 3] *= r; else acc[ai][bj][m][1][t & 3] *= r; } }
#pragma unroll
                for (int q = 0; q < 2; ++q) { ca[q] = na[q]; cb[q] = nb[q]; }
            }
        } else {
            u32x4 ca[2], na[2];
#pragma unroll
            for (int q = 0; q < 2; ++q) ca[q] = *(const GAS u32x4*)(pa + q * 1024);
#pragma unroll
            for (int grp = 0; grp < 4; ++grp) {
                if (grp < 3) {
#pragma unroll
                    for (int q = 0; q < 2; ++q) na[q] = *(const GAS u32x4*)(pa + (2 * grp + 2 + q) * 1024);
                }
                asm volatile("" ::: "memory");
#pragma unroll
                for (int q = 0; q < 2; ++q) { const int j = 2 * grp + q, ai = j >> 2, m = j & 3; const size_t row = row0 + ai * 128 + m * 16;
#pragma unroll
                    for (int bj = 0; bj < 2; ++bj) { const int col = col0 + bj * 128; float o[8];
#pragma unroll
                        for (int t = 0; t < 8; ++t) { const unsigned wa_ = ca[q][2 * bj + (t >> 2)]; const unsigned qa = (wa_ >> (8 * (t & 3))) & 255u;
                            const float a = t < 4 ? acc[ai][bj][m][0][t & 3] : acc[ai][bj][m][1][t & 3]; o[t] = a * ((float)qa * (1.f / 255.f)); }
                        *(GAS u32x4*)(MG + row * 1024 + col) = pack8(o); } }
#pragma unroll
                for (int q = 0; q < 2; ++q) ca[q] = na[q];
            }
        }
#ifdef SUBT
        SUB_T1((*Fp), 5);
#endif
    }
};
template <bool F32IN>
struct EpiG4 {
    bf16* X; const float* gate; const float* Xin;
    __device__ __forceinline__ void operator()(const f32x4 (&acc)[2][2][4][2], const GUnit& u, int wr, int wc, int fr, int fq) const {
        const int row0 = u.i0 * 256 + wr * 64 + fr, col0 = u.i1 * 256 + wc * 32 + 8 * fq; const int b = (u.i0 * 256) / S;
        f32x4 g0[2], g1[2];
#pragma unroll
        for (int bj = 0; bj < 2; ++bj) { g0[bj] = *(const GAS f32x4*)(gate + (size_t)b * 6 * D + col0 + bj * 128); g1[bj] = *(const GAS f32x4*)(gate + (size_t)b * 6 * D + col0 + bj * 128 + 4); }
        if (F32IN) {
            f32x4 cx[4], nx[4];
#pragma unroll
            for (int bj = 0; bj < 2; ++bj) { const size_t off = (size_t)row0 * D + col0 + bj * 128; cx[2 * bj] = *(const GAS f32x4*)(Xin + off); cx[2 * bj + 1] = *(const GAS f32x4*)(Xin + off + 4); }
#pragma unroll
            for (int j = 0; j < 8; ++j) { const int ai = j >> 2, m = j & 3;
                if (j < 7) { const int ai2 = (j + 1) >> 2, m2 = (j + 1) & 3;
#pragma unroll
                    for (int bj = 0; bj < 2; ++bj) { const size_t off = (size_t)(row0 + ai2 * 128 + m2 * 16) * D + col0 + bj * 128; nx[2 * bj] = *(const GAS f32x4*)(Xin + off); nx[2 * bj + 1] = *(const GAS f32x4*)(Xin + off + 4); } }
                asm volatile("" ::: "memory");
#pragma unroll
                for (int bj = 0; bj < 2; ++bj) { const size_t off = (size_t)(row0 + ai * 128 + m * 16) * D + col0 + bj * 128;
                    const f32x4 x0 = cx[2 * bj] + g0[bj] * acc[ai][bj][m][0], x1 = cx[2 * bj + 1] + g1[bj] * acc[ai][bj][m][1];
                    u32x4 w; w.x = cvtpk(x0[0], x0[1]); w.y = cvtpk(x0[2], x0[3]); w.z = cvtpk(x1[0], x1[1]); w.w = cvtpk(x1[2], x1[3]);
                    *(GAS u32x4*)(X + off) = w; }
#pragma unroll
                for (int q = 0; q < 4; ++q) cx[q] = nx[q]; }
        } else {
            u32x4 cx[2], nx[2];
#pragma unroll
            for (int bj = 0; bj < 2; ++bj) cx[bj] = *(const GAS u32x4*)(X + (size_t)row0 * D + col0 + bj * 128);
#pragma unroll
            for (int j = 0; j < 8; ++j) { const int ai = j >> 2, m = j & 3;
                if (j < 7) { const int ai2 = (j + 1) >> 2, m2 = (j + 1) & 3;
#pragma unroll
                    for (int bj = 0; bj < 2; ++bj) nx[bj] = *(const GAS u32x4*)(X + (size_t)(row0 + ai2 * 128 + m2 * 16) * D + col0 + bj * 128); }
                asm volatile("" ::: "memory");
#pragma unroll
                for (int bj = 0; bj < 2; ++bj) { const size_t off = (size_t)(row0 + ai * 128 + m * 16) * D + col0 + bj * 128;
                    float xv[8]; unpack8(cx[bj], xv); f32x4 x0 = (f32x4){xv[0], xv[1], xv[2], xv[3]}, x1 = (f32x4){xv[4], xv[5], xv[6], xv[7]};
                    x0 += g0[bj] * acc[ai][bj][m][0]; x1 += g1[bj] * acc[ai][bj][m][1];
                    u32x4 w; w.x = cvtpk(x0[0], x0[1]); w.y = cvtpk(x0[2], x0[3]); w.z = cvtpk(x1[0], x1[1]); w.w = cvtpk(x1[2], x1[3]);
                    *(GAS u32x4*)(X + off) = w; }
#pragma unroll
                for (int q = 0; q < 2; ++q) cx[q] = nx[q]; }
        }
    }
};
struct SchedG2 {
    static constexpr bool GATHER = false; static constexpr bool HALFM = false; static constexpr bool ACCUM = false;
    __device__ __forceinline__ void a_ready(const GUnit&) const {}
    __device__ __forceinline__ void done(const GUnit&) const {}
    const char* Y1; const char* WUQ; const char* WUKV; int G, c;
    __device__ __forceinline__ bool next(int i, GUnit& u) const {
        const int un = (c >> 3) + 32 * i; if (un >= 56) return false;
        const int pm = (c & 7) * 8 + un / 7, ct = un % 7; const bool kv = ct >= 3; const int pn = kv ? ct - 3 : ct;
        u.A = Y1 + (size_t)pm * 256 * 6144 + (kv ? 2816 * 2 : 2560 * 2); u.B = (kv ? WUKV : WUQ) + (size_t)pn * 256 * 512; u.nt = 4; u.i0 = pm; u.i1 = pn; u.i2 = kv ? 1 : 0; return true;
    }
    __device__ __forceinline__ void offs(const GUnit&, int R0, int R1, int C0, int C1, unsigned (&oA)[2][2]) const {
        oA[0][0] = (unsigned)R0 * 6144u + C0 * 2u; oA[0][1] = (unsigned)R1 * 6144u + C1 * 2u; oA[1][0] = (unsigned)(R0 + 128) * 6144u + C0 * 2u; oA[1][1] = (unsigned)(R1 + 128) * 6144u + C1 * 2u; }
    __device__ __forceinline__ unsigned ldb_bytes() const { return 512u; }
};
}
namespace fk {
constexpr int HT_PITCH = 2064;
constexpr int RT_SMALL = 64 * HT_PITCH;
__device__ __forceinline__ void row_router(Frame& F, const Params& p, int l, const float* mod) {
    unsigned char* ws = F.ws; LAS unsigned char* HT = F.lds;
    const bf16* X = (const bf16*)(ws + WS_X); bf16* H = (bf16*)(ws + WS_H);
    const float* g = p.norm_g + (size_t)l * 2 * D + D; const float* shift = mod + 3 * D; const float* scale = mod + 4 * D;
    const float* bg = p.router_g_b + l * 4; const float* be = p.router_e_b + l * 32;
    unsigned* CNT = (unsigned*)(ws + WS_CTL) + CW_CNT + l * 32;
    int* LIST = (int*)(ws + WS_LIST); float* ROWW = (float*)(ws + WS_ROWW); int* TOKSLOT = (int*)(ws + WS_TOKSLOT);
    LAS int* rid = (LAS int*)(F.lds + RT_SMALL); LAS int* rrank = rid + 128; LAS float* rw = (LAS float*)(rrank + 128);
    LAS unsigned* cntl = (LAS unsigned*)(rw + 128); LAS unsigned* cbase = cntl + 32;
    if (F.tid < 32) cntl[F.tid] = 0u;
    const int n16 = F.lane & 15, kq = F.lane >> 4;
    bf16x8 afr[4][3];
    { const bf16* wb = (const bf16*)(ws + WS_WRT) + (size_t)l * 48 * 1024 + (size_t)n16 * 1024 + 128 * F.wave + 8 * kq;
#pragma unroll
        for (int ks = 0; ks < 4; ++ks)
#pragma unroll
            for (int bl = 0; bl < 3; ++bl) afr[ks][bl] = *(const GAS bf16x8*)(wb + (size_t)bl * 16 * 1024 + ks * 32); }
    SUB_T0(11);
    constexpr int R = 4;
    const int mb = (F.bid & 7) * 2048 + (F.bid >> 3) * 64;
    f32x4 ga[4], shv[4];
    { const int bb = F.bid & 7;
#pragma unroll
        for (int j = 0; j < 4; ++j) { const int d = 4 * F.lane + 256 * j;
            const f32x4 gg = *(const GAS f32x4*)(g + d), sc = *(const GAS f32x4*)(scale + (size_t)bb * 6 * D + d); shv[j] = *(const GAS f32x4*)(shift + (size_t)bb * 6 * D + d);
            ga[j] = (f32x4){gg.x * (1.f + sc.x), gg.y * (1.f + sc.y), gg.z * (1.f + sc.z), gg.w * (1.f + sc.w)}; } }
    for (int kk = 0; kk < 8; kk += R) { const int m0 = mb + kk * 8 + F.wave;
        f32x4 v[R][4];
#pragma unroll
        for (int r = 0; r < R; ++r)
#pragma unroll
            for (int j = 0; j < 4; ++j) { const u32x2 xb = *(const GAS u32x2*)(X + (size_t)(m0 + 8 * r) * D + 4 * F.lane + 256 * j); v[r][j] = (f32x4){bf_lo(xb.x), bf_hi(xb.x), bf_lo(xb.y), bf_hi(xb.y)}; }
#pragma unroll
        for (int r = 0; r < R; ++r) { const int m = m0 + 8 * r, b = m / S; float s = 0.f;
#pragma unroll
            for (int j = 0; j < 4; ++j) s += (v[r][j].x * v[r][j].x + v[r][j].y * v[r][j].y) + (v[r][j].z * v[r][j].z + v[r][j].w * v[r][j].w);
            const float rstd = rsqrtf(wave_sum(s) * (1.f / D) + 1e-6f);
            LAS unsigned char* hrow = HT + ((kk + r) * 8 + F.wave) * HT_PITCH;
#pragma unroll
            for (int j = 0; j < 4; ++j) { const int d = 4 * F.lane + 256 * j;
                const float o0 = v[r][j].x * rstd * ga[j].x + shv[j].x, o1 = v[r][j].y * rstd * ga[j].y + shv[j].y, o2 = v[r][j].z * rstd * ga[j].z + shv[j].z, o3 = v[r][j].w * rstd * ga[j].w + shv[j].w;
                u32x2 o; o.x = cvtpk(o0, o1); o.y = cvtpk(o2, o3); st8x(H + (size_t)m * D + d, o); *(LAS u32x2*)(hrow + d * 2) = o; }
        }
    }
    __syncthreads();
    SUB_T1(F, 11); SUB_T0(12);
    f32x4 acc[4][3];
#pragma unroll
    for (int tt = 0; tt < 4; ++tt)
#pragma unroll
        for (int bl = 0; bl < 3; ++bl) acc[tt][bl] = (f32x4){0.f, 0.f, 0.f, 0.f};
#pragma unroll
    for (int tt = 0; tt < 4; ++tt) { const LAS unsigned char* hb = HT + (16 * tt + n16) * HT_PITCH + (128 * F.wave + 8 * kq) * 2;
#pragma unroll
        for (int ks = 0; ks < 4; ++ks) { const bf16x8 bfr = *(const LAS bf16x8*)(hb + ks * 64);
#pragma unroll
            for (int bl = 0; bl < 3; ++bl) acc[tt][bl] = __builtin_amdgcn_mfma_f32_16x16x32_bf16(afr[ks][bl], bfr, acc[tt][bl], 0, 0, 0); } }
    __syncthreads();
    LAS float* LGP = (LAS float*)(F.lds);
    LAS float* LG = (LAS float*)(F.lds + 98304);
#pragma unroll
    for (int tt = 0; tt < 4; ++tt)
#pragma unroll
        for (int bl = 0; bl < 3; ++bl)
#pragma unroll
            for (int q = 0; q < 4; ++q) LGP[(((F.wave * 4 + tt) * 3 + bl) * 4 + q) * 64 + F.lane] = acc[tt][bl][q];
    __syncthreads();
#pragma unroll
    for (int i = 0; i < 6; ++i) { const int idx = F.tid + 512 * i, ln = idx & 63, q = (idx >> 6) & 3, r = idx >> 8; const int tt = r / 3, bl = r - 3 * tt; float v = 0.f;
#pragma unroll
        for (int w = 0; w < 8; ++w) v += LGP[((w * 12 + r) * 4 + q) * 64 + ln];
        LG[(16 * tt + (ln & 15)) * 48 + bl * 16 + 4 * (ln >> 4) + q] = v; }
    __syncthreads();
    SUB_T1(F, 12); SUB_T0(13);
    if (F.tid < 64) {
        const int slot = F.tid; const LAS float* lg = LG + slot * 48;
        const float g0 = lg[32] + bg[0], g1 = lg[33] + bg[1], g2 = lg[34] + bg[2], g3 = lg[35] + bg[3];
        int gi = 0; float mx = g0; if (g1 > mx) { mx = g1; gi = 1; } if (g2 > mx) { mx = g2; gi = 2; } if (g3 > mx) { mx = g3; gi = 3; }
        const float gw = 1.f / (__expf(g0 - mx) + __expf(g1 - mx) + __expf(g2 - mx) + __expf(g3 - mx));
        float e[8];
#pragma unroll
        for (int i = 0; i < 8; ++i) e[i] = lg[gi * 8 + i] + be[gi * 8 + i];
        float emx = e[0]; int e0 = 0;
#pragma unroll
        for (int i = 1; i < 8; ++i) if (e[i] > emx) { emx = e[i]; e0 = i; }
        float e2 = -1e30f; int e1 = 0;
#pragma unroll
        for (int i = 0; i < 8; ++i) if (i != e0 && e[i] > e2) { e2 = e[i]; e1 = i; }
        const float p1 = __expf(e2 - emx), w0 = 1.f / (1.f + p1), w1 = p1 / (1.f + p1);
        const int id0 = gi * 8 + e0, id1 = gi * 8 + e1;
        rid[2 * slot] = id0; rid[2 * slot + 1] = id1; rw[2 * slot] = gw * w0; rw[2 * slot + 1] = gw * w1;
        rrank[2 * slot] = (int)__hip_atomic_fetch_add(&cntl[id0], 1u, __ATOMIC_RELAXED, __HIP_MEMORY_SCOPE_WORKGROUP);
        rrank[2 * slot + 1] = (int)__hip_atomic_fetch_add(&cntl[id1], 1u, __ATOMIC_RELAXED, __HIP_MEMORY_SCOPE_WORKGROUP);
    }
    __syncthreads();
    if (F.tid < 32) { const unsigned c = cntl[F.tid]; cbase[F.tid] = c ? atomicAdd(&CNT[F.tid], c) : 0u; }
    __syncthreads();
    if (F.tid < 128) { const int slot = F.tid >> 1, id = rid[F.tid], pos = (int)cbase[id] + rrank[F.tid]; const int m = mb + slot;
        LIST[id * 16384 + pos] = m; ROWW[id * 16384 + pos] = rw[F.tid]; TOKSLOT[id * 16384 + pos] = 2 * m + (F.tid & 1); }
    SUB_T1(F, 13);
}
__device__ __forceinline__ void moe_table(Frame& F, int l, bool gmode) {
    LAS int* T = (LAS int*)(F.lds + TAB_OFF + 6144);
    int t = threadIdx.x; asm volatile("" : "+v"(t));
    if (t < 32) { const unsigned* CNT = (const unsigned*)(F.ws + WS_CTL) + CW_CNT + l * 32;
        T[t] = (int)__hip_atomic_load(CNT + t, __ATOMIC_RELAXED, __HIP_MEMORY_SCOPE_AGENT); }
    __syncthreads();
    if (t < 33) { int a = 0; for (int e = 0; e < t; ++e) a += (T[e] + 255) >> 8; T[32 + t] = a; }
    if (t < 32) { int x = 0;
        if (gmode) { const int c = T[t]; int pos = 0; for (int k = 0; k < 32; ++k) { const int ck = T[k]; pos += (ck > c || (ck == c && k < t)) ? 1 : 0; }
            const int xcd = ((pos >> 3) & 1) ? 7 - (pos & 7) : (pos & 7); x = (xcd == (F.bid & 7)) ? 1 : 0; }
        else x = 1;
        T[400 + t] = x; }
    __syncthreads();
    if (t < 64) {
        const int e = t & 31, pass = t >> 5; const int c = T[e], nt_ = (c + 255) >> 8; int nhalf_before = 0, nfull_before = 0, nfull_total = 0, nhalf_total = 0;
        for (int k = 0; k < 32; ++k) { const int ck = T[k], ntk = (ck + 255) >> 8; const int lastrows = ck - 256 * (ntk - 1); const int hk = (ntk > 0 && lastrows <= 128) ? 1 : 0;
            if (T[400 + k]) { nfull_total += ntk - hk; nhalf_total += hk; if (k < e) { nfull_before += ntk - hk; nhalf_before += hk; } } }
        const int lastrows = c - 256 * (nt_ - 1); const int he = (nt_ > 0 && lastrows <= 128) ? 1 : 0;
        if (T[400 + e]) {
            if (pass == 0) { for (int m = 0; m < nt_ - he; ++m) T[72 + nfull_before + m] = (e << 16) | (m << 1); }
            else if (he) T[72 + nfull_total + nhalf_before] = (e << 16) | ((nt_ - 1) << 1) | 1; }
        if (t == 0) T[65] = nfull_total + nhalf_total;
    }
    __syncthreads();
}
struct SchedG5 {
    static constexpr bool GATHER = true; static constexpr bool HALFM = true; static constexpr bool ACCUM = false;
    const char* H; const char* WGU; const int* LIST; LAS const int* T; int G, c; unsigned* RDY;
    __device__ __forceinline__ void a_ready(const GUnit&) const {}
    __device__ __forceinline__ void done(const GUnit& u) const { asm volatile("s_waitcnt vmcnt(0)" ::: "memory"); if ((threadIdx.x & 63) == 0) __hip_atomic_fetch_add(RDY + u.i3, 1u, __ATOMIC_RELAXED, __HIP_MEMORY_SCOPE_AGENT); }
    __device__ __forceinline__ bool next(int i, GUnit& u) const {
        const int L = i * G + c; const int tot = __builtin_amdgcn_readfirstlane(T[65]); if (L >= 2 * tot) return false;
        const int ent = __builtin_amdgcn_readfirstlane(T[72 + (L >> 1)]), ntile = L & 1; const int e = ent >> 16, mt = (ent >> 1) & 0x7fff;
        const int tpe = __builtin_amdgcn_readfirstlane(T[32 + e]);
        u.A = H; u.B = WGU + ((size_t)e * 512 + ntile * 256) * 2048; u.nt = 16; u.i0 = e; u.i1 = mt; u.i2 = ntile; u.i3 = tpe + mt; u.hm = ent & 1; return true;
    }
    __device__ __forceinline__ void offs(const GUnit& u, int R0, int R1, int C0, int C1, unsigned (&oA)[2][2]) const {
        const int cnt = __builtin_amdgcn_readfirstlane(T[u.i0]); const int* li = LIST + u.i0 * 16384; const int base = u.i1 * 256;
        const int a0 = base + R0, a1 = base + R1, a2 = base + R0 + 128, a3 = base + R1 + 128;
        const int t0 = a0 < cnt ? li[a0] : 0, t1 = a1 < cnt ? li[a1] : 0, t2 = a2 < cnt ? li[a2] : 0, t3 = a3 < cnt ? li[a3] : 0;
        oA[0][0] = (unsigned)t0 * 2048u + C0 * 2u; oA[0][1] = (unsigned)t1 * 2048u + C1 * 2u; oA[1][0] = (unsigned)t2 * 2048u + C0 * 2u; oA[1][1] = (unsigned)t3 * 2048u + C1 * 2u; }
    __device__ __forceinline__ unsigned ldb_bytes() const { return 2048u; }
};
struct EpiG5 {
    bf16* ACT; const float* ROWW; LAS const int* T;
    __device__ __forceinline__ void operator()(const f32x4 (&acc)[2][2][4][2], const GUnit& u, int wr, int wc, int fr, int fq) const {
        const int e = u.i0, cnt = __builtin_amdgcn_readfirstlane(T[e]), rbase = u.i1 * 256, arow0 = (__builtin_amdgcn_readfirstlane(T[32 + e]) + u.i1) * 256; const int f0 = u.i2 * 128 + wc * 32 + 8 * fq;
#pragma unroll
        for (int ai = 0; ai < 2; ++ai)
#pragma unroll
            for (int m = 0; m < 4; ++m) { const int rt = ai * 128 + wr * 64 + m * 16 + fr;
                if (rbase + rt < cnt) { const float w = ROWW[e * 16384 + rbase + rt]; float o[8];
#pragma unroll
                    for (int t = 0; t < 8; ++t) { const float gt = t < 4 ? acc[ai][0][m][0][t & 3] : acc[ai][0][m][1][t & 3], up = t < 4 ? acc[ai][1][m][0][t & 3] : acc[ai][1][m][1][t & 3];
                        o[t] = gt * fast_sigmoid(gt) * up * w; }
                    st16_wt(ACT + (size_t)(arow0 + rt) * 256 + f0, pack8(o)); } }
    }
};
struct SchedG6 {
    static constexpr bool GATHER = false; static constexpr bool HALFM = true; static constexpr bool ACCUM = false;
    const char* ACT; const char* WDN; LAS const int* T; int G, c; const unsigned* RDY; unsigned* tmo;
    __device__ __forceinline__ bool next(int i, GUnit& u) const {
        const int tot = __builtin_amdgcn_readfirstlane(T[65]); const int u5 = 2 * tot; const int nx = (u5 > G && u5 < 2 * G) ? u5 - G : 0;
        if (c < nx) return false;
        const int L = i * (G - nx) + (c - nx); if (L >= 4 * tot) return false;
        const int ent = __builtin_amdgcn_readfirstlane(T[72 + (L >> 2)]), ntile = L & 3; const int e = ent >> 16, mt = (ent >> 1) & 0x7fff;
        const int mtg = __builtin_amdgcn_readfirstlane(T[32 + e]) + mt;
        u.A = ACT + (size_t)mtg * 256 * 512; u.B = WDN + ((size_t)e * 1024 + ntile * 256) * 512; u.nt = 4; u.i0 = e; u.i1 = mt; u.i2 = ntile; u.i3 = mtg; u.hm = ent & 1; return true;
    }
    __device__ __forceinline__ void offs(const GUnit&, int R0, int R1, int C0, int C1, unsigned (&oA)[2][2]) const {
        oA[0][0] = (unsigned)R0 * 512u + C0 * 2u; oA[0][1] = (unsigned)R1 * 512u + C1 * 2u; oA[1][0] = (unsigned)(R0 + 128) * 512u + C0 * 2u; oA[1][1] = (unsigned)(R1 + 128) * 512u + C1 * 2u; }
    __device__ __forceinline__ unsigned ldb_bytes() const { return 512u; }
    __device__ __forceinline__ void a_ready(const GUnit& u) const {
        if (__builtin_amdgcn_readfirstlane(threadIdx.x >> 6) == 0) {
            unsigned polls = 0;
            while ((unsigned)__builtin_amdgcn_readfirstlane(__hip_atomic_load(RDY + u.i3, __ATOMIC_RELAXED, __HIP_MEMORY_SCOPE_AGENT)) < 16u) {
                if ((++polls & 255u) == 0u && __builtin_amdgcn_readfirstlane(__hip_atomic_load(tmo, __ATOMIC_RELAXED, __HIP_MEMORY_SCOPE_AGENT)) != 0u) break;
                if (polls > (1u << 17)) { __hip_atomic_store(tmo, 1u, __ATOMIC_RELAXED, __HIP_MEMORY_SCOPE_AGENT); break; }
                __builtin_amdgcn_s_sleep(8); }
            __builtin_amdgcn_fence(__ATOMIC_ACQUIRE, "agent");
            asm volatile("s_waitcnt vmcnt(0)" ::: "memory");
        }
        asm volatile("" ::: "memory"); __builtin_amdgcn_s_barrier(); asm volatile("" ::: "memory");
    }
    __device__ __forceinline__ void done(const GUnit&) const {}
};
struct EpiG6 {
    bf16* Z; const int* TOKSLOT; LAS const int* T;
    __device__ __forceinline__ void operator()(const f32x4 (&acc)[2][2][4][2], const GUnit& u, int wr, int wc, int fr, int fq) const {
        const int e = u.i0, cnt = __builtin_amdgcn_readfirstlane(T[e]), rbase = u.i1 * 256; const int c0 = u.i2 * 256 + wc * 32 + 8 * fq;
#pragma unroll
        for (int ai = 0; ai < 2; ++ai)
#pragma unroll
            for (int m = 0; m < 4; ++m) { const int rt = ai * 128 + wr * 64 + m * 16 + fr;
                if (rbase + rt < cnt) { const int ts = TOKSLOT[e * 16384 + rbase + rt]; bf16* zp = Z + zrow(ts) + c0;
#pragma unroll
                    for (int bj = 0; bj < 2; ++bj) { const f32x4 v0 = acc[ai][bj][m][0], v1 = acc[ai][bj][m][1];
                        u32x4 w; w.x = cvtpk(v0[0], v0[1]); w.y = cvtpk(v0[2], v0[3]); w.z = cvtpk(v1[0], v1[1]); w.w = cvtpk(v1[2], v1[3]);
                        st16x(zp + bj * 128, w); } } }
    }
};
}
#ifndef PH4MASK
#define PH4MASK 7
#endif
#ifndef PHMASK
#define PHMASK 0xFFFF
#endif
namespace fk {
__device__ __forceinline__ void relaunder(Frame& F) { int t = threadIdx.x; asm volatile("" : "+v"(t)); F.tid = t; F.lane = t & 63; }
__global__ void __launch_bounds__(NTHR, 2) fwd(Params p) {
    extern __shared__ __attribute__((aligned(16))) unsigned char lds_[];
#ifdef PADN
    if (p.pad_ == 0x7fffffff) { asm volatile(".rept %0\n\ts_nop 0\n\t.endr" :: "n"(PADN)); }
#endif
    Frame F; F.lds = (LAS unsigned char*)lds_; F.ws = p.ws; F.tid = threadIdx.x; F.lane = F.tid & 63; F.wave = __builtin_amdgcn_readfirstlane(F.tid >> 6);
#ifdef SUBT
    F.tsub = 0;
#endif
    F.G = gridDim.x; F.bid = blockIdx.x; F.gw = F.bid * NWAVES + F.wave; F.NGW = F.G * NWAVES;
    volatile LAS unsigned* MISC = (volatile LAS unsigned*)(F.lds + MISC_OFF);
    if (F.tid < 64) MISC[F.tid] = 0u;
    __syncthreads();
    unsigned* ctl = (unsigned*)(p.ws + WS_CTL);
    XcdBarrier bar = xcd_barrier_post(ctl + CW_BAR, MISC + 8);
    bool first = true; bool gmode = false; bool mode_known = false;
    const int lo = p.ph_lo, hi = p.ph_hi;
#ifdef TIMEPH
    unsigned long long tacc = 0, tprev = 0; int prevph = -1;
#define TSTAMP(k) do { const unsigned long long now_ = __builtin_amdgcn_s_memrealtime(); if (prevph == (TIMEPH) || ((TIMEPH) == -2 && prevph >= 100)) tacc += now_ - tprev; tprev = now_; prevph = (k); if (threadIdx.x == 0) MISC[21] = (unsigned)(k); } while (0)
#else
#define TSTAMP(k) do {} while (0)
#endif
#ifdef TIMEPH
#define TBAR() do { const unsigned long long now_ = __builtin_amdgcn_s_memrealtime(); if (prevph == (TIMEPH)) tacc += now_ - tprev; tprev = now_; prevph += 100; } while (0)
#else
#define TBAR() do {} while (0)
#endif
#define PHASE(k) PHASE_(k, true)
#define PHASEG(k) PHASE_(k, false)
#define PHASE_(k, glob) if (lo <= (k) && (k) < hi) if ((first ? (void)0 : (({ TBAR(); }), ((glob) || !gmode) ? xcd_barrier(bar) : xcc_barrier(bar, ctl + CW_GBAR, 32u))), first = false, relaunder(F), true) if (({ TSTAMP(k); true; }))
    unsigned char* ws = p.ws;
    if (p.l_lo == 0) PHASE(0) if constexpr (((PHMASK) >> 0) & 1) { p0_prologue(F, p); }
    for (int l = p.l_lo; l < p.l_hi; ++l) {
        const float* mod = (const float*)(ws + WS_MOD) + (size_t)l * NB * 6 * D;
        PHASE(1) if constexpr (((PHMASK) >> 1) & 1) {
            if (!mode_known) {
                mode_known = true;
                if (F.tid == 0) { bool ok = (lo == 0) && (F.G == 256); for (int j = 0; j < 16; ++j) ok = ok && (xb_ld(ctl + CW_BAR + XB_XCNT(j)) == (j < 8 ? 32u : 0u));
#ifdef FORCE_NOGROUP
                    ok = false;
#endif
                    MISC[11] = ok ? 1u : 0u; }
                __syncthreads();
                gmode = MISC[11] != 0u;
                if (gmode) F.bid = (int)MISC[10] * 8 + (int)bar.x;
                F.gw = F.bid * NWAVES + F.wave;
            }
            if (l == 0) row_normmod<0>(F, p.x, (bf16*)(ws + WS_X), nullptr, nullptr, p.norm_g + (size_t)l * 2 * D, mod, mod + D, (bf16*)(ws + WS_H), nullptr);
            else row_normmod<2>(F, nullptr, (bf16*)(ws + WS_X), (const bf16*)(ws + WS_Z), mod - (size_t)NB * 6 * D + 5 * D, p.norm_g + (size_t)l * 2 * D, mod, mod + D, (bf16*)(ws + WS_H), nullptr);
        }
        PHASEG(2) if constexpr (((PHMASK) >> 2) & 1) {
            SchedDense S{(const char*)(ws + WS_H), (const char*)(ws + WS_WIN + (size_t)l * 6144 * 2048), 2048u, 2048u, 64, 24, 16, F.G, F.bid};
            EpiG1 E{(bf16*)(ws + WS_Y1), (bf16*)(ws + WS_XG), (bf16*)(ws + WS_KR), (float*)(ws + WS_STAT), (float*)(ws + WS_STAT2), p.diff_qk_g + l * 128, p.mla_qk_g + l * 192 + 96, (const float*)(ws + WS_CS), (const float*)(ws + WS_SN)};
            gemm_phase(F.lds, S, E);
        }
        PHASEG(4) if constexpr (((PHMASK) >> 4) & 1) {
            if constexpr ((PH4MASK) & 1) {
                SchedG2 S{(const char*)(ws + WS_Y1), (const char*)(ws + WS_WUQ + (size_t)l * 768 * 512), (const char*)(ws + WS_WUKV + (size_t)l * 1024 * 512), F.G, F.bid};
                EpiG2Both E{{(bf16*)(ws + WS_QC), (const float*)(ws + WS_STAT), p.mla_qk_g + l * 192, (const float*)(ws + WS_CS), (const float*)(ws + WS_SN)},
                            {(bf16*)(ws + WS_KVC), (const float*)(ws + WS_STAT), p.mla_qk_g + l * 192 + 96, (const float*)(ws + WS_CS), (const float*)(ws + WS_SN)}};
                gemm_phase(F.lds, S, E); }
            TSTAMP(41);
            if constexpr ((PH4MASK) & 2) attn_phase<true>(F, p, l);
            TSTAMP(42);
            if constexpr ((PH4MASK) & 4) sgu_pair(F, p, l, (F.bid & 7) * 64 + (F.bid >> 3));
        }
        PHASEG(6) if constexpr (((PHMASK) >> 6) & 1) { attn_phase<false>(F, p, l); }
        PHASEG(7) if constexpr (((PHMASK) >> 7) & 1) {
            SchedG3 S{(const char*)(ws + WS_OA), (const char*)(ws + WS_WBR + (size_t)l * 3 * MiB), F.G, F.bid};
            EpiG3 E{(const bf16*)(ws + WS_XG), (bf16*)(ws + WS_MERGED)
#ifdef SUBT
                , &F
#endif
            };
            gemm_phase(F.lds, S, E);
        }
        PHASEG(8) if constexpr (((PHMASK) >> 8) & 1) {
            SchedDense S{(const char*)(ws + WS_MERGED), (const char*)(ws + WS_WOUT + (size_t)l * 2 * MiB), 2048u, 2048u, 64, 4, 16, F.G, F.bid};
            if (l == 0) { EpiG4<true> E{(bf16*)(ws + WS_X), mod + 2 * D, p.x}; gemm_phase(F.lds, S, E); }
            else { EpiG4<false> E{(bf16*)(ws + WS_X), mod + 2 * D, nullptr}; gemm_phase(F.lds, S, E); }
        }
        PHASEG(9) if constexpr (((PHMASK) >> 9) & 1) { row_router(F, p, l, mod); }
        PHASE(10) if constexpr (((PHMASK) >> 10) & 1) {
            moe_table(F, l, gmode);
            const int mG = gmode ? 32 : F.G, mc = gmode ? (F.bid >> 3) : F.bid;
            unsigned* RDY = (unsigned*)(ws + WS_CTL) + CW_RDY + l * 256;
            { SchedG5 S{(const char*)(ws + WS_H), (const char*)(ws + WS_WGU + (size_t)l * 32 * MiB), (const int*)(ws + WS_LIST), (LAS const int*)(F.lds + TAB_OFF + 6144), mG, mc, RDY};
              EpiG5 E{(bf16*)(ws + WS_ACT), (const float*)(ws + WS_ROWW), (LAS const int*)(F.lds + TAB_OFF + 6144)};
              gemm_phase(F.lds, S, E); }
            TSTAMP(43);
            { SchedG6 S{(const char*)(ws + WS_ACT), (const char*)(ws + WS_WDN + (size_t)l * 16 * MiB), (LAS const int*)(F.lds + TAB_OFF + 6144), mG, mc, RDY, (unsigned*)(ws + WS_CTL) + CW_TMO2};
              EpiG6 E{(bf16*)(ws + WS_Z), (const int*)(ws + WS_TOKSLOT), (LAS const int*)(F.lds + TAB_OFF + 6144)};
              gemm_phase(F.lds, S, E); }
        }
    }
    if (p.l_hi == p.nlayers) PHASE(12) if constexpr (((PHMASK) >> 12) & 1) {
        const float* modl = (const float*)(ws + WS_MOD) + (size_t)(p.nlayers - 1) * NB * 6 * D;
        row_normmod<3>(F, nullptr, (bf16*)(ws + WS_X), (const bf16*)(ws + WS_Z), modl + 5 * D, nullptr, nullptr, nullptr, nullptr, p.out);
    }
#undef PHASE
#ifdef CENSUS_TEST
    if (blockIdx.x == 0 && threadIdx.x == 0) { bool ok = true; for (int j = 0; j < 8; ++j) ok = ok && (xb_ld(ctl + CW_BAR + XB_XCNT(j)) == 32u);
        if (!ok) { const unsigned long long t0 = __builtin_amdgcn_s_memrealtime(); while (__builtin_amdgcn_s_memrealtime() - t0 < 100000ull) __builtin_amdgcn_s_sleep(32); } }
#endif
#ifdef TIMEPH
    TSTAMP(99);
#ifndef TBLK
#define TBLK 0
#endif
    if (blockIdx.x == (TBLK) && threadIdx.x == 0) { const unsigned long long t0 = __builtin_amdgcn_s_memrealtime(), wait = (tacc
#ifdef SUBT
        + F.tsub
#endif
#ifdef SUBPH
        + MISC[20]
#endif
        ) * (TMULT);
        while (__builtin_amdgcn_s_memrealtime() - t0 < wait) __builtin_amdgcn_s_sleep(32); }
#endif
}
}
static void fill_params(fk::Params& p, void* const* d_in, void* d_out, void* d_ws) {
    p.x = (const float*)d_in[0]; p.c = (const float*)d_in[1]; p.positions = (const int*)d_in[2];
    p.w_ada = (const float*)d_in[3]; p.b_ada = (const float*)d_in[4]; p.norm_g = (const float*)d_in[5]; p.w_in = (const float*)d_in[6];
    p.diff_qk_g = (const float*)d_in[7]; p.diff_lambda = (const float*)d_in[8]; p.diff_out_g = (const float*)d_in[9]; p.rel_bias = (const float*)d_in[10];
    p.sgu_v_g = (const float*)d_in[11]; p.sgu_w = (const float*)d_in[12]; p.sgu_b = (const float*)d_in[13];
    p.mla_lat_g = (const float*)d_in[14]; p.mla_w_uq = (const float*)d_in[15]; p.mla_w_ukv = (const float*)d_in[16]; p.mla_qk_g = (const float*)d_in[17];
    p.w_branch = (const float*)d_in[18]; p.w_out = (const float*)d_in[19]; p.router_g_w = (const float*)d_in[20]; p.router_g_b = (const float*)d_in[21];
    p.router_e_w = (const float*)d_in[22]; p.router_e_b = (const float*)d_in[23]; p.w_e_gate = (const float*)d_in[24]; p.w_e_up = (const float*)d_in[25]; p.w_e_down = (const float*)d_in[26];
    p.out = (float*)d_out; p.ws = (unsigned char*)d_ws;
}
static void launch_fast(hipStream_t st, fk::Params p, int l_lo, int l_hi, int ph_lo, int ph_hi) {
    static bool attr = false;
    if (!attr) { (void)hipFuncSetAttribute((const void*)fk::fwd, hipFuncAttributeMaxDynamicSharedMemorySize, fk::LDS_BYTES); attr = true; }
#if NLAUNCH != 1
    (void)hipMemsetAsync((char*)p.ws + fk::WS_CTL + fk::CW_BAR * 4, 0, XCD_BAR_WORDS * 4, st);
#endif
    p.l_lo = l_lo; p.l_hi = l_hi; p.ph_lo = ph_lo; p.ph_hi = ph_hi;
    hipLaunchKernelGGL(fk::fwd, dim3(256), dim3(fk::NTHR), fk::LDS_BYTES, st, p);
}
extern "C" void kernel_launch(void* const* d_in, const int* in_sizes, int n_in, void* d_out, int out_size, void* d_ws, size_t ws_size, hipStream_t stream) {
    if (fk::WS_END > ws_size) { fprintf(stderr, "ws too small: need %zu have %zu\n", (size_t)fk::WS_END, ws_size); return; }
    (void)hipMemsetAsync((char*)d_ws + fk::WS_CTL, 0, fk::CTL_ZERO_BYTES, stream);
    fk::Params p{}; fill_params(p, d_in, d_out, d_ws); p.nlayers = 4; p.pad_ = 0;
#if NLAUNCH == 1
    launch_fast(stream, p, 0, 4, 0, 13);
#else
    launch_fast(stream, p, 0, 1, 0, 1);
    for (int l = 0; l < 4; ++l) for (int ph = 1; ph <= 11; ++ph) launch_fast(stream, p, l, l + 1, ph, ph + 1);
    launch_fast(stream, p, 3, 4, 12, 13);
#endif
}
```
